# Optimizing an MI355X kernel written in HIP

```python
import math
import jax, jax.numpy as jnp
from jax import lax
import numpy as np

D_MODEL = 2048
BATCH = 1
SEQ = 16384
DEPTH = 1

CHUNK = 64
MIX_WIDTH = D_MODEL
RET_WIDTH = MIX_WIDTH // 2
LRU_WIDTH = MIX_WIDTH - RET_WIDTH
RET_HEADS = 8
RET_HEAD_DIM = RET_WIDTH // RET_HEADS
LRU_BLOCKS = 8
LRU_BLOCK_DIM = LRU_WIDTH // LRU_BLOCKS
CONV_WIDTH = 4
LRU_C = 8.0
ROPE_BASE = 10000.0
PEER_HEADS = 8
PEER_QUERY_DIM = 256
PEER_HALF = PEER_QUERY_DIM // 2
N_KEYS = 128
N_EXPERTS = N_KEYS * N_KEYS
PEER_TOPK = 16
PEER_TOKEN_BLOCK = 128
IN_COLS = 4 * RET_WIDTH + 2 * LRU_WIDTH
DN_ALPHA = (2.0 * DEPTH) ** 0.25
DN_BETA = (8.0 * DEPTH) ** -0.25
LN_EPS = 1e-5
GN_EPS = 1e-6

kernel_name = "hybrid_retention_rglru_peer_deepnorm"


def layer_norm(x, g, b):
    x32 = x.astype(jnp.float32)
    mu = jnp.mean(x32, axis=-1, keepdims=True)
    var = jnp.mean(jnp.square(x32 - mu), axis=-1, keepdims=True)
    return (x32 - mu) * lax.rsqrt(var + LN_EPS) * g + b


def rotary(x, positions):
    half = x.shape[-1] // 2
    inv_freq = ROPE_BASE ** (-jnp.arange(half, dtype=jnp.float32) / half)
    ang = positions.astype(jnp.float32)[..., None] * inv_freq
    cos = jnp.cos(ang)[:, :, None, :]
    sin = jnp.sin(ang)[:, :, None, :]
    x1, x2 = x[..., :half], x[..., half:]
    return jnp.concatenate([x1 * cos - x2 * sin, x2 * cos + x1 * sin], axis=-1)


def retention(q, k, v, g, positions):
    B, S = q.shape[:2]
    NC = S // CHUNK
    H, dh = RET_HEADS, RET_HEAD_DIM
    q = rotary(q.reshape(B, S, H, dh).astype(jnp.float32), positions) * (dh ** -0.5)
    k = rotary(k.reshape(B, S, H, dh).astype(jnp.float32), positions)
    v = v.reshape(B, S, H, dh).astype(jnp.float32)
    gamma = 1.0 - 2.0 ** (-5.0 - jnp.arange(H, dtype=jnp.float32))
    log_g = jnp.log(gamma)
    l = jnp.arange(CHUNK, dtype=jnp.float32)
    d_intra = jnp.exp(log_g[:, None, None] * jnp.abs(l[:, None] - l[None, :]))
    q_dec = jnp.exp(log_g[None, :] * (l[:, None] + 1.0))
    k_dec = jnp.exp(log_g[None, :] * (CHUNK - 1.0 - l[:, None]))
    chunk_dec = jnp.exp(log_g * CHUNK)
    qc = q.reshape(B, NC, CHUNK, H, dh)
    kc = k.reshape(B, NC, CHUNK, H, dh)
    vc = v.reshape(B, NC, CHUNK, H, dh)
    scores = jnp.einsum('bncht,bnmht->bnhcm', qc, kc) * d_intra
    o_intra = jnp.einsum('bnhcm,bnmhe->bnche', scores, vc)
    kv = jnp.einsum('bnmht,bnmhe->bnhte', kc * k_dec[:, :, None], vc)

    def step(state, kv_n):
        return chunk_dec[:, None, None] * state + kv_n, state

    _, states = lax.scan(step, jnp.zeros((B, H, dh, dh), jnp.float32), jnp.moveaxis(kv, 1, 0))
    states = jnp.moveaxis(states, 0, 1)
    o_cross = jnp.einsum('bncht,bnhte->bnche', qc * q_dec[:, :, None], states)
    o = (o_intra + o_cross).reshape(B, S, H, dh)
    mu = jnp.mean(o, axis=-1, keepdims=True)
    var = jnp.mean(jnp.square(o - mu), axis=-1, keepdims=True)
    o = ((o - mu) * lax.rsqrt(var + GN_EPS)).reshape(B, S, RET_WIDTH)
    return jax.nn.silu(g.astype(jnp.float32)) * o


def rglru(xr, gr, conv_w, conv_b, w_ra, b_ra, w_ri, b_ri, lam):
    B, S = xr.shape[:2]
    x = xr.astype(jnp.float32)
    pad = jnp.pad(x, ((0, 0), (CONV_WIDTH - 1, 0), (0, 0)))
    xc = conv_b + sum(conv_w[kk] * pad[:, kk:kk + S] for kk in range(CONV_WIDTH))
    xh = xc.reshape(B, S, LRU_BLOCKS, LRU_BLOCK_DIM)
    r = jax.nn.sigmoid(jnp.einsum('bsgi,gij->bsgj', xh, w_ra).reshape(B, S, LRU_WIDTH) + b_ra)
    i = jax.nn.sigmoid(jnp.einsum('bsgi,gij->bsgj', xh, w_ri).reshape(B, S, LRU_WIDTH) + b_ri)
    log_a = LRU_C * r * jax.nn.log_sigmoid(lam.astype(jnp.float32))
    a = jnp.exp(log_a)
    b = jnp.sqrt(-jnp.expm1(2.0 * log_a)) * (i * xc)

    def combine(e1, e2):
        a1, b1 = e1
        a2, b2 = e2
        return a1 * a2, a2 * b1 + b2

    _, h = lax.associative_scan(combine, (a, b), axis=1)
    return h * jax.nn.gelu(gr.astype(jnp.float32))


def peer(x, w_pq, sub_keys, peer_u, peer_v):
    B, S, D = x.shape
    xt = x.reshape(-1, PEER_TOKEN_BLOCK, D)
    K = PEER_TOPK

    def block(xb):
        q = (xb @ w_pq).reshape(PEER_TOKEN_BLOCK, PEER_HEADS, 2, PEER_HALF)
        s1 = jnp.einsum('thd,hnd->thn', q[:, :, 0], sub_keys[:, 0])
        s2 = jnp.einsum('thd,hnd->thn', q[:, :, 1], sub_keys[:, 1])
        v1, i1 = lax.top_k(s1, K)
        v2, i2 = lax.top_k(s2, K)
        cand = (v1[..., :, None] + v2[..., None, :]).reshape(PEER_TOKEN_BLOCK, PEER_HEADS, K * K)
        vs, ci = lax.top_k(cand, K)
        e1 = jnp.take_along_axis(i1, ci // K, axis=-1)
        e2 = jnp.take_along_axis(i2, ci % K, axis=-1)
        expert = e1 * N_KEYS + e2
        gates = jax.nn.softmax(vs.astype(jnp.float32), axis=-1)
        u = peer_u[expert]
        act = jax.nn.gelu(jnp.einsum('thkd,td->thk', u, xb))
        return jnp.einsum('thk,thkd->td', gates * act, peer_v[expert])

    return lax.map(block, xt).reshape(B, S, D)


def setup_inputs(seed: int = 0) -> dict:
    key = jax.random.key(seed)
    ks = jax.random.split(key, 18)
    f32 = jnp.float32
    x = jax.random.normal(ks[0], (BATCH, SEQ, D_MODEL), f32)
    positions = jnp.broadcast_to(jnp.arange(SEQ, dtype=jnp.int32), (BATCH, SEQ))
    col_scale = jnp.concatenate([
        jnp.ones((2 * RET_WIDTH,), f32), jnp.full((RET_WIDTH,), DN_BETA, f32),
        jnp.ones((RET_WIDTH,), f32), jnp.full((LRU_WIDTH,), DN_BETA, f32),
        jnp.ones((LRU_WIDTH,), f32)])
    w_in = jax.random.normal(ks[1], (DEPTH, D_MODEL, IN_COLS), f32) * (D_MODEL ** -0.5) * col_scale
    w_out = jax.random.normal(ks[2], (DEPTH, MIX_WIDTH, D_MODEL), f32) * (MIX_WIDTH ** -0.5) * DN_BETA
    conv_w = jax.random.normal(ks[3], (DEPTH, CONV_WIDTH, LRU_WIDTH), f32) * (CONV_WIDTH ** -0.5)
    conv_b = 0.01 * jax.random.normal(ks[4], (DEPTH, LRU_WIDTH), f32)
    w_ra = jax.random.normal(ks[5], (DEPTH, LRU_BLOCKS, LRU_BLOCK_DIM, LRU_BLOCK_DIM), f32) * (LRU_BLOCK_DIM ** -0.5)
    b_ra = 0.01 * jax.random.normal(ks[6], (DEPTH, LRU_WIDTH), f32)
    w_ri = jax.random.normal(ks[7], (DEPTH, LRU_BLOCKS, LRU_BLOCK_DIM, LRU_BLOCK_DIM), f32) * (LRU_BLOCK_DIM ** -0.5)
    b_ri = 0.01 * jax.random.normal(ks[8], (DEPTH, LRU_WIDTH), f32)
    a_c = jax.random.uniform(ks[9], (DEPTH, LRU_WIDTH), f32, minval=0.9, maxval=0.999)
    a0 = a_c ** (1.0 / LRU_C)
    lru_lambda = jnp.log(a0) - jnp.log1p(-a0)
    ln1_g = 1.0 + 0.02 * jax.random.normal(ks[10], (DEPTH, D_MODEL), f32)
    ln1_b = 0.02 * jax.random.normal(ks[11], (DEPTH, D_MODEL), f32)
    w_pq = jax.random.normal(ks[12], (DEPTH, D_MODEL, PEER_HEADS * PEER_QUERY_DIM), f32) * (D_MODEL ** -0.5)
    sub_keys = jax.random.normal(ks[13], (DEPTH, PEER_HEADS, 2, N_KEYS, PEER_HALF), f32) * (PEER_HALF ** -0.5)
    peer_u = jax.random.normal(ks[14], (DEPTH, N_EXPERTS, D_MODEL), f32) * (D_MODEL ** -0.5)
    peer_v = jax.random.normal(ks[15], (DEPTH, N_EXPERTS, D_MODEL), f32) * DN_BETA
    ln2_g = 1.0 + 0.02 * jax.random.normal(ks[16], (DEPTH, D_MODEL), f32)
    ln2_b = 0.02 * jax.random.normal(ks[17], (DEPTH, D_MODEL), f32)
    return {"x": x, "positions": positions, "w_in": w_in, "w_out": w_out,
            "conv_w": conv_w, "conv_b": conv_b, "w_ra": w_ra, "b_ra": b_ra,
            "w_ri": w_ri, "b_ri": b_ri, "lru_lambda": lru_lambda,
            "ln1_g": ln1_g, "ln1_b": ln1_b, "w_pq": w_pq, "sub_keys": sub_keys,
            "peer_u": peer_u, "peer_v": peer_v, "ln2_g": ln2_g, "ln2_b": ln2_b}


def reference(x, positions, w_in, w_out, conv_w, conv_b, w_ra, b_ra, w_ri, b_ri, lru_lambda,
              ln1_g, ln1_b, w_pq, sub_keys, peer_u, peer_v, ln2_g, ln2_b):
    R, L = RET_WIDTH, LRU_WIDTH
    h = x
    for l in range(DEPTH):
        proj = h @ w_in[l]
        q, k, v, g, xr, gr = jnp.split(proj, [R, 2 * R, 3 * R, 4 * R, 4 * R + L], axis=-1)
        y_ret = retention(q, k, v, g, positions)
        y_lru = rglru(xr, gr, conv_w[l], conv_b[l], w_ra[l], b_ra[l], w_ri[l], b_ri[l], lru_lambda[l])
        mix = jnp.concatenate([y_ret, y_lru], axis=-1) @ w_out[l]
        h = layer_norm(DN_ALPHA * h + mix, ln1_g[l], ln1_b[l])
        h = layer_norm(DN_ALPHA * h + peer(h, w_pq[l], sub_keys[l], peer_u[l], peer_v[l]), ln2_g[l], ln2_b[l])
    return h
```

```cpp
#include <hip/hip_runtime.h>
#include <cstdio>
#include <cstdint>
#include <cmath>

namespace pg8 {
#define PG8_LAS __attribute__((address_space(3)))
typedef unsigned short bf16_t;
typedef short bf16x8 __attribute__((ext_vector_type(8)));
typedef float f32x4 __attribute__((ext_vector_type(4)));
typedef unsigned u32x4 __attribute__((ext_vector_type(4)));
constexpr int BM = 256, BK = 64, HALF = 128, HTB = HALF * BK * 2  , STAGE_BYTES = 8 * HTB, NXCD = 8, WGM = 8;

__host__ __device__ __forceinline__ int lds_byte(int r, int c) { const int st = (r >> 4) * 2 + (c >> 5), rr = r & 15, cc = c & 31, ob = rr * 64 + cc * 2; return st * 1024 + (ob ^ (((ob >> 9) & 1) << 5)); }
__host__ __device__ __forceinline__ void stage_rc(int b, int& R, int& C) { const int st = b / 1024, sb = b % 1024, swz = sb ^ (((sb >> 9) & 1) << 5); R = (st >> 1) * 16 + swz / 64; C = (st & 1) * 32 + (swz % 64) / 2; }
__host__ __device__ __forceinline__ int perm32(int rho) { const int n = rho >> 4, i = rho & 15; return 8 * (i >> 2) + 4 * n + (i & 3); }

struct Unit { int pm, pn; };
struct Gemm { const bf16_t* A; const bf16_t* Bt; int M, N, K; };

struct StaticOrder {
    int nM, nN, nwg, G, c;
    __host__ __device__ void init(int M, int N, int G_, int c_) { nM = M / BM; nN = N / BM; nwg = nM * nN; G = G_; c = c_; }
    __host__ __device__ bool next(int i, Unit& u) const {
        const long L = (long)i * G + c; if (L >= nwg) return false;
        int wgid = (int)L; { const int q = nwg / NXCD, r = nwg % NXCD, xcd = wgid % NXCD, off = wgid / NXCD; wgid = (xcd < r ? xcd * (q + 1) : r * (q + 1) + (xcd - r) * q) + off; }
        const int nig = WGM * nN, gid = wgid / nig, fm = gid * WGM, gsz = (nM - fm) < WGM ? (nM - fm) : WGM;
        u.pm = fm + ((wgid % nig) % gsz); u.pn = (wgid % nig) / gsz; return true;
    }
    __device__ __forceinline__ void a_ready(const Unit&) const {}
    __device__ __forceinline__ void done(const Unit&) const {}
};

__device__ __forceinline__ unsigned cvt_pk_bf16(float lo, float hi) { unsigned r; asm volatile("v_cvt_pk_bf16_f32 %0, %1, %2" : "=v"(r) : "v"(lo), "v"(hi)); return r; }
typedef float f32x2 __attribute__((ext_vector_type(2)));
__device__ __forceinline__ f32x2 gelu_pk(f32x2 v) {
    const f32x2 av = __builtin_elementwise_abs(v), d = av * 0.2316418882f + 1.0f;
    f32x2 t; t.x = __builtin_amdgcn_rcpf(d.x); t.y = __builtin_amdgcn_rcpf(d.y);
    f32x2 q = t * 0.5307027145f + (-0.7265760135f); q = q * t + 0.7107068705f; q = q * t + (-0.142248368f); q = q * t + 0.127414796f; q = q * t;
    const f32x2 s = (v * v) * (-0.72134752044f);
    f32x2 e; e.x = __builtin_amdgcn_exp2f(s.x); e.y = __builtin_amdgcn_exp2f(s.y);
    const f32x2 m = v * (q * e), r = v - m;
    f32x2 o; o.x = v.x < 0.f ? m.x : r.x; o.y = v.y < 0.f ? m.y : r.y; return o;
}

template <int ACT  > struct EpiBf16 {
    static constexpr bool PERM = true, AFTER_DRAIN = false; static_assert(ACT == 0 || ACT == 1, "EpiBf16: ACT is 0 (none) or 1 (gelu_pk)");
    bf16_t* O; int ldc; const float* bias; int split_cols; size_t split_stride; float scale0;
    __device__ __forceinline__ void operator()(const f32x4 (&acc)[2][2][4][2], const Unit& u, int wr, int wc, int fr, int fq) const {
        const int row0 = u.pm * BM + wr * 64 + fr; int colt = u.pn * BM; bf16_t* base = O;
        float sc = 1.f; if (split_cols) { const int t = colt / split_cols; base += (size_t)t * split_stride; colt -= t * split_cols; if (t == 0) sc = scale0; }
        const int col0 = colt + wc * 32 + 8 * fq, bcol0 = u.pn * BM + wc * 32 + 8 * fq;
        f32x4 bv[2][2];
#pragma unroll
        for (int bj = 0; bj < 2; ++bj)
#pragma unroll
            for (int n = 0; n < 2; ++n) bv[bj][n] = bias ? *(const f32x4*)(bias + bcol0 + bj * HALF + 4 * n) : (f32x4){0.f, 0.f, 0.f, 0.f};
#pragma unroll
        for (int ai = 0; ai < 2; ++ai)
#pragma unroll
            for (int m = 0; m < 4; ++m) { bf16_t* rowp = base + (size_t)(row0 + ai * HALF + m * 16) * ldc + col0;
#pragma unroll
                for (int bj = 0; bj < 2; ++bj) { f32x4 v0 = acc[ai][bj][m][0] + bv[bj][0], v1 = acc[ai][bj][m][1] + bv[bj][1];
                    if (ACT == 1) { f32x2 a = gelu_pk((f32x2){v0[0], v0[1]}), b = gelu_pk((f32x2){v0[2], v0[3]}), c = gelu_pk((f32x2){v1[0], v1[1]}), d = gelu_pk((f32x2){v1[2], v1[3]});
                        v0 = (f32x4){a.x, a.y, b.x, b.y}; v1 = (f32x4){c.x, c.y, d.x, d.y}; }
                    v0 = v0 * sc; v1 = v1 * sc; u32x4 w; w.x = cvt_pk_bf16(v0[0], v0[1]); w.y = cvt_pk_bf16(v0[2], v0[3]); w.z = cvt_pk_bf16(v1[0], v1[1]); w.w = cvt_pk_bf16(v1[2], v1[3]);
                    *(u32x4*)(rowp + bj * HALF) = w; } }
    }
};
struct EpiResF32 {
    static constexpr bool PERM = false, AFTER_DRAIN = false;
    const float* base; float* out; int ldc; float alpha;
    __device__ __forceinline__ void operator()(const f32x4 (&acc)[2][2][4][2], const Unit& u, int wr, int wc, int fr, int fq) const {
        const int row0 = u.pm * BM + wr * 64 + fr, col0 = u.pn * BM + wc * 32 + 4 * fq;
#pragma unroll
        for (int ai = 0; ai < 2; ++ai)
#pragma unroll
            for (int m = 0; m < 4; ++m) { const size_t off = (size_t)(row0 + ai * HALF + m * 16) * ldc + col0;
#pragma unroll
                for (int bj = 0; bj < 2; ++bj)
#pragma unroll
                    for (int n = 0; n < 2; ++n) { const f32x4 bs = *(const f32x4*)(base + off + bj * HALF + n * 16); *(f32x4*)(out + off + bj * HALF + n * 16) = bs * alpha + acc[ai][bj][m][n]; }
                asm volatile("" ::: "memory"); }
    }
};
template <class Epi, class Sched, bool ALIGN_EPI = false, bool SP2 = false>
__device__ __forceinline__ void gemm_phase(PG8_LAS unsigned char* lds, const Gemm g, const Sched& S, const Epi& E) {
    const int tid = threadIdx.x, wid = __builtin_amdgcn_readfirstlane(tid >> 6), lane = tid & 63, wr = wid >> 2, wc = wid & 3, fr = lane & 15, fq = lane >> 4;
    const int K = g.K, nt = K / BK;
    unsigned voffA[2], voffB[2];
#pragma unroll
    for (int i = 0; i < 2; ++i) { int R, C; stage_rc(tid * 16 + i * 8192, R, C); const int Rb = Epi::PERM ? ((R & ~31) + perm32(R & 31)) : R;
        voffA[i] = (unsigned)(R * K + C) * 2u; voffB[i] = (unsigned)(Rb * K + C) * 2u; }
    const size_t kstep = (size_t)(BK * 2);
    const size_t hstep = (size_t)HALF * K * 2;
    const size_t tstep = 2 * hstep;
    const unsigned ldsw = (unsigned)wid * 1024u;
    const int aoff = lds_byte(wr * 64 + fr, fq * 8), boff = lds_byte(wc * 32 + fr, fq * 8);
#define PG8_SA(b, h) (((b) * 2 + (h)) * HTB)
#define PG8_SB(b, h) ((4 + (b) * 2 + (h)) * HTB)
#define PG8_STAGE(bufoff, gbase, voff) do { _Pragma("unroll") for (int _i = 0; _i < 2; ++_i) \
        __builtin_amdgcn_global_load_lds((const unsigned*)((const char*)(gbase) + (voff)[_i]), (PG8_LAS unsigned*)(lds + (bufoff) + ldsw + _i * 8192), 16, 0, 0); } while (0)
#define PG8_LDA(dst, b, h) do { _Pragma("unroll") for (int m = 0; m < 4; ++m) _Pragma("unroll") for (int k = 0; k < 2; ++k) dst[m][k] = *(const PG8_LAS bf16x8*)(lds + PG8_SA(b, h) + aoff + m * 2048 + k * 1024); } while (0)
#define PG8_LDB(dst, b, h) do { _Pragma("unroll") for (int n = 0; n < 2; ++n) _Pragma("unroll") for (int k = 0; k < 2; ++k) dst[n][k] = *(const PG8_LAS bf16x8*)(lds + PG8_SB(b, h) + boff + n * 2048 + k * 1024); } while (0)
#define PG8_MMA(ai, bj, At, Bt) do { __builtin_amdgcn_s_setprio(1); _Pragma("unroll") for (int m = 0; m < 4; ++m) _Pragma("unroll") for (int n = 0; n < 2; ++n) _Pragma("unroll") for (int k = 0; k < 2; ++k) \
        acc[ai][bj][m][n] = __builtin_amdgcn_mfma_f32_16x16x32_bf16(Bt[n][k], At[m][k], acc[ai][bj][m][n], 0, 0, 0); __builtin_amdgcn_s_setprio(0); } while (0)
#define PG8_WAIT_V(n) asm volatile("s_waitcnt vmcnt(" #n ")" ::: "memory")
#define PG8_WAIT_L(n) asm volatile("s_waitcnt lgkmcnt(" #n ")" ::: "memory")
#define PG8_BAR __builtin_amdgcn_s_barrier()
#define PG8_SCHED __builtin_amdgcn_sched_barrier(0)
    Unit cur, nxt; int ui = 0;
    if (!S.next(0, cur)) return;
    f32x4 acc[2][2][4][2];
#pragma unroll
    for (int a = 0; a < 2; ++a)
#pragma unroll
        for (int b = 0; b < 2; ++b)
#pragma unroll
            for (int m = 0; m < 4; ++m)
#pragma unroll
                for (int n = 0; n < 2; ++n) acc[a][b][m][n] = (f32x4){0.f, 0.f, 0.f, 0.f};
    bf16x8 At[4][2], B0[2][2], B1[2][2];
    const char* cA = (const char*)g.A + (size_t)cur.pm * tstep; const char* cB = (const char*)g.Bt + (size_t)cur.pn * tstep;
    S.a_ready(cur);
    if constexpr (SP2) {
        PG8_STAGE(PG8_SB(0, 0), cB, voffB); PG8_STAGE(PG8_SB(0, 1), cB + hstep, voffB); PG8_STAGE(PG8_SA(0, 0), cA, voffA); PG8_STAGE(PG8_SA(0, 1), cA + hstep, voffA);
        if (wr == 1) PG8_BAR;
        PG8_WAIT_V(2); PG8_BAR;
        PG8_STAGE(PG8_SB(1, 0), cB + kstep, voffB); PG8_STAGE(PG8_SA(1, 0), cA + kstep, voffA); PG8_STAGE(PG8_SB(1, 1), cB + hstep + kstep, voffB);
        PG8_WAIT_V(6); PG8_BAR;
    } else {
        PG8_STAGE(PG8_SB(0, 0), cB, voffB); PG8_STAGE(PG8_SA(0, 0), cA, voffA); PG8_STAGE(PG8_SB(0, 1), cB + hstep, voffB); PG8_STAGE(PG8_SA(0, 1), cA + hstep, voffA);
        if (wr == 1) PG8_BAR;
        PG8_WAIT_V(4); PG8_BAR;
        PG8_STAGE(PG8_SB(1, 0), cB + kstep, voffB); PG8_STAGE(PG8_SA(1, 0), cA + kstep, voffA); PG8_STAGE(PG8_SB(1, 1), cB + hstep + kstep, voffB);
        PG8_WAIT_V(6); PG8_BAR;
    }
    for (;;) {
        const bool has_next = S.next(ui + 1, nxt);
        const char* nA = has_next ? (const char*)g.A + (size_t)nxt.pm * tstep : cA; const char* nB = has_next ? (const char*)g.Bt + (size_t)nxt.pn * tstep : cB;
        for (int t = 0; t < nt; t += 2) {
            const bool last = (t == nt - 2);
            const char* a1 = cA + (size_t)(t + 1) * kstep;
            const char* a2 = last ? nA : cA + (size_t)(t + 2) * kstep; const char* b2 = last ? nB : cB + (size_t)(t + 2) * kstep;
            const char* a3 = a2 + kstep; const char* b3 = b2 + kstep;
            if (last && has_next) S.a_ready(nxt);
            if constexpr (SP2) {
            PG8_LDB(B0, 0, 0); PG8_LDB(B1, 0, 1); PG8_SCHED; PG8_LDA(At, 0, 0); PG8_STAGE(PG8_SA(1, 1), a1 + hstep, voffA);
            PG8_WAIT_V(8); PG8_WAIT_L(0); PG8_BAR; PG8_MMA(0, 0, At, B0); PG8_MMA(0, 1, At, B1); PG8_BAR; PG8_SCHED;
            PG8_LDA(At, 0, 1); PG8_STAGE(PG8_SB(0, 0), b2, voffB); PG8_STAGE(PG8_SB(0, 1), b2 + hstep, voffB); PG8_STAGE(PG8_SA(0, 0), a2, voffA);
            PG8_WAIT_V(8); PG8_WAIT_L(0); PG8_BAR; PG8_MMA(1, 0, At, B0); PG8_MMA(1, 1, At, B1); PG8_BAR; PG8_SCHED;
            PG8_LDB(B0, 1, 0); PG8_LDB(B1, 1, 1); PG8_SCHED; PG8_LDA(At, 1, 0); PG8_STAGE(PG8_SA(0, 1), a2 + hstep, voffA);
            PG8_WAIT_V(8); PG8_WAIT_L(0); PG8_BAR; PG8_MMA(0, 0, At, B0); PG8_MMA(0, 1, At, B1); PG8_BAR; PG8_SCHED;
            PG8_LDA(At, 1, 1); PG8_STAGE(PG8_SB(1, 0), b3, voffB); PG8_STAGE(PG8_SB(1, 1), b3 + hstep, voffB); PG8_STAGE(PG8_SA(1, 0), a3, voffA);
            PG8_WAIT_V(8); PG8_WAIT_L(0); PG8_BAR; PG8_MMA(1, 0, At, B0); PG8_MMA(1, 1, At, B1); PG8_BAR; PG8_SCHED;
            } else {
            PG8_LDB(B0, 0, 0); PG8_SCHED; PG8_LDA(At, 0, 0); PG8_STAGE(PG8_SA(1, 1), a1 + hstep, voffA);
            PG8_WAIT_L(8); PG8_BAR; PG8_WAIT_L(0); PG8_MMA(0, 0, At, B0); PG8_BAR; PG8_SCHED;
            PG8_LDB(B1, 0, 1); PG8_STAGE(PG8_SB(0, 0), b2, voffB);
            PG8_BAR; PG8_WAIT_L(0); PG8_MMA(0, 1, At, B1); PG8_BAR;
            PG8_LDA(At, 0, 1); PG8_STAGE(PG8_SA(0, 0), a2, voffA);
            PG8_BAR; PG8_WAIT_L(0); PG8_MMA(1, 0, At, B0); PG8_BAR; PG8_SCHED;
            PG8_STAGE(PG8_SB(0, 1), b2 + hstep, voffB);
            PG8_WAIT_V(6); PG8_BAR; PG8_MMA(1, 1, At, B1); PG8_BAR;
            PG8_LDB(B0, 1, 0); PG8_SCHED; PG8_LDA(At, 1, 0); PG8_STAGE(PG8_SA(0, 1), a2 + hstep, voffA);
            PG8_WAIT_L(8); PG8_BAR; PG8_WAIT_L(0); PG8_MMA(0, 0, At, B0); PG8_BAR; PG8_SCHED;
            PG8_LDB(B1, 1, 1); PG8_STAGE(PG8_SB(1, 0), b3, voffB);
            PG8_BAR; PG8_WAIT_L(0); PG8_MMA(0, 1, At, B1); PG8_BAR;
            PG8_LDA(At, 1, 1); PG8_STAGE(PG8_SA(1, 0), a3, voffA);
            PG8_BAR; PG8_WAIT_L(0); PG8_MMA(1, 0, At, B0); PG8_BAR; PG8_SCHED;
            PG8_STAGE(PG8_SB(1, 1), b3 + hstep, voffB);
            PG8_WAIT_V(6); PG8_BAR; PG8_MMA(1, 1, At, B1); PG8_BAR;
            }
        }
        if constexpr (ALIGN_EPI) { if (wr == 0) PG8_BAR; }
        if constexpr (!Epi::AFTER_DRAIN) { E(acc, cur, wr, wc, fr, fq); S.done(cur); }
        if (!has_next) break;
#pragma unroll
        for (int a = 0; a < 2; ++a)
#pragma unroll
            for (int b = 0; b < 2; ++b)
#pragma unroll
                for (int m = 0; m < 4; ++m)
#pragma unroll
                    for (int n = 0; n < 2; ++n) acc[a][b][m][n] = (f32x4){0.f, 0.f, 0.f, 0.f};
        cur = nxt; cA = nA; cB = nB; ++ui;
        if constexpr (ALIGN_EPI) { if (wr == 1) PG8_BAR; }
    }
    PG8_WAIT_V(0);
    if constexpr (!ALIGN_EPI) { if (wr == 0) PG8_BAR; }
    PG8_BAR;
    if constexpr (Epi::AFTER_DRAIN) { E.fused(acc, cur, wr, wc, fr, fq, lds, wid, lane); S.done(cur); }
#undef PG8_SA
#undef PG8_SB
#undef PG8_STAGE
#undef PG8_LDA
#undef PG8_LDB
#undef PG8_MMA
#undef PG8_WAIT_V
#undef PG8_WAIT_L
#undef PG8_BAR
#undef PG8_SCHED
}
}
constexpr int S_ = 16384, D_ = 2048, INC = 6144, NH = 8, DH = 128, CH = 64, NCH = 256;
constexpr float DN_ALPHA = 1.189207115002721f;
constexpr float LN_EPS = 1e-5f, GN_EPS = 1e-6f;
constexpr int NWAVES = 8, NTHREADS = 512;
constexpr int LDS_BYTES = 147456;

constexpr size_t MiB = 1u << 20;
constexpr size_t WS_CTL = 0;
constexpr size_t WS_WOUT_T = 1 * MiB, WS_WPQ_T = 9 * MiB, WS_KEYS = 17 * MiB, WS_WRA_T = 17 * MiB + 512 * 1024, WS_WRI_T = 17 * MiB + 768 * 1024;
constexpr size_t WS_COS = 18 * MiB, WS_SIN = 22 * MiB, WS_SUMA = 26 * MiB, WS_SUMH = 27 * MiB, WS_HIN = 28 * MiB;
constexpr size_t WS_UB = 32 * MiB, WS_VB = 96 * MiB;
constexpr size_t WS_WIN_T = 160 * MiB, WS_XB = 184 * MiB, WS_KVS = 184 * MiB, WS_H1B = 184 * MiB;
constexpr size_t WS_PROJ = 248 * MiB, WS_QP = 248 * MiB, WS_SELE = 312 * MiB, WS_SELG = 320 * MiB;
constexpr size_t WS_YCAT = 440 * MiB, WS_END = 504 * MiB;

#define LAS __attribute__((address_space(3)))
typedef unsigned short bf16_t;
typedef short bf16x8 __attribute__((ext_vector_type(8)));
typedef float f32x4 __attribute__((ext_vector_type(4)));
typedef unsigned u32x4 __attribute__((ext_vector_type(4)));
typedef unsigned u32x2 __attribute__((ext_vector_type(2)));

__device__ __forceinline__ unsigned f2bf(float f) { unsigned u = __float_as_uint(f); return (u + 0x7fffu + ((u >> 16) & 1u)) >> 16; }
__device__ __forceinline__ unsigned pk2(float lo, float hi) { return f2bf(lo) | (f2bf(hi) << 16); }
__device__ __forceinline__ float bflo(unsigned w) { return __uint_as_float(w << 16); }
__device__ __forceinline__ float bfhi(unsigned w) { return __uint_as_float(w & 0xffff0000u); }
__device__ __forceinline__ float bf2f(bf16_t b) { return __uint_as_float(((unsigned)b) << 16); }
__device__ __forceinline__ f32x4 mfma16(bf16x8 a, bf16x8 b, f32x4 c) { return __builtin_amdgcn_mfma_f32_16x16x32_bf16(a, b, c, 0, 0, 0); }
__device__ __forceinline__ float sigmoidf_(float x) { return 1.0f / (1.0f + __expf(-x)); }
__device__ __forceinline__ float gelu_tanh(float x) { const float y = 0.7978845608028654f * (x + 0.044715f * x * x * x); return x / (1.0f + __expf(-2.0f * y)); }
__device__ __forceinline__ float wave_sum(float v) {
#pragma unroll
    for (int o = 1; o < 64; o <<= 1) v += __shfl_xor(v, o);
    return v;
}
__device__ __forceinline__ float head_log_gamma(int h) { return logf(1.0f - exp2f(-5.0f - (float)h)); }

__device__ __forceinline__ void transpose_item(const float* W, int K, int N, bf16_t* WT, LAS float* scr, int item, int lane) {
    const int nblk = N / 32, kb = item / nblk, nb = item % nblk, k0 = 64 * kb, n0 = 32 * nb;
#pragma unroll 8
    for (int i = 0; i < 32; ++i) { const int kk = 2 * i + (lane >> 5); scr[kk * 33 + (lane & 31)] = W[(size_t)(k0 + kk) * N + n0 + (lane & 31)]; }
    asm volatile("s_waitcnt lgkmcnt(0)" ::: "memory");
    const int c = lane & 7;
#pragma unroll
    for (int j = 0; j < 4; ++j) { const int n = (lane >> 3) + 8 * j; const LAS float* s = scr + (8 * c) * 33 + n;
        u32x4 o; o.x = pk2(s[0 * 33], s[1 * 33]); o.y = pk2(s[2 * 33], s[3 * 33]); o.z = pk2(s[4 * 33], s[5 * 33]); o.w = pk2(s[6 * 33], s[7 * 33]);
        *(u32x4*)(WT + (size_t)(n0 + n) * K + k0 + 8 * c) = o; }
    asm volatile("s_waitcnt lgkmcnt(0)" ::: "memory");
}
__device__ __forceinline__ void cvt_stream(const float* src, bf16_t* dst, size_t n8, size_t gtid, size_t gthreads) {
    for (size_t i = gtid; i < n8; i += gthreads) {
        const f32x4 a = ((const f32x4*)src)[2 * i], b = ((const f32x4*)src)[2 * i + 1];
        u32x4 o; o.x = pk2(a.x, a.y); o.y = pk2(a.z, a.w); o.z = pk2(b.x, b.y); o.w = pk2(b.z, b.w);
        ((u32x4*)dst)[i] = o;
    }
}
struct Ptrs {
    const float *x; const int* pos; const float *w_in, *w_out, *conv_w, *conv_b, *w_ra, *b_ra, *w_ri, *b_ri, *lam, *ln1_g, *ln1_b, *w_pq, *sub_keys, *peer_u, *peer_v, *ln2_g, *ln2_b;
    float* out; unsigned char* ws;
};
__device__ __forceinline__ void prologue_phase(LAS unsigned char* lds, const Ptrs& P, int G, int b) {
    const int tid = threadIdx.x, lane = tid & 63, wid = tid >> 6;
    LAS float* scr = (LAS float*)(lds + wid * 16384);
    const int gw = b * NWAVES + wid, NGW = G * NWAVES;
    unsigned char* ws = P.ws;
    constexpr int I_IN = (D_ / 64) * (INC / 32), I_SQ = (D_ / 64) * (D_ / 32), I_G = 2 * 4;
    constexpr int NITEMS = I_IN + 2 * I_SQ + 16 * I_G;
    for (int it = gw; it < NITEMS; it += NGW) {
        int r = it;
        if (r < I_IN) { transpose_item(P.w_in, D_, INC, (bf16_t*)(ws + WS_WIN_T), scr, r, lane); continue; } r -= I_IN;
        if (r < I_SQ) { transpose_item(P.w_out, D_, D_, (bf16_t*)(ws + WS_WOUT_T), scr, r, lane); continue; } r -= I_SQ;
        if (r < I_SQ) { transpose_item(P.w_pq, D_, D_, (bf16_t*)(ws + WS_WPQ_T), scr, r, lane); continue; } r -= I_SQ;
        if (r < 8 * I_G) { const int g = r / I_G; transpose_item(P.w_ra + g * 16384, 128, 128, (bf16_t*)(ws + WS_WRA_T) + g * 16384, scr, r % I_G, lane); continue; } r -= 8 * I_G;
        { const int g = r / I_G; transpose_item(P.w_ri + g * 16384, 128, 128, (bf16_t*)(ws + WS_WRI_T) + g * 16384, scr, r % I_G, lane); }
    }
    const size_t gtid = (size_t)b * NTHREADS + tid, gth = (size_t)G * NTHREADS;
    cvt_stream(P.x, (bf16_t*)(ws + WS_XB), (size_t)S_ * D_ / 8, gtid, gth);
    cvt_stream(P.peer_u, (bf16_t*)(ws + WS_UB), (size_t)16384 * D_ / 8, gtid, gth);
    cvt_stream(P.peer_v, (bf16_t*)(ws + WS_VB), (size_t)16384 * D_ / 8, gtid, gth);
    cvt_stream(P.sub_keys, (bf16_t*)(ws + WS_KEYS), (size_t)8 * 2 * 128 * 128 / 8, gtid, gth);
    float* cosT = (float*)(ws + WS_COS); float* sinT = (float*)(ws + WS_SIN);
    for (size_t i = gtid; i < (size_t)S_ * 64; i += gth) {
        const int s = (int)(i >> 6), f = (int)(i & 63);
        const float inv = powf(10000.0f, -(float)f / 64.0f);
        const float ang = (float)P.pos[s] * inv;
        float sn, cs; sincosf(ang, &sn, &cs);
        cosT[i] = cs; sinT[i] = sn;
    }
}
__device__ __forceinline__ void rot8(const u32x4 x1, const u32x4 x2, const float* cp, const float* sp, float scale, float (&o1)[8], float (&o2)[8]) {
    const f32x4 c0 = *(const f32x4*)cp, c1 = *(const f32x4*)(cp + 4), s0 = *(const f32x4*)sp, s1 = *(const f32x4*)(sp + 4);
    const float cs[8] = {c0.x, c0.y, c0.z, c0.w, c1.x, c1.y, c1.z, c1.w}, sn[8] = {s0.x, s0.y, s0.z, s0.w, s1.x, s1.y, s1.z, s1.w};
    const unsigned w1[4] = {x1.x, x1.y, x1.z, x1.w}, w2[4] = {x2.x, x2.y, x2.z, x2.w};
#pragma unroll
    for (int j = 0; j < 8; ++j) {
        const float a = (j & 1) ? bfhi(w1[j >> 1]) : bflo(w1[j >> 1]);
        const float bb = (j & 1) ? bfhi(w2[j >> 1]) : bflo(w2[j >> 1]);
        o1[j] = (a * cs[j] - bb * sn[j]) * scale;
        o2[j] = (bb * cs[j] + a * sn[j]) * scale;
    }
}
__device__ __forceinline__ void ret_kv_phase(LAS unsigned char* lds, const bf16_t* proj, const float* cosT, const float* sinT, bf16_t* kvs, int G, int b) {
    const int tid = threadIdx.x, lane = tid & 63, wid = tid >> 6, fr = lane & 15, fq = lane >> 4;
    LAS bf16_t* KT = (LAS bf16_t*)lds;
    LAS bf16_t* VT = (LAS bf16_t*)(lds + 18432);
    for (int unit = b; unit < NCH * NH; unit += G) {
        const int n = unit >> 3, h = unit & 7;
        const float log_g = head_log_gamma(h);
        const int m = tid >> 3, tq = tid & 7; const int s = n * 64 + m;
        {
            const bf16_t* kp = proj + (size_t)s * INC + 1024 + h * 128 + tq * 8;
            const u32x4 x1 = *(const u32x4*)kp, x2 = *(const u32x4*)(kp + 64);
            float o1[8], o2[8];
            rot8(x1, x2, cosT + (size_t)s * 64 + tq * 8, sinT + (size_t)s * 64 + tq * 8, expf(log_g * (63.0f - (float)m)), o1, o2);
#pragma unroll
            for (int j = 0; j < 8; ++j) { KT[(tq * 8 + j) * 72 + m] = (bf16_t)f2bf(o1[j]); KT[(64 + tq * 8 + j) * 72 + m] = (bf16_t)f2bf(o2[j]); }
            const bf16_t* vp = proj + (size_t)s * INC + 2048 + h * 128 + tq * 16;
            const u32x4 y0 = *(const u32x4*)vp, y1 = *(const u32x4*)(vp + 8);
            const unsigned yw[8] = {y0.x, y0.y, y0.z, y0.w, y1.x, y1.y, y1.z, y1.w};
#pragma unroll
            for (int j = 0; j < 8; ++j) { VT[(tq * 16 + 2 * j) * 72 + m] = (bf16_t)(yw[j] & 0xffffu); VT[(tq * 16 + 2 * j + 1) * 72 + m] = (bf16_t)(yw[j] >> 16); }
        }
        __syncthreads();
        f32x4 acc[8];
#pragma unroll
        for (int et = 0; et < 8; ++et) acc[et] = (f32x4){0.f, 0.f, 0.f, 0.f};
#pragma unroll
        for (int ks = 0; ks < 2; ++ks) {
            const bf16x8 a = *(const LAS bf16x8*)(KT + (wid * 16 + fr) * 72 + ks * 32 + fq * 8);
#pragma unroll
            for (int et = 0; et < 8; ++et) { const bf16x8 bb = *(const LAS bf16x8*)(VT + (et * 16 + fr) * 72 + ks * 32 + fq * 8); acc[et] = mfma16(a, bb, acc[et]); }
        }
        bf16_t* outp = kvs + (size_t)unit * 16384;
#pragma unroll
        for (int et = 0; et < 8; ++et) { u32x2 w; w.x = pk2(acc[et][0], acc[et][1]); w.y = pk2(acc[et][2], acc[et][3]); *(u32x2*)(outp + (et * 16 + fr) * 128 + wid * 16 + fq * 4) = w; }
        __syncthreads();
    }
}
__device__ __forceinline__ void scan_phase(bf16_t* kvs, const float* sumA, const float* sumH, float* Hin, int G, int b) {
    const int gtid = b * NTHREADS + threadIdx.x, gth = G * NTHREADS;
    for (int p = gtid; p < 65536; p += gth) {
        const int h = p >> 13;
        const float dec = expf(64.0f * head_log_gamma(h));
        unsigned* ptr = (unsigned*)kvs + p;
        float s0 = 0.f, s1 = 0.f;
        for (int n = 0; n < NCH; n += 8) {
            unsigned v[8];
#pragma unroll
            for (int j = 0; j < 8; ++j) v[j] = ptr[(size_t)(n + j) * 65536];
#pragma unroll
            for (int j = 0; j < 8; ++j) { ptr[(size_t)(n + j) * 65536] = pk2(s0, s1); s0 = dec * s0 + bflo(v[j]); s1 = dec * s1 + bfhi(v[j]); }
        }
    }
    const int c = gth - 1 - gtid;
    if (c < 1024) {
        float H = 0.f;
        for (int n = 0; n < NCH; n += 8) {
            float a[8], hh[8];
#pragma unroll
            for (int j = 0; j < 8; ++j) { a[j] = sumA[(n + j) * 1024 + c]; hh[j] = sumH[(n + j) * 1024 + c]; }
#pragma unroll
            for (int j = 0; j < 8; ++j) { Hin[(n + j) * 1024 + c] = H; H = a[j] * H + hh[j]; }
        }
    }
}
__device__ __forceinline__ void ret_out_phase(LAS unsigned char* lds, const bf16_t* proj, const float* cosT, const float* sinT, const bf16_t* kvs, bf16_t* ycat, int G, int b) {
    const int tid = threadIdx.x, lane = tid & 63, wid = tid >> 6, fr = lane & 15, fq = lane >> 4;
    LAS bf16_t* QS = (LAS bf16_t*)lds;
    LAS bf16_t* KS = (LAS bf16_t*)(lds + 17408);
    LAS bf16_t* VT = (LAS bf16_t*)(lds + 34816);
    LAS bf16_t* PS = (LAS bf16_t*)(lds + 53248);
    LAS float*  OS = (LAS float*)(lds + 62464);
    for (int unit = b; unit < NCH * NH; unit += G) {
        const int n = unit >> 3, h = unit & 7;
        const float log_g = head_log_gamma(h);
        const int m = tid >> 3, tq = tid & 7; const int s = n * 64 + m;
        {
            const float* cp = cosT + (size_t)s * 64 + tq * 8; const float* sp = sinT + (size_t)s * 64 + tq * 8;
            float o1[8], o2[8];
            const bf16_t* qp = proj + (size_t)s * INC + h * 128 + tq * 8;
            rot8(*(const u32x4*)qp, *(const u32x4*)(qp + 64), cp, sp, 0.08838834764831845f, o1, o2);
            u32x4 w; w.x = pk2(o1[0], o1[1]); w.y = pk2(o1[2], o1[3]); w.z = pk2(o1[4], o1[5]); w.w = pk2(o1[6], o1[7]);
            *(LAS u32x4*)(QS + m * 136 + tq * 8) = w;
            w.x = pk2(o2[0], o2[1]); w.y = pk2(o2[2], o2[3]); w.z = pk2(o2[4], o2[5]); w.w = pk2(o2[6], o2[7]);
            *(LAS u32x4*)(QS + m * 136 + 64 + tq * 8) = w;
            const bf16_t* kp = proj + (size_t)s * INC + 1024 + h * 128 + tq * 8;
            rot8(*(const u32x4*)kp, *(const u32x4*)(kp + 64), cp, sp, 1.0f, o1, o2);
            w.x = pk2(o1[0], o1[1]); w.y = pk2(o1[2], o1[3]); w.z = pk2(o1[4], o1[5]); w.w = pk2(o1[6], o1[7]);
            *(LAS u32x4*)(KS + m * 136 + tq * 8) = w;
            w.x = pk2(o2[0], o2[1]); w.y = pk2(o2[2], o2[3]); w.z = pk2(o2[4], o2[5]); w.w = pk2(o2[6], o2[7]);
            *(LAS u32x4*)(KS + m * 136 + 64 + tq * 8) = w;
            const bf16_t* vp = proj + (size_t)s * INC + 2048 + h * 128 + tq * 16;
            const u32x4 y0 = *(const u32x4*)vp, y1 = *(const u32x4*)(vp + 8);
            const unsigned yw[8] = {y0.x, y0.y, y0.z, y0.w, y1.x, y1.y, y1.z, y1.w};
#pragma unroll
            for (int j = 0; j < 8; ++j) { VT[(tq * 16 + 2 * j) * 72 + m] = (bf16_t)(yw[j] & 0xffffu); VT[(tq * 16 + 2 * j + 1) * 72 + m] = (bf16_t)(yw[j] >> 16); }
        }
        __syncthreads();
        const int ct = wid & 3;
        {
            const int mt0 = (wid >> 2) * 2;
            f32x4 sacc[2] = {(f32x4){0.f, 0.f, 0.f, 0.f}, (f32x4){0.f, 0.f, 0.f, 0.f}};
#pragma unroll
            for (int ks = 0; ks < 4; ++ks) {
                const bf16x8 a = *(const LAS bf16x8*)(QS + (ct * 16 + fr) * 136 + ks * 32 + fq * 8);
#pragma unroll
                for (int j = 0; j < 2; ++j) { const bf16x8 bb = *(const LAS bf16x8*)(KS + ((mt0 + j) * 16 + fr) * 136 + ks * 32 + fq * 8); sacc[j] = mfma16(a, bb, sacc[j]); }
            }
#pragma unroll
            for (int j = 0; j < 2; ++j)
#pragma unroll
                for (int r = 0; r < 4; ++r) { const int c = ct * 16 + fq * 4 + r, mm = (mt0 + j) * 16 + fr; const float dd = fabsf((float)(c - mm));
                    PS[c * 72 + mm] = (bf16_t)f2bf(sacc[j][r] * expf(log_g * dd)); }
        }
        __syncthreads();
        {
            const int et0 = (wid >> 2) * 4;
            f32x4 oacc[4];
#pragma unroll
            for (int j = 0; j < 4; ++j) oacc[j] = (f32x4){0.f, 0.f, 0.f, 0.f};
            const bf16_t* st = kvs + (size_t)unit * 16384;
#pragma unroll
            for (int ks = 0; ks < 4; ++ks) {
                const bf16x8 a = *(const LAS bf16x8*)(QS + (ct * 16 + fr) * 136 + ks * 32 + fq * 8);
#pragma unroll
                for (int j = 0; j < 4; ++j) { const bf16x8 bb = *(const bf16x8*)(st + ((et0 + j) * 16 + fr) * 128 + ks * 32 + fq * 8); oacc[j] = mfma16(a, bb, oacc[j]); }
            }
#pragma unroll
            for (int r = 0; r < 4; ++r) { const float qd = expf(log_g * (float)(ct * 16 + fq * 4 + r + 1));
#pragma unroll
                for (int j = 0; j < 4; ++j) oacc[j][r] *= qd; }
#pragma unroll
            for (int ks = 0; ks < 2; ++ks) {
                const bf16x8 a = *(const LAS bf16x8*)(PS + (ct * 16 + fr) * 72 + ks * 32 + fq * 8);
#pragma unroll
                for (int j = 0; j < 4; ++j) { const bf16x8 bb = *(const LAS bf16x8*)(VT + ((et0 + j) * 16 + fr) * 72 + ks * 32 + fq * 8); oacc[j] = mfma16(a, bb, oacc[j]); }
            }
#pragma unroll
            for (int j = 0; j < 4; ++j)
#pragma unroll
                for (int r = 0; r < 4; ++r) OS[(ct * 16 + fq * 4 + r) * 132 + (et0 + j) * 16 + fr] = oacc[j][r];
        }
        __syncthreads();
        {
            float v[16]; float sum = 0.f;
#pragma unroll
            for (int q = 0; q < 4; ++q) { const f32x4 t = *(const LAS f32x4*)(OS + m * 132 + tq * 16 + q * 4); v[4 * q] = t.x; v[4 * q + 1] = t.y; v[4 * q + 2] = t.z; v[4 * q + 3] = t.w; sum += (t.x + t.y) + (t.z + t.w); }
            sum += __shfl_xor(sum, 1); sum += __shfl_xor(sum, 2); sum += __shfl_xor(sum, 4);
            const float mean = sum * (1.0f / 128.0f); float sq = 0.f;
#pragma unroll
            for (int i = 0; i < 16; ++i) { v[i] -= mean; sq += v[i] * v[i]; }
            sq += __shfl_xor(sq, 1); sq += __shfl_xor(sq, 2); sq += __shfl_xor(sq, 4);
            const float rstd = 1.0f / sqrtf(sq * (1.0f / 128.0f) + GN_EPS);
            const bf16_t* gp = proj + (size_t)s * INC + 3072 + h * 128 + tq * 16;
            const u32x4 g0 = *(const u32x4*)gp, g1 = *(const u32x4*)(gp + 8);
            const unsigned gw[8] = {g0.x, g0.y, g0.z, g0.w, g1.x, g1.y, g1.z, g1.w};
            unsigned ow[8];
#pragma unroll
            for (int j = 0; j < 8; ++j) { const float ga = bflo(gw[j]), gb = bfhi(gw[j]);
                ow[j] = pk2(ga * sigmoidf_(ga) * v[2 * j] * rstd, gb * sigmoidf_(gb) * v[2 * j + 1] * rstd); }
            bf16_t* yp = ycat + (size_t)s * D_ + h * 128 + tq * 16;
            *(u32x4*)yp = (u32x4){ow[0], ow[1], ow[2], ow[3]}; *(u32x4*)(yp + 8) = (u32x4){ow[4], ow[5], ow[6], ow[7]};
        }
        __syncthreads();
    }
}
template <int MODE>
__device__ __forceinline__ void lru_phase(LAS unsigned char* lds, const bf16_t* proj, const Ptrs& P, const bf16_t* wraT, const bf16_t* wriT,
                                          float* sumA, float* sumH, const float* Hin, bf16_t* ycat, int G, int b) {
    const int tid = threadIdx.x, lane = tid & 63, wid = tid >> 6, fr = lane & 15, fq = lane >> 4;
    LAS float*  XC  = (LAS float*)lds;
    LAS bf16_t* XCb = (LAS bf16_t*)(lds + 33792);
    LAS float*  AA  = (LAS float*)(lds + 51200);
    LAS float*  BB  = (LAS float*)(lds + 84992);
    for (int unit = b; unit < NCH * 8; unit += G) {
        const int n = unit >> 3, g = unit & 7, c0 = g * 128;
        const int m = tid >> 3, part = tid & 7, j0 = part * 16; const int s = n * 64 + m;
        {
            float xc[16];
#pragma unroll
            for (int q = 0; q < 4; ++q) { const f32x4 t = *(const f32x4*)(P.conv_b + c0 + j0 + 4 * q); xc[4 * q] = t.x; xc[4 * q + 1] = t.y; xc[4 * q + 2] = t.z; xc[4 * q + 3] = t.w; }
#pragma unroll
            for (int kk = 0; kk < 4; ++kk) {
                const int srow = s - 3 + kk;
                if (srow >= 0) {
                    const bf16_t* xp = proj + (size_t)srow * INC + 4096 + c0 + j0;
                    const u32x4 y0 = *(const u32x4*)xp, y1 = *(const u32x4*)(xp + 8);
                    const unsigned yw[8] = {y0.x, y0.y, y0.z, y0.w, y1.x, y1.y, y1.z, y1.w};
                    const float* wp = P.conv_w + kk * 1024 + c0 + j0;
#pragma unroll
                    for (int q = 0; q < 4; ++q) { const f32x4 w = *(const f32x4*)(wp + 4 * q);
                        xc[4 * q] += w.x * bflo(yw[2 * q]); xc[4 * q + 1] += w.y * bfhi(yw[2 * q]); xc[4 * q + 2] += w.z * bflo(yw[2 * q + 1]); xc[4 * q + 3] += w.w * bfhi(yw[2 * q + 1]); }
                }
            }
#pragma unroll
            for (int q = 0; q < 4; ++q) *(LAS f32x4*)(XC + m * 132 + j0 + 4 * q) = (f32x4){xc[4 * q], xc[4 * q + 1], xc[4 * q + 2], xc[4 * q + 3]};
            *(LAS u32x4*)(XCb + m * 136 + j0) = (u32x4){pk2(xc[0], xc[1]), pk2(xc[2], xc[3]), pk2(xc[4], xc[5]), pk2(xc[6], xc[7])};
            *(LAS u32x4*)(XCb + m * 136 + j0 + 8) = (u32x4){pk2(xc[8], xc[9]), pk2(xc[10], xc[11]), pk2(xc[12], xc[13]), pk2(xc[14], xc[15])};
        }
        __syncthreads();
        {
            const int st = wid & 3, jt0 = (wid >> 2) * 4;
            f32x4 ar[4], ai[4];
#pragma unroll
            for (int j = 0; j < 4; ++j) { ar[j] = (f32x4){0.f, 0.f, 0.f, 0.f}; ai[j] = (f32x4){0.f, 0.f, 0.f, 0.f}; }
#pragma unroll
            for (int ks = 0; ks < 4; ++ks) {
                const bf16x8 a = *(const LAS bf16x8*)(XCb + (st * 16 + fr) * 136 + ks * 32 + fq * 8);
#pragma unroll
                for (int j = 0; j < 4; ++j) { const size_t wo = (size_t)g * 16384 + ((jt0 + j) * 16 + fr) * 128 + ks * 32 + fq * 8;
                    ar[j] = mfma16(a, *(const bf16x8*)(wraT + wo), ar[j]); ai[j] = mfma16(a, *(const bf16x8*)(wriT + wo), ai[j]); }
            }
#pragma unroll
            for (int j = 0; j < 4; ++j) {
                const int col = (jt0 + j) * 16 + fr, c = c0 + col;
                const float bra = P.b_ra[c], bri = P.b_ri[c];
                const float ls = -log1pf(expf(-P.lam[c]));
#pragma unroll
                for (int r = 0; r < 4; ++r) {
                    const int sl = st * 16 + fq * 4 + r;
                    const float rg = sigmoidf_(ar[j][r] + bra), ig = sigmoidf_(ai[j][r] + bri);
                    const float la = 8.0f * rg * ls;
                    const float a = expf(la);
                    const float bv = sqrtf(-expm1f(2.0f * la)) * (ig * XC[sl * 132 + col]);
                    AA[sl * 132 + col] = a; BB[sl * 132 + col] = bv;
                }
            }
        }
        __syncthreads();
        if (tid < 128) {
            const int j = tid;
            float hcur = (MODE == 1) ? Hin[n * 1024 + c0 + j] : 0.f, acum = 1.f;
#pragma unroll 8
            for (int sl = 0; sl < 64; ++sl) { const float a = AA[sl * 132 + j], bv = BB[sl * 132 + j]; hcur = a * hcur + bv; acum *= a; if (MODE == 1) BB[sl * 132 + j] = hcur; }
            if (MODE == 0) { sumA[n * 1024 + c0 + j] = acum; sumH[n * 1024 + c0 + j] = hcur; }
        }
        if (MODE == 1) {
            __syncthreads();
            const bf16_t* gp = proj + (size_t)s * INC + 5120 + c0 + j0;
            const u32x4 g0 = *(const u32x4*)gp, g1 = *(const u32x4*)(gp + 8);
            const unsigned gw[8] = {g0.x, g0.y, g0.z, g0.w, g1.x, g1.y, g1.z, g1.w};
            unsigned ow[8];
#pragma unroll
            for (int q = 0; q < 8; ++q) { const float h0 = BB[m * 132 + j0 + 2 * q], h1 = BB[m * 132 + j0 + 2 * q + 1];
                ow[q] = pk2(h0 * gelu_tanh(bflo(gw[q])), h1 * gelu_tanh(bfhi(gw[q]))); }
            bf16_t* yp = ycat + (size_t)s * D_ + 1024 + c0 + j0;
            *(u32x4*)yp = (u32x4){ow[0], ow[1], ow[2], ow[3]}; *(u32x4*)(yp + 8) = (u32x4){ow[4], ow[5], ow[6], ow[7]};
        }
        __syncthreads();
    }
}
__device__ __forceinline__ void ln1_phase(float* buf, bf16_t* h1b, const float* gam, const float* bet, int G, int b) {
    const int lane = threadIdx.x & 63, wid = threadIdx.x >> 6;
    const int gw = b * NWAVES + wid, NGW = G * NWAVES;
    for (int row = gw; row < S_; row += NGW) {
        float* rp = buf + (size_t)row * D_;
        f32x4 v[8]; float sum = 0.f;
#pragma unroll
        for (int j = 0; j < 8; ++j) { v[j] = *(const f32x4*)(rp + 256 * j + 4 * lane); sum += (v[j].x + v[j].y) + (v[j].z + v[j].w); }
        const float mean = wave_sum(sum) * (1.0f / D_); float sq = 0.f;
#pragma unroll
        for (int j = 0; j < 8; ++j) { v[j] = v[j] - mean; sq += (v[j].x * v[j].x + v[j].y * v[j].y) + (v[j].z * v[j].z + v[j].w * v[j].w); }
        const float rstd = 1.0f / sqrtf(wave_sum(sq) * (1.0f / D_) + LN_EPS);
#pragma unroll
        for (int j = 0; j < 8; ++j) {
            const f32x4 gg = *(const f32x4*)(gam + 256 * j + 4 * lane), bb = *(const f32x4*)(bet + 256 * j + 4 * lane);
            const f32x4 o = v[j] * rstd * gg + bb;
            *(f32x4*)(rp + 256 * j + 4 * lane) = o;
            *(u32x2*)(h1b + (size_t)row * D_ + 256 * j + 4 * lane) = (u32x2){pk2(o.x, o.y), pk2(o.z, o.w)};
        }
    }
}
__device__ __forceinline__ unsigned mono(float f) { const unsigned u = __float_as_uint(f); return (u & 0x80000000u) ? ~u : (u ^ 0x80000000u); }
__device__ __forceinline__ float unmono(unsigned u) { return __uint_as_float((u & 0x80000000u) ? (u ^ 0x80000000u) : ~u); }
__device__ __forceinline__ unsigned umax_(unsigned a, unsigned b) { return a > b ? a : b; }
__device__ __forceinline__ constexpr int cand_i(int c) { return c < 16 ? 0 : c < 24 ? 1 : c < 29 ? 2 : c < 33 ? 3 : c < 36 ? 4 : c < 38 ? 5 : c < 40 ? 6 : c < 42 ? 7 : c - 34; }
__device__ __forceinline__ constexpr int cand_j(int c) { return c < 16 ? c : c < 24 ? c - 16 : c < 29 ? c - 24 : c < 33 ? c - 29 : c < 36 ? c - 33 : c < 38 ? c - 36 : c < 40 ? c - 38 : c < 42 ? c - 40 : 0; }

__device__ __forceinline__ void topk_phase(LAS unsigned char* lds, const bf16_t* qp, const bf16_t* keys, int* sel_e, float* sel_g, int G, int b) {
    const int tid = threadIdx.x, lane = tid & 63, wid = tid >> 6, fr = lane & 15, fq = lane >> 4;
    LAS unsigned* wl = (LAS unsigned*)(lds + wid * 2048 + fr * 128);
    for (int unit = b; unit < (S_ / 128) * 8; unit += G) {
        const int tt = unit >> 3, h = unit & 7;
        const int tok = tt * 128 + wid * 16 + fr;
        unsigned w[2][16];
#pragma unroll
        for (int p = 0; p < 2; ++p) {
            f32x4 acc[8];
#pragma unroll
            for (int mt = 0; mt < 8; ++mt) acc[mt] = (f32x4){0.f, 0.f, 0.f, 0.f};
            bf16x8 bq[4];
#pragma unroll
            for (int ks = 0; ks < 4; ++ks) bq[ks] = *(const bf16x8*)(qp + (size_t)tok * D_ + h * 256 + p * 128 + ks * 32 + fq * 8);
            const bf16_t* kb = keys + (size_t)(h * 2 + p) * 16384;
#pragma unroll
            for (int mt = 0; mt < 8; ++mt)
#pragma unroll
                for (int ks = 0; ks < 4; ++ks) { const bf16x8 a = *(const bf16x8*)(kb + (mt * 16 + fr) * 128 + ks * 32 + fq * 8); acc[mt] = mfma16(a, bq[ks], acc[mt]); }
            unsigned pk[32];
#pragma unroll
            for (int mt = 0; mt < 8; ++mt)
#pragma unroll
                for (int r = 0; r < 4; ++r) pk[mt * 4 + r] = (mono(acc[mt][r]) & ~127u) | (unsigned)(127 - (mt * 16 + fq * 4 + r));
            unsigned prev = 0xFFFFFFFFu;
#pragma unroll
            for (int i = 0; i < 16; ++i) {
                unsigned mx = 0u;
#pragma unroll
                for (int j = 0; j < 32; ++j) { const unsigned x = pk[j] < prev ? pk[j] : 0u; mx = umax_(mx, x); }
                mx = umax_(mx, (unsigned)__shfl_xor((int)mx, 16)); mx = umax_(mx, (unsigned)__shfl_xor((int)mx, 32));
                w[p][i] = mx; prev = mx;
            }
        }
        float v1[16], v2[16];
#pragma unroll
        for (int i = 0; i < 16; ++i) { v1[i] = unmono(w[0][i] & ~127u); v2[i] = unmono(w[1][i] & ~127u); }
        unsigned ck[13];
#pragma unroll
        for (int sidx = 0; sidx < 13; ++sidx) {
            unsigned keyk[4];
#pragma unroll
            for (int k = 0; k < 4; ++k) {
                const int c = 4 * sidx + k;
                if (c < 50) { const int ci = cand_i(c), cj = cand_j(c); keyk[k] = (mono(v1[ci] + v2[cj]) & ~255u) | (unsigned)(255 - (ci * 16 + cj)); }
                else keyk[k] = 0u;
            }
            ck[sidx] = fq == 0 ? keyk[0] : fq == 1 ? keyk[1] : fq == 2 ? keyk[2] : keyk[3];
        }
        unsigned W2[16];
        {
            unsigned prev = 0xFFFFFFFFu;
#pragma unroll
            for (int k = 0; k < 16; ++k) {
                unsigned mx = 0u;
#pragma unroll
                for (int sidx = 0; sidx < 13; ++sidx) { const unsigned x = ck[sidx] < prev ? ck[sidx] : 0u; mx = umax_(mx, x); }
                mx = umax_(mx, (unsigned)__shfl_xor((int)mx, 16)); mx = umax_(mx, (unsigned)__shfl_xor((int)mx, 32));
                W2[k] = mx; prev = mx;
            }
        }
        float ev[16]; float esum = 0.f; const float vmax = unmono(W2[0] & ~255u);
#pragma unroll
        for (int k = 0; k < 16; ++k) { ev[k] = __expf(unmono(W2[k] & ~255u) - vmax); esum += ev[k]; }
        const float einv = 1.0f / esum;
        __syncthreads();
        if (fq == 0) {
#pragma unroll
            for (int i = 0; i < 16; ++i) { wl[i] = w[0][i]; wl[16 + i] = w[1][i]; }
        }
        __syncthreads();
#pragma unroll
        for (int k = 0; k < 16; ++k) {
            if ((k >> 2) == fq) {
                const unsigned id = 255u - (W2[k] & 255u);
                const unsigned e1 = 127u - (wl[id >> 4] & 127u), e2 = 127u - (wl[16 + (id & 15u)] & 127u);
                const size_t o = ((size_t)tok * 8 + h) * 16 + k;
                sel_e[o] = (int)(e1 * 128u + e2); sel_g[o] = ev[k] * einv;
            }
        }
    }
}
__device__ __forceinline__ void peer_row(const bf16_t* tab, int e, int lane, u32x4 (&r)[4]) {
    const u32x4* p = (const u32x4*)(tab + (size_t)e * D_) + lane;
#pragma unroll
    for (int jj = 0; jj < 4; ++jj) r[jj] = p[64 * jj];
}
__device__ __forceinline__ void peer_use(const u32x4 (&u)[4], const u32x4 (&v)[4], const float (&x)[32], float (&acc)[32], float gate) {
    float d = 0.f;
#pragma unroll
    for (int jj = 0; jj < 4; ++jj) {
        const unsigned w[4] = {u[jj].x, u[jj].y, u[jj].z, u[jj].w};
#pragma unroll
        for (int q = 0; q < 4; ++q) { d += x[jj * 8 + 2 * q] * bflo(w[q]); d += x[jj * 8 + 2 * q + 1] * bfhi(w[q]); }
    }
    d = wave_sum(d);
    const float coef = gate * gelu_tanh(d);
#pragma unroll
    for (int jj = 0; jj < 4; ++jj) {
        const unsigned w[4] = {v[jj].x, v[jj].y, v[jj].z, v[jj].w};
#pragma unroll
        for (int q = 0; q < 4; ++q) { acc[jj * 8 + 2 * q] += coef * bflo(w[q]); acc[jj * 8 + 2 * q + 1] += coef * bfhi(w[q]); }
    }
}
__device__ __forceinline__ void peer_phase(float* hbuf  , const bf16_t* UB, const bf16_t* VB, const int* sel_e, const float* sel_g,
                                           const float* gam, const float* bet, int G, int b) {
    const int lane = threadIdx.x & 63, wid = threadIdx.x >> 6;
    const int gw = b * NWAVES + wid, NGW = G * NWAVES;
    for (int tok = gw; tok < S_; tok += NGW) {
        float* rp = hbuf + (size_t)tok * D_;
        float x[32], acc[32];
#pragma unroll
        for (int jj = 0; jj < 4; ++jj) { const f32x4 a = *(const f32x4*)(rp + 512 * jj + 8 * lane), c = *(const f32x4*)(rp + 512 * jj + 8 * lane + 4);
            x[jj * 8] = a.x; x[jj * 8 + 1] = a.y; x[jj * 8 + 2] = a.z; x[jj * 8 + 3] = a.w; x[jj * 8 + 4] = c.x; x[jj * 8 + 5] = c.y; x[jj * 8 + 6] = c.z; x[jj * 8 + 7] = c.w; }
#pragma unroll
        for (int i = 0; i < 32; ++i) acc[i] = 0.f;
        const int e0 = sel_e[(size_t)tok * 128 + lane], e1 = sel_e[(size_t)tok * 128 + 64 + lane];
        const float g0 = sel_g[(size_t)tok * 128 + lane], g1 = sel_g[(size_t)tok * 128 + 64 + lane];
        u32x4 ua[4], va[4], ub[4], vb[4];
#pragma unroll
        for (int half = 0; half < 2; ++half) {
            const int ev = half ? e1 : e0; const float gv = half ? g1 : g0;
            { const int e = __builtin_amdgcn_readlane(ev, 0); peer_row(UB, e, lane, ua); peer_row(VB, e, lane, va); }
            for (int k = 0; k < 64; k += 2) {
                { const int e = __builtin_amdgcn_readlane(ev, k + 1); peer_row(UB, e, lane, ub); peer_row(VB, e, lane, vb); }
                peer_use(ua, va, x, acc, __uint_as_float(__builtin_amdgcn_readlane(__float_as_uint(gv), k)));
                if (k + 2 < 64) { const int e = __builtin_amdgcn_readlane(ev, k + 2); peer_row(UB, e, lane, ua); peer_row(VB, e, lane, va); }
                peer_use(ub, vb, x, acc, __uint_as_float(__builtin_amdgcn_readlane(__float_as_uint(gv), k + 1)));
            }
        }
        float sum = 0.f;
#pragma unroll
        for (int i = 0; i < 32; ++i) { acc[i] = DN_ALPHA * x[i] + acc[i]; sum += acc[i]; }
        const float mean = wave_sum(sum) * (1.0f / D_); float sq = 0.f;
#pragma unroll
        for (int i = 0; i < 32; ++i) { acc[i] -= mean; sq += acc[i] * acc[i]; }
        const float rstd = 1.0f / sqrtf(wave_sum(sq) * (1.0f / D_) + LN_EPS);
#pragma unroll
        for (int jj = 0; jj < 4; ++jj) {
            const int col = 512 * jj + 8 * lane;
            const f32x4 ga = *(const f32x4*)(gam + col), gb = *(const f32x4*)(gam + col + 4), ba = *(const f32x4*)(bet + col), bb = *(const f32x4*)(bet + col + 4);
            *(f32x4*)(rp + col) = (f32x4){acc[jj * 8] * rstd * ga.x + ba.x, acc[jj * 8 + 1] * rstd * ga.y + ba.y, acc[jj * 8 + 2] * rstd * ga.z + ba.z, acc[jj * 8 + 3] * rstd * ga.w + ba.w};
            *(f32x4*)(rp + col + 4) = (f32x4){acc[jj * 8 + 4] * rstd * gb.x + bb.x, acc[jj * 8 + 5] * rstd * gb.y + bb.y, acc[jj * 8 + 6] * rstd * gb.z + bb.z, acc[jj * 8 + 7] * rstd * gb.w + bb.w};
        }
    }
}
#define PRELUDE extern __shared__ __attribute__((aligned(16))) unsigned char lds_raw[]; LAS unsigned char* lds = (LAS unsigned char*)lds_raw; unsigned char* ws = P.ws; (void)ws; (void)lds;
__global__ void __launch_bounds__(NTHREADS, 2) k_prologue(Ptrs P) { PRELUDE; prologue_phase(lds, P, gridDim.x, blockIdx.x); }
__global__ void __launch_bounds__(NTHREADS, 2) k_gemm_proj(Ptrs P) { PRELUDE;
    pg8::Gemm g{(const pg8::bf16_t*)(ws + WS_XB), (const pg8::bf16_t*)(ws + WS_WIN_T), S_, INC, D_};
    pg8::StaticOrder S; S.init(S_, INC, gridDim.x, blockIdx.x);
    pg8::EpiBf16<0> E{(pg8::bf16_t*)(ws + WS_PROJ), INC, nullptr, 0, 0, 1.f};
    pg8::gemm_phase<pg8::EpiBf16<0>, pg8::StaticOrder, true, true>(lds, g, S, E); }
__global__ void __launch_bounds__(NTHREADS, 2) k_ret_kv(Ptrs P) { PRELUDE;
    ret_kv_phase(lds, (const bf16_t*)(ws + WS_PROJ), (const float*)(ws + WS_COS), (const float*)(ws + WS_SIN), (bf16_t*)(ws + WS_KVS), gridDim.x, blockIdx.x); }
__global__ void __launch_bounds__(NTHREADS, 2) k_lru_a(Ptrs P) { PRELUDE;
    lru_phase<0>(lds, (const bf16_t*)(ws + WS_PROJ), P, (const bf16_t*)(ws + WS_WRA_T), (const bf16_t*)(ws + WS_WRI_T), (float*)(ws + WS_SUMA), (float*)(ws + WS_SUMH), (const float*)(ws + WS_HIN), (bf16_t*)(ws + WS_YCAT), gridDim.x, blockIdx.x); }
__global__ void __launch_bounds__(NTHREADS, 2) k_scan(Ptrs P) { PRELUDE;
    scan_phase((bf16_t*)(ws + WS_KVS), (const float*)(ws + WS_SUMA), (const float*)(ws + WS_SUMH), (float*)(ws + WS_HIN), gridDim.x, blockIdx.x); }
__global__ void __launch_bounds__(NTHREADS, 2) k_ret_out(Ptrs P) { PRELUDE;
    ret_out_phase(lds, (const bf16_t*)(ws + WS_PROJ), (const float*)(ws + WS_COS), (const float*)(ws + WS_SIN), (const bf16_t*)(ws + WS_KVS), (bf16_t*)(ws + WS_YCAT), gridDim.x, blockIdx.x); }
__global__ void __launch_bounds__(NTHREADS, 2) k_lru_c(Ptrs P) { PRELUDE;
    lru_phase<1>(lds, (const bf16_t*)(ws + WS_PROJ), P, (const bf16_t*)(ws + WS_WRA_T), (const bf16_t*)(ws + WS_WRI_T), (float*)(ws + WS_SUMA), (float*)(ws + WS_SUMH), (const float*)(ws + WS_HIN), (bf16_t*)(ws + WS_YCAT), gridDim.x, blockIdx.x); }
__global__ void __launch_bounds__(NTHREADS, 2) k_gemm_mix(Ptrs P) { PRELUDE;
    pg8::Gemm g{(const pg8::bf16_t*)(ws + WS_YCAT), (const pg8::bf16_t*)(ws + WS_WOUT_T), S_, D_, D_};
    pg8::StaticOrder S; S.init(S_, D_, gridDim.x, blockIdx.x);
    pg8::EpiResF32 E{P.x, P.out, D_, DN_ALPHA};
    pg8::gemm_phase<pg8::EpiResF32, pg8::StaticOrder, true, true>(lds, g, S, E); }
__global__ void __launch_bounds__(NTHREADS, 2) k_ln1(Ptrs P) { PRELUDE;
    ln1_phase(P.out, (bf16_t*)(ws + WS_H1B), P.ln1_g, P.ln1_b, gridDim.x, blockIdx.x); }
__global__ void __launch_bounds__(NTHREADS, 2) k_gemm_q(Ptrs P) { PRELUDE;
    pg8::Gemm g{(const pg8::bf16_t*)(ws + WS_H1B), (const pg8::bf16_t*)(ws + WS_WPQ_T), S_, D_, D_};
    pg8::StaticOrder S; S.init(S_, D_, gridDim.x, blockIdx.x);
    pg8::EpiBf16<0> E{(pg8::bf16_t*)(ws + WS_QP), D_, nullptr, 0, 0, 1.f};
    pg8::gemm_phase<pg8::EpiBf16<0>, pg8::StaticOrder, true, true>(lds, g, S, E); }
__global__ void __launch_bounds__(NTHREADS, 2) k_topk(Ptrs P) { PRELUDE;
    topk_phase(lds, (const bf16_t*)(ws + WS_QP), (const bf16_t*)(ws + WS_KEYS), (int*)(ws + WS_SELE), (float*)(ws + WS_SELG), gridDim.x, blockIdx.x); }
__global__ void __launch_bounds__(NTHREADS, 2) k_peer(Ptrs P) { PRELUDE;
    peer_phase(P.out, (const bf16_t*)(ws + WS_UB), (const bf16_t*)(ws + WS_VB), (const int*)(ws + WS_SELE), (const float*)(ws + WS_SELG), P.ln2_g, P.ln2_b, gridDim.x, blockIdx.x); }

extern "C" void kernel_launch(void* const* d_in, const int* in_sizes, int n_in, void* d_out, int out_size, void* d_ws, size_t ws_size, hipStream_t stream) {
    static int grid = 0;
    if (grid == 0) {
        if (n_in != 19 || in_sizes[0] != S_ * D_ || out_size != S_ * D_ || ws_size < WS_END) {
            fprintf(stderr, "kernel_launch: unexpected shapes: n_in %d in0 %d out %d ws %zu (need >= %zu)\n", n_in, n_in > 0 ? in_sizes[0] : -1, out_size, ws_size, (size_t)WS_END); grid = -1; return; }
        int dev = 0, cus = 0;
        if (hipGetDevice(&dev) != hipSuccess || hipDeviceGetAttribute(&cus, hipDeviceAttributeMultiprocessorCount, dev) != hipSuccess) { grid = -1; return; }
        const void* ks[] = {(const void*)k_prologue, (const void*)k_gemm_proj, (const void*)k_ret_kv, (const void*)k_lru_a, (const void*)k_scan, (const void*)k_ret_out, (const void*)k_lru_c,
                            (const void*)k_gemm_mix, (const void*)k_ln1, (const void*)k_gemm_q, (const void*)k_topk, (const void*)k_peer};
        for (const void* k : ks) if (hipFuncSetAttribute(k, hipFuncAttributeMaxDynamicSharedMemorySize, LDS_BYTES) != hipSuccess) { fprintf(stderr, "kernel_launch: hipFuncSetAttribute failed\n"); grid = -1; return; }
        grid = cus;
    }
    if (grid < 0) return;
    Ptrs P{};
    P.x = (const float*)d_in[0]; P.pos = (const int*)d_in[1]; P.w_in = (const float*)d_in[2]; P.w_out = (const float*)d_in[3]; P.conv_w = (const float*)d_in[4]; P.conv_b = (const float*)d_in[5];
    P.w_ra = (const float*)d_in[6]; P.b_ra = (const float*)d_in[7]; P.w_ri = (const float*)d_in[8]; P.b_ri = (const float*)d_in[9]; P.lam = (const float*)d_in[10];
    P.ln1_g = (const float*)d_in[11]; P.ln1_b = (const float*)d_in[12]; P.w_pq = (const float*)d_in[13]; P.sub_keys = (const float*)d_in[14]; P.peer_u = (const float*)d_in[15]; P.peer_v = (const float*)d_in[16];
    P.ln2_g = (const float*)d_in[17]; P.ln2_b = (const float*)d_in[18]; P.out = (float*)d_out; P.ws = (unsigned char*)d_ws;
    const dim3 g(grid), t(NTHREADS);
    hipLaunchKernelGGL(k_prologue, g, t, LDS_BYTES, stream, P);
    hipLaunchKernelGGL(k_gemm_proj, g, t, LDS_BYTES, stream, P);
    hipLaunchKernelGGL(k_ret_kv, g, t, LDS_BYTES, stream, P);
    hipLaunchKernelGGL(k_lru_a, g, t, LDS_BYTES, stream, P);
    hipLaunchKernelGGL(k_scan, g, t, LDS_BYTES, stream, P);
    hipLaunchKernelGGL(k_ret_out, g, t, LDS_BYTES, stream, P);
    hipLaunchKernelGGL(k_lru_c, g, t, LDS_BYTES, stream, P);
    hipLaunchKernelGGL(k_gemm_mix, g, t, LDS_BYTES, stream, P);
    hipLaunchKernelGGL(k_ln1, g, t, LDS_BYTES, stream, P);
    hipLaunchKernelGGL(k_gemm_q, g, t, LDS_BYTES, stream, P);
    hipLaunchKernelGGL(k_topk, g, t, LDS_BYTES, stream, P);
    hipLaunchKernelGGL(k_peer, g, t, LDS_BYTES, stream, P);
}
```

```cpp
#include <hip/hip_runtime.h>
#include <cstdio>
#include <cstdint>
#include <cmath>

namespace pg8 {
#define PG8_LAS __attribute__((address_space(3)))
typedef unsigned short bf16_t;
typedef short bf16x8 __attribute__((ext_vector_type(8)));
typedef float f32x4 __attribute__((ext_vector_type(4)));
typedef unsigned u32x4 __attribute__((ext_vector_type(4)));
constexpr int BM = 256, BK = 64, HALF = 128, HTB = HALF * BK * 2  , STAGE_BYTES = 8 * HTB, NXCD = 8, WGM = 8;

__host__ __device__ __forceinline__ int lds_byte(int r, int c) { const int st = (r >> 4) * 2 + (c >> 5), rr = r & 15, cc = c & 31, ob = rr * 64 + cc * 2; return st * 1024 + (ob ^ (((ob >> 9) & 1) << 5)); }
__host__ __device__ __forceinline__ void stage_rc(int b, int& R, int& C) { const int st = b / 1024, sb = b % 1024, swz = sb ^ (((sb >> 9) & 1) << 5); R = (st >> 1) * 16 + swz / 64; C = (st & 1) * 32 + (swz % 64) / 2; }
__host__ __device__ __forceinline__ int perm32(int rho) { const int n = rho >> 4, i = rho & 15; return 8 * (i >> 2) + 4 * n + (i & 3); }

struct Unit { int pm, pn; };
struct Gemm { const bf16_t* A; const bf16_t* Bt; int M, N, K; };

struct StaticOrder {
    int nM, nN, nwg, G, c;
    __host__ __device__ void init(int M, int N, int G_, int c_) { nM = M / BM; nN = N / BM; nwg = nM * nN; G = G_; c = c_; }
    __host__ __device__ bool next(int i, Unit& u) const {
        const long L = (long)i * G + c; if (L >= nwg) return false;
        int wgid = (int)L; { const int q = nwg / NXCD, r = nwg % NXCD, xcd = wgid % NXCD, off = wgid / NXCD; wgid = (xcd < r ? xcd * (q + 1) : r * (q + 1) + (xcd - r) * q) + off; }
        const int nig = WGM * nN, gid = wgid / nig, fm = gid * WGM, gsz = (nM - fm) < WGM ? (nM - fm) : WGM;
        u.pm = fm + ((wgid % nig) % gsz); u.pn = (wgid % nig) / gsz; return true;
    }
    __device__ __forceinline__ void a_ready(const Unit&) const {}
    __device__ __forceinline__ void done(const Unit&) const {}
};

__device__ __forceinline__ unsigned cvt_pk_bf16(float lo, float hi) { unsigned r; asm volatile("v_cvt_pk_bf16_f32 %0, %1, %2" : "=v"(r) : "v"(lo), "v"(hi)); return r; }
typedef float f32x2 __attribute__((ext_vector_type(2)));
__device__ __forceinline__ f32x2 gelu_pk(f32x2 v) {
    const f32x2 av = __builtin_elementwise_abs(v), d = av * 0.2316418882f + 1.0f;
    f32x2 t; t.x = __builtin_amdgcn_rcpf(d.x); t.y = __builtin_amdgcn_rcpf(d.y);
    f32x2 q = t * 0.5307027145f + (-0.7265760135f); q = q * t + 0.7107068705f; q = q * t + (-0.142248368f); q = q * t + 0.127414796f; q = q * t;
    const f32x2 s = (v * v) * (-0.72134752044f);
    f32x2 e; e.x = __builtin_amdgcn_exp2f(s.x); e.y = __builtin_amdgcn_exp2f(s.y);
    const f32x2 m = v * (q * e), r = v - m;
    f32x2 o; o.x = v.x < 0.f ? m.x : r.x; o.y = v.y < 0.f ? m.y : r.y; return o;
}

template <int ACT  > struct EpiBf16 {
    static constexpr bool PERM = true, AFTER_DRAIN = false; static_assert(ACT == 0 || ACT == 1, "EpiBf16: ACT is 0 (none) or 1 (gelu_pk)");
    bf16_t* O; int ldc; const float* bias; int split_cols; size_t split_stride; float scale0;
    __device__ __forceinline__ void operator()(const f32x4 (&acc)[2][2][4][2], const Unit& u, int wr, int wc, int fr, int fq) const {
        const int row0 = u.pm * BM + wr * 64 + fr; int colt = u.pn * BM; bf16_t* base = O;
        float sc = 1.f; if (split_cols) { const int t = colt / split_cols; base += (size_t)t * split_stride; colt -= t * split_cols; if (t == 0) sc = scale0; }
        const int col0 = colt + wc * 32 + 8 * fq, bcol0 = u.pn * BM + wc * 32 + 8 * fq;
        f32x4 bv[2][2];
#pragma unroll
        for (int bj = 0; bj < 2; ++bj)
#pragma unroll
            for (int n = 0; n < 2; ++n) bv[bj][n] = bias ? *(const f32x4*)(bias + bcol0 + bj * HALF + 4 * n) : (f32x4){0.f, 0.f, 0.f, 0.f};
#pragma unroll
        for (int ai = 0; ai < 2; ++ai)
#pragma unroll
            for (int m = 0; m < 4; ++m) { bf16_t* rowp = base + (size_t)(row0 + ai * HALF + m * 16) * ldc + col0;
#pragma unroll
                for (int bj = 0; bj < 2; ++bj) { f32x4 v0 = acc[ai][bj][m][0] + bv[bj][0], v1 = acc[ai][bj][m][1] + bv[bj][1];
                    if (ACT == 1) { f32x2 a = gelu_pk((f32x2){v0[0], v0[1]}), b = gelu_pk((f32x2){v0[2], v0[3]}), c = gelu_pk((f32x2){v1[0], v1[1]}), d = gelu_pk((f32x2){v1[2], v1[3]});
                        v0 = (f32x4){a.x, a.y, b.x, b.y}; v1 = (f32x4){c.x, c.y, d.x, d.y}; }
                    v0 = v0 * sc; v1 = v1 * sc; u32x4 w; w.x = cvt_pk_bf16(v0[0], v0[1]); w.y = cvt_pk_bf16(v0[2], v0[3]); w.z = cvt_pk_bf16(v1[0], v1[1]); w.w = cvt_pk_bf16(v1[2], v1[3]);
                    *(u32x4*)(rowp + bj * HALF) = w; } }
    }
};
struct EpiResF32 {
    static constexpr bool PERM = false, AFTER_DRAIN = false;
    const float* base; float* out; int ldc; float alpha;
    __device__ __forceinline__ void operator()(const f32x4 (&acc)[2][2][4][2], const Unit& u, int wr, int wc, int fr, int fq) const {
        const int row0 = u.pm * BM + wr * 64 + fr, col0 = u.pn * BM + wc * 32 + 4 * fq;
#pragma unroll
        for (int ai = 0; ai < 2; ++ai)
#pragma unroll
            for (int m = 0; m < 4; ++m) { const size_t off = (size_t)(row0 + ai * HALF + m * 16) * ldc + col0;
#pragma unroll
                for (int bj = 0; bj < 2; ++bj)
#pragma unroll
                    for (int n = 0; n < 2; ++n) { const f32x4 bs = *(const f32x4*)(base + off + bj * HALF + n * 16); *(f32x4*)(out + off + bj * HALF + n * 16) = bs * alpha + acc[ai][bj][m][n]; }
                asm volatile("" ::: "memory"); }
    }
};
template <class Epi, class Sched, bool ALIGN_EPI = false, bool SP2 = false>
__device__ __forceinline__ void gemm_phase(PG8_LAS unsigned char* lds, const Gemm g, const Sched& S, const Epi& E) {
    const int tid = threadIdx.x, wid = __builtin_amdgcn_readfirstlane(tid >> 6), lane = tid & 63, wr = wid >> 2, wc = wid & 3, fr = lane & 15, fq = lane >> 4;
    const int K = g.K, nt = K / BK;
    unsigned voffA[2], voffB[2];
#pragma unroll
    for (int i = 0; i < 2; ++i) { int R, C; stage_rc(tid * 16 + i * 8192, R, C); const int Rb = Epi::PERM ? ((R & ~31) + perm32(R & 31)) : R;
        voffA[i] = (unsigned)(R * K + C) * 2u; voffB[i] = (unsigned)(Rb * K + C) * 2u; }
    const size_t kstep = (size_t)(BK * 2);
    const size_t hstep = (size_t)HALF * K * 2;
    const size_t tstep = 2 * hstep;
    const unsigned ldsw = (unsigned)wid * 1024u;
    const int aoff = lds_byte(wr * 64 + fr, fq * 8), boff = lds_byte(wc * 32 + fr, fq * 8);
#define PG8_SA(b, h) (((b) * 2 + (h)) * HTB)
#define PG8_SB(b, h) ((4 + (b) * 2 + (h)) * HTB)
#define PG8_STAGE(bufoff, gbase, voff) do { _Pragma("unroll") for (int _i = 0; _i < 2; ++_i) \
        __builtin_amdgcn_global_load_lds((const unsigned*)((const char*)(gbase) + (voff)[_i]), (PG8_LAS unsigned*)(lds + (bufoff) + ldsw + _i * 8192), 16, 0, 0); } while (0)
#define PG8_LDA(dst, b, h) do { _Pragma("unroll") for (int m = 0; m < 4; ++m) _Pragma("unroll") for (int k = 0; k < 2; ++k) dst[m][k] = *(const PG8_LAS bf16x8*)(lds + PG8_SA(b, h) + aoff + m * 2048 + k * 1024); } while (0)
#define PG8_LDB(dst, b, h) do { _Pragma("unroll") for (int n = 0; n < 2; ++n) _Pragma("unroll") for (int k = 0; k < 2; ++k) dst[n][k] = *(const PG8_LAS bf16x8*)(lds + PG8_SB(b, h) + boff + n * 2048 + k * 1024); } while (0)
#define PG8_MMA(ai, bj, At, Bt) do { __builtin_amdgcn_s_setprio(1); _Pragma("unroll") for (int m = 0; m < 4; ++m) _Pragma("unroll") for (int n = 0; n < 2; ++n) _Pragma("unroll") for (int k = 0; k < 2; ++k) \
        acc[ai][bj][m][n] = __builtin_amdgcn_mfma_f32_16x16x32_bf16(Bt[n][k], At[m][k], acc[ai][bj][m][n], 0, 0, 0); __builtin_amdgcn_s_setprio(0); } while (0)
#define PG8_WAIT_V(n) asm volatile("s_waitcnt vmcnt(" #n ")" ::: "memory")
#define PG8_WAIT_L(n) asm volatile("s_waitcnt lgkmcnt(" #n ")" ::: "memory")
#define PG8_BAR __builtin_amdgcn_s_barrier()
#define PG8_SCHED __builtin_amdgcn_sched_barrier(0)
    Unit cur, nxt; int ui = 0;
    if (!S.next(0, cur)) return;
    f32x4 acc[2][2][4][2];
#pragma unroll
    for (int a = 0; a < 2; ++a)
#pragma unroll
        for (int b = 0; b < 2; ++b)
#pragma unroll
            for (int m = 0; m < 4; ++m)
#pragma unroll
                for (int n = 0; n < 2; ++n) acc[a][b][m][n] = (f32x4){0.f, 0.f, 0.f, 0.f};
    bf16x8 At[4][2], B0[2][2], B1[2][2];
    const char* cA = (const char*)g.A + (size_t)cur.pm * tstep; const char* cB = (const char*)g.Bt + (size_t)cur.pn * tstep;
    S.a_ready(cur);
    if constexpr (SP2) {
        PG8_STAGE(PG8_SB(0, 0), cB, voffB); PG8_STAGE(PG8_SB(0, 1), cB + hstep, voffB); PG8_STAGE(PG8_SA(0, 0), cA, voffA); PG8_STAGE(PG8_SA(0, 1), cA + hstep, voffA);
        if (wr == 1) PG8_BAR;
        PG8_WAIT_V(2); PG8_BAR;
        PG8_STAGE(PG8_SB(1, 0), cB + kstep, voffB); PG8_STAGE(PG8_SA(1, 0), cA + kstep, voffA); PG8_STAGE(PG8_SB(1, 1), cB + hstep + kstep, voffB);
        PG8_WAIT_V(6); PG8_BAR;
    } else {
        PG8_STAGE(PG8_SB(0, 0), cB, voffB); PG8_STAGE(PG8_SA(0, 0), cA, voffA); PG8_STAGE(PG8_SB(0, 1), cB + hstep, voffB); PG8_STAGE(PG8_SA(0, 1), cA + hstep, voffA);
        if (wr == 1) PG8_BAR;
        PG8_WAIT_V(4); PG8_BAR;
        PG8_STAGE(PG8_SB(1, 0), cB + kstep, voffB); PG8_STAGE(PG8_SA(1, 0), cA + kstep, voffA); PG8_STAGE(PG8_SB(1, 1), cB + hstep + kstep, voffB);
        PG8_WAIT_V(6); PG8_BAR;
    }
    for (;;) {
        const bool has_next = S.next(ui + 1, nxt);
        const char* nA = has_next ? (const char*)g.A + (size_t)nxt.pm * tstep : cA; const char* nB = has_next ? (const char*)g.Bt + (size_t)nxt.pn * tstep : cB;
        for (int t = 0; t < nt; t += 2) {
            const bool last = (t == nt - 2);
            const char* a1 = cA + (size_t)(t + 1) * kstep;
            const char* a2 = last ? nA : cA + (size_t)(t + 2) * kstep; const char* b2 = last ? nB : cB + (size_t)(t + 2) * kstep;
            const char* a3 = a2 + kstep; const char* b3 = b2 + kstep;
            if (last && has_next) S.a_ready(nxt);
            if constexpr (SP2) {
            PG8_LDB(B0, 0, 0); PG8_LDB(B1, 0, 1); PG8_SCHED; PG8_LDA(At, 0, 0); PG8_STAGE(PG8_SA(1, 1), a1 + hstep, voffA);
            PG8_WAIT_V(8); PG8_WAIT_L(0); PG8_BAR; PG8_MMA(0, 0, At, B0); PG8_MMA(0, 1, At, B1); PG8_BAR; PG8_SCHED;
            PG8_LDA(At, 0, 1); PG8_STAGE(PG8_SB(0, 0), b2, voffB); PG8_STAGE(PG8_SB(0, 1), b2 + hstep, voffB); PG8_STAGE(PG8_SA(0, 0), a2, voffA);
            PG8_WAIT_V(8); PG8_WAIT_L(0); PG8_BAR; PG8_MMA(1, 0, At, B0); PG8_MMA(1, 1, At, B1); PG8_BAR; PG8_SCHED;
            PG8_LDB(B0, 1, 0); PG8_LDB(B1, 1, 1); PG8_SCHED; PG8_LDA(At, 1, 0); PG8_STAGE(PG8_SA(0, 1), a2 + hstep, voffA);
            PG8_WAIT_V(8); PG8_WAIT_L(0); PG8_BAR; PG8_MMA(0, 0, At, B0); PG8_MMA(0, 1, At, B1); PG8_BAR; PG8_SCHED;
            PG8_LDA(At, 1, 1); PG8_STAGE(PG8_SB(1, 0), b3, voffB); PG8_STAGE(PG8_SB(1, 1), b3 + hstep, voffB); PG8_STAGE(PG8_SA(1, 0), a3, voffA);
            PG8_WAIT_V(8); PG8_WAIT_L(0); PG8_BAR; PG8_MMA(1, 0, At, B0); PG8_MMA(1, 1, At, B1); PG8_BAR; PG8_SCHED;
            } else {
            PG8_LDB(B0, 0, 0); PG8_SCHED; PG8_LDA(At, 0, 0); PG8_STAGE(PG8_SA(1, 1), a1 + hstep, voffA);
            PG8_WAIT_L(8); PG8_BAR; PG8_WAIT_L(0); PG8_MMA(0, 0, At, B0); PG8_BAR; PG8_SCHED;
            PG8_LDB(B1, 0, 1); PG8_STAGE(PG8_SB(0, 0), b2, voffB);
            PG8_BAR; PG8_WAIT_L(0); PG8_MMA(0, 1, At, B1); PG8_BAR;
            PG8_LDA(At, 0, 1); PG8_STAGE(PG8_SA(0, 0), a2, voffA);
            PG8_BAR; PG8_WAIT_L(0); PG8_MMA(1, 0, At, B0); PG8_BAR; PG8_SCHED;
            PG8_STAGE(PG8_SB(0, 1), b2 + hstep, voffB);
            PG8_WAIT_V(6); PG8_BAR; PG8_MMA(1, 1, At, B1); PG8_BAR;
            PG8_LDB(B0, 1, 0); PG8_SCHED; PG8_LDA(At, 1, 0); PG8_STAGE(PG8_SA(0, 1), a2 + hstep, voffA);
            PG8_WAIT_L(8); PG8_BAR; PG8_WAIT_L(0); PG8_MMA(0, 0, At, B0); PG8_BAR; PG8_SCHED;
            PG8_LDB(B1, 1, 1); PG8_STAGE(PG8_SB(1, 0), b3, voffB);
            PG8_BAR; PG8_WAIT_L(0); PG8_MMA(0, 1, At, B1); PG8_BAR;
            PG8_LDA(At, 1, 1); PG8_STAGE(PG8_SA(1, 0), a3, voffA);
            PG8_BAR; PG8_WAIT_L(0); PG8_MMA(1, 0, At, B0); PG8_BAR; PG8_SCHED;
            PG8_STAGE(PG8_SB(1, 1), b3 + hstep, voffB);
            PG8_WAIT_V(6); PG8_BAR; PG8_MMA(1, 1, At, B1); PG8_BAR;
            }
        }
        if constexpr (ALIGN_EPI) { if (wr == 0) PG8_BAR; }
        if constexpr (!Epi::AFTER_DRAIN) { E(acc, cur, wr, wc, fr, fq); S.done(cur); }
        if (!has_next) break;
#pragma unroll
        for (int a = 0; a < 2; ++a)
#pragma unroll
            for (int b = 0; b < 2; ++b)
#pragma unroll
                for (int m = 0; m < 4; ++m)
#pragma unroll
                    for (int n = 0; n < 2; ++n) acc[a][b][m][n] = (f32x4){0.f, 0.f, 0.f, 0.f};
        cur = nxt; cA = nA; cB = nB; ++ui;
        if constexpr (ALIGN_EPI) { if (wr == 1) PG8_BAR; }
    }
    PG8_WAIT_V(0);
    if constexpr (!ALIGN_EPI) { if (wr == 0) PG8_BAR; }
    PG8_BAR;
    if constexpr (Epi::AFTER_DRAIN) { E.fused(acc, cur, wr, wc, fr, fq, lds, wid, lane); S.done(cur); }
#undef PG8_SA
#undef PG8_SB
#undef PG8_STAGE
#undef PG8_LDA
#undef PG8_LDB
#undef PG8_MMA
#undef PG8_WAIT_V
#undef PG8_WAIT_L
#undef PG8_BAR
#undef PG8_SCHED
}
}
constexpr int S_ = 16384, D_ = 2048, INC = 6144, NH = 8, DH = 128, CH = 64, NCH = 256;
constexpr float DN_ALPHA = 1.189207115002721f;
constexpr float LN_EPS = 1e-5f, GN_EPS = 1e-6f;
constexpr int NWAVES = 8, NTHREADS = 512;
constexpr int LDS_BYTES = 147456;

constexpr size_t MiB = 1u << 20;
constexpr size_t WS_CTL = 0;
constexpr size_t WS_WOUT_T = 1 * MiB, WS_WPQ_T = 9 * MiB, WS_KEYS = 17 * MiB, WS_WRA_T = 17 * MiB + 512 * 1024, WS_WRI_T = 17 * MiB + 768 * 1024;
constexpr size_t WS_COS = 18 * MiB, WS_SIN = 22 * MiB, WS_SUMA = 26 * MiB, WS_SUMH = 27 * MiB, WS_HIN = 28 * MiB;
constexpr size_t WS_UB = 32 * MiB, WS_VB = 96 * MiB;
constexpr size_t WS_WIN_T = 160 * MiB, WS_XB = 184 * MiB, WS_KVS = 184 * MiB, WS_H1B = 184 * MiB;
constexpr size_t WS_PROJ = 248 * MiB, WS_QP = 248 * MiB, WS_SELE = 312 * MiB, WS_SELG = 320 * MiB;
constexpr size_t WS_YCAT = 440 * MiB, WS_END = 504 * MiB;

#define LAS __attribute__((address_space(3)))
typedef unsigned short bf16_t;
typedef short bf16x8 __attribute__((ext_vector_type(8)));
typedef float f32x4 __attribute__((ext_vector_type(4)));
typedef unsigned u32x4 __attribute__((ext_vector_type(4)));
typedef unsigned u32x2 __attribute__((ext_vector_type(2)));

__device__ __forceinline__ unsigned f2bf(float f) { unsigned u = __float_as_uint(f); return (u + 0x7fffu + ((u >> 16) & 1u)) >> 16; }
__device__ __forceinline__ unsigned pk2(float lo, float hi) { return f2bf(lo) | (f2bf(hi) << 16); }
__device__ __forceinline__ float bflo(unsigned w) { return __uint_as_float(w << 16); }
__device__ __forceinline__ float bfhi(unsigned w) { return __uint_as_float(w & 0xffff0000u); }
__device__ __forceinline__ float bf2f(bf16_t b) { return __uint_as_float(((unsigned)b) << 16); }
__device__ __forceinline__ f32x4 mfma16(bf16x8 a, bf16x8 b, f32x4 c) { return __builtin_amdgcn_mfma_f32_16x16x32_bf16(a, b, c, 0, 0, 0); }
__device__ __forceinline__ float sigmoidf_(float x) { return 1.0f / (1.0f + __expf(-x)); }
__device__ __forceinline__ float gelu_tanh(float x) { const float y = 0.7978845608028654f * (x + 0.044715f * x * x * x); return x / (1.0f + __expf(-2.0f * y)); }
__device__ __forceinline__ float wave_sum(float v) {
#pragma unroll
    for (int o = 1; o < 64; o <<= 1) v += __shfl_xor(v, o);
    return v;
}
__device__ __forceinline__ float head_log_gamma(int h) { return logf(1.0f - exp2f(-5.0f - (float)h)); }

__device__ __forceinline__ void transpose_item(const float* W, int K, int N, bf16_t* WT, LAS float* scr, int item, int lane) {
    const int nblk = N / 32, kb = item / nblk, nb = item % nblk, k0 = 64 * kb, n0 = 32 * nb;
#pragma unroll 8
    for (int i = 0; i < 32; ++i) { const int kk = 2 * i + (lane >> 5); scr[kk * 33 + (lane & 31)] = W[(size_t)(k0 + kk) * N + n0 + (lane & 31)]; }
    asm volatile("s_waitcnt lgkmcnt(0)" ::: "memory");
    const int c = lane & 7;
#pragma unroll
    for (int j = 0; j < 4; ++j) { const int n = (lane >> 3) + 8 * j; const LAS float* s = scr + (8 * c) * 33 + n;
        u32x4 o; o.x = pk2(s[0 * 33], s[1 * 33]); o.y = pk2(s[2 * 33], s[3 * 33]); o.z = pk2(s[4 * 33], s[5 * 33]); o.w = pk2(s[6 * 33], s[7 * 33]);
        *(u32x4*)(WT + (size_t)(n0 + n) * K + k0 + 8 * c) = o; }
    asm volatile("s_waitcnt lgkmcnt(0)" ::: "memory");
}
__device__ __forceinline__ void cvt_stream(const float* src, bf16_t* dst, size_t n8, size_t gtid, size_t gthreads) {
    for (size_t i = gtid; i < n8; i += gthreads) {
        const f32x4 a = ((const f32x4*)src)[2 * i], b = ((const f32x4*)src)[2 * i + 1];
        u32x4 o; o.x = pk2(a.x, a.y); o.y = pk2(a.z, a.w); o.z = pk2(b.x, b.y); o.w = pk2(b.z, b.w);
        ((u32x4*)dst)[i] = o;
    }
}
struct Ptrs {
    const float *x; const int* pos; const float *w_in, *w_out, *conv_w, *conv_b, *w_ra, *b_ra, *w_ri, *b_ri, *lam, *ln1_g, *ln1_b, *w_pq, *sub_keys, *peer_u, *peer_v, *ln2_g, *ln2_b;
    float* out; unsigned char* ws;
};
__device__ __forceinline__ void prologue_phase(LAS unsigned char* lds, const Ptrs& P, int G, int b) {
    const int tid = threadIdx.x, lane = tid & 63, wid = tid >> 6;
    LAS float* scr = (LAS float*)(lds + wid * 16384);
    const int gw = b * NWAVES + wid, NGW = G * NWAVES;
    unsigned char* ws = P.ws;
    constexpr int I_IN = (D_ / 64) * (INC / 32), I_SQ = (D_ / 64) * (D_ / 32), I_G = 2 * 4;
    constexpr int NITEMS = I_IN + 2 * I_SQ + 16 * I_G;
    for (int it = gw; it < NITEMS; it += NGW) {
        int r = it;
        if (r < I_IN) { transpose_item(P.w_in, D_, INC, (bf16_t*)(ws + WS_WIN_T), scr, r, lane); continue; } r -= I_IN;
        if (r < I_SQ) { transpose_item(P.w_out, D_, D_, (bf16_t*)(ws + WS_WOUT_T), scr, r, lane); continue; } r -= I_SQ;
        if (r < I_SQ) { transpose_item(P.w_pq, D_, D_, (bf16_t*)(ws + WS_WPQ_T), scr, r, lane); continue; } r -= I_SQ;
        if (r < 8 * I_G) { const int g = r / I_G; transpose_item(P.w_ra + g * 16384, 128, 128, (bf16_t*)(ws + WS_WRA_T) + g * 16384, scr, r % I_G, lane); continue; } r -= 8 * I_G;
        { const int g = r / I_G; transpose_item(P.w_ri + g * 16384, 128, 128, (bf16_t*)(ws + WS_WRI_T) + g * 16384, scr, r % I_G, lane); }
    }
    const size_t gtid = (size_t)b * NTHREADS + tid, gth = (size_t)G * NTHREADS;
    cvt_stream(P.x, (bf16_t*)(ws + WS_XB), (size_t)S_ * D_ / 8, gtid, gth);
    cvt_stream(P.peer_u, (bf16_t*)(ws + WS_UB), (size_t)16384 * D_ / 8, gtid, gth);
    cvt_stream(P.peer_v, (bf16_t*)(ws + WS_VB), (size_t)16384 * D_ / 8, gtid, gth);
    cvt_stream(P.sub_keys, (bf16_t*)(ws + WS_KEYS), (size_t)8 * 2 * 128 * 128 / 8, gtid, gth);
    float* cosT = (float*)(ws + WS_COS); float* sinT = (float*)(ws + WS_SIN);
    for (size_t i = gtid; i < (size_t)S_ * 64; i += gth) {
        const int s = (int)(i >> 6), f = (int)(i & 63);
        const float inv = powf(10000.0f, -(float)f / 64.0f);
        const float ang = (float)P.pos[s] * inv;
        float sn, cs; sincosf(ang, &sn, &cs);
        cosT[i] = cs; sinT[i] = sn;
    }
}
#define XB_TMO      128
#define XB_XCNT(j)  (256  + 64 * (j))
#define XB_XSUB(j)  (1280 + 64 * (j))
#define XB_XGEN(j)  (2304 + 64 * (j))
#define XB_TOP      3328
#define XB_TOPGEN   3392
#define XCD_BAR_WORDS 3456
#define XB_SPIN_CAP (1u << 18)

__device__ __forceinline__ unsigned xb_ld(unsigned* p)              { return __hip_atomic_load(p, __ATOMIC_RELAXED, __HIP_MEMORY_SCOPE_AGENT); }
__device__ __forceinline__ unsigned xb_add(unsigned* p, unsigned v) { return __hip_atomic_fetch_add(p, v, __ATOMIC_RELAXED, __HIP_MEMORY_SCOPE_AGENT); }
__device__ __forceinline__ unsigned xb_xcc_id() { return (unsigned)__builtin_amdgcn_s_getreg((3 << 11) | 20) & 0xFu; }
#define XB_SPIN(cond, bar) do { unsigned _sp = 0; while (cond) { __builtin_amdgcn_s_sleep(1); \
    if ((++_sp & 255u) == 0u) { if (xb_ld(&(bar)[XB_TMO])) break; if (_sp > XB_SPIN_CAP) { atomicAdd(&(bar)[XB_TMO], 1u); break; } } } } while (0)

struct XcdBarrier {
    unsigned* bar; unsigned x;
    volatile LAS unsigned* st;
};

__device__ __forceinline__ XcdBarrier xcd_barrier_post(unsigned* bar, volatile LAS unsigned* st) {
    XcdBarrier b; b.bar = bar; b.x = xb_xcc_id(); b.st = st;
    if (threadIdx.x == 0) (void)xb_add(&bar[XB_XCNT(b.x)], 1u);
    return b;
}
__device__ __forceinline__ void xcd_barrier_complete(unsigned* bar, unsigned x, unsigned& nloc, unsigned& nx) {
    const unsigned G = gridDim.x * gridDim.y * gridDim.z;
    unsigned sum, cnt, mine, sp = 0u;
    for (;;) {
        sum = 0u; cnt = 0u; mine = 0u;
#pragma unroll
        for (unsigned j = 0; j < 16; ++j) { const unsigned c = xb_ld(&bar[XB_XCNT(j)]); sum += c; cnt += (c > 0u) ? 1u : 0u; mine = (j == x) ? c : mine; }
        if (sum == G) break;
        __builtin_amdgcn_s_sleep(1);
        if ((++sp & 255u) == 0u) { if (xb_ld(&bar[XB_TMO])) break; if (sp > XB_SPIN_CAP) { atomicAdd(&bar[XB_TMO], 1u); break; } }
    }
    nloc = mine > 0u ? mine : 1u; nx = cnt > 0u ? cnt : 1u;
}

__device__ __forceinline__ void xcd_barrier(const XcdBarrier& b) {
    asm volatile("s_waitcnt vmcnt(0)" ::: "memory");
    __syncthreads();
    if (threadIdx.x == 0) {
        unsigned* bar = b.bar;
        __builtin_amdgcn_s_waitcnt(0);
        unsigned nloc = b.st[0], nx = b.st[1];
        if (nloc == 0u) { xcd_barrier_complete(bar, b.x, nloc, nx); b.st[0] = nloc; b.st[1] = nx; }
        const unsigned old = xb_add(&bar[XB_XSUB(b.x)], 1u);
        const unsigned gen = old / nloc;
        if (old + 1u == (gen + 1u) * nloc) {
            __builtin_amdgcn_fence(__ATOMIC_RELEASE, "agent");
            asm volatile("s_waitcnt vmcnt(0)" ::: "memory");
            const unsigned og = xb_add(&bar[XB_TOP], 1u);
            const unsigned tg = og / nx;
            if (og + 1u == (tg + 1u) * nx) xb_add(&bar[XB_TOPGEN], 1u);
            else XB_SPIN(xb_ld(&bar[XB_TOPGEN]) == tg, bar);
            __builtin_amdgcn_fence(__ATOMIC_ACQUIRE, "agent");
            xb_add(&bar[XB_XGEN(b.x)], 1u);
            asm volatile("s_waitcnt vmcnt(0)" ::: "memory");
        } else {
            XB_SPIN(xb_ld(&bar[XB_XGEN(b.x)]) == gen, bar);
            __builtin_amdgcn_fence(__ATOMIC_ACQUIRE, "agent");
            asm volatile("s_waitcnt vmcnt(0)" ::: "memory");
        }
    }
    __syncthreads();
}
__device__ __forceinline__ void rot8(const u32x4 x1, const u32x4 x2, const float* cp, const float* sp, float scale, float (&o1)[8], float (&o2)[8]) {
    const f32x4 c0 = *(const f32x4*)cp, c1 = *(const f32x4*)(cp + 4), s0 = *(const f32x4*)sp, s1 = *(const f32x4*)(sp + 4);
    const float cs[8] = {c0.x, c0.y, c0.z, c0.w, c1.x, c1.y, c1.z, c1.w}, sn[8] = {s0.x, s0.y, s0.z, s0.w, s1.x, s1.y, s1.z, s1.w};
    const unsigned w1[4] = {x1.x, x1.y, x1.z, x1.w}, w2[4] = {x2.x, x2.y, x2.z, x2.w};
#pragma unroll
    for (int j = 0; j < 8; ++j) {
        const float a = (j & 1) ? bfhi(w1[j >> 1]) : bflo(w1[j >> 1]);
        const float bb = (j & 1) ? bfhi(w2[j >> 1]) : bflo(w2[j >> 1]);
        o1[j] = (a * cs[j] - bb * sn[j]) * scale;
        o2[j] = (bb * cs[j] + a * sn[j]) * scale;
    }
}
__device__ __forceinline__ void ret_kv_phase(LAS unsigned char* lds, const bf16_t* proj, const float* cosT, const float* sinT, bf16_t* kvs, int G, int b) {
    const int tid = threadIdx.x, lane = tid & 63, wid = tid >> 6, fr = lane & 15, fq = lane >> 4;
    LAS bf16_t* KT = (LAS bf16_t*)lds;
    LAS bf16_t* VT = (LAS bf16_t*)(lds + 18432);
    for (int unit = b; unit < NCH * NH; unit += G) {
        const int n = unit >> 3, h = unit & 7;
        const float log_g = head_log_gamma(h);
        const int m = tid >> 3, tq = tid & 7; const int s = n * 64 + m;
        {
            const bf16_t* kp = proj + (size_t)s * INC + 1024 + h * 128 + tq * 8;
            const u32x4 x1 = *(const u32x4*)kp, x2 = *(const u32x4*)(kp + 64);
            float o1[8], o2[8];
            rot8(x1, x2, cosT + (size_t)s * 64 + tq * 8, sinT + (size_t)s * 64 + tq * 8, expf(log_g * (63.0f - (float)m)), o1, o2);
#pragma unroll
            for (int j = 0; j < 8; ++j) { KT[(tq * 8 + j) * 72 + m] = (bf16_t)f2bf(o1[j]); KT[(64 + tq * 8 + j) * 72 + m] = (bf16_t)f2bf(o2[j]); }
            const bf16_t* vp = proj + (size_t)s * INC + 2048 + h * 128 + tq * 16;
            const u32x4 y0 = *(const u32x4*)vp, y1 = *(const u32x4*)(vp + 8);
            const unsigned yw[8] = {y0.x, y0.y, y0.z, y0.w, y1.x, y1.y, y1.z, y1.w};
#pragma unroll
            for (int j = 0; j < 8; ++j) { VT[(tq * 16 + 2 * j) * 72 + m] = (bf16_t)(yw[j] & 0xffffu); VT[(tq * 16 + 2 * j + 1) * 72 + m] = (bf16_t)(yw[j] >> 16); }
        }
        __syncthreads();
        f32x4 acc[8];
#pragma unroll
        for (int et = 0; et < 8; ++et) acc[et] = (f32x4){0.f, 0.f, 0.f, 0.f};
#pragma unroll
        for (int ks = 0; ks < 2; ++ks) {
            const bf16x8 a = *(const LAS bf16x8*)(KT + (wid * 16 + fr) * 72 + ks * 32 + fq * 8);
#pragma unroll
            for (int et = 0; et < 8; ++et) { const bf16x8 bb = *(const LAS bf16x8*)(VT + (et * 16 + fr) * 72 + ks * 32 + fq * 8); acc[et] = mfma16(a, bb, acc[et]); }
        }
        bf16_t* outp = kvs + (size_t)unit * 16384;
#pragma unroll
        for (int et = 0; et < 8; ++et) { u32x2 w; w.x = pk2(acc[et][0], acc[et][1]); w.y = pk2(acc[et][2], acc[et][3]); *(u32x2*)(outp + (et * 16 + fr) * 128 + wid * 16 + fq * 4) = w; }
        __syncthreads();
    }
}
__device__ __forceinline__ void scan_phase(bf16_t* kvs, const float* sumA, const float* sumH, float* Hin, int G, int b) {
    const int gtid = b * NTHREADS + threadIdx.x, gth = G * NTHREADS;
    for (int p = gtid; p < 65536; p += gth) {
        const int h = p >> 13;
        const float dec = expf(64.0f * head_log_gamma(h));
        unsigned* ptr = (unsigned*)kvs + p;
        float s0 = 0.f, s1 = 0.f;
        for (int n = 0; n < NCH; n += 8) {
            unsigned v[8];
#pragma unroll
            for (int j = 0; j < 8; ++j) v[j] = ptr[(size_t)(n + j) * 65536];
#pragma unroll
            for (int j = 0; j < 8; ++j) { ptr[(size_t)(n + j) * 65536] = pk2(s0, s1); s0 = dec * s0 + bflo(v[j]); s1 = dec * s1 + bfhi(v[j]); }
        }
    }
    const int c = gth - 1 - gtid;
    if (c < 1024) {
        float H = 0.f;
        for (int n = 0; n < NCH; n += 8) {
            float a[8], hh[8];
#pragma unroll
            for (int j = 0; j < 8; ++j) { a[j] = sumA[(n + j) * 1024 + c]; hh[j] = sumH[(n + j) * 1024 + c]; }
#pragma unroll
            for (int j = 0; j < 8; ++j) { Hin[(n + j) * 1024 + c] = H; H = a[j] * H + hh[j]; }
        }
    }
}
__device__ __forceinline__ void ret_out_phase(LAS unsigned char* lds, const bf16_t* proj, const float* cosT, const float* sinT, const bf16_t* kvs, bf16_t* ycat, int G, int b) {
    const int tid = threadIdx.x, lane = tid & 63, wid = tid >> 6, fr = lane & 15, fq = lane >> 4;
    LAS bf16_t* QS = (LAS bf16_t*)lds;
    LAS bf16_t* KS = (LAS bf16_t*)(lds + 17408);
    LAS bf16_t* VT = (LAS bf16_t*)(lds + 34816);
    LAS bf16_t* PS = (LAS bf16_t*)(lds + 53248);
    LAS float*  OS = (LAS float*)(lds + 62464);
    for (int unit = b; unit < NCH * NH; unit += G) {
        const int n = unit >> 3, h = unit & 7;
        const float log_g = head_log_gamma(h);
        const int m = tid >> 3, tq = tid & 7; const int s = n * 64 + m;
        {
            const float* cp = cosT + (size_t)s * 64 + tq * 8; const float* sp = sinT + (size_t)s * 64 + tq * 8;
            float o1[8], o2[8];
            const bf16_t* qp = proj + (size_t)s * INC + h * 128 + tq * 8;
            rot8(*(const u32x4*)qp, *(const u32x4*)(qp + 64), cp, sp, 0.08838834764831845f, o1, o2);
            u32x4 w; w.x = pk2(o1[0], o1[1]); w.y = pk2(o1[2], o1[3]); w.z = pk2(o1[4], o1[5]); w.w = pk2(o1[6], o1[7]);
            *(LAS u32x4*)(QS + m * 136 + tq * 8) = w;
            w.x = pk2(o2[0], o2[1]); w.y = pk2(o2[2], o2[3]); w.z = pk2(o2[4], o2[5]); w.w = pk2(o2[6], o2[7]);
            *(LAS u32x4*)(QS + m * 136 + 64 + tq * 8) = w;
            const bf16_t* kp = proj + (size_t)s * INC + 1024 + h * 128 + tq * 8;
            rot8(*(const u32x4*)kp, *(const u32x4*)(kp + 64), cp, sp, 1.0f, o1, o2);
            w.x = pk2(o1[0], o1[1]); w.y = pk2(o1[2], o1[3]); w.z = pk2(o1[4], o1[5]); w.w = pk2(o1[6], o1[7]);
            *(LAS u32x4*)(KS + m * 136 + tq * 8) = w;
            w.x = pk2(o2[0], o2[1]); w.y = pk2(o2[2], o2[3]); w.z = pk2(o2[4], o2[5]); w.w = pk2(o2[6], o2[7]);
            *(LAS u32x4*)(KS + m * 136 + 64 + tq * 8) = w;
            const bf16_t* vp = proj + (size_t)s * INC + 2048 + h * 128 + tq * 16;
            const u32x4 y0 = *(const u32x4*)vp, y1 = *(const u32x4*)(vp + 8);
            const unsigned yw[8] = {y0.x, y0.y, y0.z, y0.w, y1.x, y1.y, y1.z, y1.w};
#pragma unroll
            for (int j = 0; j < 8; ++j) { VT[(tq * 16 + 2 * j) * 72 + m] = (bf16_t)(yw[j] & 0xffffu); VT[(tq * 16 + 2 * j + 1) * 72 + m] = (bf16_t)(yw[j] >> 16); }
        }
        __syncthreads();
        const int ct = wid & 3;
        {
            const int mt0 = (wid >> 2) * 2;
            f32x4 sacc[2] = {(f32x4){0.f, 0.f, 0.f, 0.f}, (f32x4){0.f, 0.f, 0.f, 0.f}};
#pragma unroll
            for (int ks = 0; ks < 4; ++ks) {
                const bf16x8 a = *(const LAS bf16x8*)(QS + (ct * 16 + fr) * 136 + ks * 32 + fq * 8);
#pragma unroll
                for (int j = 0; j < 2; ++j) { const bf16x8 bb = *(const LAS bf16x8*)(KS + ((mt0 + j) * 16 + fr) * 136 + ks * 32 + fq * 8); sacc[j] = mfma16(a, bb, sacc[j]); }
            }
#pragma unroll
            for (int j = 0; j < 2; ++j)
#pragma unroll
                for (int r = 0; r < 4; ++r) { const int c = ct * 16 + fq * 4 + r, mm = (mt0 + j) * 16 + fr; const float dd = fabsf((float)(c - mm));
                    PS[c * 72 + mm] = (bf16_t)f2bf(sacc[j][r] * expf(log_g * dd)); }
        }
        __syncthreads();
        {
            const int et0 = (wid >> 2) * 4;
            f32x4 oacc[4];
#pragma unroll
            for (int j = 0; j < 4; ++j) oacc[j] = (f32x4){0.f, 0.f, 0.f, 0.f};
            const bf16_t* st = kvs + (size_t)unit * 16384;
#pragma unroll
            for (int ks = 0; ks < 4; ++ks) {
                const bf16x8 a = *(const LAS bf16x8*)(QS + (ct * 16 + fr) * 136 + ks * 32 + fq * 8);
#pragma unroll
                for (int j = 0; j < 4; ++j) { const bf16x8 bb = *(const bf16x8*)(st + ((et0 + j) * 16 + fr) * 128 + ks * 32 + fq * 8); oacc[j] = mfma16(a, bb, oacc[j]); }
            }
#pragma unroll
            for (int r = 0; r < 4; ++r) { const float qd = expf(log_g * (float)(ct * 16 + fq * 4 + r + 1));
#pragma unroll
                for (int j = 0; j < 4; ++j) oacc[j][r] *= qd; }
#pragma unroll
            for (int ks = 0; ks < 2; ++ks) {
                const bf16x8 a = *(const LAS bf16x8*)(PS + (ct * 16 + fr) * 72 + ks * 32 + fq * 8);
#pragma unroll
                for (int j = 0; j < 4; ++j) { const bf16x8 bb = *(const LAS bf16x8*)(VT + ((et0 + j) * 16 + fr) * 72 + ks * 32 + fq * 8); oacc[j] = mfma16(a, bb, oacc[j]); }
            }
#pragma unroll
            for (int j = 0; j < 4; ++j)
#pragma unroll
                for (int r = 0; r < 4; ++r) OS[(ct * 16 + fq * 4 + r) * 132 + (et0 + j) * 16 + fr] = oacc[j][r];
        }
        __syncthreads();
        {
            float v[16]; float sum = 0.f;
#pragma unroll
            for (int q = 0; q < 4; ++q) { const f32x4 t = *(const LAS f32x4*)(OS + m * 132 + tq * 16 + q * 4); v[4 * q] = t.x; v[4 * q + 1] = t.y; v[4 * q + 2] = t.z; v[4 * q + 3] = t.w; sum += (t.x + t.y) + (t.z + t.w); }
            sum += __shfl_xor(sum, 1); sum += __shfl_xor(sum, 2); sum += __shfl_xor(sum, 4);
            const float mean = sum * (1.0f / 128.0f); float sq = 0.f;
#pragma unroll
            for (int i = 0; i < 16; ++i) { v[i] -= mean; sq += v[i] * v[i]; }
            sq += __shfl_xor(sq, 1); sq += __shfl_xor(sq, 2); sq += __shfl_xor(sq, 4);
            const float rstd = 1.0f / sqrtf(sq * (1.0f / 128.0f) + GN_EPS);
            const bf16_t* gp = proj + (size_t)s * INC + 3072 + h * 128 + tq * 16;
            const u32x4 g0 = *(const u32x4*)gp, g1 = *(const u32x4*)(gp + 8);
            const unsigned gw[8] = {g0.x, g0.y, g0.z, g0.w, g1.x, g1.y, g1.z, g1.w};
            unsigned ow[8];
#pragma unroll
            for (int j = 0; j < 8; ++j) { const float ga = bflo(gw[j]), gb = bfhi(gw[j]);
                ow[j] = pk2(ga * sigmoidf_(ga) * v[2 * j] * rstd, gb * sigmoidf_(gb) * v[2 * j + 1] * rstd); }
            bf16_t* yp = ycat + (size_t)s * D_ + h * 128 + tq * 16;
            *(u32x4*)yp = (u32x4){ow[0], ow[1], ow[2], ow[3]}; *(u32x4*)(yp + 8) = (u32x4){ow[4], ow[5], ow[6], ow[7]};
        }
        __syncthreads();
    }
}
template <int MODE>
__device__ __forceinline__ void lru_phase(LAS unsigned char* lds, const bf16_t* proj, const Ptrs& P, const bf16_t* wraT, const bf16_t* wriT,
                                          float* sumA, float* sumH, const float* Hin, bf16_t* ycat, int G, int b) {
    const int tid = threadIdx.x, lane = tid & 63, wid = tid >> 6, fr = lane & 15, fq = lane >> 4;
    LAS float*  XC  = (LAS float*)lds;
    LAS bf16_t* XCb = (LAS bf16_t*)(lds + 33792);
    LAS float*  AA  = (LAS float*)(lds + 51200);
    LAS float*  BB  = (LAS float*)(lds + 84992);
    for (int unit = b; unit < NCH * 8; unit += G) {
        const int n = unit >> 3, g = unit & 7, c0 = g * 128;
        const int m = tid >> 3, part = tid & 7, j0 = part * 16; const int s = n * 64 + m;
        {
            float xc[16];
#pragma unroll
            for (int q = 0; q < 4; ++q) { const f32x4 t = *(const f32x4*)(P.conv_b + c0 + j0 + 4 * q); xc[4 * q] = t.x; xc[4 * q + 1] = t.y; xc[4 * q + 2] = t.z; xc[4 * q + 3] = t.w; }
#pragma unroll
            for (int kk = 0; kk < 4; ++kk) {
                const int srow = s - 3 + kk;
                if (srow >= 0) {
                    const bf16_t* xp = proj + (size_t)srow * INC + 4096 + c0 + j0;
                    const u32x4 y0 = *(const u32x4*)xp, y1 = *(const u32x4*)(xp + 8);
                    const unsigned yw[8] = {y0.x, y0.y, y0.z, y0.w, y1.x, y1.y, y1.z, y1.w};
                    const float* wp = P.conv_w + kk * 1024 + c0 + j0;
#pragma unroll
                    for (int q = 0; q < 4; ++q) { const f32x4 w = *(const f32x4*)(wp + 4 * q);
                        xc[4 * q] += w.x * bflo(yw[2 * q]); xc[4 * q + 1] += w.y * bfhi(yw[2 * q]); xc[4 * q + 2] += w.z * bflo(yw[2 * q + 1]); xc[4 * q + 3] += w.w * bfhi(yw[2 * q + 1]); }
                }
            }
#pragma unroll
            for (int q = 0; q < 4; ++q) *(LAS f32x4*)(XC + m * 132 + j0 + 4 * q) = (f32x4){xc[4 * q], xc[4 * q + 1], xc[4 * q + 2], xc[4 * q + 3]};
            *(LAS u32x4*)(XCb + m * 136 + j0) = (u32x4){pk2(xc[0], xc[1]), pk2(xc[2], xc[3]), pk2(xc[4], xc[5]), pk2(xc[6], xc[7])};
            *(LAS u32x4*)(XCb + m * 136 + j0 + 8) = (u32x4){pk2(xc[8], xc[9]), pk2(xc[10], xc[11]), pk2(xc[12], xc[13]), pk2(xc[14], xc[15])};
        }
        __syncthreads();
        {
            const int st = wid & 3, jt0 = (wid >> 2) * 4;
            f32x4 ar[4], ai[4];
#pragma unroll
            for (int j = 0; j < 4; ++j) { ar[j] = (f32x4){0.f, 0.f, 0.f, 0.f}; ai[j] = (f32x4){0.f, 0.f, 0.f, 0.f}; }
#pragma unroll
            for (int ks = 0; ks < 4; ++ks) {
                const bf16x8 a = *(const LAS bf16x8*)(XCb + (st * 16 + fr) * 136 + ks * 32 + fq * 8);
#pragma unroll
                for (int j = 0; j < 4; ++j) { const size_t wo = (size_t)g * 16384 + ((jt0 + j) * 16 + fr) * 128 + ks * 32 + fq * 8;
                    ar[j] = mfma16(a, *(const bf16x8*)(wraT + wo), ar[j]); ai[j] = mfma16(a, *(const bf16x8*)(wriT + wo), ai[j]); }
            }
#pragma unroll
            for (int j = 0; j < 4; ++j) {
                const int col = (jt0 + j) * 16 + fr, c = c0 + col;
                const float bra = P.b_ra[c], bri = P.b_ri[c];
                const float ls = -log1pf(expf(-P.lam[c]));
#pragma unroll
                for (int r = 0; r < 4; ++r) {
                    const int sl = st * 16 + fq * 4 + r;
                    const float rg = sigmoidf_(ar[j][r] + bra), ig = sigmoidf_(ai[j][r] + bri);
                    const float la = 8.0f * rg * ls;
                    const float a = expf(la);
                    const float bv = sqrtf(-expm1f(2.0f * la)) * (ig * XC[sl * 132 + col]);
                    AA[sl * 132 + col] = a; BB[sl * 132 + col] = bv;
                }
            }
        }
        __syncthreads();
        if (tid < 128) {
            const int j = tid;
            float hcur = (MODE == 1) ? Hin[n * 1024 + c0 + j] : 0.f, acum = 1.f;
#pragma unroll 8
            for (int sl = 0; sl < 64; ++sl) { const float a = AA[sl * 132 + j], bv = BB[sl * 132 + j]; hcur = a * hcur + bv; acum *= a; if (MODE == 1) BB[sl * 132 + j] = hcur; }
            if (MODE == 0) { sumA[n * 1024 + c0 + j] = acum; sumH[n * 1024 + c0 + j] = hcur; }
        }
        if (MODE == 1) {
            __syncthreads();
            const bf16_t* gp = proj + (size_t)s * INC + 5120 + c0 + j0;
            const u32x4 g0 = *(const u32x4*)gp, g1 = *(const u32x4*)(gp + 8);
            const unsigned gw[8] = {g0.x, g0.y, g0.z, g0.w, g1.x, g1.y, g1.z, g1.w};
            unsigned ow[8];
#pragma unroll
            for (int q = 0; q < 8; ++q) { const float h0 = BB[m * 132 + j0 + 2 * q], h1 = BB[m * 132 + j0 + 2 * q + 1];
                ow[q] = pk2(h0 * gelu_tanh(bflo(gw[q])), h1 * gelu_tanh(bfhi(gw[q]))); }
            bf16_t* yp = ycat + (size_t)s * D_ + 1024 + c0 + j0;
            *(u32x4*)yp = (u32x4){ow[0], ow[1], ow[2], ow[3]}; *(u32x4*)(yp + 8) = (u32x4){ow[4], ow[5], ow[6], ow[7]};
        }
        __syncthreads();
    }
}
__device__ __forceinline__ void ln1_phase(float* buf, bf16_t* h1b, const float* gam, const float* bet, int G, int b) {
    const int lane = threadIdx.x & 63, wid = threadIdx.x >> 6;
    const int gw = b * NWAVES + wid, NGW = G * NWAVES;
    for (int row = gw; row < S_; row += NGW) {
        float* rp = buf + (size_t)row * D_;
        f32x4 v[8]; float sum = 0.f;
#pragma unroll
        for (int j = 0; j < 8; ++j) { v[j] = *(const f32x4*)(rp + 256 * j + 4 * lane); sum += (v[j].x + v[j].y) + (v[j].z + v[j].w); }
        const float mean = wave_sum(sum) * (1.0f / D_); float sq = 0.f;
#pragma unroll
        for (int j = 0; j < 8; ++j) { v[j] = v[j] - mean; sq += (v[j].x * v[j].x + v[j].y * v[j].y) + (v[j].z * v[j].z + v[j].w * v[j].w); }
        const float rstd = 1.0f / sqrtf(wave_sum(sq) * (1.0f / D_) + LN_EPS);
#pragma unroll
        for (int j = 0; j < 8; ++j) {
            const f32x4 gg = *(const f32x4*)(gam + 256 * j + 4 * lane), bb = *(const f32x4*)(bet + 256 * j + 4 * lane);
            const f32x4 o = v[j] * rstd * gg + bb;
            *(f32x4*)(rp + 256 * j + 4 * lane) = o;
            *(u32x2*)(h1b + (size_t)row * D_ + 256 * j + 4 * lane) = (u32x2){pk2(o.x, o.y), pk2(o.z, o.w)};
        }
    }
}
__device__ __forceinline__ unsigned mono(float f) { const unsigned u = __float_as_uint(f); return (u & 0x80000000u) ? ~u : (u ^ 0x80000000u); }
__device__ __forceinline__ float unmono(unsigned u) { return __uint_as_float((u & 0x80000000u) ? (u ^ 0x80000000u) : ~u); }
__device__ __forceinline__ unsigned umax_(unsigned a, unsigned b) { return a > b ? a : b; }
__device__ __forceinline__ constexpr int cand_i(int c) { return c < 16 ? 0 : c < 24 ? 1 : c < 29 ? 2 : c < 33 ? 3 : c < 36 ? 4 : c < 38 ? 5 : c < 40 ? 6 : c < 42 ? 7 : c - 34; }
__device__ __forceinline__ constexpr int cand_j(int c) { return c < 16 ? c : c < 24 ? c - 16 : c < 29 ? c - 24 : c < 33 ? c - 29 : c < 36 ? c - 33 : c < 38 ? c - 36 : c < 40 ? c - 38 : c < 42 ? c - 40 : 0; }

__device__ __forceinline__ void topk_phase(LAS unsigned char* lds, const bf16_t* qp, const bf16_t* keys, int* sel_e, float* sel_g, int G, int b) {
    const int tid = threadIdx.x, lane = tid & 63, wid = tid >> 6, fr = lane & 15, fq = lane >> 4;
    LAS unsigned* wl = (LAS unsigned*)(lds + wid * 2048 + fr * 128);
    for (int unit = b; unit < (S_ / 128) * 8; unit += G) {
        const int tt = unit >> 3, h = unit & 7;
        const int tok = tt * 128 + wid * 16 + fr;
        unsigned w[2][16];
#pragma unroll
        for (int p = 0; p < 2; ++p) {
            f32x4 acc[8];
#pragma unroll
            for (int mt = 0; mt < 8; ++mt) acc[mt] = (f32x4){0.f, 0.f, 0.f, 0.f};
            bf16x8 bq[4];
#pragma unroll
            for (int ks = 0; ks < 4; ++ks) bq[ks] = *(const bf16x8*)(qp + (size_t)tok * D_ + h * 256 + p * 128 + ks * 32 + fq * 8);
            const bf16_t* kb = keys + (size_t)(h * 2 + p) * 16384;
#pragma unroll
            for (int mt = 0; mt < 8; ++mt)
#pragma unroll
                for (int ks = 0; ks < 4; ++ks) { const bf16x8 a = *(const bf16x8*)(kb + (mt * 16 + fr) * 128 + ks * 32 + fq * 8); acc[mt] = mfma16(a, bq[ks], acc[mt]); }
            unsigned pk[32];
#pragma unroll
            for (int mt = 0; mt < 8; ++mt)
#pragma unroll
                for (int r = 0; r < 4; ++r) pk[mt * 4 + r] = (mono(acc[mt][r]) & ~127u) | (unsigned)(127 - (mt * 16 + fq * 4 + r));
            unsigned prev = 0xFFFFFFFFu;
#pragma unroll
            for (int i = 0; i < 16; ++i) {
                unsigned mx = 0u;
#pragma unroll
                for (int j = 0; j < 32; ++j) { const unsigned x = pk[j] < prev ? pk[j] : 0u; mx = umax_(mx, x); }
                mx = umax_(mx, (unsigned)__shfl_xor((int)mx, 16)); mx = umax_(mx, (unsigned)__shfl_xor((int)mx, 32));
                w[p][i] = mx; prev = mx;
            }
        }
        float v1[16], v2[16];
#pragma unroll
        for (int i = 0; i < 16; ++i) { v1[i] = unmono(w[0][i] & ~127u); v2[i] = unmono(w[1][i] & ~127u); }
        unsigned ck[13];
#pragma unroll
        for (int sidx = 0; sidx < 13; ++sidx) {
            unsigned keyk[4];
#pragma unroll
            for (int k = 0; k < 4; ++k) {
                const int c = 4 * sidx + k;
                if (c < 50) { const int ci = cand_i(c), cj = cand_j(c); keyk[k] = (mono(v1[ci] + v2[cj]) & ~255u) | (unsigned)(255 - (ci * 16 + cj)); }
                else keyk[k] = 0u;
            }
            ck[sidx] = fq == 0 ? keyk[0] : fq == 1 ? keyk[1] : fq == 2 ? keyk[2] : keyk[3];
        }
        unsigned W2[16];
        {
            unsigned prev = 0xFFFFFFFFu;
#pragma unroll
            for (int k = 0; k < 16; ++k) {
                unsigned mx = 0u;
#pragma unroll
                for (int sidx = 0; sidx < 13; ++sidx) { const unsigned x = ck[sidx] < prev ? ck[sidx] : 0u; mx = umax_(mx, x); }
                mx = umax_(mx, (unsigned)__shfl_xor((int)mx, 16)); mx = umax_(mx, (unsigned)__shfl_xor((int)mx, 32));
                W2[k] = mx; prev = mx;
            }
        }
        float ev[16]; float esum = 0.f; const float vmax = unmono(W2[0] & ~255u);
#pragma unroll
        for (int k = 0; k < 16; ++k) { ev[k] = __expf(unmono(W2[k] & ~255u) - vmax); esum += ev[k]; }
        const float einv = 1.0f / esum;
        __syncthreads();
        if (fq == 0) {
#pragma unroll
            for (int i = 0; i < 16; ++i) { wl[i] = w[0][i]; wl[16 + i] = w[1][i]; }
        }
        __syncthreads();
#pragma unroll
        for (int k = 0; k < 16; ++k) {
            if ((k >> 2) == fq) {
                const unsigned id = 255u - (W2[k] & 255u);
                const unsigned e1 = 127u - (wl[id >> 4] & 127u), e2 = 127u - (wl[16 + (id & 15u)] & 127u);
                const size_t o = ((size_t)tok * 8 + h) * 16 + k;
                sel_e[o] = (int)(e1 * 128u + e2); sel_g[o] = ev[k] * einv;
            }
        }
    }
}
__device__ __forceinline__ void peer_row(const bf16_t* tab, int e, int lane, u32x4 (&r)[4]) {
    const u32x4* p = (const u32x4*)(tab + (size_t)e * D_) + lane;
#pragma unroll
    for (int jj = 0; jj < 4; ++jj) r[jj] = p[64 * jj];
}
__device__ __forceinline__ void peer_use(const u32x4 (&u)[4], const u32x4 (&v)[4], const float (&x)[32], float (&acc)[32], float gate) {
    float d = 0.f;
#pragma unroll
    for (int jj = 0; jj < 4; ++jj) {
        const unsigned w[4] = {u[jj].x, u[jj].y, u[jj].z, u[jj].w};
#pragma unroll
        for (int q = 0; q < 4; ++q) { d += x[jj * 8 + 2 * q] * bflo(w[q]); d += x[jj * 8 + 2 * q + 1] * bfhi(w[q]); }
    }
    d = wave_sum(d);
    const float coef = gate * gelu_tanh(d);
#pragma unroll
    for (int jj = 0; jj < 4; ++jj) {
        const unsigned w[4] = {v[jj].x, v[jj].y, v[jj].z, v[jj].w};
#pragma unroll
        for (int q = 0; q < 4; ++q) { acc[jj * 8 + 2 * q] += coef * bflo(w[q]); acc[jj * 8 + 2 * q + 1] += coef * bfhi(w[q]); }
    }
}
__device__ __forceinline__ void peer_phase(float* hbuf  , const bf16_t* UB, const bf16_t* VB, const int* sel_e, const float* sel_g,
                                           const float* gam, const float* bet, int G, int b) {
    const int lane = threadIdx.x & 63, wid = threadIdx.x >> 6;
    const int gw = b * NWAVES + wid, NGW = G * NWAVES;
    for (int tok = gw; tok < S_; tok += NGW) {
        float* rp = hbuf + (size_t)tok * D_;
        float x[32], acc[32];
#pragma unroll
        for (int jj = 0; jj < 4; ++jj) { const f32x4 a = *(const f32x4*)(rp + 512 * jj + 8 * lane), c = *(const f32x4*)(rp + 512 * jj + 8 * lane + 4);
            x[jj * 8] = a.x; x[jj * 8 + 1] = a.y; x[jj * 8 + 2] = a.z; x[jj * 8 + 3] = a.w; x[jj * 8 + 4] = c.x; x[jj * 8 + 5] = c.y; x[jj * 8 + 6] = c.z; x[jj * 8 + 7] = c.w; }
#pragma unroll
        for (int i = 0; i < 32; ++i) acc[i] = 0.f;
        const int e0 = sel_e[(size_t)tok * 128 + lane], e1 = sel_e[(size_t)tok * 128 + 64 + lane];
        const float g0 = sel_g[(size_t)tok * 128 + lane], g1 = sel_g[(size_t)tok * 128 + 64 + lane];
        u32x4 ua[4], va[4], ub[4], vb[4];
#pragma unroll
        for (int half = 0; half < 2; ++half) {
            const int ev = half ? e1 : e0; const float gv = half ? g1 : g0;
            { const int e = __builtin_amdgcn_readlane(ev, 0); peer_row(UB, e, lane, ua); peer_row(VB, e, lane, va); }
            for (int k = 0; k < 64; k += 2) {
                { const int e = __builtin_amdgcn_readlane(ev, k + 1); peer_row(UB, e, lane, ub); peer_row(VB, e, lane, vb); }
                peer_use(ua, va, x, acc, __uint_as_float(__builtin_amdgcn_readlane(__float_as_uint(gv), k)));
                if (k + 2 < 64) { const int e = __builtin_amdgcn_readlane(ev, k + 2); peer_row(UB, e, lane, ua); peer_row(VB, e, lane, va); }
                peer_use(ub, vb, x, acc, __uint_as_float(__builtin_amdgcn_readlane(__float_as_uint(gv), k + 1)));
            }
        }
        float sum = 0.f;
#pragma unroll
        for (int i = 0; i < 32; ++i) { acc[i] = DN_ALPHA * x[i] + acc[i]; sum += acc[i]; }
        const float mean = wave_sum(sum) * (1.0f / D_); float sq = 0.f;
#pragma unroll
        for (int i = 0; i < 32; ++i) { acc[i] -= mean; sq += acc[i] * acc[i]; }
        const float rstd = 1.0f / sqrtf(wave_sum(sq) * (1.0f / D_) + LN_EPS);
#pragma unroll
        for (int jj = 0; jj < 4; ++jj) {
            const int col = 512 * jj + 8 * lane;
            const f32x4 ga = *(const f32x4*)(gam + col), gb = *(const f32x4*)(gam + col + 4), ba = *(const f32x4*)(bet + col), bb = *(const f32x4*)(bet + col + 4);
            *(f32x4*)(rp + col) = (f32x4){acc[jj * 8] * rstd * ga.x + ba.x, acc[jj * 8 + 1] * rstd * ga.y + ba.y, acc[jj * 8 + 2] * rstd * ga.z + ba.z, acc[jj * 8 + 3] * rstd * ga.w + ba.w};
            *(f32x4*)(rp + col + 4) = (f32x4){acc[jj * 8 + 4] * rstd * gb.x + bb.x, acc[jj * 8 + 5] * rstd * gb.y + bb.y, acc[jj * 8 + 6] * rstd * gb.z + bb.z, acc[jj * 8 + 7] * rstd * gb.w + bb.w};
        }
    }
}
constexpr int LDSCTL_OFF = 131072, MISC_OFF = LDSCTL_OFF + 320;
constexpr int CW_BAR = 1024;
constexpr size_t CTL_ZERO_BYTES = 64 * 1024;
static_assert((CW_BAR + XCD_BAR_WORDS) * 4 <= (int)CTL_ZERO_BYTES && MISC_OFF + 128 <= LDS_BYTES, "control words");

__global__ void __launch_bounds__(NTHREADS, 2) mega_fwd(Ptrs P) {
    extern __shared__ __attribute__((aligned(16))) unsigned char lds_raw[];
    LAS unsigned char* lds = (LAS unsigned char*)lds_raw;
    unsigned char* ws = P.ws;
    const int G = gridDim.x, b = blockIdx.x;
    for (int u = threadIdx.x; u < (LDS_BYTES - LDSCTL_OFF) / 4; u += NTHREADS) ((LAS unsigned*)(lds + LDSCTL_OFF))[u] = 0u;
    __syncthreads();
    const XcdBarrier bar = xcd_barrier_post((unsigned*)(ws + WS_CTL) + CW_BAR, (volatile LAS unsigned*)(lds + MISC_OFF) + 8);

    bf16_t* const proj = (bf16_t*)(ws + WS_PROJ); bf16_t* const kvs = (bf16_t*)(ws + WS_KVS); bf16_t* const ycat = (bf16_t*)(ws + WS_YCAT);
    const float* const cosT = (const float*)(ws + WS_COS); const float* const sinT = (const float*)(ws + WS_SIN);
    float* const sumA = (float*)(ws + WS_SUMA); float* const sumH = (float*)(ws + WS_SUMH); float* const Hin = (float*)(ws + WS_HIN);
    const bf16_t* const wraT = (const bf16_t*)(ws + WS_WRA_T); const bf16_t* const wriT = (const bf16_t*)(ws + WS_WRI_T);

    prologue_phase(lds, P, G, b);
    xcd_barrier(bar);
    {   pg8::Gemm g{(const pg8::bf16_t*)(ws + WS_XB), (const pg8::bf16_t*)(ws + WS_WIN_T), S_, INC, D_};
        pg8::StaticOrder S; S.init(S_, INC, G, b);
        pg8::EpiBf16<0> E{(pg8::bf16_t*)proj, INC, nullptr, 0, 0, 1.f};
        pg8::gemm_phase<pg8::EpiBf16<0>, pg8::StaticOrder, true, true>(lds, g, S, E); }
    xcd_barrier(bar);
    ret_kv_phase(lds, proj, cosT, sinT, kvs, G, b);
    lru_phase<0>(lds, proj, P, wraT, wriT, sumA, sumH, Hin, ycat, G, b);
    xcd_barrier(bar);
    scan_phase(kvs, sumA, sumH, Hin, G, b);
    xcd_barrier(bar);
    ret_out_phase(lds, proj, cosT, sinT, kvs, ycat, G, b);
    lru_phase<1>(lds, proj, P, wraT, wriT, sumA, sumH, Hin, ycat, G, b);
    xcd_barrier(bar);
    {   pg8::Gemm g{(const pg8::bf16_t*)ycat, (const pg8::bf16_t*)(ws + WS_WOUT_T), S_, D_, D_};
        pg8::StaticOrder S; S.init(S_, D_, G, b);
        pg8::EpiResF32 E{P.x, P.out, D_, DN_ALPHA};
        pg8::gemm_phase<pg8::EpiResF32, pg8::StaticOrder, true, true>(lds, g, S, E); }
    xcd_barrier(bar);
    ln1_phase(P.out, (bf16_t*)(ws + WS_H1B), P.ln1_g, P.ln1_b, G, b);
    xcd_barrier(bar);
    {   pg8::Gemm g{(const pg8::bf16_t*)(ws + WS_H1B), (const pg8::bf16_t*)(ws + WS_WPQ_T), S_, D_, D_};
        pg8::StaticOrder S; S.init(S_, D_, G, b);
        pg8::EpiBf16<0> E{(pg8::bf16_t*)(ws + WS_QP), D_, nullptr, 0, 0, 1.f};
        pg8::gemm_phase<pg8::EpiBf16<0>, pg8::StaticOrder, true, true>(lds, g, S, E); }
    xcd_barrier(bar);
    topk_phase(lds, (const bf16_t*)(ws + WS_QP), (const bf16_t*)(ws + WS_KEYS), (int*)(ws + WS_SELE), (float*)(ws + WS_SELG), G, b);
    xcd_barrier(bar);
    peer_phase(P.out, (const bf16_t*)(ws + WS_UB), (const bf16_t*)(ws + WS_VB), (const int*)(ws + WS_SELE), (const float*)(ws + WS_SELG), P.ln2_g, P.ln2_b, G, b);
}

extern "C" void kernel_launch(void* const* d_in, const int* in_sizes, int n_in, void* d_out, int out_size, void* d_ws, size_t ws_size, hipStream_t stream) {
    static int grid = 0;
    if (grid == 0) {
        if (n_in != 19 || in_sizes[0] != S_ * D_ || out_size != S_ * D_ || ws_size < WS_END) {
            fprintf(stderr, "kernel_launch: unexpected shapes: n_in %d in0 %d out %d ws %zu (need >= %zu)\n", n_in, n_in > 0 ? in_sizes[0] : -1, out_size, ws_size, (size_t)WS_END); grid = -1; return; }
        int dev = 0, cus = 0, per_cu = 0;
        if (hipGetDevice(&dev) != hipSuccess || hipDeviceGetAttribute(&cus, hipDeviceAttributeMultiprocessorCount, dev) != hipSuccess) { grid = -1; return; }
        if (hipFuncSetAttribute((const void*)mega_fwd, hipFuncAttributeMaxDynamicSharedMemorySize, LDS_BYTES) != hipSuccess) { fprintf(stderr, "kernel_launch: hipFuncSetAttribute failed\n"); grid = -1; return; }
        if (hipOccupancyMaxActiveBlocksPerMultiprocessor(&per_cu, (const void*)mega_fwd, NTHREADS, LDS_BYTES) != hipSuccess || per_cu < 1) {
            fprintf(stderr, "kernel_launch: occupancy query reports %d workgroups per CU; nothing launched\n", per_cu); (void)hipGetLastError(); grid = -1; return; }
        grid = cus;
    }
    if (grid < 0) return;
    Ptrs P{};
    P.x = (const float*)d_in[0]; P.pos = (const int*)d_in[1]; P.w_in = (const float*)d_in[2]; P.w_out = (const float*)d_in[3]; P.conv_w = (const float*)d_in[4]; P.conv_b = (const float*)d_in[5];
    P.w_ra = (const float*)d_in[6]; P.b_ra = (const float*)d_in[7]; P.w_ri = (const float*)d_in[8]; P.b_ri = (const float*)d_in[9]; P.lam = (const float*)d_in[10];
    P.ln1_g = (const float*)d_in[11]; P.ln1_b = (const float*)d_in[12]; P.w_pq = (const float*)d_in[13]; P.sub_keys = (const float*)d_in[14]; P.peer_u = (const float*)d_in[15]; P.peer_v = (const float*)d_in[16];
    P.ln2_g = (const float*)d_in[17]; P.ln2_b = (const float*)d_in[18]; P.out = (float*)d_out; P.ws = (unsigned char*)d_ws;
    if (hipMemsetAsync((char*)d_ws + WS_CTL, 0, CTL_ZERO_BYTES, stream) != hipSuccess) { fprintf(stderr, "kernel_launch: hipMemsetAsync failed\n"); return; }
    void* args[] = {&P};
    const hipError_t e = hipLaunchCooperativeKernel((const void*)mega_fwd, dim3(grid), dim3(NTHREADS), args, LDS_BYTES, stream);
    if (e != hipSuccess) fprintf(stderr, "kernel_launch: cooperative launch failed: %s (grid %d)\n", hipGetErrorString(e), grid);
}
```

```cpp
#include <hip/hip_runtime.h>
#include <cstdio>
#include <cstdint>
#include <cmath>

namespace pg8 {
#define PG8_LAS __attribute__((address_space(3)))
typedef unsigned short bf16_t;
typedef short bf16x8 __attribute__((ext_vector_type(8)));
typedef float f32x4 __attribute__((ext_vector_type(4)));
typedef unsigned u32x4 __attribute__((ext_vector_type(4)));
constexpr int BM = 256, BK = 64, HALF = 128, HTB = HALF * BK * 2  , STAGE_BYTES = 8 * HTB, NXCD = 8, WGM = 8;

__host__ __device__ __forceinline__ int lds_byte(int r, int c) { const int st = (r >> 4) * 2 + (c >> 5), rr = r & 15, cc = c & 31, ob = rr * 64 + cc * 2; return st * 1024 + (ob ^ (((ob >> 9) & 1) << 5)); }
__host__ __device__ __forceinline__ void stage_rc(int b, int& R, int& C) { const int st = b / 1024, sb = b % 1024, swz = sb ^ (((sb >> 9) & 1) << 5); R = (st >> 1) * 16 + swz / 64; C = (st & 1) * 32 + (swz % 64) / 2; }
__host__ __device__ __forceinline__ int perm32(int rho) { const int n = rho >> 4, i = rho & 15; return 8 * (i >> 2) + 4 * n + (i & 3); }

struct Unit { int pm, pn; };
struct Gemm { const bf16_t* A; const bf16_t* Bt; int M, N, K; };

struct StaticOrder {
    int nM, nN, nwg, G, c;
    __host__ __device__ void init(int M, int N, int G_, int c_) { nM = M / BM; nN = N / BM; nwg = nM * nN; G = G_; c = c_; }
    __host__ __device__ bool next(int i, Unit& u) const {
        const long L = (long)i * G + c; if (L >= nwg) return false;
        int wgid = (int)L; { const int q = nwg / NXCD, r = nwg % NXCD, xcd = wgid % NXCD, off = wgid / NXCD; wgid = (xcd < r ? xcd * (q + 1) : r * (q + 1) + (xcd - r) * q) + off; }
        const int nig = WGM * nN, gid = wgid / nig, fm = gid * WGM, gsz = (nM - fm) < WGM ? (nM - fm) : WGM;
        u.pm = fm + ((wgid % nig) % gsz); u.pn = (wgid % nig) / gsz; return true;
    }
    __device__ __forceinline__ void a_ready(const Unit&) const {}
    __device__ __forceinline__ void done(const Unit&) const {}
};

__device__ __forceinline__ unsigned cvt_pk_bf16(float lo, float hi) { unsigned r; asm volatile("v_cvt_pk_bf16_f32 %0, %1, %2" : "=v"(r) : "v"(lo), "v"(hi)); return r; }
typedef float f32x2 __attribute__((ext_vector_type(2)));
__device__ __forceinline__ f32x2 gelu_pk(f32x2 v) {
    const f32x2 av = __builtin_elementwise_abs(v), d = av * 0.2316418882f + 1.0f;
    f32x2 t; t.x = __builtin_amdgcn_rcpf(d.x); t.y = __builtin_amdgcn_rcpf(d.y);
    f32x2 q = t * 0.5307027145f + (-0.7265760135f); q = q * t + 0.7107068705f; q = q * t + (-0.142248368f); q = q * t + 0.127414796f; q = q * t;
    const f32x2 s = (v * v) * (-0.72134752044f);
    f32x2 e; e.x = __builtin_amdgcn_exp2f(s.x); e.y = __builtin_amdgcn_exp2f(s.y);
    const f32x2 m = v * (q * e), r = v - m;
    f32x2 o; o.x = v.x < 0.f ? m.x : r.x; o.y = v.y < 0.f ? m.y : r.y; return o;
}

template <int ACT  > struct EpiBf16 {
    static constexpr bool PERM = true, AFTER_DRAIN = false; static_assert(ACT == 0 || ACT == 1, "EpiBf16: ACT is 0 (none) or 1 (gelu_pk)");
    bf16_t* O; int ldc; const float* bias; int split_cols; size_t split_stride; float scale0;
    __device__ __forceinline__ void operator()(const f32x4 (&acc)[2][2][4][2], const Unit& u, int wr, int wc, int fr, int fq) const {
        const int row0 = u.pm * BM + wr * 64 + fr; int colt = u.pn * BM; bf16_t* base = O;
        float sc = 1.f; if (split_cols) { const int t = colt / split_cols; base += (size_t)t * split_stride; colt -= t * split_cols; if (t == 0) sc = scale0; }
        const int col0 = colt + wc * 32 + 8 * fq, bcol0 = u.pn * BM + wc * 32 + 8 * fq;
        f32x4 bv[2][2];
#pragma unroll
        for (int bj = 0; bj < 2; ++bj)
#pragma unroll
            for (int n = 0; n < 2; ++n) bv[bj][n] = bias ? *(const f32x4*)(bias + bcol0 + bj * HALF + 4 * n) : (f32x4){0.f, 0.f, 0.f, 0.f};
#pragma unroll
        for (int ai = 0; ai < 2; ++ai)
#pragma unroll
            for (int m = 0; m < 4; ++m) { bf16_t* rowp = base + (size_t)(row0 + ai * HALF + m * 16) * ldc + col0;
#pragma unroll
                for (int bj = 0; bj < 2; ++bj) { f32x4 v0 = acc[ai][bj][m][0] + bv[bj][0], v1 = acc[ai][bj][m][1] + bv[bj][1];
                    if (ACT == 1) { f32x2 a = gelu_pk((f32x2){v0[0], v0[1]}), b = gelu_pk((f32x2){v0[2], v0[3]}), c = gelu_pk((f32x2){v1[0], v1[1]}), d = gelu_pk((f32x2){v1[2], v1[3]});
                        v0 = (f32x4){a.x, a.y, b.x, b.y}; v1 = (f32x4){c.x, c.y, d.x, d.y}; }
                    v0 = v0 * sc; v1 = v1 * sc; u32x4 w; w.x = cvt_pk_bf16(v0[0], v0[1]); w.y = cvt_pk_bf16(v0[2], v0[3]); w.z = cvt_pk_bf16(v1[0], v1[1]); w.w = cvt_pk_bf16(v1[2], v1[3]);
                    *(u32x4*)(rowp + bj * HALF) = w; } }
    }
};
struct EpiResF32 {
    static constexpr bool PERM = false, AFTER_DRAIN = false;
    const float* base; float* out; int ldc; float alpha;
    __device__ __forceinline__ void operator()(const f32x4 (&acc)[2][2][4][2], const Unit& u, int wr, int wc, int fr, int fq) const {
        const int row0 = u.pm * BM + wr * 64 + fr, col0 = u.pn * BM + wc * 32 + 4 * fq;
#pragma unroll
        for (int ai = 0; ai < 2; ++ai)
#pragma unroll
            for (int m = 0; m < 4; ++m) { const size_t off = (size_t)(row0 + ai * HALF + m * 16) * ldc + col0;
#pragma unroll
                for (int bj = 0; bj < 2; ++bj)
#pragma unroll
                    for (int n = 0; n < 2; ++n) { const f32x4 bs = *(const f32x4*)(base + off + bj * HALF + n * 16); *(f32x4*)(out + off + bj * HALF + n * 16) = bs * alpha + acc[ai][bj][m][n]; }
                asm volatile("" ::: "memory"); }
    }
};
template <class Epi, class Sched, bool ALIGN_EPI = false, bool SP2 = false>
__device__ __forceinline__ void gemm_phase(PG8_LAS unsigned char* lds, const Gemm g, const Sched& S, const Epi& E) {
    const int tid = threadIdx.x, wid = __builtin_amdgcn_readfirstlane(tid >> 6), lane = tid & 63, wr = wid >> 2, wc = wid & 3, fr = lane & 15, fq = lane >> 4;
    const int K = g.K, nt = K / BK;
    unsigned voffA[2], voffB[2];
#pragma unroll
    for (int i = 0; i < 2; ++i) { int R, C; stage_rc(tid * 16 + i * 8192, R, C); const int Rb = Epi::PERM ? ((R & ~31) + perm32(R & 31)) : R;
        voffA[i] = (unsigned)(R * K + C) * 2u; voffB[i] = (unsigned)(Rb * K + C) * 2u; }
    const size_t kstep = (size_t)(BK * 2);
    const size_t hstep = (size_t)HALF * K * 2;
    const size_t tstep = 2 * hstep;
    const unsigned ldsw = (unsigned)wid * 1024u;
    const int aoff = lds_byte(wr * 64 + fr, fq * 8), boff = lds_byte(wc * 32 + fr, fq * 8);
#define PG8_SA(b, h) (((b) * 2 + (h)) * HTB)
#define PG8_SB(b, h) ((4 + (b) * 2 + (h)) * HTB)
#define PG8_STAGE(bufoff, gbase, voff) do { _Pragma("unroll") for (int _i = 0; _i < 2; ++_i) \
        __builtin_amdgcn_global_load_lds((const unsigned*)((const char*)(gbase) + (voff)[_i]), (PG8_LAS unsigned*)(lds + (bufoff) + ldsw + _i * 8192), 16, 0, 0); } while (0)
#define PG8_LDA(dst, b, h) do { _Pragma("unroll") for (int m = 0; m < 4; ++m) _Pragma("unroll") for (int k = 0; k < 2; ++k) dst[m][k] = *(const PG8_LAS bf16x8*)(lds + PG8_SA(b, h) + aoff + m * 2048 + k * 1024); } while (0)
#define PG8_LDB(dst, b, h) do { _Pragma("unroll") for (int n = 0; n < 2; ++n) _Pragma("unroll") for (int k = 0; k < 2; ++k) dst[n][k] = *(const PG8_LAS bf16x8*)(lds + PG8_SB(b, h) + boff + n * 2048 + k * 1024); } while (0)
#define PG8_MMA(ai, bj, At, Bt) do { __builtin_amdgcn_s_setprio(1); _Pragma("unroll") for (int m = 0; m < 4; ++m) _Pragma("unroll") for (int n = 0; n < 2; ++n) _Pragma("unroll") for (int k = 0; k < 2; ++k) \
        acc[ai][bj][m][n] = __builtin_amdgcn_mfma_f32_16x16x32_bf16(Bt[n][k], At[m][k], acc[ai][bj][m][n], 0, 0, 0); __builtin_amdgcn_s_setprio(0); } while (0)
#define PG8_WAIT_V(n) asm volatile("s_waitcnt vmcnt(" #n ")" ::: "memory")
#define PG8_WAIT_L(n) asm volatile("s_waitcnt lgkmcnt(" #n ")" ::: "memory")
#define PG8_BAR __builtin_amdgcn_s_barrier()
#define PG8_SCHED __builtin_amdgcn_sched_barrier(0)
    Unit cur, nxt; int ui = 0;
    if (!S.next(0, cur)) return;
    f32x4 acc[2][2][4][2];
#pragma unroll
    for (int a = 0; a < 2; ++a)
#pragma unroll
        for (int b = 0; b < 2; ++b)
#pragma unroll
            for (int m = 0; m < 4; ++m)
#pragma unroll
                for (int n = 0; n < 2; ++n) acc[a][b][m][n] = (f32x4){0.f, 0.f, 0.f, 0.f};
    bf16x8 At[4][2], B0[2][2], B1[2][2];
    const char* cA = (const char*)g.A + (size_t)cur.pm * tstep; const char* cB = (const char*)g.Bt + (size_t)cur.pn * tstep;
    S.a_ready(cur);
    if constexpr (SP2) {
        PG8_STAGE(PG8_SB(0, 0), cB, voffB); PG8_STAGE(PG8_SB(0, 1), cB + hstep, voffB); PG8_STAGE(PG8_SA(0, 0), cA, voffA); PG8_STAGE(PG8_SA(0, 1), cA + hstep, voffA);
        if (wr == 1) PG8_BAR;
        PG8_WAIT_V(2); PG8_BAR;
        PG8_STAGE(PG8_SB(1, 0), cB + kstep, voffB); PG8_STAGE(PG8_SA(1, 0), cA + kstep, voffA); PG8_STAGE(PG8_SB(1, 1), cB + hstep + kstep, voffB);
        PG8_WAIT_V(6); PG8_BAR;
    } else {
        PG8_STAGE(PG8_SB(0, 0), cB, voffB); PG8_STAGE(PG8_SA(0, 0), cA, voffA); PG8_STAGE(PG8_SB(0, 1), cB + hstep, voffB); PG8_STAGE(PG8_SA(0, 1), cA + hstep, voffA);
        if (wr == 1) PG8_BAR;
        PG8_WAIT_V(4); PG8_BAR;
        PG8_STAGE(PG8_SB(1, 0), cB + kstep, voffB); PG8_STAGE(PG8_SA(1, 0), cA + kstep, voffA); PG8_STAGE(PG8_SB(1, 1), cB + hstep + kstep, voffB);
        PG8_WAIT_V(6); PG8_BAR;
    }
    for (;;) {
        const bool has_next = S.next(ui + 1, nxt);
        const char* nA = has_next ? (const char*)g.A + (size_t)nxt.pm * tstep : cA; const char* nB = has_next ? (const char*)g.Bt + (size_t)nxt.pn * tstep : cB;
        for (int t = 0; t < nt; t += 2) {
            const bool last = (t == nt - 2);
            const char* a1 = cA + (size_t)(t + 1) * kstep;
            const char* a2 = last ? nA : cA + (size_t)(t + 2) * kstep; const char* b2 = last ? nB : cB + (size_t)(t + 2) * kstep;
            const char* a3 = a2 + kstep; const char* b3 = b2 + kstep;
            if (last && has_next) S.a_ready(nxt);
            if constexpr (SP2) {
            PG8_LDB(B0, 0, 0); PG8_LDB(B1, 0, 1); PG8_SCHED; PG8_LDA(At, 0, 0); PG8_STAGE(PG8_SA(1, 1), a1 + hstep, voffA);
            PG8_WAIT_V(8); PG8_WAIT_L(0); PG8_BAR; PG8_MMA(0, 0, At, B0); PG8_MMA(0, 1, At, B1); PG8_BAR; PG8_SCHED;
            PG8_LDA(At, 0, 1); PG8_STAGE(PG8_SB(0, 0), b2, voffB); PG8_STAGE(PG8_SB(0, 1), b2 + hstep, voffB); PG8_STAGE(PG8_SA(0, 0), a2, voffA);
            PG8_WAIT_V(8); PG8_WAIT_L(0); PG8_BAR; PG8_MMA(1, 0, At, B0); PG8_MMA(1, 1, At, B1); PG8_BAR; PG8_SCHED;
            PG8_LDB(B0, 1, 0); PG8_LDB(B1, 1, 1); PG8_SCHED; PG8_LDA(At, 1, 0); PG8_STAGE(PG8_SA(0, 1), a2 + hstep, voffA);
            PG8_WAIT_V(8); PG8_WAIT_L(0); PG8_BAR; PG8_MMA(0, 0, At, B0); PG8_MMA(0, 1, At, B1); PG8_BAR; PG8_SCHED;
            PG8_LDA(At, 1, 1); PG8_STAGE(PG8_SB(1, 0), b3, voffB); PG8_STAGE(PG8_SB(1, 1), b3 + hstep, voffB); PG8_STAGE(PG8_SA(1, 0), a3, voffA);
            PG8_WAIT_V(8); PG8_WAIT_L(0); PG8_BAR; PG8_MMA(1, 0, At, B0); PG8_MMA(1, 1, At, B1); PG8_BAR; PG8_SCHED;
            } else {
            PG8_LDB(B0, 0, 0); PG8_SCHED; PG8_LDA(At, 0, 0); PG8_STAGE(PG8_SA(1, 1), a1 + hstep, voffA);
            PG8_WAIT_L(8); PG8_BAR; PG8_WAIT_L(0); PG8_MMA(0, 0, At, B0); PG8_BAR; PG8_SCHED;
            PG8_LDB(B1, 0, 1); PG8_STAGE(PG8_SB(0, 0), b2, voffB);
            PG8_BAR; PG8_WAIT_L(0); PG8_MMA(0, 1, At, B1); PG8_BAR;
            PG8_LDA(At, 0, 1); PG8_STAGE(PG8_SA(0, 0), a2, voffA);
            PG8_BAR; PG8_WAIT_L(0); PG8_MMA(1, 0, At, B0); PG8_BAR; PG8_SCHED;
            PG8_STAGE(PG8_SB(0, 1), b2 + hstep, voffB);
            PG8_WAIT_V(6); PG8_BAR; PG8_MMA(1, 1, At, B1); PG8_BAR;
            PG8_LDB(B0, 1, 0); PG8_SCHED; PG8_LDA(At, 1, 0); PG8_STAGE(PG8_SA(0, 1), a2 + hstep, voffA);
            PG8_WAIT_L(8); PG8_BAR; PG8_WAIT_L(0); PG8_MMA(0, 0, At, B0); PG8_BAR; PG8_SCHED;
            PG8_LDB(B1, 1, 1); PG8_STAGE(PG8_SB(1, 0), b3, voffB);
            PG8_BAR; PG8_WAIT_L(0); PG8_MMA(0, 1, At, B1); PG8_BAR;
            PG8_LDA(At, 1, 1); PG8_STAGE(PG8_SA(1, 0), a3, voffA);
            PG8_BAR; PG8_WAIT_L(0); PG8_MMA(1, 0, At, B0); PG8_BAR; PG8_SCHED;
            PG8_STAGE(PG8_SB(1, 1), b3 + hstep, voffB);
            PG8_WAIT_V(6); PG8_BAR; PG8_MMA(1, 1, At, B1); PG8_BAR;
            }
        }
        if constexpr (ALIGN_EPI) { if (wr == 0) PG8_BAR; }
        if constexpr (!Epi::AFTER_DRAIN) { E(acc, cur, wr, wc, fr, fq); S.done(cur); }
        if (!has_next) break;
#pragma unroll
        for (int a = 0; a < 2; ++a)
#pragma unroll
            for (int b = 0; b < 2; ++b)
#pragma unroll
                for (int m = 0; m < 4; ++m)
#pragma unroll
                    for (int n = 0; n < 2; ++n) acc[a][b][m][n] = (f32x4){0.f, 0.f, 0.f, 0.f};
        cur = nxt; cA = nA; cB = nB; ++ui;
        if constexpr (ALIGN_EPI) { if (wr == 1) PG8_BAR; }
    }
    PG8_WAIT_V(0);
    if constexpr (!ALIGN_EPI) { if (wr == 0) PG8_BAR; }
    PG8_BAR;
    if constexpr (Epi::AFTER_DRAIN) { E.fused(acc, cur, wr, wc, fr, fq, lds, wid, lane); S.done(cur); }
#undef PG8_SA
#undef PG8_SB
#undef PG8_STAGE
#undef PG8_LDA
#undef PG8_LDB
#undef PG8_MMA
#undef PG8_WAIT_V
#undef PG8_WAIT_L
#undef PG8_BAR
#undef PG8_SCHED
}
}
constexpr int S_ = 16384, D_ = 2048, INC = 6144, NH = 8, DH = 128, CH = 64, NCH = 256;
constexpr float DN_ALPHA = 1.189207115002721f;
constexpr float LN_EPS = 1e-5f, GN_EPS = 1e-6f;
constexpr int NWAVES = 8, NTHREADS = 512;
constexpr int LDS_BYTES = 147456;

constexpr size_t MiB = 1u << 20;
constexpr size_t WS_CTL = 0;
constexpr size_t WS_WOUT_T = 1 * MiB, WS_WPQ_T = 9 * MiB, WS_KEYS = 17 * MiB, WS_WRA_T = 17 * MiB + 512 * 1024, WS_WRI_T = 17 * MiB + 768 * 1024;
constexpr size_t WS_COS = 18 * MiB, WS_SIN = 22 * MiB, WS_SUMA = 26 * MiB, WS_SUMH = 27 * MiB, WS_HIN = 28 * MiB;
constexpr size_t WS_SU = 29 * MiB, WS_SV = 30 * MiB;
constexpr size_t WS_UQ = 32 * MiB, WS_VQ = 64 * MiB;
constexpr size_t WS_WIN_T = 160 * MiB, WS_XB = 184 * MiB, WS_KVS = 184 * MiB, WS_H1B = 184 * MiB;
constexpr size_t WS_PROJ = 248 * MiB, WS_QP = 248 * MiB, WS_SELE = 312 * MiB, WS_SELG = 320 * MiB;
constexpr size_t WS_YCAT = 440 * MiB, WS_END = 504 * MiB;

#define LAS __attribute__((address_space(3)))
typedef unsigned short bf16_t;
typedef short bf16x8 __attribute__((ext_vector_type(8)));
typedef float f32x4 __attribute__((ext_vector_type(4)));
typedef unsigned u32x4 __attribute__((ext_vector_type(4)));
typedef unsigned u32x2 __attribute__((ext_vector_type(2)));

__device__ __forceinline__ unsigned f2bf(float f) { unsigned u = __float_as_uint(f); return (u + 0x7fffu + ((u >> 16) & 1u)) >> 16; }
__device__ __forceinline__ unsigned pk2(float lo, float hi) { return f2bf(lo) | (f2bf(hi) << 16); }
__device__ __forceinline__ float bflo(unsigned w) { return __uint_as_float(w << 16); }
__device__ __forceinline__ float bfhi(unsigned w) { return __uint_as_float(w & 0xffff0000u); }
__device__ __forceinline__ float bf2f(bf16_t b) { return __uint_as_float(((unsigned)b) << 16); }
__device__ __forceinline__ f32x4 mfma16(bf16x8 a, bf16x8 b, f32x4 c) { return __builtin_amdgcn_mfma_f32_16x16x32_bf16(a, b, c, 0, 0, 0); }
__device__ __forceinline__ float sigmoidf_(float x) { return 1.0f / (1.0f + __expf(-x)); }
__device__ __forceinline__ float gelu_tanh(float x) { const float y = 0.7978845608028654f * (x + 0.044715f * x * x * x); return x / (1.0f + __expf(-2.0f * y)); }
__device__ __forceinline__ float wave_sum(float v) {
#pragma unroll
    for (int o = 1; o < 64; o <<= 1) v += __shfl_xor(v, o);
    return v;
}
__device__ __forceinline__ float wave_max(float v) {
#pragma unroll
    for (int o = 1; o < 64; o <<= 1) v = fmaxf(v, __shfl_xor(v, o));
    return v;
}
__device__ __forceinline__ int wave_sum_i(int v) {
#pragma unroll
    for (int o = 1; o < 64; o <<= 1) v += __shfl_xor(v, o);
    return v;
}
__device__ __forceinline__ float head_log_gamma(int h) { return logf(1.0f - exp2f(-5.0f - (float)h)); }

__device__ __forceinline__ void transpose_item(const float* W, int K, int N, bf16_t* WT, LAS float* scr, int item, int lane) {
    const int nblk = N / 32, kb = item / nblk, nb = item % nblk, k0 = 64 * kb, n0 = 32 * nb;
#pragma unroll 8
    for (int i = 0; i < 32; ++i) { const int kk = 2 * i + (lane >> 5); scr[kk * 33 + (lane & 31)] = W[(size_t)(k0 + kk) * N + n0 + (lane & 31)]; }
    asm volatile("s_waitcnt lgkmcnt(0)" ::: "memory");
    const int c = lane & 7;
#pragma unroll
    for (int j = 0; j < 4; ++j) { const int n = (lane >> 3) + 8 * j; const LAS float* s = scr + (8 * c) * 33 + n;
        u32x4 o; o.x = pk2(s[0 * 33], s[1 * 33]); o.y = pk2(s[2 * 33], s[3 * 33]); o.z = pk2(s[4 * 33], s[5 * 33]); o.w = pk2(s[6 * 33], s[7 * 33]);
        *(u32x4*)(WT + (size_t)(n0 + n) * K + k0 + 8 * c) = o; }
    asm volatile("s_waitcnt lgkmcnt(0)" ::: "memory");
}
__device__ __forceinline__ void cvt_stream(const float* src, bf16_t* dst, size_t n8, size_t gtid, size_t gthreads) {
    for (size_t i = gtid; i < n8; i += gthreads) {
        const f32x4 a = ((const f32x4*)src)[2 * i], b = ((const f32x4*)src)[2 * i + 1];
        u32x4 o; o.x = pk2(a.x, a.y); o.y = pk2(a.z, a.w); o.z = pk2(b.x, b.y); o.w = pk2(b.z, b.w);
        ((u32x4*)dst)[i] = o;
    }
}
struct Ptrs {
    const float *x; const int* pos; const float *w_in, *w_out, *conv_w, *conv_b, *w_ra, *b_ra, *w_ri, *b_ri, *lam, *ln1_g, *ln1_b, *w_pq, *sub_keys, *peer_u, *peer_v, *ln2_g, *ln2_b;
    float* out; unsigned char* ws;
};
__device__ __forceinline__ void prologue_phase(LAS unsigned char* lds, const Ptrs& P, int G, int b) {
    const int tid = threadIdx.x, lane = tid & 63, wid = tid >> 6;
    LAS float* scr = (LAS float*)(lds + wid * 16384);
    const int gw = b * NWAVES + wid, NGW = G * NWAVES;
    unsigned char* ws = P.ws;
    constexpr int I_IN = (D_ / 64) * (INC / 32), I_SQ = (D_ / 64) * (D_ / 32), I_G = 2 * 4;
    constexpr int NITEMS = I_IN + 2 * I_SQ + 16 * I_G;
    for (int it = gw; it < NITEMS; it += NGW) {
        int r = it;
        if (r < I_IN) { transpose_item(P.w_in, D_, INC, (bf16_t*)(ws + WS_WIN_T), scr, r, lane); continue; } r -= I_IN;
        if (r < I_SQ) { transpose_item(P.w_out, D_, D_, (bf16_t*)(ws + WS_WOUT_T), scr, r, lane); continue; } r -= I_SQ;
        if (r < I_SQ) { transpose_item(P.w_pq, D_, D_, (bf16_t*)(ws + WS_WPQ_T), scr, r, lane); continue; } r -= I_SQ;
        if (r < 8 * I_G) { const int g = r / I_G; transpose_item(P.w_ra + g * 16384, 128, 128, (bf16_t*)(ws + WS_WRA_T) + g * 16384, scr, r % I_G, lane); continue; } r -= 8 * I_G;
        { const int g = r / I_G; transpose_item(P.w_ri + g * 16384, 128, 128, (bf16_t*)(ws + WS_WRI_T) + g * 16384, scr, r % I_G, lane); }
    }
    const size_t gtid = (size_t)b * NTHREADS + tid, gth = (size_t)G * NTHREADS;
    cvt_stream(P.x, (bf16_t*)(ws + WS_XB), (size_t)S_ * D_ / 8, gtid, gth);
    for (int row = gw; row < 2 * 16384; row += NGW) {
        const int isv = row >> 14, e = row & 16383;
        const float* rp = (isv ? P.peer_v : P.peer_u) + (size_t)e * D_;
        f32x4 v[8]; float amax = 0.f;
#pragma unroll
        for (int j = 0; j < 8; ++j) { v[j] = *(const f32x4*)(rp + 256 * j + 4 * lane); amax = fmaxf(amax, fmaxf(fmaxf(fabsf(v[j].x), fabsf(v[j].y)), fmaxf(fabsf(v[j].z), fabsf(v[j].w)))); }
        amax = wave_max(amax);
        const float inv = amax > 0.f ? 127.0f / amax : 0.f;
        if (lane == 0) ((float*)(ws + (isv ? WS_SV : WS_SU)))[e] = amax > 0.f ? amax / 127.0f : 0.f;
        unsigned* qp = (unsigned*)(ws + (isv ? WS_VQ : WS_UQ)) + (size_t)e * (D_ / 4);
        const int off = isv ? 128 : 0;
#pragma unroll
        for (int j = 0; j < 8; ++j) {
            const int a = (int)rintf(v[j].x * inv) + off, bq = (int)rintf(v[j].y * inv) + off, c = (int)rintf(v[j].z * inv) + off, d = (int)rintf(v[j].w * inv) + off;
            qp[64 * j + lane] = (unsigned)(a & 255) | ((unsigned)(bq & 255) << 8) | ((unsigned)(c & 255) << 16) | ((unsigned)(d & 255) << 24);
        }
    }
    cvt_stream(P.sub_keys, (bf16_t*)(ws + WS_KEYS), (size_t)8 * 2 * 128 * 128 / 8, gtid, gth);
    float* cosT = (float*)(ws + WS_COS); float* sinT = (float*)(ws + WS_SIN);
    for (size_t i = gtid; i < (size_t)S_ * 64; i += gth) {
        const int s = (int)(i >> 6), f = (int)(i & 63);
        const float inv = powf(10000.0f, -(float)f / 64.0f);
        const float ang = (float)P.pos[s] * inv;
        float sn, cs; sincosf(ang, &sn, &cs);
        cosT[i] = cs; sinT[i] = sn;
    }
}
#define XB_TMO      128
#define XB_XCNT(j)  (256  + 64 * (j))
#define XB_XSUB(j)  (1280 + 64 * (j))
#define XB_XGEN(j)  (2304 + 64 * (j))
#define XB_TOP      3328
#define XB_TOPGEN   3392
#define XCD_BAR_WORDS 3456
#define XB_SPIN_CAP (1u << 18)

__device__ __forceinline__ unsigned xb_ld(unsigned* p)              { return __hip_atomic_load(p, __ATOMIC_RELAXED, __HIP_MEMORY_SCOPE_AGENT); }
__device__ __forceinline__ unsigned xb_add(unsigned* p, unsigned v) { return __hip_atomic_fetch_add(p, v, __ATOMIC_RELAXED, __HIP_MEMORY_SCOPE_AGENT); }
__device__ __forceinline__ unsigned xb_xcc_id() { return (unsigned)__builtin_amdgcn_s_getreg((3 << 11) | 20) & 0xFu; }
#define XB_SPIN(cond, bar) do { unsigned _sp = 0; while (cond) { __builtin_amdgcn_s_sleep(1); \
    if ((++_sp & 255u) == 0u) { if (xb_ld(&(bar)[XB_TMO])) break; if (_sp > XB_SPIN_CAP) { atomicAdd(&(bar)[XB_TMO], 1u); break; } } } } while (0)

struct XcdBarrier {
    unsigned* bar; unsigned x;
    volatile LAS unsigned* st;
};

__device__ __forceinline__ XcdBarrier xcd_barrier_post(unsigned* bar, volatile LAS unsigned* st) {
    XcdBarrier b; b.bar = bar; b.x = xb_xcc_id(); b.st = st;
    if (threadIdx.x == 0) (void)xb_add(&bar[XB_XCNT(b.x)], 1u);
    return b;
}
__device__ __forceinline__ void xcd_barrier_complete(unsigned* bar, unsigned x, unsigned& nloc, unsigned& nx) {
    const unsigned G = gridDim.x * gridDim.y * gridDim.z;
    unsigned sum, cnt, mine, sp = 0u;
    for (;;) {
        sum = 0u; cnt = 0u; mine = 0u;
#pragma unroll
        for (unsigned j = 0; j < 16; ++j) { const unsigned c = xb_ld(&bar[XB_XCNT(j)]); sum += c; cnt += (c > 0u) ? 1u : 0u; mine = (j == x) ? c : mine; }
        if (sum == G) break;
        __builtin_amdgcn_s_sleep(1);
        if ((++sp & 255u) == 0u) { if (xb_ld(&bar[XB_TMO])) break; if (sp > XB_SPIN_CAP) { atomicAdd(&bar[XB_TMO], 1u); break; } }
    }
    nloc = mine > 0u ? mine : 1u; nx = cnt > 0u ? cnt : 1u;
}

__device__ __forceinline__ void xcd_barrier(const XcdBarrier& b) {
    asm volatile("s_waitcnt vmcnt(0)" ::: "memory");
    __syncthreads();
    if (threadIdx.x == 0) {
        unsigned* bar = b.bar;
        __builtin_amdgcn_s_waitcnt(0);
        unsigned nloc = b.st[0], nx = b.st[1];
        if (nloc == 0u) { xcd_barrier_complete(bar, b.x, nloc, nx); b.st[0] = nloc; b.st[1] = nx; }
        const unsigned old = xb_add(&bar[XB_XSUB(b.x)], 1u);
        const unsigned gen = old / nloc;
        if (old + 1u == (gen + 1u) * nloc) {
            __builtin_amdgcn_fence(__ATOMIC_RELEASE, "agent");
            asm volatile("s_waitcnt vmcnt(0)" ::: "memory");
            const unsigned og = xb_add(&bar[XB_TOP], 1u);
            const unsigned tg = og / nx;
            if (og + 1u == (tg + 1u) * nx) xb_add(&bar[XB_TOPGEN], 1u);
            else XB_SPIN(xb_ld(&bar[XB_TOPGEN]) == tg, bar);
            __builtin_amdgcn_fence(__ATOMIC_ACQUIRE, "agent");
            xb_add(&bar[XB_XGEN(b.x)], 1u);
            asm volatile("s_waitcnt vmcnt(0)" ::: "memory");
        } else {
            XB_SPIN(xb_ld(&bar[XB_XGEN(b.x)]) == gen, bar);
            __builtin_amdgcn_fence(__ATOMIC_ACQUIRE, "agent");
            asm volatile("s_waitcnt vmcnt(0)" ::: "memory");
        }
    }
    __syncthreads();
}
__device__ __forceinline__ void rot8(const u32x4 x1, const u32x4 x2, const float* cp, const float* sp, float scale, float (&o1)[8], float (&o2)[8]) {
    const f32x4 c0 = *(const f32x4*)cp, c1 = *(const f32x4*)(cp + 4), s0 = *(const f32x4*)sp, s1 = *(const f32x4*)(sp + 4);
    const float cs[8] = {c0.x, c0.y, c0.z, c0.w, c1.x, c1.y, c1.z, c1.w}, sn[8] = {s0.x, s0.y, s0.z, s0.w, s1.x, s1.y, s1.z, s1.w};
    const unsigned w1[4] = {x1.x, x1.y, x1.z, x1.w}, w2[4] = {x2.x, x2.y, x2.z, x2.w};
#pragma unroll
    for (int j = 0; j < 8; ++j) {
        const float a = (j & 1) ? bfhi(w1[j >> 1]) : bflo(w1[j >> 1]);
        const float bb = (j & 1) ? bfhi(w2[j >> 1]) : bflo(w2[j >> 1]);
        o1[j] = (a * cs[j] - bb * sn[j]) * scale;
        o2[j] = (bb * cs[j] + a * sn[j]) * scale;
    }
}
__device__ __forceinline__ void ret_kv_phase(LAS unsigned char* lds, const bf16_t* proj, const float* cosT, const float* sinT, bf16_t* kvs, int G, int b) {
    const int tid = threadIdx.x, lane = tid & 63, wid = tid >> 6, fr = lane & 15, fq = lane >> 4;
    LAS bf16_t* KT = (LAS bf16_t*)lds;
    LAS bf16_t* VT = (LAS bf16_t*)(lds + 18432);
    for (int unit = b; unit < NCH * NH; unit += G) {
        const int n = unit >> 3, h = unit & 7;
        const float log_g = head_log_gamma(h);
        const int m = tid >> 3, tq = tid & 7; const int s = n * 64 + m;
        {
            const bf16_t* kp = proj + (size_t)s * INC + 1024 + h * 128 + tq * 8;
            const u32x4 x1 = *(const u32x4*)kp, x2 = *(const u32x4*)(kp + 64);
            float o1[8], o2[8];
            rot8(x1, x2, cosT + (size_t)s * 64 + tq * 8, sinT + (size_t)s * 64 + tq * 8, expf(log_g * (63.0f - (float)m)), o1, o2);
#pragma unroll
            for (int j = 0; j < 8; ++j) { KT[(tq * 8 + j) * 72 + m] = (bf16_t)f2bf(o1[j]); KT[(64 + tq * 8 + j) * 72 + m] = (bf16_t)f2bf(o2[j]); }
            const bf16_t* vp = proj + (size_t)s * INC + 2048 + h * 128 + tq * 16;
            const u32x4 y0 = *(const u32x4*)vp, y1 = *(const u32x4*)(vp + 8);
            const unsigned yw[8] = {y0.x, y0.y, y0.z, y0.w, y1.x, y1.y, y1.z, y1.w};
#pragma unroll
            for (int j = 0; j < 8; ++j) { VT[(tq * 16 + 2 * j) * 72 + m] = (bf16_t)(yw[j] & 0xffffu); VT[(tq * 16 + 2 * j + 1) * 72 + m] = (bf16_t)(yw[j] >> 16); }
        }
        __syncthreads();
        f32x4 acc[8];
#pragma unroll
        for (int et = 0; et < 8; ++et) acc[et] = (f32x4){0.f, 0.f, 0.f, 0.f};
#pragma unroll
        for (int ks = 0; ks < 2; ++ks) {
            const bf16x8 a = *(const LAS bf16x8*)(KT + (wid * 16 + fr) * 72 + ks * 32 + fq * 8);
#pragma unroll
            for (int et = 0; et < 8; ++et) { const bf16x8 bb = *(const LAS bf16x8*)(VT + (et * 16 + fr) * 72 + ks * 32 + fq * 8); acc[et] = mfma16(a, bb, acc[et]); }
        }
        bf16_t* outp = kvs + (size_t)unit * 16384;
#pragma unroll
        for (int et = 0; et < 8; ++et) { u32x2 w; w.x = pk2(acc[et][0], acc[et][1]); w.y = pk2(acc[et][2], acc[et][3]); *(u32x2*)(outp + (et * 16 + fr) * 128 + wid * 16 + fq * 4) = w; }
        __syncthreads();
    }
}
__device__ __forceinline__ void scan_phase(bf16_t* kvs, const float* sumA, const float* sumH, float* Hin, int G, int b) {
    const int gtid = b * NTHREADS + threadIdx.x, gth = G * NTHREADS;
    for (int p = gtid; p < 65536; p += gth) {
        const int h = p >> 13;
        const float dec = expf(64.0f * head_log_gamma(h));
        unsigned* ptr = (unsigned*)kvs + p;
        float s0 = 0.f, s1 = 0.f;
        for (int n = 0; n < NCH; n += 8) {
            unsigned v[8];
#pragma unroll
            for (int j = 0; j < 8; ++j) v[j] = ptr[(size_t)(n + j) * 65536];
#pragma unroll
            for (int j = 0; j < 8; ++j) { ptr[(size_t)(n + j) * 65536] = pk2(s0, s1); s0 = dec * s0 + bflo(v[j]); s1 = dec * s1 + bfhi(v[j]); }
        }
    }
    const int c = gth - 1 - gtid;
    if (c < 1024) {
        float H = 0.f;
        for (int n = 0; n < NCH; n += 8) {
            float a[8], hh[8];
#pragma unroll
            for (int j = 0; j < 8; ++j) { a[j] = sumA[(n + j) * 1024 + c]; hh[j] = sumH[(n + j) * 1024 + c]; }
#pragma unroll
            for (int j = 0; j < 8; ++j) { Hin[(n + j) * 1024 + c] = H; H = a[j] * H + hh[j]; }
        }
    }
}
__device__ __forceinline__ void ret_out_phase(LAS unsigned char* lds, const bf16_t* proj, const float* cosT, const float* sinT, const bf16_t* kvs, bf16_t* ycat, int G, int b) {
    const int tid = threadIdx.x, lane = tid & 63, wid = tid >> 6, fr = lane & 15, fq = lane >> 4;
    LAS bf16_t* QS = (LAS bf16_t*)lds;
    LAS bf16_t* KS = (LAS bf16_t*)(lds + 17408);
    LAS bf16_t* VT = (LAS bf16_t*)(lds + 34816);
    LAS bf16_t* PS = (LAS bf16_t*)(lds + 53248);
    LAS float*  OS = (LAS float*)(lds + 62464);
    for (int unit = b; unit < NCH * NH; unit += G) {
        const int n = unit >> 3, h = unit & 7;
        const float log_g = head_log_gamma(h);
        const int m = tid >> 3, tq = tid & 7; const int s = n * 64 + m;
        {
            const float* cp = cosT + (size_t)s * 64 + tq * 8; const float* sp = sinT + (size_t)s * 64 + tq * 8;
            float o1[8], o2[8];
            const bf16_t* qp = proj + (size_t)s * INC + h * 128 + tq * 8;
            rot8(*(const u32x4*)qp, *(const u32x4*)(qp + 64), cp, sp, 0.08838834764831845f, o1, o2);
            u32x4 w; w.x = pk2(o1[0], o1[1]); w.y = pk2(o1[2], o1[3]); w.z = pk2(o1[4], o1[5]); w.w = pk2(o1[6], o1[7]);
            *(LAS u32x4*)(QS + m * 136 + tq * 8) = w;
            w.x = pk2(o2[0], o2[1]); w.y = pk2(o2[2], o2[3]); w.z = pk2(o2[4], o2[5]); w.w = pk2(o2[6], o2[7]);
            *(LAS u32x4*)(QS + m * 136 + 64 + tq * 8) = w;
            const bf16_t* kp = proj + (size_t)s * INC + 1024 + h * 128 + tq * 8;
            rot8(*(const u32x4*)kp, *(const u32x4*)(kp + 64), cp, sp, 1.0f, o1, o2);
            w.x = pk2(o1[0], o1[1]); w.y = pk2(o1[2], o1[3]); w.z = pk2(o1[4], o1[5]); w.w = pk2(o1[6], o1[7]);
            *(LAS u32x4*)(KS + m * 136 + tq * 8) = w;
            w.x = pk2(o2[0], o2[1]); w.y = pk2(o2[2], o2[3]); w.z = pk2(o2[4], o2[5]); w.w = pk2(o2[6], o2[7]);
            *(LAS u32x4*)(KS + m * 136 + 64 + tq * 8) = w;
            const bf16_t* vp = proj + (size_t)s * INC + 2048 + h * 128 + tq * 16;
            const u32x4 y0 = *(const u32x4*)vp, y1 = *(const u32x4*)(vp + 8);
            const unsigned yw[8] = {y0.x, y0.y, y0.z, y0.w, y1.x, y1.y, y1.z, y1.w};
#pragma unroll
            for (int j = 0; j < 8; ++j) { VT[(tq * 16 + 2 * j) * 72 + m] = (bf16_t)(yw[j] & 0xffffu); VT[(tq * 16 + 2 * j + 1) * 72 + m] = (bf16_t)(yw[j] >> 16); }
        }
        __syncthreads();
        const int ct = wid & 3;
        {
            const int mt0 = (wid >> 2) * 2;
            f32x4 sacc[2] = {(f32x4){0.f, 0.f, 0.f, 0.f}, (f32x4){0.f, 0.f, 0.f, 0.f}};
#pragma unroll
            for (int ks = 0; ks < 4; ++ks) {
                const bf16x8 a = *(const LAS bf16x8*)(QS + (ct * 16 + fr) * 136 + ks * 32 + fq * 8);
#pragma unroll
                for (int j = 0; j < 2; ++j) { const bf16x8 bb = *(const LAS bf16x8*)(KS + ((mt0 + j) * 16 + fr) * 136 + ks * 32 + fq * 8); sacc[j] = mfma16(a, bb, sacc[j]); }
            }
#pragma unroll
            for (int j = 0; j < 2; ++j)
#pragma unroll
                for (int r = 0; r < 4; ++r) { const int c = ct * 16 + fq * 4 + r, mm = (mt0 + j) * 16 + fr; const float dd = fabsf((float)(c - mm));
                    PS[c * 72 + mm] = (bf16_t)f2bf(sacc[j][r] * expf(log_g * dd)); }
        }
        __syncthreads();
        {
            const int et0 = (wid >> 2) * 4;
            f32x4 oacc[4];
#pragma unroll
            for (int j = 0; j < 4; ++j) oacc[j] = (f32x4){0.f, 0.f, 0.f, 0.f};
            const bf16_t* st = kvs + (size_t)unit * 16384;
#pragma unroll
            for (int ks = 0; ks < 4; ++ks) {
                const bf16x8 a = *(const LAS bf16x8*)(QS + (ct * 16 + fr) * 136 + ks * 32 + fq * 8);
#pragma unroll
                for (int j = 0; j < 4; ++j) { const bf16x8 bb = *(const bf16x8*)(st + ((et0 + j) * 16 + fr) * 128 + ks * 32 + fq * 8); oacc[j] = mfma16(a, bb, oacc[j]); }
            }
#pragma unroll
            for (int r = 0; r < 4; ++r) { const float qd = expf(log_g * (float)(ct * 16 + fq * 4 + r + 1));
#pragma unroll
                for (int j = 0; j < 4; ++j) oacc[j][r] *= qd; }
#pragma unroll
            for (int ks = 0; ks < 2; ++ks) {
                const bf16x8 a = *(const LAS bf16x8*)(PS + (ct * 16 + fr) * 72 + ks * 32 + fq * 8);
#pragma unroll
                for (int j = 0; j < 4; ++j) { const bf16x8 bb = *(const LAS bf16x8*)(VT + ((et0 + j) * 16 + fr) * 72 + ks * 32 + fq * 8); oacc[j] = mfma16(a, bb, oacc[j]); }
            }
#pragma unroll
            for (int j = 0; j < 4; ++j)
#pragma unroll
                for (int r = 0; r < 4; ++r) OS[(ct * 16 + fq * 4 + r) * 132 + (et0 + j) * 16 + fr] = oacc[j][r];
        }
        __syncthreads();
        {
            float v[16]; float sum = 0.f;
#pragma unroll
            for (int q = 0; q < 4; ++q) { const f32x4 t = *(const LAS f32x4*)(OS + m * 132 + tq * 16 + q * 4); v[4 * q] = t.x; v[4 * q + 1] = t.y; v[4 * q + 2] = t.z; v[4 * q + 3] = t.w; sum += (t.x + t.y) + (t.z + t.w); }
            sum += __shfl_xor(sum, 1); sum += __shfl_xor(sum, 2); sum += __shfl_xor(sum, 4);
            const float mean = sum * (1.0f / 128.0f); float sq = 0.f;
#pragma unroll
            for (int i = 0; i < 16; ++i) { v[i] -= mean; sq += v[i] * v[i]; }
            sq += __shfl_xor(sq, 1); sq += __shfl_xor(sq, 2); sq += __shfl_xor(sq, 4);
            const float rstd = 1.0f / sqrtf(sq * (1.0f / 128.0f) + GN_EPS);
            const bf16_t* gp = proj + (size_t)s * INC + 3072 + h * 128 + tq * 16;
            const u32x4 g0 = *(const u32x4*)gp, g1 = *(const u32x4*)(gp + 8);
            const unsigned gw[8] = {g0.x, g0.y, g0.z, g0.w, g1.x, g1.y, g1.z, g1.w};
            unsigned ow[8];
#pragma unroll
            for (int j = 0; j < 8; ++j) { const float ga = bflo(gw[j]), gb = bfhi(gw[j]);
                ow[j] = pk2(ga * sigmoidf_(ga) * v[2 * j] * rstd, gb * sigmoidf_(gb) * v[2 * j + 1] * rstd); }
            bf16_t* yp = ycat + (size_t)s * D_ + h * 128 + tq * 16;
            *(u32x4*)yp = (u32x4){ow[0], ow[1], ow[2], ow[3]}; *(u32x4*)(yp + 8) = (u32x4){ow[4], ow[5], ow[6], ow[7]};
        }
        __syncthreads();
    }
}
template <int MODE>
__device__ __forceinline__ void lru_phase(LAS unsigned char* lds, const bf16_t* proj, const Ptrs& P, const bf16_t* wraT, const bf16_t* wriT,
                                          float* sumA, float* sumH, const float* Hin, bf16_t* ycat, int G, int b) {
    const int tid = threadIdx.x, lane = tid & 63, wid = tid >> 6, fr = lane & 15, fq = lane >> 4;
    LAS float*  XC  = (LAS float*)lds;
    LAS bf16_t* XCb = (LAS bf16_t*)(lds + 33792);
    LAS float*  AA  = (LAS float*)(lds + 51200);
    LAS float*  BB  = (LAS float*)(lds + 84992);
    for (int unit = b; unit < NCH * 8; unit += G) {
        const int n = unit >> 3, g = unit & 7, c0 = g * 128;
        const int m = tid >> 3, part = tid & 7, j0 = part * 16; const int s = n * 64 + m;
        {
            float xc[16];
#pragma unroll
            for (int q = 0; q < 4; ++q) { const f32x4 t = *(const f32x4*)(P.conv_b + c0 + j0 + 4 * q); xc[4 * q] = t.x; xc[4 * q + 1] = t.y; xc[4 * q + 2] = t.z; xc[4 * q + 3] = t.w; }
#pragma unroll
            for (int kk = 0; kk < 4; ++kk) {
                const int srow = s - 3 + kk;
                if (srow >= 0) {
                    const bf16_t* xp = proj + (size_t)srow * INC + 4096 + c0 + j0;
                    const u32x4 y0 = *(const u32x4*)xp, y1 = *(const u32x4*)(xp + 8);
                    const unsigned yw[8] = {y0.x, y0.y, y0.z, y0.w, y1.x, y1.y, y1.z, y1.w};
                    const float* wp = P.conv_w + kk * 1024 + c0 + j0;
#pragma unroll
                    for (int q = 0; q < 4; ++q) { const f32x4 w = *(const f32x4*)(wp + 4 * q);
                        xc[4 * q] += w.x * bflo(yw[2 * q]); xc[4 * q + 1] += w.y * bfhi(yw[2 * q]); xc[4 * q + 2] += w.z * bflo(yw[2 * q + 1]); xc[4 * q + 3] += w.w * bfhi(yw[2 * q + 1]); }
                }
            }
#pragma unroll
            for (int q = 0; q < 4; ++q) *(LAS f32x4*)(XC + m * 132 + j0 + 4 * q) = (f32x4){xc[4 * q], xc[4 * q + 1], xc[4 * q + 2], xc[4 * q + 3]};
            *(LAS u32x4*)(XCb + m * 136 + j0) = (u32x4){pk2(xc[0], xc[1]), pk2(xc[2], xc[3]), pk2(xc[4], xc[5]), pk2(xc[6], xc[7])};
            *(LAS u32x4*)(XCb + m * 136 + j0 + 8) = (u32x4){pk2(xc[8], xc[9]), pk2(xc[10], xc[11]), pk2(xc[12], xc[13]), pk2(xc[14], xc[15])};
        }
        __syncthreads();
        {
            const int st = wid & 3, jt0 = (wid >> 2) * 4;
            f32x4 ar[4], ai[4];
#pragma unroll
            for (int j = 0; j < 4; ++j) { ar[j] = (f32x4){0.f, 0.f, 0.f, 0.f}; ai[j] = (f32x4){0.f, 0.f, 0.f, 0.f}; }
#pragma unroll
            for (int ks = 0; ks < 4; ++ks) {
                const bf16x8 a = *(const LAS bf16x8*)(XCb + (st * 16 + fr) * 136 + ks * 32 + fq * 8);
#pragma unroll
                for (int j = 0; j < 4; ++j) { const size_t wo = (size_t)g * 16384 + ((jt0 + j) * 16 + fr) * 128 + ks * 32 + fq * 8;
                    ar[j] = mfma16(a, *(const bf16x8*)(wraT + wo), ar[j]); ai[j] = mfma16(a, *(const bf16x8*)(wriT + wo), ai[j]); }
            }
#pragma unroll
            for (int j = 0; j < 4; ++j) {
                const int col = (jt0 + j) * 16 + fr, c = c0 + col;
                const float bra = P.b_ra[c], bri = P.b_ri[c];
                const float ls = -log1pf(expf(-P.lam[c]));
#pragma unroll
                for (int r = 0; r < 4; ++r) {
                    const int sl = st * 16 + fq * 4 + r;
                    const float rg = sigmoidf_(ar[j][r] + bra), ig = sigmoidf_(ai[j][r] + bri);
                    const float la = 8.0f * rg * ls;
                    const float a = expf(la);
                    const float bv = sqrtf(-expm1f(2.0f * la)) * (ig * XC[sl * 132 + col]);
                    AA[sl * 132 + col] = a; BB[sl * 132 + col] = bv;
                }
            }
        }
        __syncthreads();
        if (tid < 128) {
            const int j = tid;
            float hcur = (MODE == 1) ? Hin[n * 1024 + c0 + j] : 0.f, acum = 1.f;
#pragma unroll 8
            for (int sl = 0; sl < 64; ++sl) { const float a = AA[sl * 132 + j], bv = BB[sl * 132 + j]; hcur = a * hcur + bv; acum *= a; if (MODE == 1) BB[sl * 132 + j] = hcur; }
            if (MODE == 0) { sumA[n * 1024 + c0 + j] = acum; sumH[n * 1024 + c0 + j] = hcur; }
        }
        if (MODE == 1) {
            __syncthreads();
            const bf16_t* gp = proj + (size_t)s * INC + 5120 + c0 + j0;
            const u32x4 g0 = *(const u32x4*)gp, g1 = *(const u32x4*)(gp + 8);
            const unsigned gw[8] = {g0.x, g0.y, g0.z, g0.w, g1.x, g1.y, g1.z, g1.w};
            unsigned ow[8];
#pragma unroll
            for (int q = 0; q < 8; ++q) { const float h0 = BB[m * 132 + j0 + 2 * q], h1 = BB[m * 132 + j0 + 2 * q + 1];
                ow[q] = pk2(h0 * gelu_tanh(bflo(gw[q])), h1 * gelu_tanh(bfhi(gw[q]))); }
            bf16_t* yp = ycat + (size_t)s * D_ + 1024 + c0 + j0;
            *(u32x4*)yp = (u32x4){ow[0], ow[1], ow[2], ow[3]}; *(u32x4*)(yp + 8) = (u32x4){ow[4], ow[5], ow[6], ow[7]};
        }
        __syncthreads();
    }
}
__device__ __forceinline__ void ln1_phase(float* buf, bf16_t* h1b, const float* gam, const float* bet, int G, int b) {
    const int lane = threadIdx.x & 63, wid = threadIdx.x >> 6;
    const int gw = b * NWAVES + wid, NGW = G * NWAVES;
    for (int row = gw; row < S_; row += NGW) {
        float* rp = buf + (size_t)row * D_;
        f32x4 v[8]; float sum = 0.f;
#pragma unroll
        for (int j = 0; j < 8; ++j) { v[j] = *(const f32x4*)(rp + 256 * j + 4 * lane); sum += (v[j].x + v[j].y) + (v[j].z + v[j].w); }
        const float mean = wave_sum(sum) * (1.0f / D_); float sq = 0.f;
#pragma unroll
        for (int j = 0; j < 8; ++j) { v[j] = v[j] - mean; sq += (v[j].x * v[j].x + v[j].y * v[j].y) + (v[j].z * v[j].z + v[j].w * v[j].w); }
        const float rstd = 1.0f / sqrtf(wave_sum(sq) * (1.0f / D_) + LN_EPS);
#pragma unroll
        for (int j = 0; j < 8; ++j) {
            const f32x4 gg = *(const f32x4*)(gam + 256 * j + 4 * lane), bb = *(const f32x4*)(bet + 256 * j + 4 * lane);
            const f32x4 o = v[j] * rstd * gg + bb;
            *(f32x4*)(rp + 256 * j + 4 * lane) = o;
            *(u32x2*)(h1b + (size_t)row * D_ + 256 * j + 4 * lane) = (u32x2){pk2(o.x, o.y), pk2(o.z, o.w)};
        }
    }
}
__device__ __forceinline__ unsigned mono(float f) { const unsigned u = __float_as_uint(f); return (u & 0x80000000u) ? ~u : (u ^ 0x80000000u); }
__device__ __forceinline__ float unmono(unsigned u) { return __uint_as_float((u & 0x80000000u) ? (u ^ 0x80000000u) : ~u); }
__device__ __forceinline__ unsigned umax_(unsigned a, unsigned b) { return a > b ? a : b; }
__device__ __forceinline__ constexpr int cand_i(int c) { return c < 16 ? 0 : c < 24 ? 1 : c < 29 ? 2 : c < 33 ? 3 : c < 36 ? 4 : c < 38 ? 5 : c < 40 ? 6 : c < 42 ? 7 : c - 34; }
__device__ __forceinline__ constexpr int cand_j(int c) { return c < 16 ? c : c < 24 ? c - 16 : c < 29 ? c - 24 : c < 33 ? c - 29 : c < 36 ? c - 33 : c < 38 ? c - 36 : c < 40 ? c - 38 : c < 42 ? c - 40 : 0; }

__device__ __forceinline__ void topk_phase(LAS unsigned char* lds, const bf16_t* qp, const bf16_t* keys, int* sel_e, float* sel_g, int G, int b) {
    const int tid = threadIdx.x, lane = tid & 63, wid = tid >> 6, fr = lane & 15, fq = lane >> 4;
    LAS unsigned* wl = (LAS unsigned*)(lds + wid * 2048 + fr * 128);
    for (int unit = b; unit < (S_ / 128) * 8; unit += G) {
        const int tt = unit >> 3, h = unit & 7;
        const int tok = tt * 128 + wid * 16 + fr;
        unsigned w[2][16];
#pragma unroll
        for (int p = 0; p < 2; ++p) {
            f32x4 acc[8];
#pragma unroll
            for (int mt = 0; mt < 8; ++mt) acc[mt] = (f32x4){0.f, 0.f, 0.f, 0.f};
            bf16x8 bq[4];
#pragma unroll
            for (int ks = 0; ks < 4; ++ks) bq[ks] = *(const bf16x8*)(qp + (size_t)tok * D_ + h * 256 + p * 128 + ks * 32 + fq * 8);
            const bf16_t* kb = keys + (size_t)(h * 2 + p) * 16384;
#pragma unroll
            for (int mt = 0; mt < 8; ++mt)
#pragma unroll
                for (int ks = 0; ks < 4; ++ks) { const bf16x8 a = *(const bf16x8*)(kb + (mt * 16 + fr) * 128 + ks * 32 + fq * 8); acc[mt] = mfma16(a, bq[ks], acc[mt]); }
            unsigned pk[32];
#pragma unroll
            for (int mt = 0; mt < 8; ++mt)
#pragma unroll
                for (int r = 0; r < 4; ++r) pk[mt * 4 + r] = (mono(acc[mt][r]) & ~127u) | (unsigned)(127 - (mt * 16 + fq * 4 + r));
            unsigned prev = 0xFFFFFFFFu;
#pragma unroll
            for (int i = 0; i < 16; ++i) {
                unsigned mx = 0u;
#pragma unroll
                for (int j = 0; j < 32; ++j) { const unsigned x = pk[j] < prev ? pk[j] : 0u; mx = umax_(mx, x); }
                mx = umax_(mx, (unsigned)__shfl_xor((int)mx, 16)); mx = umax_(mx, (unsigned)__shfl_xor((int)mx, 32));
                w[p][i] = mx; prev = mx;
            }
        }
        float v1[16], v2[16];
#pragma unroll
        for (int i = 0; i < 16; ++i) { v1[i] = unmono(w[0][i] & ~127u); v2[i] = unmono(w[1][i] & ~127u); }
        unsigned ck[13];
#pragma unroll
        for (int sidx = 0; sidx < 13; ++sidx) {
            unsigned keyk[4];
#pragma unroll
            for (int k = 0; k < 4; ++k) {
                const int c = 4 * sidx + k;
                if (c < 50) { const int ci = cand_i(c), cj = cand_j(c); keyk[k] = (mono(v1[ci] + v2[cj]) & ~255u) | (unsigned)(255 - (ci * 16 + cj)); }
                else keyk[k] = 0u;
            }
            ck[sidx] = fq == 0 ? keyk[0] : fq == 1 ? keyk[1] : fq == 2 ? keyk[2] : keyk[3];
        }
        unsigned W2[16];
        {
            unsigned prev = 0xFFFFFFFFu;
#pragma unroll
            for (int k = 0; k < 16; ++k) {
                unsigned mx = 0u;
#pragma unroll
                for (int sidx = 0; sidx < 13; ++sidx) { const unsigned x = ck[sidx] < prev ? ck[sidx] : 0u; mx = umax_(mx, x); }
                mx = umax_(mx, (unsigned)__shfl_xor((int)mx, 16)); mx = umax_(mx, (unsigned)__shfl_xor((int)mx, 32));
                W2[k] = mx; prev = mx;
            }
        }
        float ev[16]; float esum = 0.f; const float vmax = unmono(W2[0] & ~255u);
#pragma unroll
        for (int k = 0; k < 16; ++k) { ev[k] = __expf(unmono(W2[k] & ~255u) - vmax); esum += ev[k]; }
        const float einv = 1.0f / esum;
        __syncthreads();
        if (fq == 0) {
#pragma unroll
            for (int i = 0; i < 16; ++i) { wl[i] = w[0][i]; wl[16 + i] = w[1][i]; }
        }
        __syncthreads();
#pragma unroll
        for (int k = 0; k < 16; ++k) {
            if ((k >> 2) == fq) {
                const unsigned id = 255u - (W2[k] & 255u);
                const unsigned e1 = 127u - (wl[id >> 4] & 127u), e2 = 127u - (wl[16 + (id & 15u)] & 127u);
                const size_t o = ((size_t)tok * 8 + h) * 16 + k;
                sel_e[o] = (int)(e1 * 128u + e2); sel_g[o] = ev[k] * einv;
            }
        }
    }
}
struct PeerRow { u32x4 u[2], v[2]; };
__device__ __forceinline__ void peer_load(PeerRow& r, const unsigned char* UQ, const unsigned char* VQ, int e, int lane) {
    const u32x4* pu = (const u32x4*)(UQ + (size_t)e * D_) + lane; const u32x4* pv = (const u32x4*)(VQ + (size_t)e * D_) + lane;
    r.u[0] = pu[0]; r.u[1] = pu[64]; r.v[0] = pv[0]; r.v[1] = pv[64];
}
__device__ __forceinline__ void peer_use(const PeerRow& r, const int (&xq)[8], float (&acc)[32], float& csum, float cu, float cv) {
    int id = 0;
    id = __builtin_amdgcn_sdot4((int)r.u[0].x, xq[0], id, false); id = __builtin_amdgcn_sdot4((int)r.u[0].y, xq[1], id, false);
    id = __builtin_amdgcn_sdot4((int)r.u[0].z, xq[2], id, false); id = __builtin_amdgcn_sdot4((int)r.u[0].w, xq[3], id, false);
    id = __builtin_amdgcn_sdot4((int)r.u[1].x, xq[4], id, false); id = __builtin_amdgcn_sdot4((int)r.u[1].y, xq[5], id, false);
    id = __builtin_amdgcn_sdot4((int)r.u[1].z, xq[6], id, false); id = __builtin_amdgcn_sdot4((int)r.u[1].w, xq[7], id, false);
    id = wave_sum_i(id);
    const float coef = cv * gelu_tanh((float)id * cu);
    csum += coef;
#pragma unroll
    for (int jj = 0; jj < 2; ++jj) {
        const unsigned w[4] = {r.v[jj].x, r.v[jj].y, r.v[jj].z, r.v[jj].w};
#pragma unroll
        for (int q = 0; q < 4; ++q) {
            acc[jj * 16 + 4 * q + 0] += coef * (float)(w[q] & 255u);
            acc[jj * 16 + 4 * q + 1] += coef * (float)((w[q] >> 8) & 255u);
            acc[jj * 16 + 4 * q + 2] += coef * (float)((w[q] >> 16) & 255u);
            acc[jj * 16 + 4 * q + 3] += coef * (float)(w[q] >> 24);
        }
    }
}
__device__ __forceinline__ void peer_phase(const float* hbuf  , float* obuf  , const unsigned char* UQ, const unsigned char* VQ, const float* SU, const float* SV,
                                           const int* sel_e, const float* sel_g, const float* gam, const float* bet, int G, int b) {
    const int lane = threadIdx.x & 63, wid = threadIdx.x >> 6;
    const int gw = b * NWAVES + wid, NGW = G * NWAVES;
    for (int tok = gw; tok < S_; tok += NGW) {
        const float* rp = hbuf + (size_t)tok * D_; float* op = obuf + (size_t)tok * D_;
        float x[32], acc[32];
        float amax = 0.f;
#pragma unroll
        for (int jj = 0; jj < 2; ++jj)
#pragma unroll
            for (int q = 0; q < 4; ++q) { const f32x4 a = *(const f32x4*)(rp + 1024 * jj + 16 * lane + 4 * q);
                x[jj * 16 + 4 * q] = a.x; x[jj * 16 + 4 * q + 1] = a.y; x[jj * 16 + 4 * q + 2] = a.z; x[jj * 16 + 4 * q + 3] = a.w;
                amax = fmaxf(amax, fmaxf(fmaxf(fabsf(a.x), fabsf(a.y)), fmaxf(fabsf(a.z), fabsf(a.w)))); }
        const int e0 = sel_e[(size_t)tok * 128 + lane], e1 = sel_e[(size_t)tok * 128 + 64 + lane];
        const float g0 = sel_g[(size_t)tok * 128 + lane], g1 = sel_g[(size_t)tok * 128 + 64 + lane];
        amax = wave_max(amax);
        const float xinv = amax > 0.f ? 127.0f / amax : 0.f, sx = amax * (1.0f / 127.0f);
        int xq[8];
#pragma unroll
        for (int j = 0; j < 8; ++j) {
            const int a = (int)rintf(x[4 * j] * xinv), bq = (int)rintf(x[4 * j + 1] * xinv), c = (int)rintf(x[4 * j + 2] * xinv), d = (int)rintf(x[4 * j + 3] * xinv);
            xq[j] = (int)((unsigned)(a & 255) | ((unsigned)(bq & 255) << 8) | ((unsigned)(c & 255) << 16) | ((unsigned)(d & 255) << 24));
        }
        const float cu0 = SU[e0] * sx, cu1 = SU[e1] * sx, cv0 = g0 * SV[e0], cv1 = g1 * SV[e1];
#pragma unroll
        for (int i = 0; i < 32; ++i) acc[i] = 0.f;
        float csum = 0.f;
        PeerRow r0, r1, r2, r3;
#define PEER_E(k) ((k) < 64 ? __builtin_amdgcn_readlane(e0, (k)) : __builtin_amdgcn_readlane(e1, (k) - 64))
#define PEER_CU(k) __uint_as_float((k) < 64 ? __builtin_amdgcn_readlane(__float_as_uint(cu0), (k)) : __builtin_amdgcn_readlane(__float_as_uint(cu1), (k) - 64))
#define PEER_CV(k) __uint_as_float((k) < 64 ? __builtin_amdgcn_readlane(__float_as_uint(cv0), (k)) : __builtin_amdgcn_readlane(__float_as_uint(cv1), (k) - 64))
        peer_load(r0, UQ, VQ, PEER_E(0), lane); peer_load(r1, UQ, VQ, PEER_E(1), lane); peer_load(r2, UQ, VQ, PEER_E(2), lane); peer_load(r3, UQ, VQ, PEER_E(3), lane);
        for (int k = 0; k < 128; k += 4) {
            const bool more = (k + 4) < 128;
            peer_use(r0, xq, acc, csum, PEER_CU(k), PEER_CV(k));         if (more) peer_load(r0, UQ, VQ, PEER_E(k + 4), lane);
            peer_use(r1, xq, acc, csum, PEER_CU(k + 1), PEER_CV(k + 1)); if (more) peer_load(r1, UQ, VQ, PEER_E(k + 5), lane);
            peer_use(r2, xq, acc, csum, PEER_CU(k + 2), PEER_CV(k + 2)); if (more) peer_load(r2, UQ, VQ, PEER_E(k + 6), lane);
            peer_use(r3, xq, acc, csum, PEER_CU(k + 3), PEER_CV(k + 3)); if (more) peer_load(r3, UQ, VQ, PEER_E(k + 7), lane);
        }
        float sum = 0.f;
#pragma unroll
        for (int i = 0; i < 32; ++i) { acc[i] = DN_ALPHA * x[i] + (acc[i] - 128.0f * csum); sum += acc[i]; }
        const float mean = wave_sum(sum) * (1.0f / D_); float sq = 0.f;
#pragma unroll
        for (int i = 0; i < 32; ++i) { acc[i] -= mean; sq += acc[i] * acc[i]; }
        const float rstd = 1.0f / sqrtf(wave_sum(sq) * (1.0f / D_) + LN_EPS);
#pragma unroll
        for (int jj = 0; jj < 2; ++jj)
#pragma unroll
            for (int q = 0; q < 4; ++q) {
                const int col = 1024 * jj + 16 * lane + 4 * q, i0 = jj * 16 + 4 * q;
                const f32x4 ga = *(const f32x4*)(gam + col), ba = *(const f32x4*)(bet + col);
                *(f32x4*)(op + col) = (f32x4){acc[i0] * rstd * ga.x + ba.x, acc[i0 + 1] * rstd * ga.y + ba.y, acc[i0 + 2] * rstd * ga.z + ba.z, acc[i0 + 3] * rstd * ga.w + ba.w};
            }
    }
}
#ifndef PROBE_PHASE
#define PROBE_PHASE -1
#endif
constexpr int LDSCTL_OFF = 131072, MISC_OFF = LDSCTL_OFF + 320;
constexpr int CW_BAR = 1024;
constexpr size_t CTL_ZERO_BYTES = 64 * 1024;
static_assert((CW_BAR + XCD_BAR_WORDS) * 4 <= (int)CTL_ZERO_BYTES && MISC_OFF + 128 <= LDS_BYTES, "control words");

__global__ void __launch_bounds__(NTHREADS, 2) mega_fwd(Ptrs P) {
    extern __shared__ __attribute__((aligned(16))) unsigned char lds_raw[];
    LAS unsigned char* lds = (LAS unsigned char*)lds_raw;
    unsigned char* ws = P.ws;
    const int G = gridDim.x, b = blockIdx.x;
    for (int u = threadIdx.x; u < (LDS_BYTES - LDSCTL_OFF) / 4; u += NTHREADS) ((LAS unsigned*)(lds + LDSCTL_OFF))[u] = 0u;
    __syncthreads();
    const XcdBarrier bar = xcd_barrier_post((unsigned*)(ws + WS_CTL) + CW_BAR, (volatile LAS unsigned*)(lds + MISC_OFF) + 8);

    bf16_t* const proj = (bf16_t*)(ws + WS_PROJ); bf16_t* const kvs = (bf16_t*)(ws + WS_KVS); bf16_t* const ycat = (bf16_t*)(ws + WS_YCAT);
    const float* const cosT = (const float*)(ws + WS_COS); const float* const sinT = (const float*)(ws + WS_SIN);
    float* const sumA = (float*)(ws + WS_SUMA); float* const sumH = (float*)(ws + WS_SUMH); float* const Hin = (float*)(ws + WS_HIN);
    const bf16_t* const wraT = (const bf16_t*)(ws + WS_WRA_T); const bf16_t* const wriT = (const bf16_t*)(ws + WS_WRI_T);

#define NREP(k) ((PROBE_PHASE == (k)) ? 2 : 1)
    for (int r_ = 0; r_ < NREP(0); ++r_) { prologue_phase(lds, P, G, b); xcd_barrier(bar); }
#define RUN_P1 { pg8::Gemm g{(const pg8::bf16_t*)(ws + WS_XB), (const pg8::bf16_t*)(ws + WS_WIN_T), S_, INC, D_}; \
        pg8::StaticOrder S; S.init(S_, INC, G, b); \
        pg8::EpiBf16<0> E{(pg8::bf16_t*)proj, INC, nullptr, 0, 0, 1.f}; \
        pg8::gemm_phase<pg8::EpiBf16<0>, pg8::StaticOrder, true, true>(lds, g, S, E); \
        xcd_barrier(bar); }
    RUN_P1
#if PROBE_PHASE == 1
    RUN_P1
#endif
    for (int r2_ = 0; r2_ < NREP(22); ++r2_) {
    for (int r_ = 0; r_ < NREP(2); ++r_) { ret_kv_phase(lds, proj, cosT, sinT, kvs, G, b); xcd_barrier(bar); }
    for (int r_ = 0; r_ < NREP(3); ++r_) { lru_phase<0>(lds, proj, P, wraT, wriT, sumA, sumH, Hin, ycat, G, b); xcd_barrier(bar); }
    scan_phase(kvs, sumA, sumH, Hin, G, b);
    xcd_barrier(bar);
    }
    for (int r_ = 0; r_ < NREP(4); ++r_) { ret_out_phase(lds, proj, cosT, sinT, kvs, ycat, G, b); xcd_barrier(bar); }
    for (int r_ = 0; r_ < NREP(5); ++r_) { lru_phase<1>(lds, proj, P, wraT, wriT, sumA, sumH, Hin, ycat, G, b); xcd_barrier(bar); }
#define RUN_P3 { pg8::Gemm g{(const pg8::bf16_t*)ycat, (const pg8::bf16_t*)(ws + WS_WOUT_T), S_, D_, D_}; \
        pg8::StaticOrder S; S.init(S_, D_, G, b); \
        pg8::EpiResF32 E{P.x, P.out, D_, DN_ALPHA}; \
        pg8::gemm_phase<pg8::EpiResF32, pg8::StaticOrder, true, true>(lds, g, S, E); \
        xcd_barrier(bar); }
    RUN_P3
#if PROBE_PHASE == 6
    RUN_P3
#endif
    ln1_phase(P.out, (bf16_t*)(ws + WS_H1B), P.ln1_g, P.ln1_b, G, b);
    xcd_barrier(bar);
#if PROBE_PHASE == 66
    RUN_P3
    ln1_phase(P.out, (bf16_t*)(ws + WS_H1B), P.ln1_g, P.ln1_b, G, b);
    xcd_barrier(bar);
#endif
#define RUN_P5 { pg8::Gemm g{(const pg8::bf16_t*)(ws + WS_H1B), (const pg8::bf16_t*)(ws + WS_WPQ_T), S_, D_, D_}; \
        pg8::StaticOrder S; S.init(S_, D_, G, b); \
        pg8::EpiBf16<0> E{(pg8::bf16_t*)(ws + WS_QP), D_, nullptr, 0, 0, 1.f}; \
        pg8::gemm_phase<pg8::EpiBf16<0>, pg8::StaticOrder, true, true>(lds, g, S, E); \
        xcd_barrier(bar); }
    RUN_P5
#if PROBE_PHASE == 7
    RUN_P5
#endif
    for (int r_ = 0; r_ < NREP(8); ++r_) { topk_phase(lds, (const bf16_t*)(ws + WS_QP), (const bf16_t*)(ws + WS_KEYS), (int*)(ws + WS_SELE), (float*)(ws + WS_SELG), G, b); xcd_barrier(bar); }
    if (PROBE_PHASE == 9) { peer_phase(P.out, (float*)(ws + 328 * MiB), (const unsigned char*)(ws + WS_UQ), (const unsigned char*)(ws + WS_VQ), (const float*)(ws + WS_SU), (const float*)(ws + WS_SV), (const int*)(ws + WS_SELE), (const float*)(ws + WS_SELG), P.ln2_g, P.ln2_b, G, b); xcd_barrier(bar); }
    peer_phase(P.out, P.out, (const unsigned char*)(ws + WS_UQ), (const unsigned char*)(ws + WS_VQ), (const float*)(ws + WS_SU), (const float*)(ws + WS_SV), (const int*)(ws + WS_SELE), (const float*)(ws + WS_SELG), P.ln2_g, P.ln2_b, G, b);
}

extern "C" void kernel_launch(void* const* d_in, const int* in_sizes, int n_in, void* d_out, int out_size, void* d_ws, size_t ws_size, hipStream_t stream) {
    static int grid = 0;
    if (grid == 0) {
        if (n_in != 19 || in_sizes[0] != S_ * D_ || out_size != S_ * D_ || ws_size < WS_END) {
            fprintf(stderr, "kernel_launch: unexpected shapes: n_in %d in0 %d out %d ws %zu (need >= %zu)\n", n_in, n_in > 0 ? in_sizes[0] : -1, out_size, ws_size, (size_t)WS_END); grid = -1; return; }
        int dev = 0, cus = 0, per_cu = 0;
        if (hipGetDevice(&dev) != hipSuccess || hipDeviceGetAttribute(&cus, hipDeviceAttributeMultiprocessorCount, dev) != hipSuccess) { grid = -1; return; }
        if (hipFuncSetAttribute((const void*)mega_fwd, hipFuncAttributeMaxDynamicSharedMemorySize, LDS_BYTES) != hipSuccess) { fprintf(stderr, "kernel_launch: hipFuncSetAttribute failed\n"); grid = -1; return; }
        if (hipOccupancyMaxActiveBlocksPerMultiprocessor(&per_cu, (const void*)mega_fwd, NTHREADS, LDS_BYTES) != hipSuccess || per_cu < 1) {
            fprintf(stderr, "kernel_launch: occupancy query reports %d workgroups per CU; nothing launched\n", per_cu); (void)hipGetLastError(); grid = -1; return; }
        grid = cus;
    }
    if (grid < 0) return;
    Ptrs P{};
    P.x = (const float*)d_in[0]; P.pos = (const int*)d_in[1]; P.w_in = (const float*)d_in[2]; P.w_out = (const float*)d_in[3]; P.conv_w = (const float*)d_in[4]; P.conv_b = (const float*)d_in[5];
    P.w_ra = (const float*)d_in[6]; P.b_ra = (const float*)d_in[7]; P.w_ri = (const float*)d_in[8]; P.b_ri = (const float*)d_in[9]; P.lam = (const float*)d_in[10];
    P.ln1_g = (const float*)d_in[11]; P.ln1_b = (const float*)d_in[12]; P.w_pq = (const float*)d_in[13]; P.sub_keys = (const float*)d_in[14]; P.peer_u = (const float*)d_in[15]; P.peer_v = (const float*)d_in[16];
    P.ln2_g = (const float*)d_in[17]; P.ln2_b = (const float*)d_in[18]; P.out = (float*)d_out; P.ws = (unsigned char*)d_ws;
    if (hipMemsetAsync((char*)d_ws + WS_CTL, 0, CTL_ZERO_BYTES, stream) != hipSuccess) { fprintf(stderr, "kernel_launch: hipMemsetAsync failed\n"); return; }
    void* args[] = {&P};
    const hipError_t e = hipLaunchCooperativeKernel((const void*)mega_fwd, dim3(grid), dim3(NTHREADS), args, LDS_BYTES, stream);
    if (e != hipSuccess) fprintf(stderr, "kernel_launch: cooperative launch failed: %s (grid %d)\n", hipGetErrorString(e), grid);
}
```

```cpp
#include <hip/hip_runtime.h>
#include <cstdio>
#include <cstdint>
#include <cmath>

namespace pg8 {
#define PG8_LAS __attribute__((address_space(3)))
typedef unsigned short bf16_t;
typedef short bf16x8 __attribute__((ext_vector_type(8)));
typedef float f32x4 __attribute__((ext_vector_type(4)));
typedef unsigned u32x4 __attribute__((ext_vector_type(4)));
constexpr int BM = 256, BK = 64, HALF = 128, HTB = HALF * BK * 2  , STAGE_BYTES = 8 * HTB, NXCD = 8, WGM = 8;

__host__ __device__ __forceinline__ int lds_byte(int r, int c) { const int st = (r >> 4) * 2 + (c >> 5), rr = r & 15, cc = c & 31, ob = rr * 64 + cc * 2; return st * 1024 + (ob ^ (((ob >> 9) & 1) << 5)); }
__host__ __device__ __forceinline__ void stage_rc(int b, int& R, int& C) { const int st = b / 1024, sb = b % 1024, swz = sb ^ (((sb >> 9) & 1) << 5); R = (st >> 1) * 16 + swz / 64; C = (st & 1) * 32 + (swz % 64) / 2; }
__host__ __device__ __forceinline__ int perm32(int rho) { const int n = rho >> 4, i = rho & 15; return 8 * (i >> 2) + 4 * n + (i & 3); }

struct Unit { int pm, pn; };
struct Gemm { const bf16_t* A; const bf16_t* Bt; int M, N, K; };

struct StaticOrder {
    int nM, nN, nwg, G, c;
    __host__ __device__ void init(int M, int N, int G_, int c_) { nM = M / BM; nN = N / BM; nwg = nM * nN; G = G_; c = c_; }
    __host__ __device__ bool next(int i, Unit& u) const {
        const long L = (long)i * G + c; if (L >= nwg) return false;
        int wgid = (int)L; { const int q = nwg / NXCD, r = nwg % NXCD, xcd = wgid % NXCD, off = wgid / NXCD; wgid = (xcd < r ? xcd * (q + 1) : r * (q + 1) + (xcd - r) * q) + off; }
        const int nig = WGM * nN, gid = wgid / nig, fm = gid * WGM, gsz = (nM - fm) < WGM ? (nM - fm) : WGM;
        u.pm = fm + ((wgid % nig) % gsz); u.pn = (wgid % nig) / gsz; return true;
    }
    __device__ __forceinline__ void a_ready(const Unit&) const {}
    __device__ __forceinline__ void done(const Unit&) const {}
};

__device__ __forceinline__ unsigned cvt_pk_bf16(float lo, float hi) { unsigned r; asm volatile("v_cvt_pk_bf16_f32 %0, %1, %2" : "=v"(r) : "v"(lo), "v"(hi)); return r; }
typedef float f32x2 __attribute__((ext_vector_type(2)));
__device__ __forceinline__ f32x2 gelu_pk(f32x2 v) {
    const f32x2 av = __builtin_elementwise_abs(v), d = av * 0.2316418882f + 1.0f;
    f32x2 t; t.x = __builtin_amdgcn_rcpf(d.x); t.y = __builtin_amdgcn_rcpf(d.y);
    f32x2 q = t * 0.5307027145f + (-0.7265760135f); q = q * t + 0.7107068705f; q = q * t + (-0.142248368f); q = q * t + 0.127414796f; q = q * t;
    const f32x2 s = (v * v) * (-0.72134752044f);
    f32x2 e; e.x = __builtin_amdgcn_exp2f(s.x); e.y = __builtin_amdgcn_exp2f(s.y);
    const f32x2 m = v * (q * e), r = v - m;
    f32x2 o; o.x = v.x < 0.f ? m.x : r.x; o.y = v.y < 0.f ? m.y : r.y; return o;
}

template <int ACT  > struct EpiBf16 {
    static constexpr bool PERM = true, AFTER_DRAIN = false; static_assert(ACT == 0 || ACT == 1, "EpiBf16: ACT is 0 (none) or 1 (gelu_pk)");
    bf16_t* O; int ldc; const float* bias; int split_cols; size_t split_stride; float scale0;
    __device__ __forceinline__ void operator()(const f32x4 (&acc)[2][2][4][2], const Unit& u, int wr, int wc, int fr, int fq) const {
        const int row0 = u.pm * BM + wr * 64 + fr; int colt = u.pn * BM; bf16_t* base = O;
        float sc = 1.f; if (split_cols) { const int t = colt / split_cols; base += (size_t)t * split_stride; colt -= t * split_cols; if (t == 0) sc = scale0; }
        const int col0 = colt + wc * 32 + 8 * fq, bcol0 = u.pn * BM + wc * 32 + 8 * fq;
        f32x4 bv[2][2];
#pragma unroll
        for (int bj = 0; bj < 2; ++bj)
#pragma unroll
            for (int n = 0; n < 2; ++n) bv[bj][n] = bias ? *(const f32x4*)(bias + bcol0 + bj * HALF + 4 * n) : (f32x4){0.f, 0.f, 0.f, 0.f};
#pragma unroll
        for (int ai = 0; ai < 2; ++ai)
#pragma unroll
            for (int m = 0; m < 4; ++m) { bf16_t* rowp = base + (size_t)(row0 + ai * HALF + m * 16) * ldc + col0;
#pragma unroll
                for (int bj = 0; bj < 2; ++bj) { f32x4 v0 = acc[ai][bj][m][0] + bv[bj][0], v1 = acc[ai][bj][m][1] + bv[bj][1];
                    if (ACT == 1) { f32x2 a = gelu_pk((f32x2){v0[0], v0[1]}), b = gelu_pk((f32x2){v0[2], v0[3]}), c = gelu_pk((f32x2){v1[0], v1[1]}), d = gelu_pk((f32x2){v1[2], v1[3]});
                        v0 = (f32x4){a.x, a.y, b.x, b.y}; v1 = (f32x4){c.x, c.y, d.x, d.y}; }
                    v0 = v0 * sc; v1 = v1 * sc; u32x4 w; w.x = cvt_pk_bf16(v0[0], v0[1]); w.y = cvt_pk_bf16(v0[2], v0[3]); w.z = cvt_pk_bf16(v1[0], v1[1]); w.w = cvt_pk_bf16(v1[2], v1[3]);
                    *(u32x4*)(rowp + bj * HALF) = w; } }
    }
};
struct EpiResF32 {
    static constexpr bool PERM = false, AFTER_DRAIN = false;
    const float* base; float* out; int ldc; float alpha;
    __device__ __forceinline__ void operator()(const f32x4 (&acc)[2][2][4][2], const Unit& u, int wr, int wc, int fr, int fq) const {
        const int row0 = u.pm * BM + wr * 64 + fr, col0 = u.pn * BM + wc * 32 + 4 * fq;
#pragma unroll
        for (int ai = 0; ai < 2; ++ai)
#pragma unroll
            for (int m = 0; m < 4; ++m) { const size_t off = (size_t)(row0 + ai * HALF + m * 16) * ldc + col0;
#pragma unroll
                for (int bj = 0; bj < 2; ++bj)
#pragma unroll
                    for (int n = 0; n < 2; ++n) { const f32x4 bs = *(const f32x4*)(base + off + bj * HALF + n * 16); *(f32x4*)(out + off + bj * HALF + n * 16) = bs * alpha + acc[ai][bj][m][n]; }
                asm volatile("" ::: "memory"); }
    }
};
template <class Epi, class Sched, bool ALIGN_EPI = false, bool SP2 = false>
__device__ __forceinline__ void gemm_phase(PG8_LAS unsigned char* lds, const Gemm g, const Sched& S, const Epi& E) {
    const int tid = threadIdx.x, wid = __builtin_amdgcn_readfirstlane(tid >> 6), lane = tid & 63, wr = wid >> 2, wc = wid & 3, fr = lane & 15, fq = lane >> 4;
    const int K = g.K, nt = K / BK;
    unsigned voffA[2], voffB[2];
#pragma unroll
    for (int i = 0; i < 2; ++i) { int R, C; stage_rc(tid * 16 + i * 8192, R, C); const int Rb = Epi::PERM ? ((R & ~31) + perm32(R & 31)) : R;
        voffA[i] = (unsigned)(R * K + C) * 2u; voffB[i] = (unsigned)(Rb * K + C) * 2u; }
    const size_t kstep = (size_t)(BK * 2);
    const size_t hstep = (size_t)HALF * K * 2;
    const size_t tstep = 2 * hstep;
    const unsigned ldsw = (unsigned)wid * 1024u;
    const int aoff = lds_byte(wr * 64 + fr, fq * 8), boff = lds_byte(wc * 32 + fr, fq * 8);
#define PG8_SA(b, h) (((b) * 2 + (h)) * HTB)
#define PG8_SB(b, h) ((4 + (b) * 2 + (h)) * HTB)
#define PG8_STAGE(bufoff, gbase, voff) do { _Pragma("unroll") for (int _i = 0; _i < 2; ++_i) \
        __builtin_amdgcn_global_load_lds((const unsigned*)((const char*)(gbase) + (voff)[_i]), (PG8_LAS unsigned*)(lds + (bufoff) + ldsw + _i * 8192), 16, 0, 0); } while (0)
#define PG8_LDA(dst, b, h) do { _Pragma("unroll") for (int m = 0; m < 4; ++m) _Pragma("unroll") for (int k = 0; k < 2; ++k) dst[m][k] = *(const PG8_LAS bf16x8*)(lds + PG8_SA(b, h) + aoff + m * 2048 + k * 1024); } while (0)
#define PG8_LDB(dst, b, h) do { _Pragma("unroll") for (int n = 0; n < 2; ++n) _Pragma("unroll") for (int k = 0; k < 2; ++k) dst[n][k] = *(const PG8_LAS bf16x8*)(lds + PG8_SB(b, h) + boff + n * 2048 + k * 1024); } while (0)
#define PG8_MMA(ai, bj, At, Bt) do { __builtin_amdgcn_s_setprio(1); _Pragma("unroll") for (int m = 0; m < 4; ++m) _Pragma("unroll") for (int n = 0; n < 2; ++n) _Pragma("unroll") for (int k = 0; k < 2; ++k) \
        acc[ai][bj][m][n] = __builtin_amdgcn_mfma_f32_16x16x32_bf16(Bt[n][k], At[m][k], acc[ai][bj][m][n], 0, 0, 0); __builtin_amdgcn_s_setprio(0); } while (0)
#define PG8_WAIT_V(n) asm volatile("s_waitcnt vmcnt(" #n ")" ::: "memory")
#define PG8_WAIT_L(n) asm volatile("s_waitcnt lgkmcnt(" #n ")" ::: "memory")
#define PG8_BAR __builtin_amdgcn_s_barrier()
#define PG8_SCHED __builtin_amdgcn_sched_barrier(0)
    Unit cur, nxt; int ui = 0;
    if (!S.next(0, cur)) return;
    f32x4 acc[2][2][4][2];
#pragma unroll
    for (int a = 0; a < 2; ++a)
#pragma unroll
        for (int b = 0; b < 2; ++b)
#pragma unroll
            for (int m = 0; m < 4; ++m)
#pragma unroll
                for (int n = 0; n < 2; ++n) acc[a][b][m][n] = (f32x4){0.f, 0.f, 0.f, 0.f};
    bf16x8 At[4][2], B0[2][2], B1[2][2];
    const char* cA = (const char*)g.A + (size_t)cur.pm * tstep; const char* cB = (const char*)g.Bt + (size_t)cur.pn * tstep;
    S.a_ready(cur);
    if constexpr (SP2) {
        PG8_STAGE(PG8_SB(0, 0), cB, voffB); PG8_STAGE(PG8_SB(0, 1), cB + hstep, voffB); PG8_STAGE(PG8_SA(0, 0), cA, voffA); PG8_STAGE(PG8_SA(0, 1), cA + hstep, voffA);
        if (wr == 1) PG8_BAR;
        PG8_WAIT_V(2); PG8_BAR;
        PG8_STAGE(PG8_SB(1, 0), cB + kstep, voffB); PG8_STAGE(PG8_SA(1, 0), cA + kstep, voffA); PG8_STAGE(PG8_SB(1, 1), cB + hstep + kstep, voffB);
        PG8_WAIT_V(6); PG8_BAR;
    } else {
        PG8_STAGE(PG8_SB(0, 0), cB, voffB); PG8_STAGE(PG8_SA(0, 0), cA, voffA); PG8_STAGE(PG8_SB(0, 1), cB + hstep, voffB); PG8_STAGE(PG8_SA(0, 1), cA + hstep, voffA);
        if (wr == 1) PG8_BAR;
        PG8_WAIT_V(4); PG8_BAR;
        PG8_STAGE(PG8_SB(1, 0), cB + kstep, voffB); PG8_STAGE(PG8_SA(1, 0), cA + kstep, voffA); PG8_STAGE(PG8_SB(1, 1), cB + hstep + kstep, voffB);
        PG8_WAIT_V(6); PG8_BAR;
    }
    for (;;) {
        const bool has_next = S.next(ui + 1, nxt);
        const char* nA = has_next ? (const char*)g.A + (size_t)nxt.pm * tstep : cA; const char* nB = has_next ? (const char*)g.Bt + (size_t)nxt.pn * tstep : cB;
        for (int t = 0; t < nt; t += 2) {
            const bool last = (t == nt - 2);
            const char* a1 = cA + (size_t)(t + 1) * kstep;
            const char* a2 = last ? nA : cA + (size_t)(t + 2) * kstep; const char* b2 = last ? nB : cB + (size_t)(t + 2) * kstep;
            const char* a3 = a2 + kstep; const char* b3 = b2 + kstep;
            if (last && has_next) S.a_ready(nxt);
            if constexpr (SP2) {
            PG8_LDB(B0, 0, 0); PG8_LDB(B1, 0, 1); PG8_SCHED; PG8_LDA(At, 0, 0); PG8_STAGE(PG8_SA(1, 1), a1 + hstep, voffA);
            PG8_WAIT_V(8); PG8_WAIT_L(0); PG8_BAR; PG8_MMA(0, 0, At, B0); PG8_MMA(0, 1, At, B1); PG8_BAR; PG8_SCHED;
            PG8_LDA(At, 0, 1); PG8_STAGE(PG8_SB(0, 0), b2, voffB); PG8_STAGE(PG8_SB(0, 1), b2 + hstep, voffB); PG8_STAGE(PG8_SA(0, 0), a2, voffA);
            PG8_WAIT_V(8); PG8_WAIT_L(0); PG8_BAR; PG8_MMA(1, 0, At, B0); PG8_MMA(1, 1, At, B1); PG8_BAR; PG8_SCHED;
            PG8_LDB(B0, 1, 0); PG8_LDB(B1, 1, 1); PG8_SCHED; PG8_LDA(At, 1, 0); PG8_STAGE(PG8_SA(0, 1), a2 + hstep, voffA);
            PG8_WAIT_V(8); PG8_WAIT_L(0); PG8_BAR; PG8_MMA(0, 0, At, B0); PG8_MMA(0, 1, At, B1); PG8_BAR; PG8_SCHED;
            PG8_LDA(At, 1, 1); PG8_STAGE(PG8_SB(1, 0), b3, voffB); PG8_STAGE(PG8_SB(1, 1), b3 + hstep, voffB); PG8_STAGE(PG8_SA(1, 0), a3, voffA);
            PG8_WAIT_V(8); PG8_WAIT_L(0); PG8_BAR; PG8_MMA(1, 0, At, B0); PG8_MMA(1, 1, At, B1); PG8_BAR; PG8_SCHED;
            } else {
            PG8_LDB(B0, 0, 0); PG8_SCHED; PG8_LDA(At, 0, 0); PG8_STAGE(PG8_SA(1, 1), a1 + hstep, voffA);
            PG8_WAIT_L(8); PG8_BAR; PG8_WAIT_L(0); PG8_MMA(0, 0, At, B0); PG8_BAR; PG8_SCHED;
            PG8_LDB(B1, 0, 1); PG8_STAGE(PG8_SB(0, 0), b2, voffB);
            PG8_BAR; PG8_WAIT_L(0); PG8_MMA(0, 1, At, B1); PG8_BAR;
            PG8_LDA(At, 0, 1); PG8_STAGE(PG8_SA(0, 0), a2, voffA);
            PG8_BAR; PG8_WAIT_L(0); PG8_MMA(1, 0, At, B0); PG8_BAR; PG8_SCHED;
            PG8_STAGE(PG8_SB(0, 1), b2 + hstep, voffB);
            PG8_WAIT_V(6); PG8_BAR; PG8_MMA(1, 1, At, B1); PG8_BAR;
            PG8_LDB(B0, 1, 0); PG8_SCHED; PG8_LDA(At, 1, 0); PG8_STAGE(PG8_SA(0, 1), a2 + hstep, voffA);
            PG8_WAIT_L(8); PG8_BAR; PG8_WAIT_L(0); PG8_MMA(0, 0, At, B0); PG8_BAR; PG8_SCHED;
            PG8_LDB(B1, 1, 1); PG8_STAGE(PG8_SB(1, 0), b3, voffB);
            PG8_BAR; PG8_WAIT_L(0); PG8_MMA(0, 1, At, B1); PG8_BAR;
            PG8_LDA(At, 1, 1); PG8_STAGE(PG8_SA(1, 0), a3, voffA);
            PG8_BAR; PG8_WAIT_L(0); PG8_MMA(1, 0, At, B0); PG8_BAR; PG8_SCHED;
            PG8_STAGE(PG8_SB(1, 1), b3 + hstep, voffB);
            PG8_WAIT_V(6); PG8_BAR; PG8_MMA(1, 1, At, B1); PG8_BAR;
            }
        }
        if constexpr (ALIGN_EPI) { if (wr == 0) PG8_BAR; }
        if constexpr (!Epi::AFTER_DRAIN) { E(acc, cur, wr, wc, fr, fq); S.done(cur); }
        if (!has_next) break;
#pragma unroll
        for (int a = 0; a < 2; ++a)
#pragma unroll
            for (int b = 0; b < 2; ++b)
#pragma unroll
                for (int m = 0; m < 4; ++m)
#pragma unroll
                    for (int n = 0; n < 2; ++n) acc[a][b][m][n] = (f32x4){0.f, 0.f, 0.f, 0.f};
        cur = nxt; cA = nA; cB = nB; ++ui;
        if constexpr (ALIGN_EPI) { if (wr == 1) PG8_BAR; }
    }
    PG8_WAIT_V(0);
    if constexpr (!ALIGN_EPI) { if (wr == 0) PG8_BAR; }
    PG8_BAR;
    if constexpr (Epi::AFTER_DRAIN) { E.fused(acc, cur, wr, wc, fr, fq, lds, wid, lane); S.done(cur); }
#undef PG8_SA
#undef PG8_SB
#undef PG8_STAGE
#undef PG8_LDA
#undef PG8_LDB
#undef PG8_MMA
#undef PG8_WAIT_V
#undef PG8_WAIT_L
#undef PG8_BAR
#undef PG8_SCHED
}
}
constexpr int S_ = 16384, D_ = 2048, INC = 6144, NH = 8, DH = 128, CH = 64, NCH = 256;
constexpr float DN_ALPHA = 1.189207115002721f;
constexpr float LN_EPS = 1e-5f, GN_EPS = 1e-6f;
constexpr int NWAVES = 8, NTHREADS = 512;
constexpr int LDS_BYTES = 147456;

constexpr size_t MiB = 1u << 20;
constexpr size_t WS_CTL = 0;
constexpr size_t WS_WOUT_T = 1 * MiB, WS_WPQ_T = 9 * MiB, WS_KEYS = 17 * MiB, WS_WRA_T = 17 * MiB + 512 * 1024, WS_WRI_T = 17 * MiB + 768 * 1024;
constexpr size_t WS_COS = 18 * MiB, WS_SIN = 22 * MiB, WS_SUMA = 26 * MiB, WS_SUMH = 27 * MiB, WS_HIN = 28 * MiB;
constexpr size_t WS_SU = 29 * MiB, WS_SV = 30 * MiB;
constexpr size_t WS_SX = 31 * MiB;
constexpr size_t WS_UQ = 32 * MiB, WS_VQ = 64 * MiB;
constexpr size_t WS_XQ = 96 * MiB;
constexpr size_t WS_PD = 328 * MiB, WS_ZS = 392 * MiB;
constexpr size_t WS_WIN_T = 160 * MiB, WS_XB = 184 * MiB, WS_KVS = 184 * MiB, WS_H1B = 184 * MiB;
constexpr size_t WS_PROJ = 248 * MiB, WS_QP = 248 * MiB, WS_SELE = 312 * MiB, WS_SELG = 320 * MiB;
constexpr size_t WS_YCAT = 440 * MiB, WS_END = 504 * MiB;

#define LAS __attribute__((address_space(3)))
typedef unsigned short bf16_t;
typedef short bf16x8 __attribute__((ext_vector_type(8)));
typedef float f32x4 __attribute__((ext_vector_type(4)));
typedef unsigned u32x4 __attribute__((ext_vector_type(4)));
typedef unsigned u32x2 __attribute__((ext_vector_type(2)));

__device__ __forceinline__ unsigned f2bf(float f) { unsigned u = __float_as_uint(f); return (u + 0x7fffu + ((u >> 16) & 1u)) >> 16; }
__device__ __forceinline__ unsigned pk2(float lo, float hi) { return f2bf(lo) | (f2bf(hi) << 16); }
__device__ __forceinline__ float bflo(unsigned w) { return __uint_as_float(w << 16); }
__device__ __forceinline__ float bfhi(unsigned w) { return __uint_as_float(w & 0xffff0000u); }
__device__ __forceinline__ float bf2f(bf16_t b) { return __uint_as_float(((unsigned)b) << 16); }
__device__ __forceinline__ f32x4 mfma16(bf16x8 a, bf16x8 b, f32x4 c) { return __builtin_amdgcn_mfma_f32_16x16x32_bf16(a, b, c, 0, 0, 0); }
__device__ __forceinline__ float fexp_(float x) { return __builtin_amdgcn_exp2f(x * 1.4426950408889634f); }
__device__ __forceinline__ float sigmoidf_(float x) { return __builtin_amdgcn_rcpf(1.0f + fexp_(-x)); }
__device__ __forceinline__ float gelu_tanh(float x) { const float y = 0.7978845608028654f * (x + 0.044715f * x * x * x); return x * __builtin_amdgcn_rcpf(1.0f + fexp_(-2.0f * y)); }
__device__ __forceinline__ float wave_sum(float v) {
#pragma unroll
    for (int o = 1; o < 64; o <<= 1) v += __shfl_xor(v, o);
    return v;
}
__device__ __forceinline__ float wave_max(float v) {
#pragma unroll
    for (int o = 1; o < 64; o <<= 1) v = fmaxf(v, __shfl_xor(v, o));
    return v;
}
__device__ __forceinline__ int wave_sum_i(int v) {
#pragma unroll
    for (int o = 1; o < 64; o <<= 1) v += __shfl_xor(v, o);
    return v;
}
__device__ __forceinline__ float head_log_gamma(int h) { return logf(1.0f - exp2f(-5.0f - (float)h)); }

__device__ __forceinline__ void transpose_item(const float* W, int K, int N, bf16_t* WT, LAS float* scr, int item, int lane) {
    const int nblk = N / 32, kb = item / nblk, nb = item % nblk, k0 = 64 * kb, n0 = 32 * nb;
#pragma unroll 8
    for (int i = 0; i < 32; ++i) { const int kk = 2 * i + (lane >> 5); scr[kk * 33 + (lane & 31)] = W[(size_t)(k0 + kk) * N + n0 + (lane & 31)]; }
    asm volatile("s_waitcnt lgkmcnt(0)" ::: "memory");
    const int c = lane & 7;
#pragma unroll
    for (int j = 0; j < 4; ++j) { const int n = (lane >> 3) + 8 * j; const LAS float* s = scr + (8 * c) * 33 + n;
        u32x4 o; o.x = pk2(s[0 * 33], s[1 * 33]); o.y = pk2(s[2 * 33], s[3 * 33]); o.z = pk2(s[4 * 33], s[5 * 33]); o.w = pk2(s[6 * 33], s[7 * 33]);
        *(u32x4*)(WT + (size_t)(n0 + n) * K + k0 + 8 * c) = o; }
    asm volatile("s_waitcnt lgkmcnt(0)" ::: "memory");
}
__device__ __forceinline__ void cvt_stream(const float* src, bf16_t* dst, size_t n8, size_t gtid, size_t gthreads) {
    size_t i = gtid;
    for (; i + 3 * gthreads < n8; i += 4 * gthreads) {
        f32x4 a[4], b[4];
#pragma unroll
        for (int u = 0; u < 4; ++u) { a[u] = __builtin_nontemporal_load((const f32x4*)src + 2 * (i + u * gthreads)); b[u] = __builtin_nontemporal_load((const f32x4*)src + 2 * (i + u * gthreads) + 1); }
#pragma unroll
        for (int u = 0; u < 4; ++u) { u32x4 o; o.x = pk2(a[u].x, a[u].y); o.y = pk2(a[u].z, a[u].w); o.z = pk2(b[u].x, b[u].y); o.w = pk2(b[u].z, b[u].w); ((u32x4*)dst)[i + u * gthreads] = o; }
    }
    for (; i < n8; i += gthreads) {
        const f32x4 a = ((const f32x4*)src)[2 * i], b = ((const f32x4*)src)[2 * i + 1];
        u32x4 o; o.x = pk2(a.x, a.y); o.y = pk2(a.z, a.w); o.z = pk2(b.x, b.y); o.w = pk2(b.z, b.w);
        ((u32x4*)dst)[i] = o;
    }
}
struct Ptrs {
    const float *x; const int* pos; const float *w_in, *w_out, *conv_w, *conv_b, *w_ra, *b_ra, *w_ri, *b_ri, *lam, *ln1_g, *ln1_b, *w_pq, *sub_keys, *peer_u, *peer_v, *ln2_g, *ln2_b;
    float* out; unsigned char* ws;
};
__device__ __forceinline__ void prologue_phase(LAS unsigned char* lds, const Ptrs& P, int G, int b) {
    const int tid = threadIdx.x, lane = tid & 63, wid = tid >> 6;
    LAS float* scr = (LAS float*)(lds + wid * 16384);
    const int gw = b * NWAVES + wid, NGW = G * NWAVES;
    unsigned char* ws = P.ws;
    constexpr int I_IN = (D_ / 64) * (INC / 32), I_SQ = (D_ / 64) * (D_ / 32), I_G = 2 * 4;
    constexpr int NITEMS = I_IN + 2 * I_SQ + 16 * I_G;
    for (int it = gw; it < NITEMS; it += NGW) {
        int r = it;
        if (r < I_IN) { transpose_item(P.w_in, D_, INC, (bf16_t*)(ws + WS_WIN_T), scr, r, lane); continue; } r -= I_IN;
        if (r < I_SQ) { transpose_item(P.w_out, D_, D_, (bf16_t*)(ws + WS_WOUT_T), scr, r, lane); continue; } r -= I_SQ;
        if (r < I_SQ) { transpose_item(P.w_pq, D_, D_, (bf16_t*)(ws + WS_WPQ_T), scr, r, lane); continue; } r -= I_SQ;
        if (r < 8 * I_G) { const int g = r / I_G; transpose_item(P.w_ra + g * 16384, 128, 128, (bf16_t*)(ws + WS_WRA_T) + g * 16384, scr, r % I_G, lane); continue; } r -= 8 * I_G;
        { const int g = r / I_G; transpose_item(P.w_ri + g * 16384, 128, 128, (bf16_t*)(ws + WS_WRI_T) + g * 16384, scr, r % I_G, lane); }
    }
    const size_t gtid = (size_t)b * NTHREADS + tid, gth = (size_t)G * NTHREADS;
    cvt_stream(P.x, (bf16_t*)(ws + WS_XB), (size_t)S_ * D_ / 8, gtid, gth);
    for (int row = gw; row < 2 * 16384; row += NGW) {
        const int isv = row >> 14, e = row & 16383;
        const float* rp = (isv ? P.peer_v : P.peer_u) + (size_t)e * D_;
        f32x4 v[8]; float amax = 0.f;
#pragma unroll
        for (int j = 0; j < 8; ++j) { v[j] = *(const f32x4*)(rp + 256 * j + 4 * lane); amax = fmaxf(amax, fmaxf(fmaxf(fabsf(v[j].x), fabsf(v[j].y)), fmaxf(fabsf(v[j].z), fabsf(v[j].w)))); }
        amax = wave_max(amax);
        const float inv = amax > 0.f ? 127.0f / amax : 0.f;
        if (lane == 0) ((float*)(ws + (isv ? WS_SV : WS_SU)))[e] = amax > 0.f ? amax / 127.0f : 0.f;
        unsigned* qp = (unsigned*)(ws + (isv ? WS_VQ : WS_UQ)) + (size_t)e * 64;
        const int off = isv ? 128 : 0;
#pragma unroll
        for (int j = 0; j < 8; ++j) {
            const int a = (int)rintf(v[j].x * inv) + off, bq = (int)rintf(v[j].y * inv) + off, c = (int)rintf(v[j].z * inv) + off, d = (int)rintf(v[j].w * inv) + off;
            qp[(size_t)j * 16384 * 64 + lane] = (unsigned)(a & 255) | ((unsigned)(bq & 255) << 8) | ((unsigned)(c & 255) << 16) | ((unsigned)(d & 255) << 24);
        }
    }
    cvt_stream(P.sub_keys, (bf16_t*)(ws + WS_KEYS), (size_t)8 * 2 * 128 * 128 / 8, gtid, gth);
    float* cosT = (float*)(ws + WS_COS); float* sinT = (float*)(ws + WS_SIN);
    for (size_t i = gtid; i < (size_t)S_ * 64; i += gth) {
        const int s = (int)(i >> 6), f = (int)(i & 63);
        const float inv = powf(10000.0f, -(float)f / 64.0f);
        const float ang = (float)P.pos[s] * inv;
        float sn, cs; sincosf(ang, &sn, &cs);
        cosT[i] = cs; sinT[i] = sn;
    }
}
#define XB_TMO      128
#define XB_XCNT(j)  (256  + 64 * (j))
#define XB_XSUB(j)  (1280 + 64 * (j))
#define XB_XGEN(j)  (2304 + 64 * (j))
#define XB_TOP      3328
#define XB_TOPGEN   3392
#define XCD_BAR_WORDS 3456
#define XB_SPIN_CAP (1u << 18)

__device__ __forceinline__ unsigned xb_ld(unsigned* p)              { return __hip_atomic_load(p, __ATOMIC_RELAXED, __HIP_MEMORY_SCOPE_AGENT); }
__device__ __forceinline__ unsigned xb_add(unsigned* p, unsigned v) { return __hip_atomic_fetch_add(p, v, __ATOMIC_RELAXED, __HIP_MEMORY_SCOPE_AGENT); }
__device__ __forceinline__ unsigned xb_xcc_id() { return (unsigned)__builtin_amdgcn_s_getreg((3 << 11) | 20) & 0xFu; }
#define XB_SPIN(cond, bar) do { unsigned _sp = 0; while (cond) { __builtin_amdgcn_s_sleep(1); \
    if ((++_sp & 255u) == 0u) { if (xb_ld(&(bar)[XB_TMO])) break; if (_sp > XB_SPIN_CAP) { atomicAdd(&(bar)[XB_TMO], 1u); break; } } } } while (0)

struct XcdBarrier {
    unsigned* bar; unsigned x;
    volatile LAS unsigned* st;
};

__device__ __forceinline__ XcdBarrier xcd_barrier_post(unsigned* bar, volatile LAS unsigned* st) {
    XcdBarrier b; b.bar = bar; b.x = xb_xcc_id(); b.st = st;
    if (threadIdx.x == 0) (void)xb_add(&bar[XB_XCNT(b.x)], 1u);
    return b;
}
__device__ __forceinline__ void xcd_barrier_complete(unsigned* bar, unsigned x, unsigned& nloc, unsigned& nx) {
    const unsigned G = gridDim.x * gridDim.y * gridDim.z;
    unsigned sum, cnt, mine, sp = 0u;
    for (;;) {
        sum = 0u; cnt = 0u; mine = 0u;
#pragma unroll
        for (unsigned j = 0; j < 16; ++j) { const unsigned c = xb_ld(&bar[XB_XCNT(j)]); sum += c; cnt += (c > 0u) ? 1u : 0u; mine = (j == x) ? c : mine; }
        if (sum == G) break;
        __builtin_amdgcn_s_sleep(1);
        if ((++sp & 255u) == 0u) { if (xb_ld(&bar[XB_TMO])) break; if (sp > XB_SPIN_CAP) { atomicAdd(&bar[XB_TMO], 1u); break; } }
    }
    nloc = mine > 0u ? mine : 1u; nx = cnt > 0u ? cnt : 1u;
}

__device__ __forceinline__ void xcd_barrier(const XcdBarrier& b) {
    asm volatile("s_waitcnt vmcnt(0)" ::: "memory");
    __syncthreads();
    if (threadIdx.x == 0) {
        unsigned* bar = b.bar;
        __builtin_amdgcn_s_waitcnt(0);
        unsigned nloc = b.st[0], nx = b.st[1];
        if (nloc == 0u) { xcd_barrier_complete(bar, b.x, nloc, nx); b.st[0] = nloc; b.st[1] = nx; }
        const unsigned old = xb_add(&bar[XB_XSUB(b.x)], 1u);
        const unsigned gen = old / nloc;
        if (old + 1u == (gen + 1u) * nloc) {
            __builtin_amdgcn_fence(__ATOMIC_RELEASE, "agent");
            asm volatile("s_waitcnt vmcnt(0)" ::: "memory");
            const unsigned og = xb_add(&bar[XB_TOP], 1u);
            const unsigned tg = og / nx;
            if (og + 1u == (tg + 1u) * nx) xb_add(&bar[XB_TOPGEN], 1u);
            else XB_SPIN(xb_ld(&bar[XB_TOPGEN]) == tg, bar);
            __builtin_amdgcn_fence(__ATOMIC_ACQUIRE, "agent");
            xb_add(&bar[XB_XGEN(b.x)], 1u);
            asm volatile("s_waitcnt vmcnt(0)" ::: "memory");
        } else {
            XB_SPIN(xb_ld(&bar[XB_XGEN(b.x)]) == gen, bar);
            __builtin_amdgcn_fence(__ATOMIC_ACQUIRE, "agent");
            asm volatile("s_waitcnt vmcnt(0)" ::: "memory");
        }
    }
    __syncthreads();
}
__device__ __forceinline__ void rot8(const u32x4 x1, const u32x4 x2, const float* cp, const float* sp, float scale, float (&o1)[8], float (&o2)[8]) {
    const f32x4 c0 = *(const f32x4*)cp, c1 = *(const f32x4*)(cp + 4), s0 = *(const f32x4*)sp, s1 = *(const f32x4*)(sp + 4);
    const float cs[8] = {c0.x, c0.y, c0.z, c0.w, c1.x, c1.y, c1.z, c1.w}, sn[8] = {s0.x, s0.y, s0.z, s0.w, s1.x, s1.y, s1.z, s1.w};
    const unsigned w1[4] = {x1.x, x1.y, x1.z, x1.w}, w2[4] = {x2.x, x2.y, x2.z, x2.w};
#pragma unroll
    for (int j = 0; j < 8; ++j) {
        const float a = (j & 1) ? bfhi(w1[j >> 1]) : bflo(w1[j >> 1]);
        const float bb = (j & 1) ? bfhi(w2[j >> 1]) : bflo(w2[j >> 1]);
        o1[j] = (a * cs[j] - bb * sn[j]) * scale;
        o2[j] = (bb * cs[j] + a * sn[j]) * scale;
    }
}
__device__ __forceinline__ void ret_kv_phase(LAS unsigned char* lds, const bf16_t* proj, const float* cosT, const float* sinT, bf16_t* kvs, int G, int b) {
    const int tid = threadIdx.x, lane = tid & 63, wid = tid >> 6, fr = lane & 15, fq = lane >> 4;
    LAS bf16_t* KT = (LAS bf16_t*)lds;
    LAS bf16_t* VT = (LAS bf16_t*)(lds + 18432);
    for (int unit = b; unit < NCH * NH; unit += G) {
        const int n = unit >> 3, h = unit & 7;
        const float log_g = head_log_gamma(h);
        const int m = tid >> 3, tq = tid & 7; const int s = n * 64 + m;
        {
            const bf16_t* kp = proj + (size_t)s * INC + 1024 + h * 128 + tq * 8;
            const u32x4 x1 = *(const u32x4*)kp, x2 = *(const u32x4*)(kp + 64);
            float o1[8], o2[8];
            rot8(x1, x2, cosT + (size_t)s * 64 + tq * 8, sinT + (size_t)s * 64 + tq * 8, expf(log_g * (63.0f - (float)m)), o1, o2);
#pragma unroll
            for (int j = 0; j < 8; ++j) { KT[(tq * 8 + j) * 72 + m] = (bf16_t)f2bf(o1[j]); KT[(64 + tq * 8 + j) * 72 + m] = (bf16_t)f2bf(o2[j]); }
            const bf16_t* vp = proj + (size_t)s * INC + 2048 + h * 128 + tq * 16;
            const u32x4 y0 = *(const u32x4*)vp, y1 = *(const u32x4*)(vp + 8);
            const unsigned yw[8] = {y0.x, y0.y, y0.z, y0.w, y1.x, y1.y, y1.z, y1.w};
#pragma unroll
            for (int j = 0; j < 8; ++j) { VT[(tq * 16 + 2 * j) * 72 + m] = (bf16_t)(yw[j] & 0xffffu); VT[(tq * 16 + 2 * j + 1) * 72 + m] = (bf16_t)(yw[j] >> 16); }
        }
        __syncthreads();
        f32x4 acc[8];
#pragma unroll
        for (int et = 0; et < 8; ++et) acc[et] = (f32x4){0.f, 0.f, 0.f, 0.f};
#pragma unroll
        for (int ks = 0; ks < 2; ++ks) {
            const bf16x8 a = *(const LAS bf16x8*)(KT + (wid * 16 + fr) * 72 + ks * 32 + fq * 8);
#pragma unroll
            for (int et = 0; et < 8; ++et) { const bf16x8 bb = *(const LAS bf16x8*)(VT + (et * 16 + fr) * 72 + ks * 32 + fq * 8); acc[et] = mfma16(a, bb, acc[et]); }
        }
        bf16_t* outp = kvs + (size_t)unit * 16384;
#pragma unroll
        for (int et = 0; et < 8; ++et) { u32x2 w; w.x = pk2(acc[et][0], acc[et][1]); w.y = pk2(acc[et][2], acc[et][3]); *(u32x2*)(outp + (et * 16 + fr) * 128 + wid * 16 + fq * 4) = w; }
        __syncthreads();
    }
}
__device__ __forceinline__ void scan_phase(bf16_t* kvs, const float* sumA, const float* sumH, float* Hin, int G, int b) {
    const int gtid = b * NTHREADS + threadIdx.x, gth = G * NTHREADS;
    for (int p = gtid; p < 65536; p += gth) {
        const int h = p >> 13;
        const float dec = expf(64.0f * head_log_gamma(h));
        unsigned* ptr = (unsigned*)kvs + p;
        float s0 = 0.f, s1 = 0.f;
        for (int n = 0; n < NCH; n += 32) {
            unsigned v[32];
#pragma unroll
            for (int j = 0; j < 32; ++j) v[j] = ptr[(size_t)(n + j) * 65536];
#pragma unroll
            for (int j = 0; j < 32; ++j) { ptr[(size_t)(n + j) * 65536] = pk2(s0, s1); s0 = dec * s0 + bflo(v[j]); s1 = dec * s1 + bfhi(v[j]); }
        }
    }
    const int c = gth - 1 - gtid;
    if (c < 1024) {
        float H = 0.f;
        for (int n = 0; n < NCH; n += 8) {
            float a[8], hh[8];
#pragma unroll
            for (int j = 0; j < 8; ++j) { a[j] = sumA[(n + j) * 1024 + c]; hh[j] = sumH[(n + j) * 1024 + c]; }
#pragma unroll
            for (int j = 0; j < 8; ++j) { Hin[(n + j) * 1024 + c] = H; H = a[j] * H + hh[j]; }
        }
    }
}
__device__ __forceinline__ void ret_out_phase(LAS unsigned char* lds, const bf16_t* proj, const float* cosT, const float* sinT, const bf16_t* kvs, bf16_t* ycat, int G, int b) {
    const int tid = threadIdx.x, lane = tid & 63, wid = tid >> 6, fr = lane & 15, fq = lane >> 4;
    LAS bf16_t* QS = (LAS bf16_t*)lds;
    LAS bf16_t* KS = (LAS bf16_t*)(lds + 17408);
    LAS bf16_t* VT = (LAS bf16_t*)(lds + 34816);
    LAS bf16_t* PS = (LAS bf16_t*)(lds + 53248);
    LAS float*  OS = (LAS float*)(lds + 62464);
    for (int unit = b; unit < NCH * NH; unit += G) {
        const int n = unit >> 3, h = unit & 7;
        const float log_g = head_log_gamma(h);
        const int m = tid >> 3, tq = tid & 7; const int s = n * 64 + m;
        {
            const float* cp = cosT + (size_t)s * 64 + tq * 8; const float* sp = sinT + (size_t)s * 64 + tq * 8;
            float o1[8], o2[8];
            const bf16_t* qp = proj + (size_t)s * INC + h * 128 + tq * 8;
            rot8(*(const u32x4*)qp, *(const u32x4*)(qp + 64), cp, sp, 0.08838834764831845f, o1, o2);
            u32x4 w; w.x = pk2(o1[0], o1[1]); w.y = pk2(o1[2], o1[3]); w.z = pk2(o1[4], o1[5]); w.w = pk2(o1[6], o1[7]);
            *(LAS u32x4*)(QS + m * 136 + tq * 8) = w;
            w.x = pk2(o2[0], o2[1]); w.y = pk2(o2[2], o2[3]); w.z = pk2(o2[4], o2[5]); w.w = pk2(o2[6], o2[7]);
            *(LAS u32x4*)(QS + m * 136 + 64 + tq * 8) = w;
            const bf16_t* kp = proj + (size_t)s * INC + 1024 + h * 128 + tq * 8;
            rot8(*(const u32x4*)kp, *(const u32x4*)(kp + 64), cp, sp, 1.0f, o1, o2);
            w.x = pk2(o1[0], o1[1]); w.y = pk2(o1[2], o1[3]); w.z = pk2(o1[4], o1[5]); w.w = pk2(o1[6], o1[7]);
            *(LAS u32x4*)(KS + m * 136 + tq * 8) = w;
            w.x = pk2(o2[0], o2[1]); w.y = pk2(o2[2], o2[3]); w.z = pk2(o2[4], o2[5]); w.w = pk2(o2[6], o2[7]);
            *(LAS u32x4*)(KS + m * 136 + 64 + tq * 8) = w;
            const bf16_t* vp = proj + (size_t)s * INC + 2048 + h * 128 + tq * 16;
            const u32x4 y0 = *(const u32x4*)vp, y1 = *(const u32x4*)(vp + 8);
            const unsigned yw[8] = {y0.x, y0.y, y0.z, y0.w, y1.x, y1.y, y1.z, y1.w};
#pragma unroll
            for (int j = 0; j < 8; ++j) { VT[(tq * 16 + 2 * j) * 72 + m] = (bf16_t)(yw[j] & 0xffffu); VT[(tq * 16 + 2 * j + 1) * 72 + m] = (bf16_t)(yw[j] >> 16); }
        }
        __syncthreads();
        const int ct = wid & 3;
        {
            const int mt0 = (wid >> 2) * 2;
            f32x4 sacc[2] = {(f32x4){0.f, 0.f, 0.f, 0.f}, (f32x4){0.f, 0.f, 0.f, 0.f}};
#pragma unroll
            for (int ks = 0; ks < 4; ++ks) {
                const bf16x8 a = *(const LAS bf16x8*)(QS + (ct * 16 + fr) * 136 + ks * 32 + fq * 8);
#pragma unroll
                for (int j = 0; j < 2; ++j) { const bf16x8 bb = *(const LAS bf16x8*)(KS + ((mt0 + j) * 16 + fr) * 136 + ks * 32 + fq * 8); sacc[j] = mfma16(a, bb, sacc[j]); }
            }
#pragma unroll
            for (int j = 0; j < 2; ++j)
#pragma unroll
                for (int r = 0; r < 4; ++r) { const int c = ct * 16 + fq * 4 + r, mm = (mt0 + j) * 16 + fr; const float dd = fabsf((float)(c - mm));
                    PS[c * 72 + mm] = (bf16_t)f2bf(sacc[j][r] * expf(log_g * dd)); }
        }
        __syncthreads();
        {
            const int et0 = (wid >> 2) * 4;
            f32x4 oacc[4];
#pragma unroll
            for (int j = 0; j < 4; ++j) oacc[j] = (f32x4){0.f, 0.f, 0.f, 0.f};
            const bf16_t* st = kvs + (size_t)unit * 16384;
#pragma unroll
            for (int ks = 0; ks < 4; ++ks) {
                const bf16x8 a = *(const LAS bf16x8*)(QS + (ct * 16 + fr) * 136 + ks * 32 + fq * 8);
#pragma unroll
                for (int j = 0; j < 4; ++j) { const bf16x8 bb = *(const bf16x8*)(st + ((et0 + j) * 16 + fr) * 128 + ks * 32 + fq * 8); oacc[j] = mfma16(a, bb, oacc[j]); }
            }
#pragma unroll
            for (int r = 0; r < 4; ++r) { const float qd = expf(log_g * (float)(ct * 16 + fq * 4 + r + 1));
#pragma unroll
                for (int j = 0; j < 4; ++j) oacc[j][r] *= qd; }
#pragma unroll
            for (int ks = 0; ks < 2; ++ks) {
                const bf16x8 a = *(const LAS bf16x8*)(PS + (ct * 16 + fr) * 72 + ks * 32 + fq * 8);
#pragma unroll
                for (int j = 0; j < 4; ++j) { const bf16x8 bb = *(const LAS bf16x8*)(VT + ((et0 + j) * 16 + fr) * 72 + ks * 32 + fq * 8); oacc[j] = mfma16(a, bb, oacc[j]); }
            }
#pragma unroll
            for (int j = 0; j < 4; ++j)
#pragma unroll
                for (int r = 0; r < 4; ++r) OS[(ct * 16 + fq * 4 + r) * 132 + (et0 + j) * 16 + fr] = oacc[j][r];
        }
        __syncthreads();
        {
            float v[16]; float sum = 0.f;
#pragma unroll
            for (int q = 0; q < 4; ++q) { const f32x4 t = *(const LAS f32x4*)(OS + m * 132 + tq * 16 + q * 4); v[4 * q] = t.x; v[4 * q + 1] = t.y; v[4 * q + 2] = t.z; v[4 * q + 3] = t.w; sum += (t.x + t.y) + (t.z + t.w); }
            sum += __shfl_xor(sum, 1); sum += __shfl_xor(sum, 2); sum += __shfl_xor(sum, 4);
            const float mean = sum * (1.0f / 128.0f); float sq = 0.f;
#pragma unroll
            for (int i = 0; i < 16; ++i) { v[i] -= mean; sq += v[i] * v[i]; }
            sq += __shfl_xor(sq, 1); sq += __shfl_xor(sq, 2); sq += __shfl_xor(sq, 4);
            const float rstd = 1.0f / sqrtf(sq * (1.0f / 128.0f) + GN_EPS);
            const bf16_t* gp = proj + (size_t)s * INC + 3072 + h * 128 + tq * 16;
            const u32x4 g0 = *(const u32x4*)gp, g1 = *(const u32x4*)(gp + 8);
            const unsigned gw[8] = {g0.x, g0.y, g0.z, g0.w, g1.x, g1.y, g1.z, g1.w};
            unsigned ow[8];
#pragma unroll
            for (int j = 0; j < 8; ++j) { const float ga = bflo(gw[j]), gb = bfhi(gw[j]);
                ow[j] = pk2(ga * sigmoidf_(ga) * v[2 * j] * rstd, gb * sigmoidf_(gb) * v[2 * j + 1] * rstd); }
            bf16_t* yp = ycat + (size_t)s * D_ + h * 128 + tq * 16;
            *(u32x4*)yp = (u32x4){ow[0], ow[1], ow[2], ow[3]}; *(u32x4*)(yp + 8) = (u32x4){ow[4], ow[5], ow[6], ow[7]};
        }
        __syncthreads();
    }
}
template <int MODE>
__device__ __forceinline__ void lru_phase(LAS unsigned char* lds, const bf16_t* proj, const Ptrs& P, const bf16_t* wraT, const bf16_t* wriT,
                                          float* sumA, float* sumH, const float* Hin, bf16_t* ycat, int G, int b) {
    const int tid = threadIdx.x, lane = tid & 63, wid = tid >> 6, fr = lane & 15, fq = lane >> 4;
    LAS float*  XC  = (LAS float*)lds;
    LAS bf16_t* XCb = (LAS bf16_t*)(lds + 33792);
    LAS float*  AA  = (LAS float*)(lds + 51200);
    LAS float*  BB  = (LAS float*)(lds + 84992);
    for (int unit = b; unit < NCH * 8; unit += G) {
        const int n = unit >> 3, g = unit & 7, c0 = g * 128;
        const int m = tid >> 3, part = tid & 7, j0 = part * 16; const int s = n * 64 + m;
        {
            float xc[16];
#pragma unroll
            for (int q = 0; q < 4; ++q) { const f32x4 t = *(const f32x4*)(P.conv_b + c0 + j0 + 4 * q); xc[4 * q] = t.x; xc[4 * q + 1] = t.y; xc[4 * q + 2] = t.z; xc[4 * q + 3] = t.w; }
#pragma unroll
            for (int kk = 0; kk < 4; ++kk) {
                const int srow = s - 3 + kk;
                if (srow >= 0) {
                    const bf16_t* xp = proj + (size_t)srow * INC + 4096 + c0 + j0;
                    const u32x4 y0 = *(const u32x4*)xp, y1 = *(const u32x4*)(xp + 8);
                    const unsigned yw[8] = {y0.x, y0.y, y0.z, y0.w, y1.x, y1.y, y1.z, y1.w};
                    const float* wp = P.conv_w + kk * 1024 + c0 + j0;
#pragma unroll
                    for (int q = 0; q < 4; ++q) { const f32x4 w = *(const f32x4*)(wp + 4 * q);
                        xc[4 * q] += w.x * bflo(yw[2 * q]); xc[4 * q + 1] += w.y * bfhi(yw[2 * q]); xc[4 * q + 2] += w.z * bflo(yw[2 * q + 1]); xc[4 * q + 3] += w.w * bfhi(yw[2 * q + 1]); }
                }
            }
#pragma unroll
            for (int q = 0; q < 4; ++q) *(LAS f32x4*)(XC + m * 132 + j0 + 4 * q) = (f32x4){xc[4 * q], xc[4 * q + 1], xc[4 * q + 2], xc[4 * q + 3]};
            *(LAS u32x4*)(XCb + m * 136 + j0) = (u32x4){pk2(xc[0], xc[1]), pk2(xc[2], xc[3]), pk2(xc[4], xc[5]), pk2(xc[6], xc[7])};
            *(LAS u32x4*)(XCb + m * 136 + j0 + 8) = (u32x4){pk2(xc[8], xc[9]), pk2(xc[10], xc[11]), pk2(xc[12], xc[13]), pk2(xc[14], xc[15])};
        }
        __syncthreads();
        {
            const int st = wid & 3, jt0 = (wid >> 2) * 4;
            f32x4 ar[4], ai[4];
#pragma unroll
            for (int j = 0; j < 4; ++j) { ar[j] = (f32x4){0.f, 0.f, 0.f, 0.f}; ai[j] = (f32x4){0.f, 0.f, 0.f, 0.f}; }
#pragma unroll
            for (int ks = 0; ks < 4; ++ks) {
                const bf16x8 a = *(const LAS bf16x8*)(XCb + (st * 16 + fr) * 136 + ks * 32 + fq * 8);
#pragma unroll
                for (int j = 0; j < 4; ++j) { const size_t wo = (size_t)g * 16384 + ((jt0 + j) * 16 + fr) * 128 + ks * 32 + fq * 8;
                    ar[j] = mfma16(a, *(const bf16x8*)(wraT + wo), ar[j]); ai[j] = mfma16(a, *(const bf16x8*)(wriT + wo), ai[j]); }
            }
#pragma unroll
            for (int j = 0; j < 4; ++j) {
                const int col = (jt0 + j) * 16 + fr, c = c0 + col;
                const float bra = P.b_ra[c], bri = P.b_ri[c];
                const float ls = -log1pf(expf(-P.lam[c]));
#pragma unroll
                for (int r = 0; r < 4; ++r) {
                    const int sl = st * 16 + fq * 4 + r;
                    const float rg = sigmoidf_(ar[j][r] + bra), ig = sigmoidf_(ai[j][r] + bri);
                    const float la = 8.0f * rg * ls;
                    const float a = fexp_(la);
                    const float bv = __builtin_amdgcn_sqrtf(fmaxf(1.0f - a * a, 0.f)) * (ig * XC[sl * 132 + col]);
                    AA[sl * 132 + col] = a; BB[sl * 132 + col] = bv;
                }
            }
        }
        __syncthreads();
        if (tid < 128) {
            const int j = tid;
            float hcur = (MODE == 1) ? Hin[n * 1024 + c0 + j] : 0.f, acum = 1.f;
#pragma unroll 8
            for (int sl = 0; sl < 64; ++sl) { const float a = AA[sl * 132 + j], bv = BB[sl * 132 + j]; hcur = a * hcur + bv; acum *= a; if (MODE == 1) BB[sl * 132 + j] = hcur; }
            if (MODE == 0) { sumA[n * 1024 + c0 + j] = acum; sumH[n * 1024 + c0 + j] = hcur; }
        }
        if (MODE == 1) {
            __syncthreads();
            const bf16_t* gp = proj + (size_t)s * INC + 5120 + c0 + j0;
            const u32x4 g0 = *(const u32x4*)gp, g1 = *(const u32x4*)(gp + 8);
            const unsigned gw[8] = {g0.x, g0.y, g0.z, g0.w, g1.x, g1.y, g1.z, g1.w};
            unsigned ow[8];
#pragma unroll
            for (int q = 0; q < 8; ++q) { const float h0 = BB[m * 132 + j0 + 2 * q], h1 = BB[m * 132 + j0 + 2 * q + 1];
                ow[q] = pk2(h0 * gelu_tanh(bflo(gw[q])), h1 * gelu_tanh(bfhi(gw[q]))); }
            bf16_t* yp = ycat + (size_t)s * D_ + 1024 + c0 + j0;
            *(u32x4*)yp = (u32x4){ow[0], ow[1], ow[2], ow[3]}; *(u32x4*)(yp + 8) = (u32x4){ow[4], ow[5], ow[6], ow[7]};
        }
        __syncthreads();
    }
}
__device__ __forceinline__ void ln1_phase(const float* buf, bf16_t* h1b, unsigned* xqs, float* sx, const float* gam, const float* bet, int G, int b) {
    const int lane = threadIdx.x & 63, wid = threadIdx.x >> 6;
    const int gw = b * NWAVES + wid, NGW = G * NWAVES;
    for (int row = gw; row < S_; row += NGW) {
        const float* rp = buf + (size_t)row * D_;
        f32x4 v[8]; float sum = 0.f;
#pragma unroll
        for (int j = 0; j < 8; ++j) { v[j] = *(const f32x4*)(rp + 256 * j + 4 * lane); sum += (v[j].x + v[j].y) + (v[j].z + v[j].w); }
        const float mean = wave_sum(sum) * (1.0f / D_); float sq = 0.f;
#pragma unroll
        for (int j = 0; j < 8; ++j) { v[j] = v[j] - mean; sq += (v[j].x * v[j].x + v[j].y * v[j].y) + (v[j].z * v[j].z + v[j].w * v[j].w); }
        const float rstd = 1.0f / sqrtf(wave_sum(sq) * (1.0f / D_) + LN_EPS);
        float amax = 0.f;
#pragma unroll
        for (int j = 0; j < 8; ++j) {
            const f32x4 gg = *(const f32x4*)(gam + 256 * j + 4 * lane), bb = *(const f32x4*)(bet + 256 * j + 4 * lane);
            v[j] = v[j] * rstd * gg + bb;
            *(u32x2*)(h1b + (size_t)row * D_ + 256 * j + 4 * lane) = (u32x2){pk2(v[j].x, v[j].y), pk2(v[j].z, v[j].w)};
            amax = fmaxf(amax, fmaxf(fmaxf(fabsf(v[j].x), fabsf(v[j].y)), fmaxf(fabsf(v[j].z), fabsf(v[j].w))));
        }
        amax = wave_max(amax);
        const float inv = amax > 0.f ? 127.0f / amax : 0.f;
        if (lane == 0) sx[row] = amax * (1.0f / 127.0f);
#pragma unroll
        for (int j = 0; j < 8; ++j) {
            const int a = (int)rintf(v[j].x * inv), bq = (int)rintf(v[j].y * inv), c = (int)rintf(v[j].z * inv), d = (int)rintf(v[j].w * inv);
            xqs[((size_t)j * S_ + row) * 64 + lane] = (unsigned)(a & 255) | ((unsigned)(bq & 255) << 8) | ((unsigned)(c & 255) << 16) | ((unsigned)(d & 255) << 24);
        }
    }
}
__device__ __forceinline__ unsigned mono(float f) { const unsigned u = __float_as_uint(f); return (u & 0x80000000u) ? ~u : (u ^ 0x80000000u); }
__device__ __forceinline__ float unmono(unsigned u) { return __uint_as_float((u & 0x80000000u) ? (u ^ 0x80000000u) : ~u); }
__device__ __forceinline__ unsigned umax_(unsigned a, unsigned b) { return a > b ? a : b; }
__device__ __forceinline__ constexpr int cand_i(int c) { return c < 16 ? 0 : c < 24 ? 1 : c < 29 ? 2 : c < 33 ? 3 : c < 36 ? 4 : c < 38 ? 5 : c < 40 ? 6 : c < 42 ? 7 : c - 34; }
__device__ __forceinline__ constexpr int cand_j(int c) { return c < 16 ? c : c < 24 ? c - 16 : c < 29 ? c - 24 : c < 33 ? c - 29 : c < 36 ? c - 33 : c < 38 ? c - 36 : c < 40 ? c - 38 : c < 42 ? c - 40 : 0; }

__device__ __forceinline__ void topk_phase(LAS unsigned char* lds, const bf16_t* qp, const bf16_t* keys, int* sel_e, float* sel_g, int G, int b) {
    const int tid = threadIdx.x, lane = tid & 63, wid = tid >> 6, fr = lane & 15, fq = lane >> 4;
    LAS unsigned* wl = (LAS unsigned*)(lds + wid * 4096 + fr * 256);
    for (int unit = b; unit < (S_ / 128) * 8; unit += G) {
        const int tt = unit >> 3, h = unit & 7;
        const int tok = tt * 128 + wid * 16 + fr;
        for (int p = 0; p < 2; ++p) {
            f32x4 acc[8];
#pragma unroll
            for (int mt = 0; mt < 8; ++mt) acc[mt] = (f32x4){0.f, 0.f, 0.f, 0.f};
            bf16x8 bq[4];
#pragma unroll
            for (int ks = 0; ks < 4; ++ks) bq[ks] = *(const bf16x8*)(qp + (size_t)tok * D_ + h * 256 + p * 128 + ks * 32 + fq * 8);
            const bf16_t* kb = keys + (size_t)(h * 2 + p) * 16384;
#pragma unroll
            for (int mt = 0; mt < 8; ++mt)
#pragma unroll
                for (int ks = 0; ks < 4; ++ks) { const bf16x8 a = *(const bf16x8*)(kb + (mt * 16 + fr) * 128 + ks * 32 + fq * 8); acc[mt] = mfma16(a, bq[ks], acc[mt]); }
            unsigned pk[32];
#pragma unroll
            for (int mt = 0; mt < 8; ++mt)
#pragma unroll
                for (int r = 0; r < 4; ++r) pk[mt * 4 + r] = (mono(acc[mt][r]) & ~127u) | (unsigned)(127 - (mt * 16 + fq * 4 + r));
            unsigned prev = 0xFFFFFFFFu;
#pragma unroll 1
            for (int i = 0; i < 16; ++i) {
                unsigned mx = 0u;
#pragma unroll
                for (int j = 0; j < 32; ++j) { const unsigned x = pk[j] < prev ? pk[j] : 0u; mx = umax_(mx, x); }
                mx = umax_(mx, (unsigned)__shfl_xor((int)mx, 16)); mx = umax_(mx, (unsigned)__shfl_xor((int)mx, 32));
                if (fq == 0) wl[p * 16 + i] = mx;
                prev = mx;
            }
        }
        __syncthreads();
        float v1[16], v2[16];
#pragma unroll
        for (int i = 0; i < 16; ++i) { v1[i] = unmono(wl[i] & ~127u); v2[i] = unmono(wl[16 + i] & ~127u); }
        unsigned ck[13];
#pragma unroll
        for (int sidx = 0; sidx < 13; ++sidx) {
            unsigned keyk[4];
#pragma unroll
            for (int k = 0; k < 4; ++k) {
                const int c = 4 * sidx + k;
                if (c < 50) { const int ci = cand_i(c), cj = cand_j(c); keyk[k] = (mono(v1[ci] + v2[cj]) & ~255u) | (unsigned)(255 - (ci * 16 + cj)); }
                else keyk[k] = 0u;
            }
            ck[sidx] = fq == 0 ? keyk[0] : fq == 1 ? keyk[1] : fq == 2 ? keyk[2] : keyk[3];
        }
        {
            unsigned prev = 0xFFFFFFFFu;
#pragma unroll 1
            for (int k = 0; k < 16; ++k) {
                unsigned mx = 0u;
#pragma unroll
                for (int sidx = 0; sidx < 13; ++sidx) { const unsigned x = ck[sidx] < prev ? ck[sidx] : 0u; mx = umax_(mx, x); }
                mx = umax_(mx, (unsigned)__shfl_xor((int)mx, 16)); mx = umax_(mx, (unsigned)__shfl_xor((int)mx, 32));
                if (fq == 0) wl[32 + k] = mx;
                prev = mx;
            }
        }
        __syncthreads();
        {
            const float vmax = unmono(wl[32] & ~255u);
            float esum = 0.f;
#pragma unroll
            for (int k = 0; k < 16; ++k) esum += __expf(unmono(wl[32 + k] & ~255u) - vmax);
            const float einv = 1.0f / esum;
#pragma unroll
            for (int kk = 0; kk < 4; ++kk) {
                const int k = fq * 4 + kk;
                const unsigned W = wl[32 + k];
                const unsigned id = 255u - (W & 255u);
                const unsigned e1 = 127u - (wl[id >> 4] & 127u), e2 = 127u - (wl[16 + (id & 15u)] & 127u);
                const size_t o = ((size_t)tok * 8 + h) * 16 + k;
                sel_e[o] = (int)(e1 * 128u + e2); sel_g[o] = __expf(unmono(W & ~255u) - vmax) * einv;
            }
        }
        __syncthreads();
    }
}
__device__ __forceinline__ int row16_sum_i(int v) {
    v += __builtin_amdgcn_update_dpp(0, v, 0xB1, 0xF, 0xF, true);
    v += __builtin_amdgcn_update_dpp(0, v, 0x4E, 0xF, 0xF, true);
    v += __builtin_amdgcn_update_dpp(0, v, 0x141, 0xF, 0xF, true);
    v += __builtin_amdgcn_update_dpp(0, v, 0x140, 0xF, 0xF, true);
    return v;
}
__device__ __forceinline__ int dot16_i8(const u32x4 a, const u32x4 x) {
    int d = __builtin_amdgcn_sdot4((int)a.x, (int)x.x, 0, false); d = __builtin_amdgcn_sdot4((int)a.y, (int)x.y, d, false);
    d = __builtin_amdgcn_sdot4((int)a.z, (int)x.z, d, false); return __builtin_amdgcn_sdot4((int)a.w, (int)x.w, d, false);
}
__device__ __forceinline__ void peer_u_phase(LAS unsigned char* lds, const unsigned char* UQs, const unsigned char* XQs, const int* sel_e, int* pd, int xi, int nx, int rank, int nloc) {
    const int lane = threadIdx.x & 63, wid = threadIdx.x >> 6, r = lane >> 4, i = lane & 15;
    LAS int* es = (LAS int*)(lds + wid * 1024);
    const int wx = rank * NWAVES + wid, nwx = nloc * NWAVES;
    for (int j = xi; j < 8; j += nx) {
        const unsigned char* Uj = UQs + (size_t)j * 16384 * 256 + 16 * i;
        for (int t = wx; t < S_; t += nwx) {
            const int ea = sel_e[(size_t)t * 128 + lane], eb = sel_e[(size_t)t * 128 + 64 + lane];
            const u32x4 xv = *(const u32x4*)(XQs + ((size_t)j * S_ + t) * 256 + 16 * i);
            es[lane] = ea; es[64 + lane] = eb;
            asm volatile("" ::: "memory");
            u32x4 A[16], B[16];
#pragma unroll
            for (int it = 0; it < 16; ++it) A[it] = *(const u32x4*)(Uj + (size_t)es[4 * it + r] * 256);
#pragma unroll
            for (int it = 0; it < 16; ++it) B[it] = *(const u32x4*)(Uj + (size_t)es[64 + 4 * it + r] * 256);
            int keepA = 0, keepB = 0;
#pragma unroll
            for (int it = 0; it < 16; ++it) { const int d = row16_sum_i(dot16_i8(A[it], xv)); keepA = (i == it) ? d : keepA; }
#pragma unroll
            for (int it = 0; it < 16; ++it) { const int d = row16_sum_i(dot16_i8(B[it], xv)); keepB = (i == it) ? d : keepB; }
            int* pp = pd + ((size_t)j * S_ + t) * 128 + 4 * i + r;
            pp[0] = keepA; pp[64] = keepB;
            asm volatile("" ::: "memory");
        }
    }
}
__device__ __forceinline__ void acc16_u8(float (&acc)[16], const u32x4 v, float c) {
    const unsigned w[4] = {v.x, v.y, v.z, v.w};
#pragma unroll
    for (int q = 0; q < 4; ++q) {
        acc[4 * q + 0] += c * (float)(w[q] & 255u); acc[4 * q + 1] += c * (float)((w[q] >> 8) & 255u);
        acc[4 * q + 2] += c * (float)((w[q] >> 16) & 255u); acc[4 * q + 3] += c * (float)(w[q] >> 24);
    }
}
__device__ __forceinline__ void peer_v_phase(LAS unsigned char* lds, const unsigned char* VQs, const int* sel_e, const float* sel_g, const int* pd, const float* SU, const float* SV, const float* SX,
                                             bf16_t* zs, int xi, int nx, int rank, int nloc) {
    const int lane = threadIdx.x & 63, wid = threadIdx.x >> 6, r = lane >> 4, i = lane & 15;
    LAS int* es = (LAS int*)(lds + wid * 1024); LAS float* cs = (LAS float*)(lds + wid * 1024 + 512);
    const int wx = rank * NWAVES + wid, nwx = nloc * NWAVES;
    for (int j = xi; j < 8; j += nx) {
        const unsigned char* Vj = VQs + (size_t)j * 16384 * 256 + 16 * i;
        for (int t = wx; t < S_; t += nwx) {
            const float sxt = SX[t];
#pragma unroll
            for (int hh = 0; hh < 2; ++hh) {
                const int k = 64 * hh + lane;
                const int e = sel_e[(size_t)t * 128 + k]; const float g = sel_g[(size_t)t * 128 + k];
                int ds = 0;
#pragma unroll
                for (int jj = 0; jj < 8; ++jj) ds += pd[((size_t)jj * S_ + t) * 128 + k];
                const float d = (float)ds * (SU[e] * sxt);
                es[k] = e; cs[k] = g * SV[e] * gelu_tanh(d);
            }
            asm volatile("" ::: "memory");
            u32x4 A[16], B[16];
#pragma unroll
            for (int it = 0; it < 16; ++it) A[it] = *(const u32x4*)(Vj + (size_t)es[4 * it + r] * 256);
#pragma unroll
            for (int it = 0; it < 16; ++it) B[it] = *(const u32x4*)(Vj + (size_t)es[64 + 4 * it + r] * 256);
            float acc[16]; float csum = 0.f;
#pragma unroll
            for (int q = 0; q < 16; ++q) acc[q] = 0.f;
#pragma unroll
            for (int it = 0; it < 16; ++it) { const float c = cs[4 * it + r]; csum += c; acc16_u8(acc, A[it], c); }
#pragma unroll
            for (int it = 0; it < 16; ++it) { const float c = cs[64 + 4 * it + r]; csum += c; acc16_u8(acc, B[it], c); }
#pragma unroll
            for (int q = 0; q < 16; ++q) { float a = acc[q] - 128.0f * csum; a += __shfl_xor(a, 16); a += __shfl_xor(a, 32); acc[q] = a; }
            if (r == 0) {
                bf16_t* zp = zs + (size_t)t * D_ + 256 * j + 16 * i;
                *(u32x4*)zp = (u32x4){pk2(acc[0], acc[1]), pk2(acc[2], acc[3]), pk2(acc[4], acc[5]), pk2(acc[6], acc[7])};
                *(u32x4*)(zp + 8) = (u32x4){pk2(acc[8], acc[9]), pk2(acc[10], acc[11]), pk2(acc[12], acc[13]), pk2(acc[14], acc[15])};
            }
            asm volatile("" ::: "memory");
        }
    }
}
__device__ __forceinline__ void ln2_phase(const bf16_t* h1b, const bf16_t* zs, float* out, const float* gam, const float* bet, int G, int b) {
    const int lane = threadIdx.x & 63, wid = threadIdx.x >> 6;
    const int gw = b * NWAVES + wid, NGW = G * NWAVES;
    for (int row = gw; row < S_; row += NGW) {
        f32x4 v[8]; float sum = 0.f;
#pragma unroll
        for (int j = 0; j < 8; ++j) {
            const u32x2 hw = *(const u32x2*)(h1b + (size_t)row * D_ + 256 * j + 4 * lane), zw = *(const u32x2*)(zs + (size_t)row * D_ + 256 * j + 4 * lane);
            v[j] = (f32x4){DN_ALPHA * bflo(hw.x) + bflo(zw.x), DN_ALPHA * bfhi(hw.x) + bfhi(zw.x), DN_ALPHA * bflo(hw.y) + bflo(zw.y), DN_ALPHA * bfhi(hw.y) + bfhi(zw.y)};
            sum += (v[j].x + v[j].y) + (v[j].z + v[j].w);
        }
        const float mean = wave_sum(sum) * (1.0f / D_); float sq = 0.f;
#pragma unroll
        for (int j = 0; j < 8; ++j) { v[j] = v[j] - mean; sq += (v[j].x * v[j].x + v[j].y * v[j].y) + (v[j].z * v[j].z + v[j].w * v[j].w); }
        const float rstd = 1.0f / sqrtf(wave_sum(sq) * (1.0f / D_) + LN_EPS);
#pragma unroll
        for (int j = 0; j < 8; ++j) {
            const f32x4 gg = *(const f32x4*)(gam + 256 * j + 4 * lane), bb = *(const f32x4*)(bet + 256 * j + 4 * lane);
            *(f32x4*)(out + (size_t)row * D_ + 256 * j + 4 * lane) = v[j] * rstd * gg + bb;
        }
    }
}
#ifndef PROBE_PHASE
#define PROBE_PHASE -1
#endif
constexpr int LDSCTL_OFF = 131072, MISC_OFF = LDSCTL_OFF + 320;
constexpr int CW_BAR = 1024;
constexpr size_t CTL_ZERO_BYTES = 64 * 1024;
static_assert((CW_BAR + XCD_BAR_WORDS) * 4 <= (int)CTL_ZERO_BYTES && MISC_OFF + 128 <= LDS_BYTES, "control words");

__global__ void __launch_bounds__(NTHREADS, 2) mega_fwd(Ptrs P) {
    extern __shared__ __attribute__((aligned(16))) unsigned char lds_raw[];
    LAS unsigned char* lds = (LAS unsigned char*)lds_raw;
    unsigned char* ws = P.ws;
    const int G = gridDim.x, b = blockIdx.x;
    for (int u = threadIdx.x; u < (LDS_BYTES - LDSCTL_OFF) / 4; u += NTHREADS) ((LAS unsigned*)(lds + LDSCTL_OFF))[u] = 0u;
    __syncthreads();
    volatile LAS unsigned* MISC = (volatile LAS unsigned*)(lds + MISC_OFF);
    XcdBarrier bar; bar.bar = (unsigned*)(ws + WS_CTL) + CW_BAR; bar.x = xb_xcc_id(); bar.st = MISC + 8;
    if (threadIdx.x == 0) MISC[10] = xb_add(&bar.bar[XB_XCNT(bar.x)], 1u);

    bf16_t* const proj = (bf16_t*)(ws + WS_PROJ); bf16_t* const kvs = (bf16_t*)(ws + WS_KVS); bf16_t* const ycat = (bf16_t*)(ws + WS_YCAT);
    const float* const cosT = (const float*)(ws + WS_COS); const float* const sinT = (const float*)(ws + WS_SIN);
    float* const sumA = (float*)(ws + WS_SUMA); float* const sumH = (float*)(ws + WS_SUMH); float* const Hin = (float*)(ws + WS_HIN);
    const bf16_t* const wraT = (const bf16_t*)(ws + WS_WRA_T); const bf16_t* const wriT = (const bf16_t*)(ws + WS_WRI_T);

#define NREP(k) ((PROBE_PHASE == (k)) ? 2 : 1)
    for (int r_ = 0; r_ < NREP(0); ++r_) { prologue_phase(lds, P, G, b); xcd_barrier(bar); }
    if (threadIdx.x == 0) { unsigned xi_ = 0; for (unsigned jx = 0; jx < bar.x; ++jx) xi_ += xb_ld(&bar.bar[XB_XCNT(jx)]) > 0u ? 1u : 0u; MISC[11] = xi_; }
    __syncthreads();
    const int x_nloc = __builtin_amdgcn_readfirstlane((int)MISC[8]), x_nx = __builtin_amdgcn_readfirstlane((int)MISC[9]), x_rank = __builtin_amdgcn_readfirstlane((int)MISC[10]), x_xi = __builtin_amdgcn_readfirstlane((int)MISC[11]);
#define RUN_P1 { pg8::Gemm g{(const pg8::bf16_t*)(ws + WS_XB), (const pg8::bf16_t*)(ws + WS_WIN_T), S_, INC, D_}; \
        pg8::StaticOrder S; S.init(S_, INC, G, b); \
        pg8::EpiBf16<0> E{(pg8::bf16_t*)proj, INC, nullptr, 0, 0, 1.f}; \
        pg8::gemm_phase<pg8::EpiBf16<0>, pg8::StaticOrder, true, true>(lds, g, S, E); \
        xcd_barrier(bar); }
    RUN_P1
#if PROBE_PHASE == 1
    RUN_P1
#endif
    for (int r2_ = 0; r2_ < NREP(22); ++r2_) {
    for (int r_ = 0; r_ < NREP(2); ++r_) { ret_kv_phase(lds, proj, cosT, sinT, kvs, G, b); xcd_barrier(bar); }
    for (int r_ = 0; r_ < NREP(3); ++r_) { lru_phase<0>(lds, proj, P, wraT, wriT, sumA, sumH, Hin, ycat, G, b); xcd_barrier(bar); }
    scan_phase(kvs, sumA, sumH, Hin, G, b);
    xcd_barrier(bar);
    }
    for (int r_ = 0; r_ < NREP(4); ++r_) { ret_out_phase(lds, proj, cosT, sinT, kvs, ycat, G, b); xcd_barrier(bar); }
    for (int r_ = 0; r_ < NREP(5); ++r_) { lru_phase<1>(lds, proj, P, wraT, wriT, sumA, sumH, Hin, ycat, G, b); xcd_barrier(bar); }
#define RUN_P3 { pg8::Gemm g{(const pg8::bf16_t*)ycat, (const pg8::bf16_t*)(ws + WS_WOUT_T), S_, D_, D_}; \
        pg8::StaticOrder S; S.init(S_, D_, G, b); \
        pg8::EpiResF32 E{P.x, P.out, D_, DN_ALPHA}; \
        pg8::gemm_phase<pg8::EpiResF32, pg8::StaticOrder, true, true>(lds, g, S, E); \
        xcd_barrier(bar); }
    RUN_P3
#if PROBE_PHASE == 6
    RUN_P3
#endif
    ln1_phase(P.out, (bf16_t*)(ws + WS_H1B), (unsigned*)(ws + WS_XQ), (float*)(ws + WS_SX), P.ln1_g, P.ln1_b, G, b);
    xcd_barrier(bar);
#if PROBE_PHASE == 66
    RUN_P3
    ln1_phase(P.out, (bf16_t*)(ws + WS_H1B), (unsigned*)(ws + WS_XQ), (float*)(ws + WS_SX), P.ln1_g, P.ln1_b, G, b);
    xcd_barrier(bar);
#endif
#define RUN_P5 { pg8::Gemm g{(const pg8::bf16_t*)(ws + WS_H1B), (const pg8::bf16_t*)(ws + WS_WPQ_T), S_, D_, D_}; \
        pg8::StaticOrder S; S.init(S_, D_, G, b); \
        pg8::EpiBf16<0> E{(pg8::bf16_t*)(ws + WS_QP), D_, nullptr, 0, 0, 1.f}; \
        pg8::gemm_phase<pg8::EpiBf16<0>, pg8::StaticOrder, true, true>(lds, g, S, E); \
        xcd_barrier(bar); }
    RUN_P5
#if PROBE_PHASE == 7
    RUN_P5
#endif
    for (int r_ = 0; r_ < NREP(8); ++r_) { topk_phase(lds, (const bf16_t*)(ws + WS_QP), (const bf16_t*)(ws + WS_KEYS), (int*)(ws + WS_SELE), (float*)(ws + WS_SELG), G, b); xcd_barrier(bar); }
    for (int r_ = 0; r_ < NREP(9); ++r_) { peer_u_phase(lds, (const unsigned char*)(ws + WS_UQ), (const unsigned char*)(ws + WS_XQ), (const int*)(ws + WS_SELE), (int*)(ws + WS_PD), x_xi, x_nx, x_rank, x_nloc); xcd_barrier(bar); }
    for (int r_ = 0; r_ < NREP(10); ++r_) { peer_v_phase(lds, (const unsigned char*)(ws + WS_VQ), (const int*)(ws + WS_SELE), (const float*)(ws + WS_SELG), (const int*)(ws + WS_PD), (const float*)(ws + WS_SU), (const float*)(ws + WS_SV), (const float*)(ws + WS_SX),
                     (bf16_t*)(ws + WS_ZS), x_xi, x_nx, x_rank, x_nloc); xcd_barrier(bar); }
    for (int r_ = 0; r_ < NREP(11); ++r_) ln2_phase((const bf16_t*)(ws + WS_H1B), (const bf16_t*)(ws + WS_ZS), P.out, P.ln2_g, P.ln2_b, G, b);
}

extern "C" void kernel_launch(void* const* d_in, const int* in_sizes, int n_in, void* d_out, int out_size, void* d_ws, size_t ws_size, hipStream_t stream) {
    static int grid = 0;
    if (grid == 0) {
        if (n_in != 19 || in_sizes[0] != S_ * D_ || out_size != S_ * D_ || ws_size < WS_END) {
            fprintf(stderr, "kernel_launch: unexpected shapes: n_in %d in0 %d out %d ws %zu (need >= %zu)\n", n_in, n_in > 0 ? in_sizes[0] : -1, out_size, ws_size, (size_t)WS_END); grid = -1; return; }
        int dev = 0, cus = 0, per_cu = 0;
        if (hipGetDevice(&dev) != hipSuccess || hipDeviceGetAttribute(&cus, hipDeviceAttributeMultiprocessorCount, dev) != hipSuccess) { grid = -1; return; }
        if (hipFuncSetAttribute((const void*)mega_fwd, hipFuncAttributeMaxDynamicSharedMemorySize, LDS_BYTES) != hipSuccess) { fprintf(stderr, "kernel_launch: hipFuncSetAttribute failed\n"); grid = -1; return; }
        if (hipOccupancyMaxActiveBlocksPerMultiprocessor(&per_cu, (const void*)mega_fwd, NTHREADS, LDS_BYTES) != hipSuccess || per_cu < 1) {
            fprintf(stderr, "kernel_launch: occupancy query reports %d workgroups per CU; nothing launched\n", per_cu); (void)hipGetLastError(); grid = -1; return; }
        grid = cus;
    }
    if (grid < 0) return;
    Ptrs P{};
    P.x = (const float*)d_in[0]; P.pos = (const int*)d_in[1]; P.w_in = (const float*)d_in[2]; P.w_out = (const float*)d_in[3]; P.conv_w = (const float*)d_in[4]; P.conv_b = (const float*)d_in[5];
    P.w_ra = (const float*)d_in[6]; P.b_ra = (const float*)d_in[7]; P.w_ri = (const float*)d_in[8]; P.b_ri = (const float*)d_in[9]; P.lam = (const float*)d_in[10];
    P.ln1_g = (const float*)d_in[11]; P.ln1_b = (const float*)d_in[12]; P.w_pq = (const float*)d_in[13]; P.sub_keys = (const float*)d_in[14]; P.peer_u = (const float*)d_in[15]; P.peer_v = (const float*)d_in[16];
    P.ln2_g = (const float*)d_in[17]; P.ln2_b = (const float*)d_in[18]; P.out = (float*)d_out; P.ws = (unsigned char*)d_ws;
    if (hipMemsetAsync((char*)d_ws + WS_CTL, 0, CTL_ZERO_BYTES, stream) != hipSuccess) { fprintf(stderr, "kernel_launch: hipMemsetAsync failed\n"); return; }
    void* args[] = {&P};
    const hipError_t e = hipLaunchCooperativeKernel((const void*)mega_fwd, dim3(grid), dim3(NTHREADS), args, LDS_BYTES, stream);
    if (e != hipSuccess) fprintf(stderr, "kernel_launch: cooperative launch failed: %s (grid %d)\n", hipGetErrorString(e), grid);
}
```

```cpp
#include <hip/hip_runtime.h>
#include <cstdio>
#include <cstdint>
#include <cmath>

namespace pg8 {
#define PG8_LAS __attribute__((address_space(3)))
typedef unsigned short bf16_t;
typedef short bf16x8 __attribute__((ext_vector_type(8)));
typedef float f32x4 __attribute__((ext_vector_type(4)));
typedef unsigned u32x4 __attribute__((ext_vector_type(4)));
constexpr int BM = 256, BK = 64, HALF = 128, HTB = HALF * BK * 2  , STAGE_BYTES = 8 * HTB, NXCD = 8, WGM = 8;

__host__ __device__ __forceinline__ int lds_byte(int r, int c) { const int st = (r >> 4) * 2 + (c >> 5), rr = r & 15, cc = c & 31, ob = rr * 64 + cc * 2; return st * 1024 + (ob ^ (((ob >> 9) & 1) << 5)); }
__host__ __device__ __forceinline__ void stage_rc(int b, int& R, int& C) { const int st = b / 1024, sb = b % 1024, swz = sb ^ (((sb >> 9) & 1) << 5); R = (st >> 1) * 16 + swz / 64; C = (st & 1) * 32 + (swz % 64) / 2; }
__host__ __device__ __forceinline__ int perm32(int rho) { const int n = rho >> 4, i = rho & 15; return 8 * (i >> 2) + 4 * n + (i & 3); }

struct Unit { int pm, pn; };
struct Gemm { const bf16_t* A; const bf16_t* Bt; int M, N, K; };

struct StaticOrder {
    int nM, nN, nwg, G, c;
    __host__ __device__ void init(int M, int N, int G_, int c_) { nM = M / BM; nN = N / BM; nwg = nM * nN; G = G_; c = c_; }
    __host__ __device__ bool next(int i, Unit& u) const {
        const long L = (long)i * G + c; if (L >= nwg) return false;
        int wgid = (int)L; { const int q = nwg / NXCD, r = nwg % NXCD, xcd = wgid % NXCD, off = wgid / NXCD; wgid = (xcd < r ? xcd * (q + 1) : r * (q + 1) + (xcd - r) * q) + off; }
        const int nig = WGM * nN, gid = wgid / nig, fm = gid * WGM, gsz = (nM - fm) < WGM ? (nM - fm) : WGM;
        u.pm = fm + ((wgid % nig) % gsz); u.pn = (wgid % nig) / gsz; return true;
    }
    __device__ __forceinline__ void a_ready(const Unit&) const {}
    __device__ __forceinline__ void done(const Unit&) const {}
};

__device__ __forceinline__ unsigned cvt_pk_bf16(float lo, float hi) { unsigned r; asm volatile("v_cvt_pk_bf16_f32 %0, %1, %2" : "=v"(r) : "v"(lo), "v"(hi)); return r; }
typedef float f32x2 __attribute__((ext_vector_type(2)));
__device__ __forceinline__ f32x2 gelu_pk(f32x2 v) {
    const f32x2 av = __builtin_elementwise_abs(v), d = av * 0.2316418882f + 1.0f;
    f32x2 t; t.x = __builtin_amdgcn_rcpf(d.x); t.y = __builtin_amdgcn_rcpf(d.y);
    f32x2 q = t * 0.5307027145f + (-0.7265760135f); q = q * t + 0.7107068705f; q = q * t + (-0.142248368f); q = q * t + 0.127414796f; q = q * t;
    const f32x2 s = (v * v) * (-0.72134752044f);
    f32x2 e; e.x = __builtin_amdgcn_exp2f(s.x); e.y = __builtin_amdgcn_exp2f(s.y);
    const f32x2 m = v * (q * e), r = v - m;
    f32x2 o; o.x = v.x < 0.f ? m.x : r.x; o.y = v.y < 0.f ? m.y : r.y; return o;
}

template <int ACT  > struct EpiBf16 {
    static constexpr bool PERM = true, AFTER_DRAIN = false; static_assert(ACT == 0 || ACT == 1, "EpiBf16: ACT is 0 (none) or 1 (gelu_pk)");
    bf16_t* O; int ldc; const float* bias; int split_cols; size_t split_stride; float scale0;
    __device__ __forceinline__ void operator()(const f32x4 (&acc)[2][2][4][2], const Unit& u, int wr, int wc, int fr, int fq) const {
        const int row0 = u.pm * BM + wr * 64 + fr; int colt = u.pn * BM; bf16_t* base = O;
        float sc = 1.f; if (split_cols) { const int t = colt / split_cols; base += (size_t)t * split_stride; colt -= t * split_cols; if (t == 0) sc = scale0; }
        const int col0 = colt + wc * 32 + 8 * fq, bcol0 = u.pn * BM + wc * 32 + 8 * fq;
        f32x4 bv[2][2];
#pragma unroll
        for (int bj = 0; bj < 2; ++bj)
#pragma unroll
            for (int n = 0; n < 2; ++n) bv[bj][n] = bias ? *(const f32x4*)(bias + bcol0 + bj * HALF + 4 * n) : (f32x4){0.f, 0.f, 0.f, 0.f};
#pragma unroll
        for (int ai = 0; ai < 2; ++ai)
#pragma unroll
            for (int m = 0; m < 4; ++m) { bf16_t* rowp = base + (size_t)(row0 + ai * HALF + m * 16) * ldc + col0;
#pragma unroll
                for (int bj = 0; bj < 2; ++bj) { f32x4 v0 = acc[ai][bj][m][0] + bv[bj][0], v1 = acc[ai][bj][m][1] + bv[bj][1];
                    if (ACT == 1) { f32x2 a = gelu_pk((f32x2){v0[0], v0[1]}), b = gelu_pk((f32x2){v0[2], v0[3]}), c = gelu_pk((f32x2){v1[0], v1[1]}), d = gelu_pk((f32x2){v1[2], v1[3]});
                        v0 = (f32x4){a.x, a.y, b.x, b.y}; v1 = (f32x4){c.x, c.y, d.x, d.y}; }
                    v0 = v0 * sc; v1 = v1 * sc; u32x4 w; w.x = cvt_pk_bf16(v0[0], v0[1]); w.y = cvt_pk_bf16(v0[2], v0[3]); w.z = cvt_pk_bf16(v1[0], v1[1]); w.w = cvt_pk_bf16(v1[2], v1[3]);
                    *(u32x4*)(rowp + bj * HALF) = w; } }
    }
};
struct EpiResF32 {
    static constexpr bool PERM = false, AFTER_DRAIN = false;
    const float* base; float* out; int ldc; float alpha;
    __device__ __forceinline__ void operator()(const f32x4 (&acc)[2][2][4][2], const Unit& u, int wr, int wc, int fr, int fq) const {
        const int row0 = u.pm * BM + wr * 64 + fr, col0 = u.pn * BM + wc * 32 + 4 * fq;
#pragma unroll
        for (int ai = 0; ai < 2; ++ai)
#pragma unroll
            for (int m = 0; m < 4; ++m) { const size_t off = (size_t)(row0 + ai * HALF + m * 16) * ldc + col0;
#pragma unroll
                for (int bj = 0; bj < 2; ++bj)
#pragma unroll
                    for (int n = 0; n < 2; ++n) { const f32x4 bs = *(const f32x4*)(base + off + bj * HALF + n * 16); *(f32x4*)(out + off + bj * HALF + n * 16) = bs * alpha + acc[ai][bj][m][n]; }
                asm volatile("" ::: "memory"); }
    }
};
template <class Epi, class Sched, bool ALIGN_EPI = false, bool SP2 = false>
__device__ __forceinline__ void gemm_phase(PG8_LAS unsigned char* lds, const Gemm g, const Sched& S, const Epi& E) {
    const int tid = threadIdx.x, wid = __builtin_amdgcn_readfirstlane(tid >> 6), lane = tid & 63, wr = wid >> 2, wc = wid & 3, fr = lane & 15, fq = lane >> 4;
    const int K = g.K, nt = K / BK;
    unsigned voffA[2], voffB[2];
#pragma unroll
    for (int i = 0; i < 2; ++i) { int R, C; stage_rc(tid * 16 + i * 8192, R, C); const int Rb = Epi::PERM ? ((R & ~31) + perm32(R & 31)) : R;
        voffA[i] = (unsigned)(R * K + C) * 2u; voffB[i] = (unsigned)(Rb * K + C) * 2u; }
    const size_t kstep = (size_t)(BK * 2);
    const size_t hstep = (size_t)HALF * K * 2;
    const size_t tstep = 2 * hstep;
    const unsigned ldsw = (unsigned)wid * 1024u;
    const int aoff = lds_byte(wr * 64 + fr, fq * 8), boff = lds_byte(wc * 32 + fr, fq * 8);
#define PG8_SA(b, h) (((b) * 2 + (h)) * HTB)
#define PG8_SB(b, h) ((4 + (b) * 2 + (h)) * HTB)
#define PG8_STAGE(bufoff, gbase, voff) do { _Pragma("unroll") for (int _i = 0; _i < 2; ++_i) \
        __builtin_amdgcn_global_load_lds((const unsigned*)((const char*)(gbase) + (voff)[_i]), (PG8_LAS unsigned*)(lds + (bufoff) + ldsw + _i * 8192), 16, 0, 0); } while (0)
#define PG8_LDA(dst, b, h) do { _Pragma("unroll") for (int m = 0; m < 4; ++m) _Pragma("unroll") for (int k = 0; k < 2; ++k) dst[m][k] = *(const PG8_LAS bf16x8*)(lds + PG8_SA(b, h) + aoff + m * 2048 + k * 1024); } while (0)
#define PG8_LDB(dst, b, h) do { _Pragma("unroll") for (int n = 0; n < 2; ++n) _Pragma("unroll") for (int k = 0; k < 2; ++k) dst[n][k] = *(const PG8_LAS bf16x8*)(lds + PG8_SB(b, h) + boff + n * 2048 + k * 1024); } while (0)
#define PG8_MMA(ai, bj, At, Bt) do { __builtin_amdgcn_s_setprio(1); _Pragma("unroll") for (int m = 0; m < 4; ++m) _Pragma("unroll") for (int n = 0; n < 2; ++n) _Pragma("unroll") for (int k = 0; k < 2; ++k) \
        acc[ai][bj][m][n] = __builtin_amdgcn_mfma_f32_16x16x32_bf16(Bt[n][k], At[m][k], acc[ai][bj][m][n], 0, 0, 0); __builtin_amdgcn_s_setprio(0); } while (0)
#define PG8_WAIT_V(n) asm volatile("s_waitcnt vmcnt(" #n ")" ::: "memory")
#define PG8_WAIT_L(n) asm volatile("s_waitcnt lgkmcnt(" #n ")" ::: "memory")
#define PG8_BAR __builtin_amdgcn_s_barrier()
#define PG8_SCHED __builtin_amdgcn_sched_barrier(0)
    Unit cur, nxt; int ui = 0;
    if (!S.next(0, cur)) return;
    f32x4 acc[2][2][4][2];
#pragma unroll
    for (int a = 0; a < 2; ++a)
#pragma unroll
        for (int b = 0; b < 2; ++b)
#pragma unroll
            for (int m = 0; m < 4; ++m)
#pragma unroll
                for (int n = 0; n < 2; ++n) acc[a][b][m][n] = (f32x4){0.f, 0.f, 0.f, 0.f};
    bf16x8 At[4][2], B0[2][2], B1[2][2];
    const char* cA = (const char*)g.A + (size_t)cur.pm * tstep; const char* cB = (const char*)g.Bt + (size_t)cur.pn * tstep;
    S.a_ready(cur);
    if constexpr (SP2) {
        PG8_STAGE(PG8_SB(0, 0), cB, voffB); PG8_STAGE(PG8_SB(0, 1), cB + hstep, voffB); PG8_STAGE(PG8_SA(0, 0), cA, voffA); PG8_STAGE(PG8_SA(0, 1), cA + hstep, voffA);
        if (wr == 1) PG8_BAR;
        PG8_WAIT_V(2); PG8_BAR;
        PG8_STAGE(PG8_SB(1, 0), cB + kstep, voffB); PG8_STAGE(PG8_SA(1, 0), cA + kstep, voffA); PG8_STAGE(PG8_SB(1, 1), cB + hstep + kstep, voffB);
        PG8_WAIT_V(6); PG8_BAR;
    } else {
        PG8_STAGE(PG8_SB(0, 0), cB, voffB); PG8_STAGE(PG8_SA(0, 0), cA, voffA); PG8_STAGE(PG8_SB(0, 1), cB + hstep, voffB); PG8_STAGE(PG8_SA(0, 1), cA + hstep, voffA);
        if (wr == 1) PG8_BAR;
        PG8_WAIT_V(4); PG8_BAR;
        PG8_STAGE(PG8_SB(1, 0), cB + kstep, voffB); PG8_STAGE(PG8_SA(1, 0), cA + kstep, voffA); PG8_STAGE(PG8_SB(1, 1), cB + hstep + kstep, voffB);
        PG8_WAIT_V(6); PG8_BAR;
    }
    for (;;) {
        const bool has_next = S.next(ui + 1, nxt);
        const char* nA = has_next ? (const char*)g.A + (size_t)nxt.pm * tstep : cA; const char* nB = has_next ? (const char*)g.Bt + (size_t)nxt.pn * tstep : cB;
        for (int t = 0; t < nt; t += 2) {
            const bool last = (t == nt - 2);
            const char* a1 = cA + (size_t)(t + 1) * kstep;
            const char* a2 = last ? nA : cA + (size_t)(t + 2) * kstep; const char* b2 = last ? nB : cB + (size_t)(t + 2) * kstep;
            const char* a3 = a2 + kstep; const char* b3 = b2 + kstep;
            if (last && has_next) S.a_ready(nxt);
            if constexpr (SP2) {
            PG8_LDB(B0, 0, 0); PG8_LDB(B1, 0, 1); PG8_SCHED; PG8_LDA(At, 0, 0); PG8_STAGE(PG8_SA(1, 1), a1 + hstep, voffA);
            PG8_WAIT_V(8); PG8_WAIT_L(0); PG8_BAR; PG8_MMA(0, 0, At, B0); PG8_MMA(0, 1, At, B1); PG8_BAR; PG8_SCHED;
            PG8_LDA(At, 0, 1); PG8_STAGE(PG8_SB(0, 0), b2, voffB); PG8_STAGE(PG8_SB(0, 1), b2 + hstep, voffB); PG8_STAGE(PG8_SA(0, 0), a2, voffA);
            PG8_WAIT_V(8); PG8_WAIT_L(0); PG8_BAR; PG8_MMA(1, 0, At, B0); PG8_MMA(1, 1, At, B1); PG8_BAR; PG8_SCHED;
            PG8_LDB(B0, 1, 0); PG8_LDB(B1, 1, 1); PG8_SCHED; PG8_LDA(At, 1, 0); PG8_STAGE(PG8_SA(0, 1), a2 + hstep, voffA);
            PG8_WAIT_V(8); PG8_WAIT_L(0); PG8_BAR; PG8_MMA(0, 0, At, B0); PG8_MMA(0, 1, At, B1); PG8_BAR; PG8_SCHED;
            PG8_LDA(At, 1, 1); PG8_STAGE(PG8_SB(1, 0), b3, voffB); PG8_STAGE(PG8_SB(1, 1), b3 + hstep, voffB); PG8_STAGE(PG8_SA(1, 0), a3, voffA);
            PG8_WAIT_V(8); PG8_WAIT_L(0); PG8_BAR; PG8_MMA(1, 0, At, B0); PG8_MMA(1, 1, At, B1); PG8_BAR; PG8_SCHED;
            } else {
            PG8_LDB(B0, 0, 0); PG8_SCHED; PG8_LDA(At, 0, 0); PG8_STAGE(PG8_SA(1, 1), a1 + hstep, voffA);
            PG8_WAIT_L(8); PG8_BAR; PG8_WAIT_L(0); PG8_MMA(0, 0, At, B0); PG8_BAR; PG8_SCHED;
            PG8_LDB(B1, 0, 1); PG8_STAGE(PG8_SB(0, 0), b2, voffB);
            PG8_BAR; PG8_WAIT_L(0); PG8_MMA(0, 1, At, B1); PG8_BAR;
            PG8_LDA(At, 0, 1); PG8_STAGE(PG8_SA(0, 0), a2, voffA);
            PG8_BAR; PG8_WAIT_L(0); PG8_MMA(1, 0, At, B0); PG8_BAR; PG8_SCHED;
            PG8_STAGE(PG8_SB(0, 1), b2 + hstep, voffB);
            PG8_WAIT_V(6); PG8_BAR; PG8_MMA(1, 1, At, B1); PG8_BAR;
            PG8_LDB(B0, 1, 0); PG8_SCHED; PG8_LDA(At, 1, 0); PG8_STAGE(PG8_SA(0, 1), a2 + hstep, voffA);
            PG8_WAIT_L(8); PG8_BAR; PG8_WAIT_L(0); PG8_MMA(0, 0, At, B0); PG8_BAR; PG8_SCHED;
            PG8_LDB(B1, 1, 1); PG8_STAGE(PG8_SB(1, 0), b3, voffB);
            PG8_BAR; PG8_WAIT_L(0); PG8_MMA(0, 1, At, B1); PG8_BAR;
            PG8_LDA(At, 1, 1); PG8_STAGE(PG8_SA(1, 0), a3, voffA);
            PG8_BAR; PG8_WAIT_L(0); PG8_MMA(1, 0, At, B0); PG8_BAR; PG8_SCHED;
            PG8_STAGE(PG8_SB(1, 1), b3 + hstep, voffB);
            PG8_WAIT_V(6); PG8_BAR; PG8_MMA(1, 1, At, B1); PG8_BAR;
            }
        }
        if constexpr (ALIGN_EPI) { if (wr == 0) PG8_BAR; }
        if constexpr (!Epi::AFTER_DRAIN) { E(acc, cur, wr, wc, fr, fq); S.done(cur); }
        if (!has_next) break;
#pragma unroll
        for (int a = 0; a < 2; ++a)
#pragma unroll
            for (int b = 0; b < 2; ++b)
#pragma unroll
                for (int m = 0; m < 4; ++m)
#pragma unroll
                    for (int n = 0; n < 2; ++n) acc[a][b][m][n] = (f32x4){0.f, 0.f, 0.f, 0.f};
        cur = nxt; cA = nA; cB = nB; ++ui;
        if constexpr (ALIGN_EPI) { if (wr == 1) PG8_BAR; }
    }
    PG8_WAIT_V(0);
    if constexpr (!ALIGN_EPI) { if (wr == 0) PG8_BAR; }
    PG8_BAR;
    if constexpr (Epi::AFTER_DRAIN) { E.fused(acc, cur, wr, wc, fr, fq, lds, wid, lane); S.done(cur); }
#undef PG8_SA
#undef PG8_SB
#undef PG8_STAGE
#undef PG8_LDA
#undef PG8_LDB
#undef PG8_MMA
#undef PG8_WAIT_V
#undef PG8_WAIT_L
#undef PG8_BAR
#undef PG8_SCHED
}
}
constexpr int S_ = 16384, D_ = 2048, INC = 6144, NH = 8, DH = 128, CH = 64, NCH = 256;
constexpr float DN_ALPHA = 1.189207115002721f;
constexpr float LN_EPS = 1e-5f, GN_EPS = 1e-6f;
constexpr int NWAVES = 8, NTHREADS = 512;
constexpr int LDS_BYTES = 163840;

constexpr size_t MiB = 1u << 20;
constexpr size_t WS_CTL = 0;
constexpr size_t WS_WOUT_T = 1 * MiB, WS_WPQ_T = 9 * MiB, WS_KEYS = 17 * MiB, WS_WRA_T = 17 * MiB + 512 * 1024, WS_WRI_T = 17 * MiB + 768 * 1024;
constexpr size_t WS_COS = 18 * MiB, WS_SIN = 22 * MiB, WS_SUMA = 26 * MiB, WS_SUMH = 27 * MiB, WS_HIN = 28 * MiB;
constexpr size_t WS_SU = 29 * MiB, WS_SV = 30 * MiB;
constexpr size_t WS_SX = 31 * MiB;
constexpr size_t WS_UQ = 32 * MiB, WS_VQ = 64 * MiB;
constexpr size_t WS_XQ = 96 * MiB;
constexpr size_t WS_PD = 328 * MiB, WS_ZS = 392 * MiB;
constexpr size_t WS_WIN_T = 160 * MiB, WS_XB = 184 * MiB, WS_KVS = 184 * MiB, WS_H1B = 184 * MiB;
constexpr size_t WS_PROJ = 248 * MiB, WS_QP = 248 * MiB, WS_SELE = 312 * MiB, WS_SELG = 320 * MiB, WS_SELU = 456 * MiB, WS_COEF = 464 * MiB;
constexpr size_t WS_YCAT = 440 * MiB, WS_END = 504 * MiB;

#define LAS __attribute__((address_space(3)))
typedef unsigned short bf16_t;
typedef short bf16x8 __attribute__((ext_vector_type(8)));
typedef float f32x4 __attribute__((ext_vector_type(4)));
typedef unsigned u32x4 __attribute__((ext_vector_type(4)));
typedef unsigned u32x2 __attribute__((ext_vector_type(2)));

__device__ __forceinline__ unsigned f2bf(float f) { unsigned u = __float_as_uint(f); return (u + 0x7fffu + ((u >> 16) & 1u)) >> 16; }
__device__ __forceinline__ unsigned pk2(float lo, float hi) { return f2bf(lo) | (f2bf(hi) << 16); }
__device__ __forceinline__ float bflo(unsigned w) { return __uint_as_float(w << 16); }
__device__ __forceinline__ float bfhi(unsigned w) { return __uint_as_float(w & 0xffff0000u); }
__device__ __forceinline__ float bf2f(bf16_t b) { return __uint_as_float(((unsigned)b) << 16); }
__device__ __forceinline__ f32x4 mfma16(bf16x8 a, bf16x8 b, f32x4 c) { return __builtin_amdgcn_mfma_f32_16x16x32_bf16(a, b, c, 0, 0, 0); }
__device__ __forceinline__ float fexp_(float x) { return __builtin_amdgcn_exp2f(x * 1.4426950408889634f); }
__device__ __forceinline__ float sigmoidf_(float x) { return __builtin_amdgcn_rcpf(1.0f + fexp_(-x)); }
__device__ __forceinline__ float gelu_tanh(float x) { const float y = 0.7978845608028654f * (x + 0.044715f * x * x * x); return x * __builtin_amdgcn_rcpf(1.0f + fexp_(-2.0f * y)); }
__device__ __forceinline__ float wave_sum(float v) {
#pragma unroll
    for (int o = 1; o < 64; o <<= 1) v += __shfl_xor(v, o);
    return v;
}
__device__ __forceinline__ float wave_max(float v) {
#pragma unroll
    for (int o = 1; o < 64; o <<= 1) v = fmaxf(v, __shfl_xor(v, o));
    return v;
}
__device__ __forceinline__ int wave_sum_i(int v) {
#pragma unroll
    for (int o = 1; o < 64; o <<= 1) v += __shfl_xor(v, o);
    return v;
}
__device__ __forceinline__ float head_log_gamma(int h) { return logf(1.0f - exp2f(-5.0f - (float)h)); }

__device__ __forceinline__ void transpose_item(const float* W, int K, int N, bf16_t* WT, LAS float* scr, int item, int lane) {
    const int nblk = N / 32, kb = item / nblk, nb = item % nblk, k0 = 64 * kb, n0 = 32 * nb;
#pragma unroll 8
    for (int i = 0; i < 32; ++i) { const int kk = 2 * i + (lane >> 5); scr[kk * 33 + (lane & 31)] = W[(size_t)(k0 + kk) * N + n0 + (lane & 31)]; }
    asm volatile("s_waitcnt lgkmcnt(0)" ::: "memory");
    const int c = lane & 7;
#pragma unroll
    for (int j = 0; j < 4; ++j) { const int n = (lane >> 3) + 8 * j; const LAS float* s = scr + (8 * c) * 33 + n;
        u32x4 o; o.x = pk2(s[0 * 33], s[1 * 33]); o.y = pk2(s[2 * 33], s[3 * 33]); o.z = pk2(s[4 * 33], s[5 * 33]); o.w = pk2(s[6 * 33], s[7 * 33]);
        *(u32x4*)(WT + (size_t)(n0 + n) * K + k0 + 8 * c) = o; }
    asm volatile("s_waitcnt lgkmcnt(0)" ::: "memory");
}
__device__ __forceinline__ void cvt_stream(const float* src, bf16_t* dst, size_t n8, size_t gtid, size_t gthreads) {
    size_t i = gtid;
    for (; i + 3 * gthreads < n8; i += 4 * gthreads) {
        f32x4 a[4], b[4];
#pragma unroll
        for (int u = 0; u < 4; ++u) { a[u] = __builtin_nontemporal_load((const f32x4*)src + 2 * (i + u * gthreads)); b[u] = __builtin_nontemporal_load((const f32x4*)src + 2 * (i + u * gthreads) + 1); }
#pragma unroll
        for (int u = 0; u < 4; ++u) { u32x4 o; o.x = pk2(a[u].x, a[u].y); o.y = pk2(a[u].z, a[u].w); o.z = pk2(b[u].x, b[u].y); o.w = pk2(b[u].z, b[u].w); ((u32x4*)dst)[i + u * gthreads] = o; }
    }
    for (; i < n8; i += gthreads) {
        const f32x4 a = ((const f32x4*)src)[2 * i], b = ((const f32x4*)src)[2 * i + 1];
        u32x4 o; o.x = pk2(a.x, a.y); o.y = pk2(a.z, a.w); o.z = pk2(b.x, b.y); o.w = pk2(b.z, b.w);
        ((u32x4*)dst)[i] = o;
    }
}
struct Ptrs {
    const float *x; const int* pos; const float *w_in, *w_out, *conv_w, *conv_b, *w_ra, *b_ra, *w_ri, *b_ri, *lam, *ln1_g, *ln1_b, *w_pq, *sub_keys, *peer_u, *peer_v, *ln2_g, *ln2_b;
    float* out; unsigned char* ws;
};
__device__ __forceinline__ void prologue_phase(LAS unsigned char* lds, const Ptrs& P, int G, int b) {
    const int tid = threadIdx.x, lane = tid & 63, wid = tid >> 6;
    LAS float* scr = (LAS float*)(lds + wid * 16384);
    const int gw = b * NWAVES + wid, NGW = G * NWAVES;
    unsigned char* ws = P.ws;
    constexpr int I_IN = (D_ / 64) * (INC / 32), I_SQ = (D_ / 64) * (D_ / 32), I_G = 2 * 4;
    constexpr int NITEMS = I_IN + 2 * I_SQ + 16 * I_G;
    for (int it = gw; it < NITEMS; it += NGW) {
        int r = it;
        if (r < I_IN) { transpose_item(P.w_in, D_, INC, (bf16_t*)(ws + WS_WIN_T), scr, r, lane); continue; } r -= I_IN;
        if (r < I_SQ) { transpose_item(P.w_out, D_, D_, (bf16_t*)(ws + WS_WOUT_T), scr, r, lane); continue; } r -= I_SQ;
        if (r < I_SQ) { transpose_item(P.w_pq, D_, D_, (bf16_t*)(ws + WS_WPQ_T), scr, r, lane); continue; } r -= I_SQ;
        if (r < 8 * I_G) { const int g = r / I_G; transpose_item(P.w_ra + g * 16384, 128, 128, (bf16_t*)(ws + WS_WRA_T) + g * 16384, scr, r % I_G, lane); continue; } r -= 8 * I_G;
        { const int g = r / I_G; transpose_item(P.w_ri + g * 16384, 128, 128, (bf16_t*)(ws + WS_WRI_T) + g * 16384, scr, r % I_G, lane); }
    }
    const size_t gtid = (size_t)b * NTHREADS + tid, gth = (size_t)G * NTHREADS;
    cvt_stream(P.x, (bf16_t*)(ws + WS_XB), (size_t)S_ * D_ / 8, gtid, gth);
    for (int row = gw; row < 2 * 16384; row += NGW) {
        const int isv = row >> 14, e = row & 16383;
        const float* rp = (isv ? P.peer_v : P.peer_u) + (size_t)e * D_;
        f32x4 v[8]; float amax = 0.f;
#pragma unroll
        for (int j = 0; j < 8; ++j) { v[j] = *(const f32x4*)(rp + 256 * j + 4 * lane); amax = fmaxf(amax, fmaxf(fmaxf(fabsf(v[j].x), fabsf(v[j].y)), fmaxf(fabsf(v[j].z), fabsf(v[j].w)))); }
        amax = wave_max(amax);
        unsigned* qp = (unsigned*)(ws + (isv ? WS_VQ : WS_UQ)) + (size_t)e * 64;
        if (isv) {
            const float inv = amax > 0.f ? 416.0f / amax : 0.f;
            if (lane == 0) ((float*)(ws + WS_SV))[e] = amax * (1.0f / 416.0f);
#pragma unroll
            for (int j = 0; j < 8; ++j) {
                int w = __builtin_amdgcn_cvt_pk_fp8_f32(v[j].x * inv, v[j].y * inv, 0, false);
                w = __builtin_amdgcn_cvt_pk_fp8_f32(v[j].z * inv, v[j].w * inv, w, true);
                qp[(size_t)j * 16384 * 64 + lane] = (unsigned)w;
            }
        } else {
            const float inv = amax > 0.f ? 127.0f / amax : 0.f;
            if (lane == 0) ((float*)(ws + WS_SU))[e] = amax * (1.0f / 127.0f);
#pragma unroll
            for (int j = 0; j < 8; ++j) {
                const int a = (int)rintf(v[j].x * inv), bq = (int)rintf(v[j].y * inv), c = (int)rintf(v[j].z * inv), d = (int)rintf(v[j].w * inv);
                qp[(size_t)j * 16384 * 64 + lane] = (unsigned)(a & 255) | ((unsigned)(bq & 255) << 8) | ((unsigned)(c & 255) << 16) | ((unsigned)(d & 255) << 24);
            }
        }
    }
    cvt_stream(P.sub_keys, (bf16_t*)(ws + WS_KEYS), (size_t)8 * 2 * 128 * 128 / 8, gtid, gth);
    float* cosT = (float*)(ws + WS_COS); float* sinT = (float*)(ws + WS_SIN);
    for (size_t i = gtid; i < (size_t)S_ * 64; i += gth) {
        const int s = (int)(i >> 6), f = (int)(i & 63);
        const float inv = powf(10000.0f, -(float)f / 64.0f);
        const float ang = (float)P.pos[s] * inv;
        float sn, cs; sincosf(ang, &sn, &cs);
        cosT[i] = cs; sinT[i] = sn;
    }
}
#define XB_TMO      128
#define XB_XCNT(j)  (256  + 64 * (j))
#define XB_XSUB(j)  (1280 + 64 * (j))
#define XB_XGEN(j)  (2304 + 64 * (j))
#define XB_TOP      3328
#define XB_TOPGEN   3392
#define XCD_BAR_WORDS 3456
#define XB_SPIN_CAP (1u << 18)

__device__ __forceinline__ unsigned xb_ld(unsigned* p)              { return __hip_atomic_load(p, __ATOMIC_RELAXED, __HIP_MEMORY_SCOPE_AGENT); }
__device__ __forceinline__ unsigned xb_add(unsigned* p, unsigned v) { return __hip_atomic_fetch_add(p, v, __ATOMIC_RELAXED, __HIP_MEMORY_SCOPE_AGENT); }
__device__ __forceinline__ unsigned xb_xcc_id() { return (unsigned)__builtin_amdgcn_s_getreg((3 << 11) | 20) & 0xFu; }
#define XB_SPIN(cond, bar) do { unsigned _sp = 0; while (cond) { __builtin_amdgcn_s_sleep(1); \
    if ((++_sp & 255u) == 0u) { if (xb_ld(&(bar)[XB_TMO])) break; if (_sp > XB_SPIN_CAP) { atomicAdd(&(bar)[XB_TMO], 1u); break; } } } } while (0)

struct XcdBarrier {
    unsigned* bar; unsigned x;
    volatile LAS unsigned* st;
};

__device__ __forceinline__ XcdBarrier xcd_barrier_post(unsigned* bar, volatile LAS unsigned* st) {
    XcdBarrier b; b.bar = bar; b.x = xb_xcc_id(); b.st = st;
    if (threadIdx.x == 0) (void)xb_add(&bar[XB_XCNT(b.x)], 1u);
    return b;
}
__device__ __forceinline__ void xcd_barrier_complete(unsigned* bar, unsigned x, unsigned& nloc, unsigned& nx) {
    const unsigned G = gridDim.x * gridDim.y * gridDim.z;
    unsigned sum, cnt, mine, sp = 0u;
    for (;;) {
        sum = 0u; cnt = 0u; mine = 0u;
#pragma unroll
        for (unsigned j = 0; j < 16; ++j) { const unsigned c = xb_ld(&bar[XB_XCNT(j)]); sum += c; cnt += (c > 0u) ? 1u : 0u; mine = (j == x) ? c : mine; }
        if (sum == G) break;
        __builtin_amdgcn_s_sleep(1);
        if ((++sp & 255u) == 0u) { if (xb_ld(&bar[XB_TMO])) break; if (sp > XB_SPIN_CAP) { atomicAdd(&bar[XB_TMO], 1u); break; } }
    }
    nloc = mine > 0u ? mine : 1u; nx = cnt > 0u ? cnt : 1u;
}

__device__ __forceinline__ void xcd_barrier(const XcdBarrier& b) {
    asm volatile("s_waitcnt vmcnt(0)" ::: "memory");
    __syncthreads();
    if (threadIdx.x == 0) {
        unsigned* bar = b.bar;
        __builtin_amdgcn_s_waitcnt(0);
        unsigned nloc = b.st[0], nx = b.st[1];
        if (nloc == 0u) { xcd_barrier_complete(bar, b.x, nloc, nx); b.st[0] = nloc; b.st[1] = nx; }
        const unsigned old = xb_add(&bar[XB_XSUB(b.x)], 1u);
        const unsigned gen = old / nloc;
        if (old + 1u == (gen + 1u) * nloc) {
            __builtin_amdgcn_fence(__ATOMIC_RELEASE, "agent");
            asm volatile("s_waitcnt vmcnt(0)" ::: "memory");
            const unsigned og = xb_add(&bar[XB_TOP], 1u);
            const unsigned tg = og / nx;
            if (og + 1u == (tg + 1u) * nx) xb_add(&bar[XB_TOPGEN], 1u);
            else XB_SPIN(xb_ld(&bar[XB_TOPGEN]) == tg, bar);
            __builtin_amdgcn_fence(__ATOMIC_ACQUIRE, "agent");
            xb_add(&bar[XB_XGEN(b.x)], 1u);
            asm volatile("s_waitcnt vmcnt(0)" ::: "memory");
        } else {
            XB_SPIN(xb_ld(&bar[XB_XGEN(b.x)]) == gen, bar);
            __builtin_amdgcn_fence(__ATOMIC_ACQUIRE, "agent");
            asm volatile("s_waitcnt vmcnt(0)" ::: "memory");
        }
    }
    __syncthreads();
}
__device__ __forceinline__ void rot8(const u32x4 x1, const u32x4 x2, const float* cp, const float* sp, float scale, float (&o1)[8], float (&o2)[8]) {
    const f32x4 c0 = *(const f32x4*)cp, c1 = *(const f32x4*)(cp + 4), s0 = *(const f32x4*)sp, s1 = *(const f32x4*)(sp + 4);
    const float cs[8] = {c0.x, c0.y, c0.z, c0.w, c1.x, c1.y, c1.z, c1.w}, sn[8] = {s0.x, s0.y, s0.z, s0.w, s1.x, s1.y, s1.z, s1.w};
    const unsigned w1[4] = {x1.x, x1.y, x1.z, x1.w}, w2[4] = {x2.x, x2.y, x2.z, x2.w};
#pragma unroll
    for (int j = 0; j < 8; ++j) {
        const float a = (j & 1) ? bfhi(w1[j >> 1]) : bflo(w1[j >> 1]);
        const float bb = (j & 1) ? bfhi(w2[j >> 1]) : bflo(w2[j >> 1]);
        o1[j] = (a * cs[j] - bb * sn[j]) * scale;
        o2[j] = (bb * cs[j] + a * sn[j]) * scale;
    }
}
__device__ __forceinline__ void ret_kv_phase(LAS unsigned char* lds, const bf16_t* proj, const float* cosT, const float* sinT, bf16_t* kvs, int G, int b) {
    const int tid = threadIdx.x, lane = tid & 63, wid = tid >> 6, fr = lane & 15, fq = lane >> 4;
    LAS bf16_t* KT = (LAS bf16_t*)lds;
    LAS bf16_t* VT = (LAS bf16_t*)(lds + 18432);
    for (int unit = b; unit < NCH * NH; unit += G) {
        const int n = unit >> 3, h = unit & 7;
        const float log_g = head_log_gamma(h);
        const int m = tid >> 3, tq = tid & 7; const int s = n * 64 + m;
        {
            const bf16_t* kp = proj + (size_t)s * INC + 1024 + h * 128 + tq * 8;
            const u32x4 x1 = *(const u32x4*)kp, x2 = *(const u32x4*)(kp + 64);
            float o1[8], o2[8];
            rot8(x1, x2, cosT + (size_t)s * 64 + tq * 8, sinT + (size_t)s * 64 + tq * 8, expf(log_g * (63.0f - (float)m)), o1, o2);
#pragma unroll
            for (int j = 0; j < 8; ++j) { KT[(tq * 8 + j) * 72 + m] = (bf16_t)f2bf(o1[j]); KT[(64 + tq * 8 + j) * 72 + m] = (bf16_t)f2bf(o2[j]); }
            const bf16_t* vp = proj + (size_t)s * INC + 2048 + h * 128 + tq * 16;
            const u32x4 y0 = *(const u32x4*)vp, y1 = *(const u32x4*)(vp + 8);
            const unsigned yw[8] = {y0.x, y0.y, y0.z, y0.w, y1.x, y1.y, y1.z, y1.w};
#pragma unroll
            for (int j = 0; j < 8; ++j) { VT[(tq * 16 + 2 * j) * 72 + m] = (bf16_t)(yw[j] & 0xffffu); VT[(tq * 16 + 2 * j + 1) * 72 + m] = (bf16_t)(yw[j] >> 16); }
        }
        __syncthreads();
        f32x4 acc[8];
#pragma unroll
        for (int et = 0; et < 8; ++et) acc[et] = (f32x4){0.f, 0.f, 0.f, 0.f};
#pragma unroll
        for (int ks = 0; ks < 2; ++ks) {
            const bf16x8 a = *(const LAS bf16x8*)(KT + (wid * 16 + fr) * 72 + ks * 32 + fq * 8);
#pragma unroll
            for (int et = 0; et < 8; ++et) { const bf16x8 bb = *(const LAS bf16x8*)(VT + (et * 16 + fr) * 72 + ks * 32 + fq * 8); acc[et] = mfma16(a, bb, acc[et]); }
        }
        bf16_t* outp = kvs + (size_t)unit * 16384;
#pragma unroll
        for (int et = 0; et < 8; ++et) { u32x2 w; w.x = pk2(acc[et][0], acc[et][1]); w.y = pk2(acc[et][2], acc[et][3]); *(u32x2*)(outp + (et * 16 + fr) * 128 + wid * 16 + fq * 4) = w; }
        __syncthreads();
    }
}
__device__ __forceinline__ void scan_phase(bf16_t* kvs, const float* sumA, const float* sumH, float* Hin, int G, int b) {
    const int gtid = b * NTHREADS + threadIdx.x, gth = G * NTHREADS;
    for (int p = gtid; p < 65536; p += gth) {
        const int h = p >> 13;
        const float dec = expf(64.0f * head_log_gamma(h));
        unsigned* ptr = (unsigned*)kvs + p;
        float s0 = 0.f, s1 = 0.f;
        for (int n = 0; n < NCH; n += 32) {
            unsigned v[32];
#pragma unroll
            for (int j = 0; j < 32; ++j) v[j] = ptr[(size_t)(n + j) * 65536];
#pragma unroll
            for (int j = 0; j < 32; ++j) { ptr[(size_t)(n + j) * 65536] = pk2(s0, s1); s0 = dec * s0 + bflo(v[j]); s1 = dec * s1 + bfhi(v[j]); }
        }
    }
    const int c = gth - 1 - gtid;
    if (c < 1024) {
        float H = 0.f;
        for (int n = 0; n < NCH; n += 8) {
            float a[8], hh[8];
#pragma unroll
            for (int j = 0; j < 8; ++j) { a[j] = sumA[(n + j) * 1024 + c]; hh[j] = sumH[(n + j) * 1024 + c]; }
#pragma unroll
            for (int j = 0; j < 8; ++j) { Hin[(n + j) * 1024 + c] = H; H = a[j] * H + hh[j]; }
        }
    }
}
__device__ __forceinline__ void ret_out_phase(LAS unsigned char* lds, const bf16_t* proj, const float* cosT, const float* sinT, const bf16_t* kvs, bf16_t* ycat, int G, int b) {
    const int tid = threadIdx.x, lane = tid & 63, wid = tid >> 6, fr = lane & 15, fq = lane >> 4;
    LAS bf16_t* QS = (LAS bf16_t*)lds;
    LAS bf16_t* KS = (LAS bf16_t*)(lds + 17408);
    LAS bf16_t* VT = (LAS bf16_t*)(lds + 34816);
    LAS bf16_t* PS = (LAS bf16_t*)(lds + 53248);
    LAS float*  OS = (LAS float*)(lds + 62464);
    for (int unit = b; unit < NCH * NH; unit += G) {
        const int n = unit >> 3, h = unit & 7;
        const float log_g = head_log_gamma(h);
        const int m = tid >> 3, tq = tid & 7; const int s = n * 64 + m;
        {
            const float* cp = cosT + (size_t)s * 64 + tq * 8; const float* sp = sinT + (size_t)s * 64 + tq * 8;
            float o1[8], o2[8];
            const bf16_t* qp = proj + (size_t)s * INC + h * 128 + tq * 8;
            rot8(*(const u32x4*)qp, *(const u32x4*)(qp + 64), cp, sp, 0.08838834764831845f, o1, o2);
            u32x4 w; w.x = pk2(o1[0], o1[1]); w.y = pk2(o1[2], o1[3]); w.z = pk2(o1[4], o1[5]); w.w = pk2(o1[6], o1[7]);
            *(LAS u32x4*)(QS + m * 136 + tq * 8) = w;
            w.x = pk2(o2[0], o2[1]); w.y = pk2(o2[2], o2[3]); w.z = pk2(o2[4], o2[5]); w.w = pk2(o2[6], o2[7]);
            *(LAS u32x4*)(QS + m * 136 + 64 + tq * 8) = w;
            const bf16_t* kp = proj + (size_t)s * INC + 1024 + h * 128 + tq * 8;
            rot8(*(const u32x4*)kp, *(const u32x4*)(kp + 64), cp, sp, 1.0f, o1, o2);
            w.x = pk2(o1[0], o1[1]); w.y = pk2(o1[2], o1[3]); w.z = pk2(o1[4], o1[5]); w.w = pk2(o1[6], o1[7]);
            *(LAS u32x4*)(KS + m * 136 + tq * 8) = w;
            w.x = pk2(o2[0], o2[1]); w.y = pk2(o2[2], o2[3]); w.z = pk2(o2[4], o2[5]); w.w = pk2(o2[6], o2[7]);
            *(LAS u32x4*)(KS + m * 136 + 64 + tq * 8) = w;
            const bf16_t* vp = proj + (size_t)s * INC + 2048 + h * 128 + tq * 16;
            const u32x4 y0 = *(const u32x4*)vp, y1 = *(const u32x4*)(vp + 8);
            const unsigned yw[8] = {y0.x, y0.y, y0.z, y0.w, y1.x, y1.y, y1.z, y1.w};
#pragma unroll
            for (int j = 0; j < 8; ++j) { VT[(tq * 16 + 2 * j) * 72 + m] = (bf16_t)(yw[j] & 0xffffu); VT[(tq * 16 + 2 * j + 1) * 72 + m] = (bf16_t)(yw[j] >> 16); }
        }
        __syncthreads();
        const int ct = wid & 3;
        {
            const int mt0 = (wid >> 2) * 2;
            f32x4 sacc[2] = {(f32x4){0.f, 0.f, 0.f, 0.f}, (f32x4){0.f, 0.f, 0.f, 0.f}};
#pragma unroll
            for (int ks = 0; ks < 4; ++ks) {
                const bf16x8 a = *(const LAS bf16x8*)(QS + (ct * 16 + fr) * 136 + ks * 32 + fq * 8);
#pragma unroll
                for (int j = 0; j < 2; ++j) { const bf16x8 bb = *(const LAS bf16x8*)(KS + ((mt0 + j) * 16 + fr) * 136 + ks * 32 + fq * 8); sacc[j] = mfma16(a, bb, sacc[j]); }
            }
#pragma unroll
            for (int j = 0; j < 2; ++j)
#pragma unroll
                for (int r = 0; r < 4; ++r) { const int c = ct * 16 + fq * 4 + r, mm = (mt0 + j) * 16 + fr; const float dd = fabsf((float)(c - mm));
                    PS[c * 72 + mm] = (bf16_t)f2bf(sacc[j][r] * expf(log_g * dd)); }
        }
        __syncthreads();
        {
            const int et0 = (wid >> 2) * 4;
            f32x4 oacc[4];
#pragma unroll
            for (int j = 0; j < 4; ++j) oacc[j] = (f32x4){0.f, 0.f, 0.f, 0.f};
            const bf16_t* st = kvs + (size_t)unit * 16384;
#pragma unroll
            for (int ks = 0; ks < 4; ++ks) {
                const bf16x8 a = *(const LAS bf16x8*)(QS + (ct * 16 + fr) * 136 + ks * 32 + fq * 8);
#pragma unroll
                for (int j = 0; j < 4; ++j) { const bf16x8 bb = *(const bf16x8*)(st + ((et0 + j) * 16 + fr) * 128 + ks * 32 + fq * 8); oacc[j] = mfma16(a, bb, oacc[j]); }
            }
#pragma unroll
            for (int r = 0; r < 4; ++r) { const float qd = expf(log_g * (float)(ct * 16 + fq * 4 + r + 1));
#pragma unroll
                for (int j = 0; j < 4; ++j) oacc[j][r] *= qd; }
#pragma unroll
            for (int ks = 0; ks < 2; ++ks) {
                const bf16x8 a = *(const LAS bf16x8*)(PS + (ct * 16 + fr) * 72 + ks * 32 + fq * 8);
#pragma unroll
                for (int j = 0; j < 4; ++j) { const bf16x8 bb = *(const LAS bf16x8*)(VT + ((et0 + j) * 16 + fr) * 72 + ks * 32 + fq * 8); oacc[j] = mfma16(a, bb, oacc[j]); }
            }
#pragma unroll
            for (int j = 0; j < 4; ++j)
#pragma unroll
                for (int r = 0; r < 4; ++r) OS[(ct * 16 + fq * 4 + r) * 132 + (et0 + j) * 16 + fr] = oacc[j][r];
        }
        __syncthreads();
        {
            float v[16]; float sum = 0.f;
#pragma unroll
            for (int q = 0; q < 4; ++q) { const f32x4 t = *(const LAS f32x4*)(OS + m * 132 + tq * 16 + q * 4); v[4 * q] = t.x; v[4 * q + 1] = t.y; v[4 * q + 2] = t.z; v[4 * q + 3] = t.w; sum += (t.x + t.y) + (t.z + t.w); }
            sum += __shfl_xor(sum, 1); sum += __shfl_xor(sum, 2); sum += __shfl_xor(sum, 4);
            const float mean = sum * (1.0f / 128.0f); float sq = 0.f;
#pragma unroll
            for (int i = 0; i < 16; ++i) { v[i] -= mean; sq += v[i] * v[i]; }
            sq += __shfl_xor(sq, 1); sq += __shfl_xor(sq, 2); sq += __shfl_xor(sq, 4);
            const float rstd = 1.0f / sqrtf(sq * (1.0f / 128.0f) + GN_EPS);
            const bf16_t* gp = proj + (size_t)s * INC + 3072 + h * 128 + tq * 16;
            const u32x4 g0 = *(const u32x4*)gp, g1 = *(const u32x4*)(gp + 8);
            const unsigned gw[8] = {g0.x, g0.y, g0.z, g0.w, g1.x, g1.y, g1.z, g1.w};
            unsigned ow[8];
#pragma unroll
            for (int j = 0; j < 8; ++j) { const float ga = bflo(gw[j]), gb = bfhi(gw[j]);
                ow[j] = pk2(ga * sigmoidf_(ga) * v[2 * j] * rstd, gb * sigmoidf_(gb) * v[2 * j + 1] * rstd); }
            bf16_t* yp = ycat + (size_t)s * D_ + h * 128 + tq * 16;
            *(u32x4*)yp = (u32x4){ow[0], ow[1], ow[2], ow[3]}; *(u32x4*)(yp + 8) = (u32x4){ow[4], ow[5], ow[6], ow[7]};
        }
        __syncthreads();
    }
}
template <int MODE>
__device__ __forceinline__ void lru_phase(LAS unsigned char* lds, const bf16_t* proj, const Ptrs& P, const bf16_t* wraT, const bf16_t* wriT,
                                          float* sumA, float* sumH, const float* Hin, bf16_t* ycat, int G, int b) {
    const int tid = threadIdx.x, lane = tid & 63, wid = tid >> 6, fr = lane & 15, fq = lane >> 4;
    LAS float*  XC  = (LAS float*)lds;
    LAS bf16_t* XCb = (LAS bf16_t*)(lds + 33792);
    LAS float*  AA  = (LAS float*)(lds + 51200);
    LAS float*  SEG = (LAS float*)(lds + 84992);
    LAS bf16_t* WR  = (LAS bf16_t*)(lds + 89088);
    LAS bf16_t* WI  = (LAS bf16_t*)(lds + 123904);
    LAS float*  BB  = XC;
    const int st = wid & 3, jt0 = (wid >> 2) * 4;
    const int m = tid >> 3, part = tid & 7, j0 = part * 16;
    const int sj = tid & 127, seg = tid >> 7;
    int gcur = -1;
    float bra[4], bri[4], ls[4]; float cw0[4], cw1[4], cb0 = 0.f, cb1 = 0.f;
    unsigned xnext[11]; u32x4 gnext[2] = {(u32x4){0u, 0u, 0u, 0u}, (u32x4){0u, 0u, 0u, 0u}}; float hnext = 0.f;
    auto issue = [&](int unit) {
        const int n = unit >> 3, c0 = (unit & 7) * 128;
        const int r0 = n * 64 + wid * 8 - 3;
#pragma unroll
        for (int q = 0; q < 11; ++q) { const int row = r0 + q; xnext[q] = row >= 0 ? *(const unsigned*)(proj + (size_t)row * INC + 4096 + c0 + 2 * lane) : 0u; }
        if (MODE == 1) {
            const bf16_t* gp = proj + (size_t)(n * 64 + m) * INC + 5120 + c0 + j0;
            gnext[0] = *(const u32x4*)gp; gnext[1] = *(const u32x4*)(gp + 8);
            hnext = Hin[n * 1024 + c0 + sj];
        }
    };
    if (b < NCH * 8) issue(b);
    for (int unit = b; unit < NCH * 8; unit += G) {
        const int n = unit >> 3, g = unit & 7, c0 = g * 128;
        if (g != gcur) {
            gcur = g;
            __syncthreads();
            {
                const int row = tid >> 2, pc = tid & 3;
#pragma unroll
                for (int q = 0; q < 4; ++q) { const int piece = pc * 4 + q;
                    *(LAS u32x4*)(WR + row * 136 + piece * 8) = *(const u32x4*)(wraT + (size_t)g * 16384 + row * 128 + piece * 8);
                    *(LAS u32x4*)(WI + row * 136 + piece * 8) = *(const u32x4*)(wriT + (size_t)g * 16384 + row * 128 + piece * 8); }
            }
#pragma unroll
            for (int j = 0; j < 4; ++j) {
                const int c = c0 + (jt0 + j) * 16 + fr;
                bra[j] = P.b_ra[c]; bri[j] = P.b_ri[c]; ls[j] = -8.0f * log1pf(expf(-P.lam[c]));
            }
#pragma unroll
            for (int kk = 0; kk < 4; ++kk) { cw0[kk] = P.conv_w[kk * 1024 + c0 + 2 * lane]; cw1[kk] = P.conv_w[kk * 1024 + c0 + 2 * lane + 1]; }
            cb0 = P.conv_b[c0 + 2 * lane]; cb1 = P.conv_b[c0 + 2 * lane + 1];
        }
        unsigned xcur[11];
#pragma unroll
        for (int q = 0; q < 11; ++q) xcur[q] = xnext[q];
        const u32x4 gc0 = gnext[0], gc1 = gnext[1]; const float hin0 = hnext;
        if (unit + G < NCH * 8) issue(unit + G);
#pragma unroll
        for (int rr = 0; rr < 8; ++rr) {
            float x0 = cb0, x1 = cb1;
#pragma unroll
            for (int kk = 0; kk < 4; ++kk) { x0 += cw0[kk] * bflo(xcur[rr + kk]); x1 += cw1[kk] * bfhi(xcur[rr + kk]); }
            const int row = wid * 8 + rr;
            XC[row * 132 + 2 * lane] = x0; XC[row * 132 + 2 * lane + 1] = x1;
            *(LAS unsigned*)(XCb + row * 136 + 2 * lane) = pk2(x0, x1);
        }
        __syncthreads();
        {
            f32x4 ar[4], ai[4];
#pragma unroll
            for (int j = 0; j < 4; ++j) { ar[j] = (f32x4){0.f, 0.f, 0.f, 0.f}; ai[j] = (f32x4){0.f, 0.f, 0.f, 0.f}; }
#pragma unroll
            for (int ks = 0; ks < 4; ++ks) {
                const bf16x8 a = *(const LAS bf16x8*)(XCb + (st * 16 + fr) * 136 + ks * 32 + fq * 8);
#pragma unroll
                for (int j = 0; j < 4; ++j) { const int wo = ((jt0 + j) * 16 + fr) * 136 + ks * 32 + fq * 8;
                    ar[j] = mfma16(a, *(const LAS bf16x8*)(WR + wo), ar[j]); ai[j] = mfma16(a, *(const LAS bf16x8*)(WI + wo), ai[j]); }
            }
#pragma unroll
            for (int j = 0; j < 4; ++j) {
                const int col = (jt0 + j) * 16 + fr;
#pragma unroll
                for (int r = 0; r < 4; ++r) {
                    const int sl = st * 16 + fq * 4 + r;
                    const float rg = sigmoidf_(ar[j][r] + bra[j]), ig = sigmoidf_(ai[j][r] + bri[j]);
                    const float a = fexp_(rg * ls[j]);
                    const float bv = __builtin_amdgcn_sqrtf(fmaxf(1.0f - a * a, 0.f)) * (ig * XC[sl * 132 + col]);
                    AA[sl * 132 + col] = a; BB[sl * 132 + col] = bv;
                }
            }
        }
        __syncthreads();
        float ap = 1.f, he = 0.f;
#pragma unroll
        for (int q = 0; q < 16; ++q) { const float a = AA[(seg * 16 + q) * 132 + sj], bv = BB[(seg * 16 + q) * 132 + sj]; he = a * he + bv; ap *= a; }
        SEG[seg * 128 + sj] = ap; SEG[512 + seg * 128 + sj] = he;
        __syncthreads();
        float hin = (MODE == 1) ? hin0 : 0.f;
#pragma unroll
        for (int s2 = 0; s2 < 3; ++s2) if (s2 < seg) hin = SEG[s2 * 128 + sj] * hin + SEG[512 + s2 * 128 + sj];
        if (MODE == 0) {
            if (seg == 3) { sumA[n * 1024 + c0 + sj] = SEG[sj] * SEG[128 + sj] * SEG[256 + sj] * ap; sumH[n * 1024 + c0 + sj] = ap * hin + he; }
        } else {
            float hcur = hin;
#pragma unroll
            for (int q = 0; q < 16; ++q) { const int o = (seg * 16 + q) * 132 + sj; hcur = AA[o] * hcur + BB[o]; BB[o] = hcur; }
            __syncthreads();
            const unsigned gw[8] = {gc0.x, gc0.y, gc0.z, gc0.w, gc1.x, gc1.y, gc1.z, gc1.w};
            unsigned ow[8];
#pragma unroll
            for (int q = 0; q < 8; ++q) { const float h0 = BB[m * 132 + j0 + 2 * q], h1 = BB[m * 132 + j0 + 2 * q + 1];
                ow[q] = pk2(h0 * gelu_tanh(bflo(gw[q])), h1 * gelu_tanh(bfhi(gw[q]))); }
            bf16_t* yp = ycat + (size_t)(n * 64 + m) * D_ + 1024 + c0 + j0;
            *(u32x4*)yp = (u32x4){ow[0], ow[1], ow[2], ow[3]}; *(u32x4*)(yp + 8) = (u32x4){ow[4], ow[5], ow[6], ow[7]};
        }
        __syncthreads();
    }
}
__device__ __forceinline__ void ln1_phase(const float* buf, bf16_t* h1b, unsigned* xqs, float* sx, const float* gam, const float* bet, int G, int b) {
    const int lane = threadIdx.x & 63, wid = threadIdx.x >> 6;
    const int gw = b * NWAVES + wid, NGW = G * NWAVES;
    for (int row = gw; row < S_; row += NGW) {
        const float* rp = buf + (size_t)row * D_;
        f32x4 v[8]; float sum = 0.f;
#pragma unroll
        for (int j = 0; j < 8; ++j) { v[j] = *(const f32x4*)(rp + 256 * j + 4 * lane); sum += (v[j].x + v[j].y) + (v[j].z + v[j].w); }
        const float mean = wave_sum(sum) * (1.0f / D_); float sq = 0.f;
#pragma unroll
        for (int j = 0; j < 8; ++j) { v[j] = v[j] - mean; sq += (v[j].x * v[j].x + v[j].y * v[j].y) + (v[j].z * v[j].z + v[j].w * v[j].w); }
        const float rstd = 1.0f / sqrtf(wave_sum(sq) * (1.0f / D_) + LN_EPS);
        float amax = 0.f;
#pragma unroll
        for (int j = 0; j < 8; ++j) {
            const f32x4 gg = *(const f32x4*)(gam + 256 * j + 4 * lane), bb = *(const f32x4*)(bet + 256 * j + 4 * lane);
            v[j] = v[j] * rstd * gg + bb;
            *(u32x2*)(h1b + (size_t)row * D_ + 256 * j + 4 * lane) = (u32x2){pk2(v[j].x, v[j].y), pk2(v[j].z, v[j].w)};
            amax = fmaxf(amax, fmaxf(fmaxf(fabsf(v[j].x), fabsf(v[j].y)), fmaxf(fabsf(v[j].z), fabsf(v[j].w))));
        }
        amax = wave_max(amax);
        const float inv = amax > 0.f ? 127.0f / amax : 0.f;
        if (lane == 0) sx[row] = amax * (1.0f / 127.0f);
#pragma unroll
        for (int j = 0; j < 8; ++j) {
            const int a = (int)rintf(v[j].x * inv), bq = (int)rintf(v[j].y * inv), c = (int)rintf(v[j].z * inv), d = (int)rintf(v[j].w * inv);
            xqs[((size_t)j * S_ + row) * 64 + lane] = (unsigned)(a & 255) | ((unsigned)(bq & 255) << 8) | ((unsigned)(c & 255) << 16) | ((unsigned)(d & 255) << 24);
        }
    }
}
__device__ __forceinline__ unsigned mono(float f) { const unsigned u = __float_as_uint(f); return (u & 0x80000000u) ? ~u : (u ^ 0x80000000u); }
__device__ __forceinline__ float unmono(unsigned u) { return __uint_as_float((u & 0x80000000u) ? (u ^ 0x80000000u) : ~u); }
__device__ __forceinline__ unsigned umax_(unsigned a, unsigned b) { return a > b ? a : b; }
__device__ __forceinline__ constexpr int cand_i(int c) { return c < 16 ? 0 : c < 24 ? 1 : c < 29 ? 2 : c < 33 ? 3 : c < 36 ? 4 : c < 38 ? 5 : c < 40 ? 6 : c < 42 ? 7 : c - 34; }
__device__ __forceinline__ constexpr int cand_j(int c) { return c < 16 ? c : c < 24 ? c - 16 : c < 29 ? c - 24 : c < 33 ? c - 29 : c < 36 ? c - 33 : c < 38 ? c - 36 : c < 40 ? c - 38 : c < 42 ? c - 40 : 0; }

__device__ __forceinline__ void topk_phase(LAS unsigned char* lds, const bf16_t* qp, const bf16_t* keys, const float* SU, const float* SV, int* sel_e, float* sel_g, float* sel_su, int G, int b) {
    const int tid = threadIdx.x, lane = tid & 63, wid = tid >> 6, fr = lane & 15, fq = lane >> 4;
    LAS unsigned* wl = (LAS unsigned*)(lds + wid * 4096 + fr * 256);
    for (int unit = b; unit < (S_ / 128) * 8; unit += G) {
        const int tt = unit >> 3, h = unit & 7;
        const int tok = tt * 128 + wid * 16 + fr;
        for (int p = 0; p < 2; ++p) {
            f32x4 acc[8];
#pragma unroll
            for (int mt = 0; mt < 8; ++mt) acc[mt] = (f32x4){0.f, 0.f, 0.f, 0.f};
            bf16x8 bq[4];
#pragma unroll
            for (int ks = 0; ks < 4; ++ks) bq[ks] = *(const bf16x8*)(qp + (size_t)tok * D_ + h * 256 + p * 128 + ks * 32 + fq * 8);
            const bf16_t* kb = keys + (size_t)(h * 2 + p) * 16384;
#pragma unroll
            for (int mt = 0; mt < 8; ++mt)
#pragma unroll
                for (int ks = 0; ks < 4; ++ks) { const bf16x8 a = *(const bf16x8*)(kb + (mt * 16 + fr) * 128 + ks * 32 + fq * 8); acc[mt] = mfma16(a, bq[ks], acc[mt]); }
            unsigned pk[32];
#pragma unroll
            for (int mt = 0; mt < 8; ++mt)
#pragma unroll
                for (int r = 0; r < 4; ++r) pk[mt * 4 + r] = (mono(acc[mt][r]) & ~127u) | (unsigned)(127 - (mt * 16 + fq * 4 + r));
            unsigned prev = 0xFFFFFFFFu;
#pragma unroll 1
            for (int i = 0; i < 16; ++i) {
                unsigned mx = 0u;
#pragma unroll
                for (int j = 0; j < 32; ++j) { const unsigned x = pk[j] < prev ? pk[j] : 0u; mx = umax_(mx, x); }
                mx = umax_(mx, (unsigned)__shfl_xor((int)mx, 16)); mx = umax_(mx, (unsigned)__shfl_xor((int)mx, 32));
                if (fq == 0) wl[p * 16 + i] = mx;
                prev = mx;
            }
        }
        __syncthreads();
        float v1[16], v2[16];
#pragma unroll
        for (int i = 0; i < 16; ++i) { v1[i] = unmono(wl[i] & ~127u); v2[i] = unmono(wl[16 + i] & ~127u); }
        unsigned ck[13];
#pragma unroll
        for (int sidx = 0; sidx < 13; ++sidx) {
            unsigned keyk[4];
#pragma unroll
            for (int k = 0; k < 4; ++k) {
                const int c = 4 * sidx + k;
                if (c < 50) { const int ci = cand_i(c), cj = cand_j(c); keyk[k] = (mono(v1[ci] + v2[cj]) & ~255u) | (unsigned)(255 - (ci * 16 + cj)); }
                else keyk[k] = 0u;
            }
            ck[sidx] = fq == 0 ? keyk[0] : fq == 1 ? keyk[1] : fq == 2 ? keyk[2] : keyk[3];
        }
        {
            unsigned prev = 0xFFFFFFFFu;
#pragma unroll 1
            for (int k = 0; k < 16; ++k) {
                unsigned mx = 0u;
#pragma unroll
                for (int sidx = 0; sidx < 13; ++sidx) { const unsigned x = ck[sidx] < prev ? ck[sidx] : 0u; mx = umax_(mx, x); }
                mx = umax_(mx, (unsigned)__shfl_xor((int)mx, 16)); mx = umax_(mx, (unsigned)__shfl_xor((int)mx, 32));
                if (fq == 0) wl[32 + k] = mx;
                prev = mx;
            }
        }
        __syncthreads();
        {
            const float vmax = unmono(wl[32] & ~255u);
            float esum = 0.f;
#pragma unroll
            for (int k = 0; k < 16; ++k) esum += __expf(unmono(wl[32 + k] & ~255u) - vmax);
            const float einv = 1.0f / esum;
#pragma unroll
            for (int kk = 0; kk < 4; ++kk) {
                const int k = fq * 4 + kk;
                const unsigned W = wl[32 + k];
                const unsigned id = 255u - (W & 255u);
                const unsigned e1 = 127u - (wl[id >> 4] & 127u), e2 = 127u - (wl[16 + (id & 15u)] & 127u);
                const size_t o = ((size_t)tok * 8 + h) * 16 + k;
                const unsigned ex = e1 * 128u + e2;
                sel_e[o] = (int)ex; sel_g[o] = __expf(unmono(W & ~255u) - vmax) * einv * SV[ex]; sel_su[o] = SU[ex];
            }
        }
        __syncthreads();
    }
}
__device__ __forceinline__ int row16_sum_i(int v) {
    v += __builtin_amdgcn_update_dpp(0, v, 0xB1, 0xF, 0xF, true);
    v += __builtin_amdgcn_update_dpp(0, v, 0x4E, 0xF, 0xF, true);
    v += __builtin_amdgcn_update_dpp(0, v, 0x141, 0xF, 0xF, true);
    v += __builtin_amdgcn_update_dpp(0, v, 0x140, 0xF, 0xF, true);
    return v;
}
__device__ __forceinline__ int dot16_i8(const u32x4 a, const u32x4 x) {
    int d = __builtin_amdgcn_sdot4((int)a.x, (int)x.x, 0, false); d = __builtin_amdgcn_sdot4((int)a.y, (int)x.y, d, false);
    d = __builtin_amdgcn_sdot4((int)a.z, (int)x.z, d, false); return __builtin_amdgcn_sdot4((int)a.w, (int)x.w, d, false);
}
__device__ __forceinline__ void peer_u_phase(LAS unsigned char* lds, const unsigned char* UQs, const unsigned char* XQs, const int* sel_e, int* pd, int xi, int nx, int rank, int nloc) {
    const int lane = threadIdx.x & 63, wid = threadIdx.x >> 6, r = lane >> 4, i = lane & 15;
    LAS int* esb = (LAS int*)(lds + wid * 2048);
    const int wx = rank * NWAVES + wid, nwx = nloc * NWAVES;
    if (wx >= S_) return;
    const int NT = (S_ - wx + nwx - 1) / nwx;
    for (int j = xi; j < 8; j += nx) {
        const unsigned char* Uj = UQs + (size_t)j * 16384 * 256; const unsigned li = 16u * (unsigned)i;
        const unsigned char* Xj = XQs + (size_t)j * S_ * 256 + 16 * i;
        u32x4 A[16], B[16];
        int ma, mb; u32x4 xc, xn;
        {
            const int t0 = wx, t1 = (NT > 1) ? wx + nwx : wx;
            ma = sel_e[(size_t)t0 * 128 + lane]; mb = sel_e[(size_t)t0 * 128 + 64 + lane]; xc = *(const u32x4*)(Xj + (size_t)t0 * 256);
            esb[lane] = ma; esb[64 + lane] = mb;
            asm volatile("" ::: "memory");
#pragma unroll
            for (int it = 0; it < 16; ++it) A[it] = *(const u32x4*)(Uj + ((unsigned)esb[4 * it + r] * 256u + li));
#pragma unroll
            for (int it = 0; it < 16; ++it) B[it] = *(const u32x4*)(Uj + ((unsigned)esb[64 + 4 * it + r] * 256u + li));
            ma = sel_e[(size_t)t1 * 128 + lane]; mb = sel_e[(size_t)t1 * 128 + 64 + lane]; xn = *(const u32x4*)(Xj + (size_t)t1 * 256);
        }
        for (int n = 0; n < NT; ++n) {
            const int t = wx + n * nwx;
            const int t2 = (n + 2 < NT) ? t + 2 * nwx : t;
            LAS int* esn = esb + ((n + 1) & 1) * 128;
            esn[lane] = ma; esn[64 + lane] = mb;
            const u32x4 xnn = xn;
            asm volatile("" ::: "memory");
            ma = sel_e[(size_t)t2 * 128 + lane]; mb = sel_e[(size_t)t2 * 128 + 64 + lane]; xn = *(const u32x4*)(Xj + (size_t)t2 * 256);
            int keepA = 0, keepB = 0;
#pragma unroll
            for (int it = 0; it < 16; ++it) { const int d = row16_sum_i(dot16_i8(A[it], xc)); keepA = (i == it) ? d : keepA; }
            asm volatile("" : "+v"(keepA) :: "memory");
#pragma unroll
            for (int it = 0; it < 16; ++it) A[it] = *(const u32x4*)(Uj + ((unsigned)esn[4 * it + r] * 256u + li));
            asm volatile("" ::: "memory");
#pragma unroll
            for (int it = 0; it < 16; ++it) { const int d = row16_sum_i(dot16_i8(B[it], xc)); keepB = (i == it) ? d : keepB; }
            asm volatile("" : "+v"(keepB) :: "memory");
#pragma unroll
            for (int it = 0; it < 16; ++it) B[it] = *(const u32x4*)(Uj + ((unsigned)esn[64 + 4 * it + r] * 256u + li));
            asm volatile("" ::: "memory");
            int* pp = pd + ((size_t)t * 8 + j) * 128 + 4 * i + r;
            pp[0] = keepA; pp[64] = keepB;
            xc = xnn;
        }
    }
}
typedef float f32x2 __attribute__((ext_vector_type(2)));
__device__ __forceinline__ void acc16_fp8(f32x2 (&acc)[8], const u32x4 v, float c) {
    const int w[4] = {(int)v.x, (int)v.y, (int)v.z, (int)v.w};
    const f32x2 cc = {c, c};
#pragma unroll
    for (int q = 0; q < 4; ++q) {
        const f32x2 lo = __builtin_amdgcn_cvt_pk_f32_fp8(w[q], false), hi = __builtin_amdgcn_cvt_pk_f32_fp8(w[q], true);
        acc[2 * q] = __builtin_elementwise_fma(cc, lo, acc[2 * q]); acc[2 * q + 1] = __builtin_elementwise_fma(cc, hi, acc[2 * q + 1]);
    }
}
__device__ __forceinline__ void peer_coef_phase(const float* sel_g, const float* sel_su, const int* pd, const float* SX, float* coef, int G, int b) {
    const int lane = threadIdx.x & 63, wid = threadIdx.x >> 6;
    const int gw = b * NWAVES + wid, NGW = G * NWAVES;
    for (int t = gw; t < S_; t += NGW) {
        const float* gp = sel_g + (size_t)t * 128 + lane; const float* up = sel_su + (size_t)t * 128 + lane; const int* pp = pd + (size_t)t * 1024 + lane;
        const float sxt = SX[t];
#pragma unroll
        for (int hh = 0; hh < 2; ++hh) {
            int ds = 0;
#pragma unroll
            for (int jj = 0; jj < 8; ++jj) ds += pp[jj * 128 + 64 * hh];
            coef[(size_t)t * 128 + 64 * hh + lane] = gp[64 * hh] * gelu_tanh((float)ds * (up[64 * hh] * sxt));
        }
    }
}
struct PeerMeta { int e[2]; float c[2]; };
__device__ __forceinline__ void peer_meta_load(PeerMeta& m, const int* sel_e, const float* coef, int t, int lane) {
    const int* ep = sel_e + (size_t)t * 128 + lane; const float* cp = coef + (size_t)t * 128 + lane;
    m.e[0] = ep[0]; m.e[1] = ep[64]; m.c[0] = cp[0]; m.c[1] = cp[64];
}
template <int STRIP>
__device__ __forceinline__ void peer_v_phase(LAS unsigned char* lds, const unsigned char* VQs, const int* sel_e, const float* coef,
                                             bf16_t* zs, int xi, int nx, int rank, int nloc) {
    const int lane = threadIdx.x & 63, wid = threadIdx.x >> 6, r = lane >> 4, i = lane & 15;
    LAS int* esb = (LAS int*)(lds + wid * 2048); LAS float* csb = (LAS float*)(lds + wid * 2048 + 1024);
    const int wx = rank * NWAVES + wid, nwx = nloc * NWAVES;
    if (wx >= S_) return;
    const int NT = (S_ - wx + nwx - 1) / nwx;
    for (int j = xi; j < 8; j += nx) {
        const unsigned char* Vj = VQs + (size_t)j * 16384 * 256; const unsigned li = 16u * (unsigned)i;
        u32x4 A[16], B[16];
        PeerMeta m;
        {
            peer_meta_load(m, sel_e, coef, wx, lane);
#pragma unroll
            for (int hh = 0; hh < 2; ++hh) { const int k = 64 * hh + lane; esb[k] = m.e[hh]; csb[k] = m.c[hh]; }
            asm volatile("" ::: "memory");
#pragma unroll
            for (int it = 0; it < 16; ++it) A[it] = *(const u32x4*)(Vj + ((unsigned)esb[4 * it + r] * 256u + li));
#pragma unroll
            for (int it = 0; it < 16; ++it) B[it] = *(const u32x4*)(Vj + ((unsigned)esb[64 + 4 * it + r] * 256u + li));
            peer_meta_load(m, sel_e, coef, (NT > 1) ? wx + nwx : wx, lane);
        }
        for (int n = 0; n < NT; ++n) {
            const int t = wx + n * nwx;
            const int t2 = (n + 2 < NT) ? t + 2 * nwx : t;
            LAS int* esn = esb + ((n + 1) & 1) * 128; LAS float* csn = csb + ((n + 1) & 1) * 128;
            const LAS float* csc = csb + (n & 1) * 128;
            esn[lane] = m.e[0]; esn[64 + lane] = m.e[1];
            asm volatile("" ::: "memory");
            f32x2 acc2[8];
#pragma unroll
            for (int q = 0; q < 8; ++q) acc2[q] = (f32x2){0.f, 0.f};
#pragma unroll
            for (int it = 0; it < 16; ++it) { if (STRIP == 1) { acc2[it & 7].x += __uint_as_float(A[it].x ^ A[it].y ^ A[it].z ^ A[it].w) * csc[4 * it + r]; } else acc16_fp8(acc2, A[it], csc[4 * it + r]); }
            asm volatile("" : "+v"(acc2[0]), "+v"(acc2[1]), "+v"(acc2[2]), "+v"(acc2[3]), "+v"(acc2[4]), "+v"(acc2[5]), "+v"(acc2[6]), "+v"(acc2[7]) :: "memory");
#pragma unroll
            for (int it = 0; it < 16; ++it) A[it] = *(const u32x4*)(Vj + ((unsigned)esn[4 * it + r] * 256u + li));
            asm volatile("" ::: "memory");
#pragma unroll
            for (int it = 0; it < 16; ++it) { if (STRIP == 1) { acc2[it & 7].y += __uint_as_float(B[it].x ^ B[it].y ^ B[it].z ^ B[it].w) * csc[64 + 4 * it + r]; } else acc16_fp8(acc2, B[it], csc[64 + 4 * it + r]); }
            asm volatile("" : "+v"(acc2[0]), "+v"(acc2[1]), "+v"(acc2[2]), "+v"(acc2[3]), "+v"(acc2[4]), "+v"(acc2[5]), "+v"(acc2[6]), "+v"(acc2[7]) :: "memory");
#pragma unroll
            for (int it = 0; it < 16; ++it) B[it] = *(const u32x4*)(Vj + ((unsigned)esn[64 + 4 * it + r] * 256u + li));
            asm volatile("" ::: "memory");
            csn[lane] = m.c[0]; csn[64 + lane] = m.c[1];
            peer_meta_load(m, sel_e, coef, t2, lane);
            float acc[16];
#pragma unroll
            for (int q = 0; q < 8; ++q) { acc[2 * q] = acc2[q].x; acc[2 * q + 1] = acc2[q].y; }
#pragma unroll
            for (int q = 0; q < 16; ++q) { float a = acc[q]; a += __shfl_xor(a, 16); a += __shfl_xor(a, 32); acc[q] = a; }
            if (r == 0) {
                bf16_t* zp = zs + (size_t)t * D_ + 256 * j + 16 * i;
                *(u32x4*)zp = (u32x4){pk2(acc[0], acc[1]), pk2(acc[2], acc[3]), pk2(acc[4], acc[5]), pk2(acc[6], acc[7])};
                *(u32x4*)(zp + 8) = (u32x4){pk2(acc[8], acc[9]), pk2(acc[10], acc[11]), pk2(acc[12], acc[13]), pk2(acc[14], acc[15])};
            }
            asm volatile("" ::: "memory");
        }
    }
}
__device__ __forceinline__ void ln2_phase(const bf16_t* h1b, const bf16_t* zs, float* out, const float* gam, const float* bet, int G, int b) {
    const int lane = threadIdx.x & 63, wid = threadIdx.x >> 6;
    const int gw = b * NWAVES + wid, NGW = G * NWAVES;
    for (int row = gw; row < S_; row += NGW) {
        f32x4 v[8]; float sum = 0.f;
#pragma unroll
        for (int j = 0; j < 8; ++j) {
            const u32x2 hw = *(const u32x2*)(h1b + (size_t)row * D_ + 256 * j + 4 * lane), zw = *(const u32x2*)(zs + (size_t)row * D_ + 256 * j + 4 * lane);
            v[j] = (f32x4){DN_ALPHA * bflo(hw.x) + bflo(zw.x), DN_ALPHA * bfhi(hw.x) + bfhi(zw.x), DN_ALPHA * bflo(hw.y) + bflo(zw.y), DN_ALPHA * bfhi(hw.y) + bfhi(zw.y)};
            sum += (v[j].x + v[j].y) + (v[j].z + v[j].w);
        }
        const float mean = wave_sum(sum) * (1.0f / D_); float sq = 0.f;
#pragma unroll
        for (int j = 0; j < 8; ++j) { v[j] = v[j] - mean; sq += (v[j].x * v[j].x + v[j].y * v[j].y) + (v[j].z * v[j].z + v[j].w * v[j].w); }
        const float rstd = 1.0f / sqrtf(wave_sum(sq) * (1.0f / D_) + LN_EPS);
#pragma unroll
        for (int j = 0; j < 8; ++j) {
            const f32x4 gg = *(const f32x4*)(gam + 256 * j + 4 * lane), bb = *(const f32x4*)(bet + 256 * j + 4 * lane);
            *(f32x4*)(out + (size_t)row * D_ + 256 * j + 4 * lane) = v[j] * rstd * gg + bb;
        }
    }
}
#ifndef PROBE_PHASE
#define PROBE_PHASE -1
#endif
constexpr int LDSCTL_OFF = 163328, MISC_OFF = LDSCTL_OFF;
constexpr int CW_BAR = 1024;
constexpr size_t CTL_ZERO_BYTES = 64 * 1024;
static_assert((CW_BAR + XCD_BAR_WORDS) * 4 <= (int)CTL_ZERO_BYTES && MISC_OFF + 128 <= LDS_BYTES, "control words");

__global__ void __launch_bounds__(NTHREADS, 2) mega_fwd(Ptrs P) {
    extern __shared__ __attribute__((aligned(16))) unsigned char lds_raw[];
    LAS unsigned char* lds = (LAS unsigned char*)lds_raw;
    unsigned char* ws = P.ws;
    const int G = gridDim.x, b = blockIdx.x;
    for (int u = threadIdx.x; u < (LDS_BYTES - LDSCTL_OFF) / 4; u += NTHREADS) ((LAS unsigned*)(lds + LDSCTL_OFF))[u] = 0u;
    __syncthreads();
    volatile LAS unsigned* MISC = (volatile LAS unsigned*)(lds + MISC_OFF);
    XcdBarrier bar; bar.bar = (unsigned*)(ws + WS_CTL) + CW_BAR; bar.x = xb_xcc_id(); bar.st = MISC + 8;
    if (threadIdx.x == 0) MISC[10] = xb_add(&bar.bar[XB_XCNT(bar.x)], 1u);

    bf16_t* const proj = (bf16_t*)(ws + WS_PROJ); bf16_t* const kvs = (bf16_t*)(ws + WS_KVS); bf16_t* const ycat = (bf16_t*)(ws + WS_YCAT);
    const float* const cosT = (const float*)(ws + WS_COS); const float* const sinT = (const float*)(ws + WS_SIN);
    float* const sumA = (float*)(ws + WS_SUMA); float* const sumH = (float*)(ws + WS_SUMH); float* const Hin = (float*)(ws + WS_HIN);
    const bf16_t* const wraT = (const bf16_t*)(ws + WS_WRA_T); const bf16_t* const wriT = (const bf16_t*)(ws + WS_WRI_T);

#define NREP(k) ((PROBE_PHASE == (k)) ? 2 : 1)
    for (int r_ = 0; r_ < NREP(0); ++r_) { prologue_phase(lds, P, G, b); xcd_barrier(bar); }
    if (threadIdx.x == 0) { unsigned xi_ = 0; for (unsigned jx = 0; jx < bar.x; ++jx) xi_ += xb_ld(&bar.bar[XB_XCNT(jx)]) > 0u ? 1u : 0u; MISC[11] = xi_; }
    __syncthreads();
    const int x_nloc = __builtin_amdgcn_readfirstlane((int)MISC[8]), x_nx = __builtin_amdgcn_readfirstlane((int)MISC[9]), x_rank = __builtin_amdgcn_readfirstlane((int)MISC[10]), x_xi = __builtin_amdgcn_readfirstlane((int)MISC[11]);
#define RUN_P1 { pg8::Gemm g{(const pg8::bf16_t*)(ws + WS_XB), (const pg8::bf16_t*)(ws + WS_WIN_T), S_, INC, D_}; \
        pg8::StaticOrder S; S.init(S_, INC, G, b); \
        pg8::EpiBf16<0> E{(pg8::bf16_t*)proj, INC, nullptr, 0, 0, 1.f}; \
        pg8::gemm_phase<pg8::EpiBf16<0>, pg8::StaticOrder, true, true>(lds, g, S, E); \
        xcd_barrier(bar); }
    RUN_P1
#if PROBE_PHASE == 1
    RUN_P1
#endif
    for (int r2_ = 0; r2_ < NREP(22); ++r2_) {
    for (int r_ = 0; r_ < NREP(2); ++r_) { ret_kv_phase(lds, proj, cosT, sinT, kvs, G, b); xcd_barrier(bar); }
    for (int r_ = 0; r_ < NREP(3); ++r_) { lru_phase<0>(lds, proj, P, wraT, wriT, sumA, sumH, Hin, ycat, G, b); xcd_barrier(bar); }
    scan_phase(kvs, sumA, sumH, Hin, G, b);
    xcd_barrier(bar);
    }
    for (int r_ = 0; r_ < NREP(4); ++r_) { ret_out_phase(lds, proj, cosT, sinT, kvs, ycat, G, b); xcd_barrier(bar); }
    for (int r_ = 0; r_ < NREP(5); ++r_) { lru_phase<1>(lds, proj, P, wraT, wriT, sumA, sumH, Hin, ycat, G, b); xcd_barrier(bar); }
#define RUN_P3 { pg8::Gemm g{(const pg8::bf16_t*)ycat, (const pg8::bf16_t*)(ws + WS_WOUT_T), S_, D_, D_}; \
        pg8::StaticOrder S; S.init(S_, D_, G, b); \
        pg8::EpiResF32 E{P.x, P.out, D_, DN_ALPHA}; \
        pg8::gemm_phase<pg8::EpiResF32, pg8::StaticOrder, true, true>(lds, g, S, E); \
        xcd_barrier(bar); }
    RUN_P3
#if PROBE_PHASE == 6
    RUN_P3
#endif
    ln1_phase(P.out, (bf16_t*)(ws + WS_H1B), (unsigned*)(ws + WS_XQ), (float*)(ws + WS_SX), P.ln1_g, P.ln1_b, G, b);
    xcd_barrier(bar);
#if PROBE_PHASE == 66
    RUN_P3
    ln1_phase(P.out, (bf16_t*)(ws + WS_H1B), (unsigned*)(ws + WS_XQ), (float*)(ws + WS_SX), P.ln1_g, P.ln1_b, G, b);
    xcd_barrier(bar);
#endif
#define RUN_P5 { pg8::Gemm g{(const pg8::bf16_t*)(ws + WS_H1B), (const pg8::bf16_t*)(ws + WS_WPQ_T), S_, D_, D_}; \
        pg8::StaticOrder S; S.init(S_, D_, G, b); \
        pg8::EpiBf16<0> E{(pg8::bf16_t*)(ws + WS_QP), D_, nullptr, 0, 0, 1.f}; \
        pg8::gemm_phase<pg8::EpiBf16<0>, pg8::StaticOrder, true, true>(lds, g, S, E); \
        xcd_barrier(bar); }
    RUN_P5
#if PROBE_PHASE == 7
    RUN_P5
#endif
    for (int r_ = 0; r_ < NREP(8); ++r_) { topk_phase(lds, (const bf16_t*)(ws + WS_QP), (const bf16_t*)(ws + WS_KEYS), (const float*)(ws + WS_SU), (const float*)(ws + WS_SV), (int*)(ws + WS_SELE), (float*)(ws + WS_SELG), (float*)(ws + WS_SELU), G, b); xcd_barrier(bar); }
    for (int r_ = 0; r_ < NREP(9); ++r_) { peer_u_phase(lds, (const unsigned char*)(ws + WS_UQ), (const unsigned char*)(ws + WS_XQ), (const int*)(ws + WS_SELE), (int*)(ws + WS_PD), x_xi, x_nx, x_rank, x_nloc); xcd_barrier(bar); }
    for (int r_ = 0; r_ < NREP(13); ++r_) { peer_coef_phase((const float*)(ws + WS_SELG), (const float*)(ws + WS_SELU), (const int*)(ws + WS_PD), (const float*)(ws + WS_SX), (float*)(ws + WS_COEF), G, b); xcd_barrier(bar); }
    for (int r_ = 0; r_ < NREP(10); ++r_) { peer_v_phase<0>(lds, (const unsigned char*)(ws + WS_VQ), (const int*)(ws + WS_SELE), (const float*)(ws + WS_COEF),
                     (bf16_t*)(ws + WS_ZS), x_xi, x_nx, x_rank, x_nloc); xcd_barrier(bar); }
#if PROBE_PHASE == 12
    peer_v_phase<1>(lds, (const unsigned char*)(ws + WS_VQ), (const int*)(ws + WS_SELE), (const float*)(ws + WS_COEF),
                     (bf16_t*)(ws + 248 * MiB), x_xi, x_nx, x_rank, x_nloc); xcd_barrier(bar);
#endif
    for (int r_ = 0; r_ < NREP(11); ++r_) ln2_phase((const bf16_t*)(ws + WS_H1B), (const bf16_t*)(ws + WS_ZS), P.out, P.ln2_g, P.ln2_b, G, b);
}

extern "C" void kernel_launch(void* const* d_in, const int* in_sizes, int n_in, void* d_out, int out_size, void* d_ws, size_t ws_size, hipStream_t stream) {
    static int grid = 0;
    if (grid == 0) {
        if (n_in != 19 || in_sizes[0] != S_ * D_ || out_size != S_ * D_ || ws_size < WS_END) {
            fprintf(stderr, "kernel_launch: unexpected shapes: n_in %d in0 %d out %d ws %zu (need >= %zu)\n", n_in, n_in > 0 ? in_sizes[0] : -1, out_size, ws_size, (size_t)WS_END); grid = -1; return; }
        int dev = 0, cus = 0, per_cu = 0;
        if (hipGetDevice(&dev) != hipSuccess || hipDeviceGetAttribute(&cus, hipDeviceAttributeMultiprocessorCount, dev) != hipSuccess) { grid = -1; return; }
        if (hipFuncSetAttribute((const void*)mega_fwd, hipFuncAttributeMaxDynamicSharedMemorySize, LDS_BYTES) != hipSuccess) { fprintf(stderr, "kernel_launch: hipFuncSetAttribute failed\n"); grid = -1; return; }
        if (hipOccupancyMaxActiveBlocksPerMultiprocessor(&per_cu, (const void*)mega_fwd, NTHREADS, LDS_BYTES) != hipSuccess || per_cu < 1) {
            fprintf(stderr, "kernel_launch: occupancy query reports %d workgroups per CU; nothing launched\n", per_cu); (void)hipGetLastError(); grid = -1; return; }
        grid = cus;
    }
    if (grid < 0) return;
    Ptrs P{};
    P.x = (const float*)d_in[0]; P.pos = (const int*)d_in[1]; P.w_in = (const float*)d_in[2]; P.w_out = (const float*)d_in[3]; P.conv_w = (const float*)d_in[4]; P.conv_b = (const float*)d_in[5];
    P.w_ra = (const float*)d_in[6]; P.b_ra = (const float*)d_in[7]; P.w_ri = (const float*)d_in[8]; P.b_ri = (const float*)d_in[9]; P.lam = (const float*)d_in[10];
    P.ln1_g = (const float*)d_in[11]; P.ln1_b = (const float*)d_in[12]; P.w_pq = (const float*)d_in[13]; P.sub_keys = (const float*)d_in[14]; P.peer_u = (const float*)d_in[15]; P.peer_v = (const float*)d_in[16];
    P.ln2_g = (const float*)d_in[17]; P.ln2_b = (const float*)d_in[18]; P.out = (float*)d_out; P.ws = (unsigned char*)d_ws;
    if (hipMemsetAsync((char*)d_ws + WS_CTL, 0, CTL_ZERO_BYTES, stream) != hipSuccess) { fprintf(stderr, "kernel_launch: hipMemsetAsync failed\n"); return; }
    void* args[] = {&P};
    const hipError_t e = hipLaunchCooperativeKernel((const void*)mega_fwd, dim3(grid), dim3(NTHREADS), args, LDS_BYTES, stream);
    if (e != hipSuccess) fprintf(stderr, "kernel_launch: cooperative launch failed: %s (grid %d)\n", hipGetErrorString(e), grid);
}
```

```cpp
#include <hip/hip_runtime.h>
#include <cstdio>
#include <cstdint>
#include <cmath>

namespace pg8 {
#define PG8_LAS __attribute__((address_space(3)))
typedef unsigned short bf16_t;
typedef short bf16x8 __attribute__((ext_vector_type(8)));
typedef float f32x4 __attribute__((ext_vector_type(4)));
typedef unsigned u32x4 __attribute__((ext_vector_type(4)));
constexpr int BM = 256, BK = 64, HALF = 128, HTB = HALF * BK * 2  , STAGE_BYTES = 8 * HTB, NXCD = 8, WGM = 8;

__host__ __device__ __forceinline__ int lds_byte(int r, int c) { const int st = (r >> 4) * 2 + (c >> 5), rr = r & 15, cc = c & 31, ob = rr * 64 + cc * 2; return st * 1024 + (ob ^ (((ob >> 9) & 1) << 5)); }
__host__ __device__ __forceinline__ void stage_rc(int b, int& R, int& C) { const int st = b / 1024, sb = b % 1024, swz = sb ^ (((sb >> 9) & 1) << 5); R = (st >> 1) * 16 + swz / 64; C = (st & 1) * 32 + (swz % 64) / 2; }
__host__ __device__ __forceinline__ int perm32(int rho) { const int n = rho >> 4, i = rho & 15; return 8 * (i >> 2) + 4 * n + (i & 3); }

struct Unit { int pm, pn; };
struct Gemm { const bf16_t* A; const bf16_t* Bt; int M, N, K; };

struct StaticOrder {
    int nM, nN, nwg, G, c;
    __host__ __device__ void init(int M, int N, int G_, int c_) { nM = M / BM; nN = N / BM; nwg = nM * nN; G = G_; c = c_; }
    __host__ __device__ bool next(int i, Unit& u) const {
        const long L = (long)i * G + c; if (L >= nwg) return false;
        int wgid = (int)L; { const int q = nwg / NXCD, r = nwg % NXCD, xcd = wgid % NXCD, off = wgid / NXCD; wgid = (xcd < r ? xcd * (q + 1) : r * (q + 1) + (xcd - r) * q) + off; }
        const int nig = WGM * nN, gid = wgid / nig, fm = gid * WGM, gsz = (nM - fm) < WGM ? (nM - fm) : WGM;
        u.pm = fm + ((wgid % nig) % gsz); u.pn = (wgid % nig) / gsz; return true;
    }
    __device__ __forceinline__ void a_ready(const Unit&) const {}
    __device__ __forceinline__ void done(const Unit&) const {}
};

__device__ __forceinline__ unsigned cvt_pk_bf16(float lo, float hi) { unsigned r; asm volatile("v_cvt_pk_bf16_f32 %0, %1, %2" : "=v"(r) : "v"(lo), "v"(hi)); return r; }
typedef float f32x2 __attribute__((ext_vector_type(2)));
__device__ __forceinline__ f32x2 gelu_pk(f32x2 v) {
    const f32x2 av = __builtin_elementwise_abs(v), d = av * 0.2316418882f + 1.0f;
    f32x2 t; t.x = __builtin_amdgcn_rcpf(d.x); t.y = __builtin_amdgcn_rcpf(d.y);
    f32x2 q = t * 0.5307027145f + (-0.7265760135f); q = q * t + 0.7107068705f; q = q * t + (-0.142248368f); q = q * t + 0.127414796f; q = q * t;
    const f32x2 s = (v * v) * (-0.72134752044f);
    f32x2 e; e.x = __builtin_amdgcn_exp2f(s.x); e.y = __builtin_amdgcn_exp2f(s.y);
    const f32x2 m = v * (q * e), r = v - m;
    f32x2 o; o.x = v.x < 0.f ? m.x : r.x; o.y = v.y < 0.f ? m.y : r.y; return o;
}

template <int ACT  > struct EpiBf16 {
    static constexpr bool PERM = true, AFTER_DRAIN = false; static_assert(ACT == 0 || ACT == 1, "EpiBf16: ACT is 0 (none) or 1 (gelu_pk)");
    bf16_t* O; int ldc; const float* bias; int split_cols; size_t split_stride; float scale0;
    __device__ __forceinline__ void operator()(const f32x4 (&acc)[2][2][4][2], const Unit& u, int wr, int wc, int fr, int fq) const {
        const int row0 = u.pm * BM + wr * 64 + fr; int colt = u.pn * BM; bf16_t* base = O;
        float sc = 1.f; if (split_cols) { const int t = colt / split_cols; base += (size_t)t * split_stride; colt -= t * split_cols; if (t == 0) sc = scale0; }
        const int col0 = colt + wc * 32 + 8 * fq, bcol0 = u.pn * BM + wc * 32 + 8 * fq;
        f32x4 bv[2][2];
#pragma unroll
        for (int bj = 0; bj < 2; ++bj)
#pragma unroll
            for (int n = 0; n < 2; ++n) bv[bj][n] = bias ? *(const f32x4*)(bias + bcol0 + bj * HALF + 4 * n) : (f32x4){0.f, 0.f, 0.f, 0.f};
#pragma unroll
        for (int ai = 0; ai < 2; ++ai)
#pragma unroll
            for (int m = 0; m < 4; ++m) { bf16_t* rowp = base + (size_t)(row0 + ai * HALF + m * 16) * ldc + col0;
#pragma unroll
                for (int bj = 0; bj < 2; ++bj) { f32x4 v0 = acc[ai][bj][m][0] + bv[bj][0], v1 = acc[ai][bj][m][1] + bv[bj][1];
                    if (ACT == 1) { f32x2 a = gelu_pk((f32x2){v0[0], v0[1]}), b = gelu_pk((f32x2){v0[2], v0[3]}), c = gelu_pk((f32x2){v1[0], v1[1]}), d = gelu_pk((f32x2){v1[2], v1[3]});
                        v0 = (f32x4){a.x, a.y, b.x, b.y}; v1 = (f32x4){c.x, c.y, d.x, d.y}; }
                    v0 = v0 * sc; v1 = v1 * sc; u32x4 w; w.x = cvt_pk_bf16(v0[0], v0[1]); w.y = cvt_pk_bf16(v0[2], v0[3]); w.z = cvt_pk_bf16(v1[0], v1[1]); w.w = cvt_pk_bf16(v1[2], v1[3]);
                    *(u32x4*)(rowp + bj * HALF) = w; } }
    }
};
struct EpiResF32 {
    static constexpr bool PERM = false, AFTER_DRAIN = false;
    const float* base; float* out; int ldc; float alpha;
    __device__ __forceinline__ void operator()(const f32x4 (&acc)[2][2][4][2], const Unit& u, int wr, int wc, int fr, int fq) const {
        const int row0 = u.pm * BM + wr * 64 + fr, col0 = u.pn * BM + wc * 32 + 4 * fq;
#pragma unroll
        for (int ai = 0; ai < 2; ++ai)
#pragma unroll
            for (int m = 0; m < 4; ++m) { const size_t off = (size_t)(row0 + ai * HALF + m * 16) * ldc + col0;
#pragma unroll
                for (int bj = 0; bj < 2; ++bj)
#pragma unroll
                    for (int n = 0; n < 2; ++n) { const f32x4 bs = *(const f32x4*)(base + off + bj * HALF + n * 16); *(f32x4*)(out + off + bj * HALF + n * 16) = bs * alpha + acc[ai][bj][m][n]; }
                asm volatile("" ::: "memory"); }
    }
};

struct EpiResBf16 {
    static constexpr bool PERM = true, AFTER_DRAIN = false;
    const float* base; bf16_t* O; int ldc; float alpha;
    __device__ __forceinline__ void operator()(const f32x4 (&acc)[2][2][4][2], const Unit& u, int wr, int wc, int fr, int fq) const {
        const int row0 = u.pm * BM + wr * 64 + fr, col0 = u.pn * BM + wc * 32 + 8 * fq;
#pragma unroll
        for (int ai = 0; ai < 2; ++ai)
#pragma unroll
            for (int m = 0; m < 4; ++m) { const size_t off = (size_t)(row0 + ai * HALF + m * 16) * ldc + col0;
#pragma unroll
                for (int bj = 0; bj < 2; ++bj) {
                    const f32x4 b0 = *(const f32x4*)(base + off + bj * HALF), b1 = *(const f32x4*)(base + off + bj * HALF + 4);
                    const f32x4 v0 = b0 * alpha + acc[ai][bj][m][0], v1 = b1 * alpha + acc[ai][bj][m][1];
                    u32x4 w; w.x = cvt_pk_bf16(v0[0], v0[1]); w.y = cvt_pk_bf16(v0[2], v0[3]); w.z = cvt_pk_bf16(v1[0], v1[1]); w.w = cvt_pk_bf16(v1[2], v1[3]);
                    *(u32x4*)(O + off + bj * HALF) = w; }
                asm volatile("" ::: "memory"); }
    }
};
template <class Epi, class Sched, bool ALIGN_EPI = false, bool SP2 = false>
__device__ __forceinline__ void gemm_phase(PG8_LAS unsigned char* lds, const Gemm g, const Sched& S, const Epi& E) {
    const int tid = threadIdx.x, wid = __builtin_amdgcn_readfirstlane(tid >> 6), lane = tid & 63, wr = wid >> 2, wc = wid & 3, fr = lane & 15, fq = lane >> 4;
    const int K = g.K, nt = K / BK;
    unsigned voffA[2], voffB[2];
#pragma unroll
    for (int i = 0; i < 2; ++i) { int R, C; stage_rc(tid * 16 + i * 8192, R, C); const int Rb = Epi::PERM ? ((R & ~31) + perm32(R & 31)) : R;
        voffA[i] = (unsigned)(R * K + C) * 2u; voffB[i] = (unsigned)(Rb * K + C) * 2u; }
    const size_t kstep = (size_t)(BK * 2);
    const size_t hstep = (size_t)HALF * K * 2;
    const size_t tstep = 2 * hstep;
    const unsigned ldsw = (unsigned)wid * 1024u;
    const int aoff = lds_byte(wr * 64 + fr, fq * 8), boff = lds_byte(wc * 32 + fr, fq * 8);
#define PG8_SA(b, h) (((b) * 2 + (h)) * HTB)
#define PG8_SB(b, h) ((4 + (b) * 2 + (h)) * HTB)
#define PG8_STAGE(bufoff, gbase, voff) do { _Pragma("unroll") for (int _i = 0; _i < 2; ++_i) \
        __builtin_amdgcn_global_load_lds((const unsigned*)((const char*)(gbase) + (voff)[_i]), (PG8_LAS unsigned*)(lds + (bufoff) + ldsw + _i * 8192), 16, 0, 0); } while (0)
#define PG8_LDA(dst, b, h) do { _Pragma("unroll") for (int m = 0; m < 4; ++m) _Pragma("unroll") for (int k = 0; k < 2; ++k) dst[m][k] = *(const PG8_LAS bf16x8*)(lds + PG8_SA(b, h) + aoff + m * 2048 + k * 1024); } while (0)
#define PG8_LDB(dst, b, h) do { _Pragma("unroll") for (int n = 0; n < 2; ++n) _Pragma("unroll") for (int k = 0; k < 2; ++k) dst[n][k] = *(const PG8_LAS bf16x8*)(lds + PG8_SB(b, h) + boff + n * 2048 + k * 1024); } while (0)
#define PG8_MMA(ai, bj, At, Bt) do { __builtin_amdgcn_s_setprio(1); _Pragma("unroll") for (int m = 0; m < 4; ++m) _Pragma("unroll") for (int n = 0; n < 2; ++n) _Pragma("unroll") for (int k = 0; k < 2; ++k) \
        acc[ai][bj][m][n] = __builtin_amdgcn_mfma_f32_16x16x32_bf16(Bt[n][k], At[m][k], acc[ai][bj][m][n], 0, 0, 0); __builtin_amdgcn_s_setprio(0); } while (0)
#define PG8_WAIT_V(n) asm volatile("s_waitcnt vmcnt(" #n ")" ::: "memory")
#define PG8_WAIT_L(n) asm volatile("s_waitcnt lgkmcnt(" #n ")" ::: "memory")
#define PG8_BAR __builtin_amdgcn_s_barrier()
#define PG8_SCHED __builtin_amdgcn_sched_barrier(0)
    Unit cur, nxt; int ui = 0;
    if (!S.next(0, cur)) return;
    f32x4 acc[2][2][4][2];
#pragma unroll
    for (int a = 0; a < 2; ++a)
#pragma unroll
        for (int b = 0; b < 2; ++b)
#pragma unroll
            for (int m = 0; m < 4; ++m)
#pragma unroll
                for (int n = 0; n < 2; ++n) acc[a][b][m][n] = (f32x4){0.f, 0.f, 0.f, 0.f};
    bf16x8 At[4][2], B0[2][2], B1[2][2];
    const char* cA = (const char*)g.A + (size_t)cur.pm * tstep; const char* cB = (const char*)g.Bt + (size_t)cur.pn * tstep;
    S.a_ready(cur);
    if constexpr (SP2) {
        PG8_STAGE(PG8_SB(0, 0), cB, voffB); PG8_STAGE(PG8_SB(0, 1), cB + hstep, voffB); PG8_STAGE(PG8_SA(0, 0), cA, voffA); PG8_STAGE(PG8_SA(0, 1), cA + hstep, voffA);
        if (wr == 1) PG8_BAR;
        PG8_WAIT_V(2); PG8_BAR;
        PG8_STAGE(PG8_SB(1, 0), cB + kstep, voffB); PG8_STAGE(PG8_SA(1, 0), cA + kstep, voffA); PG8_STAGE(PG8_SB(1, 1), cB + hstep + kstep, voffB);
        PG8_WAIT_V(6); PG8_BAR;
    } else {
        PG8_STAGE(PG8_SB(0, 0), cB, voffB); PG8_STAGE(PG8_SA(0, 0), cA, voffA); PG8_STAGE(PG8_SB(0, 1), cB + hstep, voffB); PG8_STAGE(PG8_SA(0, 1), cA + hstep, voffA);
        if (wr == 1) PG8_BAR;
        PG8_WAIT_V(4); PG8_BAR;
        PG8_STAGE(PG8_SB(1, 0), cB + kstep, voffB); PG8_STAGE(PG8_SA(1, 0), cA + kstep, voffA); PG8_STAGE(PG8_SB(1, 1), cB + hstep + kstep, voffB);
        PG8_WAIT_V(6); PG8_BAR;
    }
    for (;;) {
        const bool has_next = S.next(ui + 1, nxt);
        const char* nA = has_next ? (const char*)g.A + (size_t)nxt.pm * tstep : cA; const char* nB = has_next ? (const char*)g.Bt + (size_t)nxt.pn * tstep : cB;
        for (int t = 0; t < nt; t += 2) {
            const bool last = (t == nt - 2);
            const char* a1 = cA + (size_t)(t + 1) * kstep;
            const char* a2 = last ? nA : cA + (size_t)(t + 2) * kstep; const char* b2 = last ? nB : cB + (size_t)(t + 2) * kstep;
            const char* a3 = a2 + kstep; const char* b3 = b2 + kstep;
            if (last && has_next) S.a_ready(nxt);
            if constexpr (SP2) {
            PG8_LDB(B0, 0, 0); PG8_LDB(B1, 0, 1); PG8_SCHED; PG8_LDA(At, 0, 0); PG8_STAGE(PG8_SA(1, 1), a1 + hstep, voffA);
            PG8_WAIT_V(8); PG8_WAIT_L(0); PG8_BAR; PG8_MMA(0, 0, At, B0); PG8_MMA(0, 1, At, B1); PG8_BAR; PG8_SCHED;
            PG8_LDA(At, 0, 1); PG8_STAGE(PG8_SB(0, 0), b2, voffB); PG8_STAGE(PG8_SB(0, 1), b2 + hstep, voffB); PG8_STAGE(PG8_SA(0, 0), a2, voffA);
            PG8_WAIT_V(8); PG8_WAIT_L(0); PG8_BAR; PG8_MMA(1, 0, At, B0); PG8_MMA(1, 1, At, B1); PG8_BAR; PG8_SCHED;
            PG8_LDB(B0, 1, 0); PG8_LDB(B1, 1, 1); PG8_SCHED; PG8_LDA(At, 1, 0); PG8_STAGE(PG8_SA(0, 1), a2 + hstep, voffA);
            PG8_WAIT_V(8); PG8_WAIT_L(0); PG8_BAR; PG8_MMA(0, 0, At, B0); PG8_MMA(0, 1, At, B1); PG8_BAR; PG8_SCHED;
            PG8_LDA(At, 1, 1); PG8_STAGE(PG8_SB(1, 0), b3, voffB); PG8_STAGE(PG8_SB(1, 1), b3 + hstep, voffB); PG8_STAGE(PG8_SA(1, 0), a3, voffA);
            PG8_WAIT_V(8); PG8_WAIT_L(0); PG8_BAR; PG8_MMA(1, 0, At, B0); PG8_MMA(1, 1, At, B1); PG8_BAR; PG8_SCHED;
            } else {
            PG8_LDB(B0, 0, 0); PG8_SCHED; PG8_LDA(At, 0, 0); PG8_STAGE(PG8_SA(1, 1), a1 + hstep, voffA);
            PG8_WAIT_L(8); PG8_BAR; PG8_WAIT_L(0); PG8_MMA(0, 0, At, B0); PG8_BAR; PG8_SCHED;
            PG8_LDB(B1, 0, 1); PG8_STAGE(PG8_SB(0, 0), b2, voffB);
            PG8_BAR; PG8_WAIT_L(0); PG8_MMA(0, 1, At, B1); PG8_BAR;
            PG8_LDA(At, 0, 1); PG8_STAGE(PG8_SA(0, 0), a2, voffA);
            PG8_BAR; PG8_WAIT_L(0); PG8_MMA(1, 0, At, B0); PG8_BAR; PG8_SCHED;
            PG8_STAGE(PG8_SB(0, 1), b2 + hstep, voffB);
            PG8_WAIT_V(6); PG8_BAR; PG8_MMA(1, 1, At, B1); PG8_BAR;
            PG8_LDB(B0, 1, 0); PG8_SCHED; PG8_LDA(At, 1, 0); PG8_STAGE(PG8_SA(0, 1), a2 + hstep, voffA);
            PG8_WAIT_L(8); PG8_BAR; PG8_WAIT_L(0); PG8_MMA(0, 0, At, B0); PG8_BAR; PG8_SCHED;
            PG8_LDB(B1, 1, 1); PG8_STAGE(PG8_SB(1, 0), b3, voffB);
            PG8_BAR; PG8_WAIT_L(0); PG8_MMA(0, 1, At, B1); PG8_BAR;
            PG8_LDA(At, 1, 1); PG8_STAGE(PG8_SA(1, 0), a3, voffA);
            PG8_BAR; PG8_WAIT_L(0); PG8_MMA(1, 0, At, B0); PG8_BAR; PG8_SCHED;
            PG8_STAGE(PG8_SB(1, 1), b3 + hstep, voffB);
            PG8_WAIT_V(6); PG8_BAR; PG8_MMA(1, 1, At, B1); PG8_BAR;
            }
        }
        if constexpr (ALIGN_EPI) { if (wr == 0) PG8_BAR; }
        if constexpr (!Epi::AFTER_DRAIN) { E(acc, cur, wr, wc, fr, fq); S.done(cur); }
        if (!has_next) break;
#pragma unroll
        for (int a = 0; a < 2; ++a)
#pragma unroll
            for (int b = 0; b < 2; ++b)
#pragma unroll
                for (int m = 0; m < 4; ++m)
#pragma unroll
                    for (int n = 0; n < 2; ++n) acc[a][b][m][n] = (f32x4){0.f, 0.f, 0.f, 0.f};
        cur = nxt; cA = nA; cB = nB; ++ui;
        if constexpr (ALIGN_EPI) { if (wr == 1) PG8_BAR; }
    }
    PG8_WAIT_V(0);
    if constexpr (!ALIGN_EPI) { if (wr == 0) PG8_BAR; }
    PG8_BAR;
    if constexpr (Epi::AFTER_DRAIN) { E.fused(acc, cur, wr, wc, fr, fq, lds, wid, lane); S.done(cur); }
#undef PG8_SA
#undef PG8_SB
#undef PG8_STAGE
#undef PG8_LDA
#undef PG8_LDB
#undef PG8_MMA
#undef PG8_WAIT_V
#undef PG8_WAIT_L
#undef PG8_BAR
#undef PG8_SCHED
}
}
constexpr int S_ = 16384, D_ = 2048, INC = 6144, NH = 8, DH = 128, CH = 64, NCH = 256;
constexpr float DN_ALPHA = 1.189207115002721f;
constexpr float LN_EPS = 1e-5f, GN_EPS = 1e-6f;
constexpr int NWAVES = 8, NTHREADS = 512;
constexpr int LDS_BYTES = 163840;

constexpr size_t MiB = 1u << 20;
constexpr size_t WS_CTL = 0;
constexpr size_t WS_WOUT_T = 1 * MiB, WS_WPQ_T = 9 * MiB, WS_KEYS = 17 * MiB, WS_WRA_T = 17 * MiB + 512 * 1024, WS_WRI_T = 17 * MiB + 768 * 1024;
constexpr size_t WS_COS = 18 * MiB, WS_SIN = 22 * MiB, WS_SUMA = 26 * MiB, WS_SUMH = 27 * MiB, WS_HIN = 28 * MiB;
constexpr size_t WS_SU = 29 * MiB, WS_SV = 30 * MiB;
constexpr size_t WS_SX = 31 * MiB;
constexpr size_t WS_UQ = 32 * MiB, WS_VQ = 64 * MiB;
constexpr size_t WS_XQ = 96 * MiB;
constexpr size_t WS_PD = 328 * MiB, WS_ZS = 392 * MiB;
constexpr size_t WS_WIN_T = 160 * MiB, WS_XB = 184 * MiB, WS_GST = 184 * MiB, WS_H1B = 184 * MiB;
constexpr size_t WS_PROJ = 248 * MiB, WS_QP = 248 * MiB, WS_SELE = 312 * MiB, WS_SELG = 320 * MiB, WS_SELU = 456 * MiB, WS_COEF = 464 * MiB;
constexpr size_t WS_Z1B = 376 * MiB;
constexpr size_t WS_YCAT = 440 * MiB, WS_END = 504 * MiB;

#define LAS __attribute__((address_space(3)))
typedef unsigned short bf16_t;
typedef short bf16x8 __attribute__((ext_vector_type(8)));
typedef float f32x4 __attribute__((ext_vector_type(4)));
typedef unsigned u32x4 __attribute__((ext_vector_type(4)));
typedef unsigned u32x2 __attribute__((ext_vector_type(2)));

__device__ __forceinline__ unsigned f2bf(float f) { unsigned u = __float_as_uint(f); return (u + 0x7fffu + ((u >> 16) & 1u)) >> 16; }
__device__ __forceinline__ unsigned pk2(float lo, float hi) { return f2bf(lo) | (f2bf(hi) << 16); }
__device__ __forceinline__ float bflo(unsigned w) { return __uint_as_float(w << 16); }
__device__ __forceinline__ float bfhi(unsigned w) { return __uint_as_float(w & 0xffff0000u); }
__device__ __forceinline__ float bf2f(bf16_t b) { return __uint_as_float(((unsigned)b) << 16); }
__device__ __forceinline__ f32x4 mfma16(bf16x8 a, bf16x8 b, f32x4 c) { return __builtin_amdgcn_mfma_f32_16x16x32_bf16(a, b, c, 0, 0, 0); }
__device__ __forceinline__ float fexp_(float x) { return __builtin_amdgcn_exp2f(x * 1.4426950408889634f); }
__device__ __forceinline__ float sigmoidf_(float x) { return __builtin_amdgcn_rcpf(1.0f + fexp_(-x)); }
__device__ __forceinline__ float gelu_tanh(float x) { const float y = 0.7978845608028654f * (x + 0.044715f * x * x * x); return x * __builtin_amdgcn_rcpf(1.0f + fexp_(-2.0f * y)); }
__device__ __forceinline__ float wave_sum(float v) {
#pragma unroll
    for (int o = 1; o < 64; o <<= 1) v += __shfl_xor(v, o);
    return v;
}
__device__ __forceinline__ float wave_max(float v) {
#pragma unroll
    for (int o = 1; o < 64; o <<= 1) v = fmaxf(v, __shfl_xor(v, o));
    return v;
}
__device__ __forceinline__ int wave_sum_i(int v) {
#pragma unroll
    for (int o = 1; o < 64; o <<= 1) v += __shfl_xor(v, o);
    return v;
}
__device__ __forceinline__ int phase_tid() { int t = (int)threadIdx.x; asm volatile("" : "+v"(t)); return t; }
__device__ __forceinline__ int phase_wid(int tid) { return __builtin_amdgcn_readfirstlane(tid >> 6); }
__device__ __forceinline__ float head_log_gamma(int h) { return logf(1.0f - exp2f(-5.0f - (float)h)); }

__device__ __forceinline__ void transpose_item(const float* W, int K, int N, bf16_t* WT, LAS float* scr, int item, int lane) {
    const int nblk = N / 32, kb = item / nblk, nb = item % nblk, k0 = 64 * kb, n0 = 32 * nb;
#pragma unroll 8
    for (int i = 0; i < 32; ++i) { const int kk = 2 * i + (lane >> 5); scr[kk * 33 + (lane & 31)] = W[(size_t)(k0 + kk) * N + n0 + (lane & 31)]; }
    asm volatile("s_waitcnt lgkmcnt(0)" ::: "memory");
    const int c = lane & 7;
#pragma unroll
    for (int j = 0; j < 4; ++j) { const int n = (lane >> 3) + 8 * j; const LAS float* s = scr + (8 * c) * 33 + n;
        u32x4 o; o.x = pk2(s[0 * 33], s[1 * 33]); o.y = pk2(s[2 * 33], s[3 * 33]); o.z = pk2(s[4 * 33], s[5 * 33]); o.w = pk2(s[6 * 33], s[7 * 33]);
        *(u32x4*)(WT + (size_t)(n0 + n) * K + k0 + 8 * c) = o; }
    asm volatile("s_waitcnt lgkmcnt(0)" ::: "memory");
}
__device__ __forceinline__ void cvt_stream(const float* src, bf16_t* dst, size_t n8, size_t gtid, size_t gthreads) {
    size_t i = gtid;
    for (; i + 3 * gthreads < n8; i += 4 * gthreads) {
        f32x4 a[4], b[4];
#pragma unroll
        for (int u = 0; u < 4; ++u) { a[u] = __builtin_nontemporal_load((const f32x4*)src + 2 * (i + u * gthreads)); b[u] = __builtin_nontemporal_load((const f32x4*)src + 2 * (i + u * gthreads) + 1); }
#pragma unroll
        for (int u = 0; u < 4; ++u) { u32x4 o; o.x = pk2(a[u].x, a[u].y); o.y = pk2(a[u].z, a[u].w); o.z = pk2(b[u].x, b[u].y); o.w = pk2(b[u].z, b[u].w); ((u32x4*)dst)[i + u * gthreads] = o; }
    }
    for (; i < n8; i += gthreads) {
        const f32x4 a = ((const f32x4*)src)[2 * i], b = ((const f32x4*)src)[2 * i + 1];
        u32x4 o; o.x = pk2(a.x, a.y); o.y = pk2(a.z, a.w); o.z = pk2(b.x, b.y); o.w = pk2(b.z, b.w);
        ((u32x4*)dst)[i] = o;
    }
}
struct Ptrs {
    const float *x; const int* pos; const float *w_in, *w_out, *conv_w, *conv_b, *w_ra, *b_ra, *w_ri, *b_ri, *lam, *ln1_g, *ln1_b, *w_pq, *sub_keys, *peer_u, *peer_v, *ln2_g, *ln2_b;
    float* out; unsigned char* ws;
};
__device__ __forceinline__ void prologue_phase(LAS unsigned char* lds, const Ptrs& P, int G, int b) {
    const int tid = phase_tid(), lane = tid & 63, wid = phase_wid(tid);
    LAS float* scr = (LAS float*)(lds + wid * 16384);
    const int gw = b * NWAVES + wid, NGW = G * NWAVES;
    unsigned char* ws = P.ws;
    constexpr int I_IN = (D_ / 64) * (INC / 32), I_SQ = (D_ / 64) * (D_ / 32), I_G = 2 * 4;
    constexpr int NITEMS = I_IN + 2 * I_SQ + 16 * I_G;
    for (int it = gw; it < NITEMS; it += NGW) {
        int r = it;
        if (r < I_IN) { transpose_item(P.w_in, D_, INC, (bf16_t*)(ws + WS_WIN_T), scr, r, lane); continue; } r -= I_IN;
        if (r < I_SQ) { transpose_item(P.w_out, D_, D_, (bf16_t*)(ws + WS_WOUT_T), scr, r, lane); continue; } r -= I_SQ;
        if (r < I_SQ) { transpose_item(P.w_pq, D_, D_, (bf16_t*)(ws + WS_WPQ_T), scr, r, lane); continue; } r -= I_SQ;
        if (r < 8 * I_G) { const int g = r / I_G; transpose_item(P.w_ra + g * 16384, 128, 128, (bf16_t*)(ws + WS_WRA_T) + g * 16384, scr, r % I_G, lane); continue; } r -= 8 * I_G;
        { const int g = r / I_G; transpose_item(P.w_ri + g * 16384, 128, 128, (bf16_t*)(ws + WS_WRI_T) + g * 16384, scr, r % I_G, lane); }
    }
    const size_t gtid = (size_t)b * NTHREADS + tid, gth = (size_t)G * NTHREADS;
    cvt_stream(P.x, (bf16_t*)(ws + WS_XB), (size_t)S_ * D_ / 8, gtid, gth);
    for (int row = gw; row < 2 * 16384; row += NGW) {
        const int isv = row >> 14, e = row & 16383;
        const float* rp = (isv ? P.peer_v : P.peer_u) + (size_t)e * D_;
        f32x4 v[8]; float amax = 0.f;
#pragma unroll
        for (int j = 0; j < 8; ++j) { v[j] = *(const f32x4*)(rp + 256 * j + 4 * lane); amax = fmaxf(amax, fmaxf(fmaxf(fabsf(v[j].x), fabsf(v[j].y)), fmaxf(fabsf(v[j].z), fabsf(v[j].w)))); }
        amax = wave_max(amax);
        unsigned* qp = (unsigned*)(ws + (isv ? WS_VQ : WS_UQ)) + (size_t)e * 64;
        if (isv) {
            const float inv = amax > 0.f ? 416.0f / amax : 0.f;
            if (lane == 0) ((float*)(ws + WS_SV))[e] = amax * (1.0f / 416.0f);
#pragma unroll
            for (int j = 0; j < 8; ++j) {
                int w = __builtin_amdgcn_cvt_pk_fp8_f32(v[j].x * inv, v[j].y * inv, 0, false);
                w = __builtin_amdgcn_cvt_pk_fp8_f32(v[j].z * inv, v[j].w * inv, w, true);
                qp[(size_t)j * 16384 * 64 + lane] = (unsigned)w;
            }
        } else {
            const float inv = amax > 0.f ? 127.0f / amax : 0.f;
            if (lane == 0) ((float*)(ws + WS_SU))[e] = amax * (1.0f / 127.0f);
#pragma unroll
            for (int j = 0; j < 8; ++j) {
                const int a = (int)rintf(v[j].x * inv), bq = (int)rintf(v[j].y * inv), c = (int)rintf(v[j].z * inv), d = (int)rintf(v[j].w * inv);
                qp[(size_t)j * 16384 * 64 + lane] = (unsigned)(a & 255) | ((unsigned)(bq & 255) << 8) | ((unsigned)(c & 255) << 16) | ((unsigned)(d & 255) << 24);
            }
        }
    }
    cvt_stream(P.sub_keys, (bf16_t*)(ws + WS_KEYS), (size_t)8 * 2 * 128 * 128 / 8, gtid, gth);
    float* cosT = (float*)(ws + WS_COS); float* sinT = (float*)(ws + WS_SIN);
    for (size_t i = gtid; i < (size_t)S_ * 64; i += gth) {
        const int s = (int)(i >> 6), f = (int)(i & 63);
        const float inv = powf(10000.0f, -(float)f / 64.0f);
        const float ang = (float)P.pos[s] * inv;
        float sn, cs; sincosf(ang, &sn, &cs);
        cosT[i] = cs; sinT[i] = sn;
    }
}
#define XB_TMO      128
#define XB_XCNT(j)  (256  + 64 * (j))
#define XB_XSUB(j)  (1280 + 64 * (j))
#define XB_XGEN(j)  (2304 + 64 * (j))
#define XB_TOP      3328
#define XB_TOPGEN   3392
#define XCD_BAR_WORDS 3456
#define XB_SPIN_CAP (1u << 18)

__device__ __forceinline__ unsigned xb_ld(unsigned* p)              { return __hip_atomic_load(p, __ATOMIC_RELAXED, __HIP_MEMORY_SCOPE_AGENT); }
__device__ __forceinline__ unsigned xb_add(unsigned* p, unsigned v) { return __hip_atomic_fetch_add(p, v, __ATOMIC_RELAXED, __HIP_MEMORY_SCOPE_AGENT); }
__device__ __forceinline__ unsigned xb_xcc_id() { return (unsigned)__builtin_amdgcn_s_getreg((3 << 11) | 20) & 0xFu; }
#define XB_SPIN(cond, bar) do { unsigned _sp = 0; while (cond) { __builtin_amdgcn_s_sleep(1); \
    if ((++_sp & 255u) == 0u) { if (xb_ld(&(bar)[XB_TMO])) break; if (_sp > XB_SPIN_CAP) { atomicAdd(&(bar)[XB_TMO], 1u); break; } } } } while (0)

struct XcdBarrier {
    unsigned* bar; unsigned x;
    volatile LAS unsigned* st;
};

__device__ __forceinline__ XcdBarrier xcd_barrier_post(unsigned* bar, volatile LAS unsigned* st) {
    XcdBarrier b; b.bar = bar; b.x = xb_xcc_id(); b.st = st;
    if (threadIdx.x == 0) (void)xb_add(&bar[XB_XCNT(b.x)], 1u);
    return b;
}
__device__ __forceinline__ void xcd_barrier_complete(unsigned* bar, unsigned x, unsigned& nloc, unsigned& nx) {
    const unsigned G = gridDim.x * gridDim.y * gridDim.z;
    unsigned sum, cnt, mine, sp = 0u;
    for (;;) {
        sum = 0u; cnt = 0u; mine = 0u;
#pragma unroll
        for (unsigned j = 0; j < 16; ++j) { const unsigned c = xb_ld(&bar[XB_XCNT(j)]); sum += c; cnt += (c > 0u) ? 1u : 0u; mine = (j == x) ? c : mine; }
        if (sum == G) break;
        __builtin_amdgcn_s_sleep(1);
        if ((++sp & 255u) == 0u) { if (xb_ld(&bar[XB_TMO])) break; if (sp > XB_SPIN_CAP) { atomicAdd(&bar[XB_TMO], 1u); break; } }
    }
    nloc = mine > 0u ? mine : 1u; nx = cnt > 0u ? cnt : 1u;
}

__device__ __forceinline__ void xcd_barrier(const XcdBarrier& b) {
    asm volatile("s_waitcnt vmcnt(0)" ::: "memory");
    __syncthreads();
    if (threadIdx.x == 0) {
        unsigned* bar = b.bar;
        __builtin_amdgcn_s_waitcnt(0);
        unsigned nloc = b.st[0], nx = b.st[1];
        if (nloc == 0u) { xcd_barrier_complete(bar, b.x, nloc, nx); b.st[0] = nloc; b.st[1] = nx; }
        const unsigned old = xb_add(&bar[XB_XSUB(b.x)], 1u);
        const unsigned gen = old / nloc;
        if (old + 1u == (gen + 1u) * nloc) {
            __builtin_amdgcn_fence(__ATOMIC_RELEASE, "agent");
            asm volatile("s_waitcnt vmcnt(0)" ::: "memory");
            const unsigned og = xb_add(&bar[XB_TOP], 1u);
            const unsigned tg = og / nx;
            if (og + 1u == (tg + 1u) * nx) xb_add(&bar[XB_TOPGEN], 1u);
            else XB_SPIN(xb_ld(&bar[XB_TOPGEN]) == tg, bar);
            __builtin_amdgcn_fence(__ATOMIC_ACQUIRE, "agent");
            xb_add(&bar[XB_XGEN(b.x)], 1u);
            asm volatile("s_waitcnt vmcnt(0)" ::: "memory");
        } else {
            XB_SPIN(xb_ld(&bar[XB_XGEN(b.x)]) == gen, bar);
            __builtin_amdgcn_fence(__ATOMIC_ACQUIRE, "agent");
            asm volatile("s_waitcnt vmcnt(0)" ::: "memory");
        }
    }
    __syncthreads();
}
__device__ __forceinline__ void rot8(const u32x4 x1, const u32x4 x2, const float* cp, const float* sp, float scale, float (&o1)[8], float (&o2)[8]) {
    const f32x4 c0 = *(const f32x4*)cp, c1 = *(const f32x4*)(cp + 4), s0 = *(const f32x4*)sp, s1 = *(const f32x4*)(sp + 4);
    const float cs[8] = {c0.x, c0.y, c0.z, c0.w, c1.x, c1.y, c1.z, c1.w}, sn[8] = {s0.x, s0.y, s0.z, s0.w, s1.x, s1.y, s1.z, s1.w};
    const unsigned w1[4] = {x1.x, x1.y, x1.z, x1.w}, w2[4] = {x2.x, x2.y, x2.z, x2.w};
#pragma unroll
    for (int j = 0; j < 8; ++j) {
        const float a = (j & 1) ? bfhi(w1[j >> 1]) : bflo(w1[j >> 1]);
        const float bb = (j & 1) ? bfhi(w2[j >> 1]) : bflo(w2[j >> 1]);
        o1[j] = (a * cs[j] - bb * sn[j]) * scale;
        o2[j] = (bb * cs[j] + a * sn[j]) * scale;
    }
}
struct RetPref { u32x4 q1, q2, k1, k2, v0, v1, g0, g1; f32x4 c0, c1, s0, s1; };
template <bool FULL>
__device__ __forceinline__ void ret_prefetch(RetPref& p, const bf16_t* proj, const float* cosT, const float* sinT, int s, int h, int tq) {
    const bf16_t* base = proj + (size_t)s * INC + h * 128;
    p.k1 = *(const u32x4*)(base + 1024 + tq * 8); p.k2 = *(const u32x4*)(base + 1024 + 64 + tq * 8);
    p.v0 = *(const u32x4*)(base + 2048 + tq * 16); p.v1 = *(const u32x4*)(base + 2048 + tq * 16 + 8);
    const float* cp = cosT + (size_t)s * 64 + tq * 8; const float* sp = sinT + (size_t)s * 64 + tq * 8;
    p.c0 = *(const f32x4*)cp; p.c1 = *(const f32x4*)(cp + 4); p.s0 = *(const f32x4*)sp; p.s1 = *(const f32x4*)(sp + 4);
    if (FULL) { p.q1 = *(const u32x4*)(base + tq * 8); p.q2 = *(const u32x4*)(base + 64 + tq * 8); p.g0 = *(const u32x4*)(base + 3072 + tq * 16); p.g1 = *(const u32x4*)(base + 3072 + tq * 16 + 8); }
}
__device__ __forceinline__ void rot8r(const u32x4 x1, const u32x4 x2, const RetPref& p, float scale, float (&o1)[8], float (&o2)[8]) {
    const float cs[8] = {p.c0.x, p.c0.y, p.c0.z, p.c0.w, p.c1.x, p.c1.y, p.c1.z, p.c1.w}, sn[8] = {p.s0.x, p.s0.y, p.s0.z, p.s0.w, p.s1.x, p.s1.y, p.s1.z, p.s1.w};
    const unsigned w1[4] = {x1.x, x1.y, x1.z, x1.w}, w2[4] = {x2.x, x2.y, x2.z, x2.w};
#pragma unroll
    for (int j = 0; j < 8; ++j) {
        const float a = (j & 1) ? bfhi(w1[j >> 1]) : bflo(w1[j >> 1]);
        const float bb = (j & 1) ? bfhi(w2[j >> 1]) : bflo(w2[j >> 1]);
        o1[j] = (a * cs[j] - bb * sn[j]) * scale;
        o2[j] = (bb * cs[j] + a * sn[j]) * scale;
    }
}
__device__ __forceinline__ void ret_stage_kv(const RetPref& p, LAS bf16_t* KT, LAS bf16_t* VT, int m, int tq, float kdec, float (&k1)[8], float (&k2)[8]) {
    rot8r(p.k1, p.k2, p, 1.0f, k1, k2);
#pragma unroll
    for (int j = 0; j < 8; ++j) { KT[(tq * 8 + j) * 72 + m] = (bf16_t)f2bf(k1[j] * kdec); KT[(64 + tq * 8 + j) * 72 + m] = (bf16_t)f2bf(k2[j] * kdec); }
    const unsigned yw[8] = {p.v0.x, p.v0.y, p.v0.z, p.v0.w, p.v1.x, p.v1.y, p.v1.z, p.v1.w};
#pragma unroll
    for (int j = 0; j < 8; ++j) { VT[(tq * 16 + 2 * j) * 72 + m] = (bf16_t)(yw[j] & 0xffffu); VT[(tq * 16 + 2 * j + 1) * 72 + m] = (bf16_t)(yw[j] >> 16); }
}
__device__ __forceinline__ void ret_state_update(f32x4 (&S)[8], const LAS bf16_t* KT, const LAS bf16_t* VT, float dec, int wid, int fr, int fq) {
#pragma unroll
    for (int tt = 0; tt < 8; ++tt) S[tt] = S[tt] * dec;
#pragma unroll
    for (int ks = 0; ks < 2; ++ks) {
        const bf16x8 bb = *(const LAS bf16x8*)(VT + (wid * 16 + fr) * 72 + ks * 32 + fq * 8);
#pragma unroll
        for (int tt = 0; tt < 8; ++tt) { const bf16x8 a = *(const LAS bf16x8*)(KT + (tt * 16 + fr) * 72 + ks * 32 + fq * 8); S[tt] = mfma16(a, bb, S[tt]); }
    }
}
__device__ __forceinline__ void ret_r1_phase(LAS unsigned char* lds, const bf16_t* proj, const float* cosT, const float* sinT, float* gst, int G, int b) {
    const int tid = phase_tid(), lane = tid & 63, wid = phase_wid(tid), fr = lane & 15, fq = lane >> 4;
    LAS bf16_t* KT = (LAS bf16_t*)lds;
    LAS bf16_t* VT = (LAS bf16_t*)(lds + 18432);
    const int m = tid >> 3, tq = tid & 7;
    for (int unit = b; unit < 32 * NH; unit += G) {
        const int gq = unit >> 3, h = unit & 7;
        const float log_g = head_log_gamma(h), dec = fexp_(64.0f * log_g), kdec = fexp_(log_g * (63.0f - (float)m));
        f32x4 S[8];
#pragma unroll
        for (int tt = 0; tt < 8; ++tt) S[tt] = (f32x4){0.f, 0.f, 0.f, 0.f};
        RetPref pn; ret_prefetch<false>(pn, proj, cosT, sinT, (gq * 8) * 64 + m, h, tq);
        for (int i = 0; i < 8; ++i) {
            float k1[8], k2[8];
            __syncthreads();
            ret_stage_kv(pn, KT, VT, m, tq, kdec, k1, k2);
            if (i + 1 < 8) ret_prefetch<false>(pn, proj, cosT, sinT, (gq * 8 + i + 1) * 64 + m, h, tq);
            __syncthreads();
            ret_state_update(S, KT, VT, dec, wid, fr, fq);
        }
        f32x4* op = (f32x4*)gst + ((size_t)unit * 64 + wid * 8) * 64 + lane;
#pragma unroll
        for (int tt = 0; tt < 8; ++tt) op[tt * 64] = S[tt];
    }
}
__device__ __forceinline__ void scan_phase(float* gst, const float* sumA, const float* sumH, float* Hin, int G, int b) {
    const int gtid = b * NTHREADS + phase_tid(), gth = G * NTHREADS;
    for (int p = gtid; p < 32768; p += gth) {
        const int h = p >> 12;
        const float dec8 = fexp_(512.0f * head_log_gamma(h));
        f32x4* ptr = (f32x4*)gst + p;
        f32x4 s = (f32x4){0.f, 0.f, 0.f, 0.f};
        for (int gq = 0; gq < 32; gq += 8) {
            f32x4 v[8];
#pragma unroll
            for (int j = 0; j < 8; ++j) v[j] = ptr[(size_t)(gq + j) * 32768];
#pragma unroll
            for (int j = 0; j < 8; ++j) { ptr[(size_t)(gq + j) * 32768] = s; s = s * dec8 + v[j]; }
        }
    }
    const int c = gth - 1 - gtid;
    if (c < 1024) {
        float H = 0.f;
        for (int n = 0; n < NCH; n += 8) {
            float a[8], hh[8];
#pragma unroll
            for (int j = 0; j < 8; ++j) { a[j] = sumA[(n + j) * 1024 + c]; hh[j] = sumH[(n + j) * 1024 + c]; }
#pragma unroll
            for (int j = 0; j < 8; ++j) { Hin[(n + j) * 1024 + c] = H; H = a[j] * H + hh[j]; }
        }
    }
}
__device__ __forceinline__ void ret_r3_phase(LAS unsigned char* lds, const bf16_t* proj, const float* cosT, const float* sinT, const float* gst, bf16_t* ycat, int G, int b) {
    const int tid = phase_tid(), lane = tid & 63, wid = phase_wid(tid), fr = lane & 15, fq = lane >> 4;
    LAS bf16_t* QS = (LAS bf16_t*)lds;
    LAS bf16_t* KS = (LAS bf16_t*)(lds + 17408);
    LAS bf16_t* KT = (LAS bf16_t*)(lds + 34816);
    LAS bf16_t* VT = (LAS bf16_t*)(lds + 53248);
    LAS bf16_t* PS = (LAS bf16_t*)(lds + 71680);
    LAS float*  OS = (LAS float*)(lds + 80896);
    const int m = tid >> 3, tq = tid & 7;
    for (int unit = b; unit < 32 * NH; unit += G) {
        const int gq = unit >> 3, h = unit & 7;
        const float log_g = head_log_gamma(h), dec = fexp_(64.0f * log_g), kdec = fexp_(log_g * (63.0f - (float)m));
        f32x4 S[8];
        {   const f32x4* ip = (const f32x4*)gst + ((size_t)unit * 64 + wid * 8) * 64 + lane;
#pragma unroll
            for (int tt = 0; tt < 8; ++tt) S[tt] = ip[tt * 64]; }
        RetPref pn; ret_prefetch<true>(pn, proj, cosT, sinT, (gq * 8) * 64 + m, h, tq);
        for (int i = 0; i < 8; ++i) {
            const int s = (gq * 8 + i) * 64 + m;
            const u32x4 gc0 = pn.g0, gc1 = pn.g1;
            {
                float o1[8], o2[8];
                rot8r(pn.q1, pn.q2, pn, 0.08838834764831845f, o1, o2);
                *(LAS u32x4*)(QS + m * 136 + tq * 8) = (u32x4){pk2(o1[0], o1[1]), pk2(o1[2], o1[3]), pk2(o1[4], o1[5]), pk2(o1[6], o1[7])};
                *(LAS u32x4*)(QS + m * 136 + 64 + tq * 8) = (u32x4){pk2(o2[0], o2[1]), pk2(o2[2], o2[3]), pk2(o2[4], o2[5]), pk2(o2[6], o2[7])};
                ret_stage_kv(pn, KT, VT, m, tq, kdec, o1, o2);
                *(LAS u32x4*)(KS + m * 136 + tq * 8) = (u32x4){pk2(o1[0], o1[1]), pk2(o1[2], o1[3]), pk2(o1[4], o1[5]), pk2(o1[6], o1[7])};
                *(LAS u32x4*)(KS + m * 136 + 64 + tq * 8) = (u32x4){pk2(o2[0], o2[1]), pk2(o2[2], o2[3]), pk2(o2[4], o2[5]), pk2(o2[6], o2[7])};
            }
            if (i + 1 < 8) ret_prefetch<true>(pn, proj, cosT, sinT, s + 64, h, tq);
            __syncthreads();
            f32x4 oacc[4];
            {
                const int ct = wid & 3, mt0 = (wid >> 2) * 2;
                f32x4 sacc[2] = {(f32x4){0.f, 0.f, 0.f, 0.f}, (f32x4){0.f, 0.f, 0.f, 0.f}};
#pragma unroll
                for (int ks = 0; ks < 4; ++ks) {
                    const bf16x8 a = *(const LAS bf16x8*)(QS + (ct * 16 + fr) * 136 + ks * 32 + fq * 8);
#pragma unroll
                    for (int j = 0; j < 2; ++j) { const bf16x8 bb = *(const LAS bf16x8*)(KS + ((mt0 + j) * 16 + fr) * 136 + ks * 32 + fq * 8); sacc[j] = mfma16(a, bb, sacc[j]); }
                }
#pragma unroll
                for (int j = 0; j < 2; ++j)
#pragma unroll
                    for (int r = 0; r < 4; ++r) { const int c = ct * 16 + fq * 4 + r, mm = (mt0 + j) * 16 + fr; const float dd = fabsf((float)(c - mm));
                        PS[c * 72 + mm] = (bf16_t)f2bf(sacc[j][r] * fexp_(log_g * dd)); }
                asm volatile("" ::: "memory");
#pragma unroll
                for (int c4 = 0; c4 < 4; ++c4) oacc[c4] = (f32x4){0.f, 0.f, 0.f, 0.f};
#pragma unroll
                for (int a4 = 0; a4 < 4; ++a4) {
                    u32x4 bw; bw.x = pk2(S[2 * a4][0], S[2 * a4][1]); bw.y = pk2(S[2 * a4][2], S[2 * a4][3]); bw.z = pk2(S[2 * a4 + 1][0], S[2 * a4 + 1][1]); bw.w = pk2(S[2 * a4 + 1][2], S[2 * a4 + 1][3]);
                    const bf16x8 bb = __builtin_bit_cast(bf16x8, bw);
#pragma unroll
                    for (int c4 = 0; c4 < 4; ++c4) {
                        const u32x2 lo = *(const LAS u32x2*)(QS + (c4 * 16 + fr) * 136 + a4 * 32 + fq * 4), hi = *(const LAS u32x2*)(QS + (c4 * 16 + fr) * 136 + a4 * 32 + 16 + fq * 4);
                        const bf16x8 a = __builtin_bit_cast(bf16x8, (u32x4){lo.x, lo.y, hi.x, hi.y});
                        oacc[c4] = mfma16(a, bb, oacc[c4]);
                    }
                    asm volatile("" ::: "memory");
                }
#pragma unroll
                for (int c4 = 0; c4 < 4; ++c4)
#pragma unroll
                    for (int r = 0; r < 4; ++r) oacc[c4][r] *= fexp_(log_g * (float)(c4 * 16 + fq * 4 + r + 1));
            }
            __syncthreads();
            {
#pragma unroll
                for (int ks = 0; ks < 2; ++ks) {
                    const bf16x8 bb = *(const LAS bf16x8*)(VT + (wid * 16 + fr) * 72 + ks * 32 + fq * 8);
#pragma unroll
                    for (int c4 = 0; c4 < 4; ++c4) { const bf16x8 a = *(const LAS bf16x8*)(PS + (c4 * 16 + fr) * 72 + ks * 32 + fq * 8); oacc[c4] = mfma16(a, bb, oacc[c4]); }
                }
#pragma unroll
                for (int c4 = 0; c4 < 4; ++c4)
#pragma unroll
                    for (int r = 0; r < 4; ++r) OS[(c4 * 16 + fq * 4 + r) * 132 + wid * 16 + fr] = oacc[c4][r];
                ret_state_update(S, KT, VT, dec, wid, fr, fq);
            }
            __syncthreads();
            {
                float v[16]; float sum = 0.f;
#pragma unroll
                for (int q = 0; q < 4; ++q) { const f32x4 t = *(const LAS f32x4*)(OS + m * 132 + tq * 16 + q * 4); v[4 * q] = t.x; v[4 * q + 1] = t.y; v[4 * q + 2] = t.z; v[4 * q + 3] = t.w; sum += (t.x + t.y) + (t.z + t.w); }
                sum += __shfl_xor(sum, 1); sum += __shfl_xor(sum, 2); sum += __shfl_xor(sum, 4);
                const float mean = sum * (1.0f / 128.0f); float sq = 0.f;
#pragma unroll
                for (int q = 0; q < 16; ++q) { v[q] -= mean; sq += v[q] * v[q]; }
                sq += __shfl_xor(sq, 1); sq += __shfl_xor(sq, 2); sq += __shfl_xor(sq, 4);
                const float rstd = 1.0f / sqrtf(sq * (1.0f / 128.0f) + GN_EPS);
                const unsigned gw[8] = {gc0.x, gc0.y, gc0.z, gc0.w, gc1.x, gc1.y, gc1.z, gc1.w};
                unsigned ow[8];
#pragma unroll
                for (int j = 0; j < 8; ++j) { const float ga = bflo(gw[j]), gb = bfhi(gw[j]);
                    ow[j] = pk2(ga * sigmoidf_(ga) * v[2 * j] * rstd, gb * sigmoidf_(gb) * v[2 * j + 1] * rstd); }
                bf16_t* yp = ycat + (size_t)s * D_ + h * 128 + tq * 16;
                *(u32x4*)yp = (u32x4){ow[0], ow[1], ow[2], ow[3]}; *(u32x4*)(yp + 8) = (u32x4){ow[4], ow[5], ow[6], ow[7]};
            }
        }
        __syncthreads();
    }
}
template <int MODE>
__device__ __forceinline__ void lru_phase(LAS unsigned char* lds, const bf16_t* proj, const Ptrs& P, const bf16_t* wraT, const bf16_t* wriT,
                                          float* sumA, float* sumH, const float* Hin, bf16_t* ycat, int G, int b) {
    const int tid = phase_tid(), lane = tid & 63, wid = phase_wid(tid), fr = lane & 15, fq = lane >> 4;
    LAS float*  XC  = (LAS float*)lds;
    LAS bf16_t* XCb = (LAS bf16_t*)(lds + 33792);
    LAS float*  AA  = (LAS float*)(lds + 51200);
    LAS float*  SEG = (LAS float*)(lds + 84992);
    LAS bf16_t* WR  = (LAS bf16_t*)(lds + 89088);
    LAS bf16_t* WI  = (LAS bf16_t*)(lds + 123904);
    LAS float*  BB  = XC;
    const int st = wid & 3, jt0 = (wid >> 2) * 4;
    const int m = tid >> 3, part = tid & 7, j0 = part * 16;
    const int sj = tid & 127, seg = tid >> 7;
    int gcur = -1;
    float bra[4], bri[4], ls[4]; float cw0[4], cw1[4], cb0 = 0.f, cb1 = 0.f;
    unsigned xnext[11]; u32x4 gnext[2] = {(u32x4){0u, 0u, 0u, 0u}, (u32x4){0u, 0u, 0u, 0u}}; float hnext = 0.f;
    auto issue = [&](int unit) {
        const int n = unit >> 3, c0 = (unit & 7) * 128;
        const int r0 = n * 64 + wid * 8 - 3;
#pragma unroll
        for (int q = 0; q < 11; ++q) { const int row = r0 + q; xnext[q] = row >= 0 ? *(const unsigned*)(proj + (size_t)row * INC + 4096 + c0 + 2 * lane) : 0u; }
        if (MODE == 1) {
            const bf16_t* gp = proj + (size_t)(n * 64 + m) * INC + 5120 + c0 + j0;
            gnext[0] = *(const u32x4*)gp; gnext[1] = *(const u32x4*)(gp + 8);
            hnext = Hin[n * 1024 + c0 + sj];
        }
    };
    if (b < NCH * 8) issue(b);
    for (int unit = b; unit < NCH * 8; unit += G) {
        const int n = unit >> 3, g = unit & 7, c0 = g * 128;
        if (g != gcur) {
            gcur = g;
            __syncthreads();
            {
                const int row = tid >> 2, pc = tid & 3;
#pragma unroll
                for (int q = 0; q < 4; ++q) { const int piece = pc * 4 + q;
                    *(LAS u32x4*)(WR + row * 136 + piece * 8) = *(const u32x4*)(wraT + (size_t)g * 16384 + row * 128 + piece * 8);
                    *(LAS u32x4*)(WI + row * 136 + piece * 8) = *(const u32x4*)(wriT + (size_t)g * 16384 + row * 128 + piece * 8); }
            }
#pragma unroll
            for (int j = 0; j < 4; ++j) {
                const int c = c0 + (jt0 + j) * 16 + fr;
                bra[j] = P.b_ra[c]; bri[j] = P.b_ri[c]; ls[j] = -8.0f * log1pf(expf(-P.lam[c]));
            }
#pragma unroll
            for (int kk = 0; kk < 4; ++kk) { cw0[kk] = P.conv_w[kk * 1024 + c0 + 2 * lane]; cw1[kk] = P.conv_w[kk * 1024 + c0 + 2 * lane + 1]; }
            cb0 = P.conv_b[c0 + 2 * lane]; cb1 = P.conv_b[c0 + 2 * lane + 1];
        }
        unsigned xcur[11];
#pragma unroll
        for (int q = 0; q < 11; ++q) xcur[q] = xnext[q];
        const u32x4 gc0 = gnext[0], gc1 = gnext[1]; const float hin0 = hnext;
        if (unit + G < NCH * 8) issue(unit + G);
#pragma unroll
        for (int rr = 0; rr < 8; ++rr) {
            float x0 = cb0, x1 = cb1;
#pragma unroll
            for (int kk = 0; kk < 4; ++kk) { x0 += cw0[kk] * bflo(xcur[rr + kk]); x1 += cw1[kk] * bfhi(xcur[rr + kk]); }
            const int row = wid * 8 + rr;
            XC[row * 132 + 2 * lane] = x0; XC[row * 132 + 2 * lane + 1] = x1;
            *(LAS unsigned*)(XCb + row * 136 + 2 * lane) = pk2(x0, x1);
        }
        __syncthreads();
        {
            f32x4 ar[4], ai[4];
#pragma unroll
            for (int j = 0; j < 4; ++j) { ar[j] = (f32x4){0.f, 0.f, 0.f, 0.f}; ai[j] = (f32x4){0.f, 0.f, 0.f, 0.f}; }
#pragma unroll
            for (int ks = 0; ks < 4; ++ks) {
                const bf16x8 a = *(const LAS bf16x8*)(XCb + (st * 16 + fr) * 136 + ks * 32 + fq * 8);
#pragma unroll
                for (int j = 0; j < 4; ++j) { const int wo = ((jt0 + j) * 16 + fr) * 136 + ks * 32 + fq * 8;
                    ar[j] = mfma16(a, *(const LAS bf16x8*)(WR + wo), ar[j]); ai[j] = mfma16(a, *(const LAS bf16x8*)(WI + wo), ai[j]); }
            }
#pragma unroll
            for (int j = 0; j < 4; ++j) {
                const int col = (jt0 + j) * 16 + fr;
#pragma unroll
                for (int r = 0; r < 4; ++r) {
                    const int sl = st * 16 + fq * 4 + r;
                    const float rg = sigmoidf_(ar[j][r] + bra[j]), ig = sigmoidf_(ai[j][r] + bri[j]);
                    const float a = fexp_(rg * ls[j]);
                    const float bv = __builtin_amdgcn_sqrtf(fmaxf(1.0f - a * a, 0.f)) * (ig * XC[sl * 132 + col]);
                    AA[sl * 132 + col] = a; BB[sl * 132 + col] = bv;
                }
            }
        }
        __syncthreads();
        float ap = 1.f, he = 0.f;
#pragma unroll
        for (int q = 0; q < 16; ++q) { const float a = AA[(seg * 16 + q) * 132 + sj], bv = BB[(seg * 16 + q) * 132 + sj]; he = a * he + bv; ap *= a; }
        SEG[seg * 128 + sj] = ap; SEG[512 + seg * 128 + sj] = he;
        __syncthreads();
        float hin = (MODE == 1) ? hin0 : 0.f;
#pragma unroll
        for (int s2 = 0; s2 < 3; ++s2) if (s2 < seg) hin = SEG[s2 * 128 + sj] * hin + SEG[512 + s2 * 128 + sj];
        if (MODE == 0) {
            if (seg == 3) { sumA[n * 1024 + c0 + sj] = SEG[sj] * SEG[128 + sj] * SEG[256 + sj] * ap; sumH[n * 1024 + c0 + sj] = ap * hin + he; }
        } else {
            float hcur = hin;
#pragma unroll
            for (int q = 0; q < 16; ++q) { const int o = (seg * 16 + q) * 132 + sj; hcur = AA[o] * hcur + BB[o]; BB[o] = hcur; }
            __syncthreads();
            const unsigned gw[8] = {gc0.x, gc0.y, gc0.z, gc0.w, gc1.x, gc1.y, gc1.z, gc1.w};
            unsigned ow[8];
#pragma unroll
            for (int q = 0; q < 8; ++q) { const float h0 = BB[m * 132 + j0 + 2 * q], h1 = BB[m * 132 + j0 + 2 * q + 1];
                ow[q] = pk2(h0 * gelu_tanh(bflo(gw[q])), h1 * gelu_tanh(bfhi(gw[q]))); }
            bf16_t* yp = ycat + (size_t)(n * 64 + m) * D_ + 1024 + c0 + j0;
            *(u32x4*)yp = (u32x4){ow[0], ow[1], ow[2], ow[3]}; *(u32x4*)(yp + 8) = (u32x4){ow[4], ow[5], ow[6], ow[7]};
        }
        __syncthreads();
    }
}
__device__ __forceinline__ void ln1_phase(const bf16_t* buf, bf16_t* h1b, unsigned* xqs, float* sx, const float* gam, const float* bet, int G, int b) {
    const int tid_ = phase_tid(), lane = tid_ & 63, wid = phase_wid(tid_);
    const int gw = b * NWAVES + wid, NGW = G * NWAVES;
    for (int row = gw; row < S_; row += NGW) {
        const bf16_t* rp = buf + (size_t)row * D_;
        f32x4 v[8]; float sum = 0.f;
#pragma unroll
        for (int j = 0; j < 8; ++j) { const u32x2 w = *(const u32x2*)(rp + 256 * j + 4 * lane); v[j] = (f32x4){bflo(w.x), bfhi(w.x), bflo(w.y), bfhi(w.y)}; sum += (v[j].x + v[j].y) + (v[j].z + v[j].w); }
        const float mean = wave_sum(sum) * (1.0f / D_); float sq = 0.f;
#pragma unroll
        for (int j = 0; j < 8; ++j) { v[j] = v[j] - mean; sq += (v[j].x * v[j].x + v[j].y * v[j].y) + (v[j].z * v[j].z + v[j].w * v[j].w); }
        const float rstd = 1.0f / sqrtf(wave_sum(sq) * (1.0f / D_) + LN_EPS);
        float amax = 0.f;
#pragma unroll
        for (int j = 0; j < 8; ++j) {
            const f32x4 gg = *(const f32x4*)(gam + 256 * j + 4 * lane), bb = *(const f32x4*)(bet + 256 * j + 4 * lane);
            v[j] = v[j] * rstd * gg + bb;
            *(u32x2*)(h1b + (size_t)row * D_ + 256 * j + 4 * lane) = (u32x2){pk2(v[j].x, v[j].y), pk2(v[j].z, v[j].w)};
            amax = fmaxf(amax, fmaxf(fmaxf(fabsf(v[j].x), fabsf(v[j].y)), fmaxf(fabsf(v[j].z), fabsf(v[j].w))));
        }
        amax = wave_max(amax);
        const float inv = amax > 0.f ? 127.0f / amax : 0.f;
        if (lane == 0) sx[row] = amax * (1.0f / 127.0f);
#pragma unroll
        for (int j = 0; j < 8; ++j) {
            const int a = (int)rintf(v[j].x * inv), bq = (int)rintf(v[j].y * inv), c = (int)rintf(v[j].z * inv), d = (int)rintf(v[j].w * inv);
            xqs[((size_t)j * S_ + row) * 64 + lane] = (unsigned)(a & 255) | ((unsigned)(bq & 255) << 8) | ((unsigned)(c & 255) << 16) | ((unsigned)(d & 255) << 24);
        }
    }
}
__device__ __forceinline__ unsigned mono(float f) { const unsigned u = __float_as_uint(f); return (u & 0x80000000u) ? ~u : (u ^ 0x80000000u); }
__device__ __forceinline__ float unmono(unsigned u) { return __uint_as_float((u & 0x80000000u) ? (u ^ 0x80000000u) : ~u); }
__device__ __forceinline__ unsigned umax_(unsigned a, unsigned b) { return a > b ? a : b; }
__device__ __forceinline__ constexpr int cand_i(int c) { return c < 16 ? 0 : c < 24 ? 1 : c < 29 ? 2 : c < 33 ? 3 : c < 36 ? 4 : c < 38 ? 5 : c < 40 ? 6 : c < 42 ? 7 : c - 34; }
__device__ __forceinline__ constexpr int cand_j(int c) { return c < 16 ? c : c < 24 ? c - 16 : c < 29 ? c - 24 : c < 33 ? c - 29 : c < 36 ? c - 33 : c < 38 ? c - 36 : c < 40 ? c - 38 : c < 42 ? c - 40 : 0; }

__device__ __forceinline__ unsigned umin_(unsigned a, unsigned b) { return a < b ? a : b; }
#define SN_CE(x, y) do { const unsigned hi_ = umax_(x, y), lo_ = umin_(x, y); x = hi_; y = lo_; } while (0)
#define SN_SORT16(a) do { SN_CE(a[0], a[1]); SN_CE(a[2], a[3]); SN_CE(a[0], a[2]); SN_CE(a[1], a[3]); SN_CE(a[1], a[2]); SN_CE(a[4], a[5]); SN_CE(a[6], a[7]); SN_CE(a[4], a[6]); SN_CE(a[5], a[7]); SN_CE(a[5], a[6]); SN_CE(a[0], a[4]); SN_CE(a[2], a[6]); SN_CE(a[2], a[4]); SN_CE(a[1], a[5]); SN_CE(a[3], a[7]); SN_CE(a[3], a[5]); SN_CE(a[1], a[2]); SN_CE(a[3], a[4]); SN_CE(a[5], a[6]); SN_CE(a[8], a[9]); SN_CE(a[10], a[11]); SN_CE(a[8], a[10]); SN_CE(a[9], a[11]); SN_CE(a[9], a[10]); SN_CE(a[12], a[13]); SN_CE(a[14], a[15]); SN_CE(a[12], a[14]); SN_CE(a[13], a[15]); SN_CE(a[13], a[14]); SN_CE(a[8], a[12]); SN_CE(a[10], a[14]); SN_CE(a[10], a[12]); SN_CE(a[9], a[13]); SN_CE(a[11], a[15]); SN_CE(a[11], a[13]); SN_CE(a[9], a[10]); SN_CE(a[11], a[12]); SN_CE(a[13], a[14]); SN_CE(a[0], a[8]); SN_CE(a[4], a[12]); SN_CE(a[4], a[8]); SN_CE(a[2], a[10]); SN_CE(a[6], a[14]); SN_CE(a[6], a[10]); SN_CE(a[2], a[4]); SN_CE(a[6], a[8]); SN_CE(a[10], a[12]); SN_CE(a[1], a[9]); SN_CE(a[5], a[13]); SN_CE(a[5], a[9]); SN_CE(a[3], a[11]); SN_CE(a[7], a[15]); SN_CE(a[7], a[11]); SN_CE(a[3], a[5]); SN_CE(a[7], a[9]); SN_CE(a[11], a[13]); SN_CE(a[1], a[2]); SN_CE(a[3], a[4]); SN_CE(a[5], a[6]); SN_CE(a[7], a[8]); SN_CE(a[9], a[10]); SN_CE(a[11], a[12]); SN_CE(a[13], a[14]); } while (0)
#define SN_BITONIC16(a) do { SN_CE(a[0], a[8]); SN_CE(a[1], a[9]); SN_CE(a[2], a[10]); SN_CE(a[3], a[11]); SN_CE(a[4], a[12]); SN_CE(a[5], a[13]); SN_CE(a[6], a[14]); SN_CE(a[7], a[15]); SN_CE(a[0], a[4]); SN_CE(a[1], a[5]); SN_CE(a[2], a[6]); SN_CE(a[3], a[7]); SN_CE(a[8], a[12]); SN_CE(a[9], a[13]); SN_CE(a[10], a[14]); SN_CE(a[11], a[15]); SN_CE(a[0], a[2]); SN_CE(a[1], a[3]); SN_CE(a[4], a[6]); SN_CE(a[5], a[7]); SN_CE(a[8], a[10]); SN_CE(a[9], a[11]); SN_CE(a[12], a[14]); SN_CE(a[13], a[15]); SN_CE(a[0], a[1]); SN_CE(a[2], a[3]); SN_CE(a[4], a[5]); SN_CE(a[6], a[7]); SN_CE(a[8], a[9]); SN_CE(a[10], a[11]); SN_CE(a[12], a[13]); SN_CE(a[14], a[15]); } while (0)

#define TOPK_XMERGE(T, mask) do { unsigned pt_[16]; \
    _Pragma("unroll") for (int i_ = 0; i_ < 16; ++i_) pt_[i_] = (unsigned)__shfl_xor((int)T[15 - i_], mask); \
    _Pragma("unroll") for (int i_ = 0; i_ < 16; ++i_) T[i_] = umax_(T[i_], pt_[i_]); \
    SN_BITONIC16(T); } while (0)
__device__ __forceinline__ void topk_phase(LAS unsigned char* lds, const bf16_t* qp, const bf16_t* keys, const float* SU, const float* SV, int* sel_e, float* sel_g, float* sel_su, int G, int b) {
    const int tid = phase_tid(), lane = tid & 63, wid = phase_wid(tid), fr = lane & 15, fq = lane >> 4;
    LAS unsigned* wl = (LAS unsigned*)(lds + wid * 4096 + fr * 256);
    for (int unit = b; unit < (S_ / 128) * 8; unit += G) {
        const int tt = unit >> 3, h = unit & 7;
        const int tok = tt * 128 + wid * 16 + fr;
        unsigned T[2][16];
#pragma unroll
        for (int p = 0; p < 2; ++p) {
            f32x4 acc[8];
#pragma unroll
            for (int mt = 0; mt < 8; ++mt) acc[mt] = (f32x4){0.f, 0.f, 0.f, 0.f};
            bf16x8 bq[4];
#pragma unroll
            for (int ks = 0; ks < 4; ++ks) bq[ks] = *(const bf16x8*)(qp + (size_t)tok * D_ + h * 256 + p * 128 + ks * 32 + fq * 8);
            const bf16_t* kb = keys + (size_t)(h * 2 + p) * 16384;
#pragma unroll
            for (int mt = 0; mt < 8; ++mt)
#pragma unroll
                for (int ks = 0; ks < 4; ++ks) { const bf16x8 a = *(const bf16x8*)(kb + (mt * 16 + fr) * 128 + ks * 32 + fq * 8); acc[mt] = mfma16(a, bq[ks], acc[mt]); }
            unsigned lo16[16];
#pragma unroll
            for (int mt = 0; mt < 4; ++mt)
#pragma unroll
                for (int r = 0; r < 4; ++r) {
                    T[p][mt * 4 + r] = (mono(acc[mt][r]) & ~127u) | (unsigned)(127 - (mt * 16 + fq * 4 + r));
                    lo16[mt * 4 + r] = (mono(acc[mt + 4][r]) & ~127u) | (unsigned)(127 - ((mt + 4) * 16 + fq * 4 + r));
                }
            SN_SORT16(T[p]); SN_SORT16(lo16);
#pragma unroll
            for (int i = 0; i < 16; ++i) T[p][i] = umax_(T[p][i], lo16[15 - i]);
            SN_BITONIC16(T[p]);
            TOPK_XMERGE(T[p], 16); TOPK_XMERGE(T[p], 32);
        }
        float v1[16], v2[16];
#pragma unroll
        for (int i = 0; i < 16; ++i) { v1[i] = unmono(T[0][i] & ~127u); v2[i] = unmono(T[1][i] & ~127u); }
        unsigned ck[16];
#pragma unroll
        for (int sidx = 0; sidx < 13; ++sidx) {
            unsigned keyk[4];
#pragma unroll
            for (int k = 0; k < 4; ++k) {
                const int c = 4 * sidx + k;
                if (c < 50) { const int ci = cand_i(c), cj = cand_j(c); keyk[k] = (mono(v1[ci] + v2[cj]) & ~255u) | (unsigned)(255 - (ci * 16 + cj)); }
                else keyk[k] = 0u;
            }
            ck[sidx] = fq == 0 ? keyk[0] : fq == 1 ? keyk[1] : fq == 2 ? keyk[2] : keyk[3];
        }
        ck[13] = 0u; ck[14] = 0u; ck[15] = 0u;
        SN_SORT16(ck);
        TOPK_XMERGE(ck, 16); TOPK_XMERGE(ck, 32);
        if (fq == 0) {
#pragma unroll
            for (int i = 0; i < 16; ++i) { wl[i] = T[0][i]; wl[16 + i] = T[1][i]; }
        }
        __syncthreads();
        {
            const float vmax = unmono(ck[0] & ~255u);
            float esum = 0.f;
#pragma unroll
            for (int k = 0; k < 16; ++k) esum += __expf(unmono(ck[k] & ~255u) - vmax);
            const float einv = 1.0f / esum;
#pragma unroll
            for (int kk = 0; kk < 4; ++kk) {
                const unsigned W = fq == 0 ? ck[kk] : fq == 1 ? ck[4 + kk] : fq == 2 ? ck[8 + kk] : ck[12 + kk];
                const int k = fq * 4 + kk;
                const unsigned id = 255u - (W & 255u);
                const unsigned e1 = 127u - (wl[id >> 4] & 127u), e2 = 127u - (wl[16 + (id & 15u)] & 127u);
                const size_t o = ((size_t)tok * 8 + h) * 16 + k;
                const unsigned ex = e1 * 128u + e2;
                sel_e[o] = (int)ex; sel_g[o] = __expf(unmono(W & ~255u) - vmax) * einv * SV[ex]; sel_su[o] = SU[ex];
            }
        }
        __syncthreads();
    }
}
__device__ __forceinline__ int row16_sum_i(int v) {
    v += __builtin_amdgcn_update_dpp(0, v, 0xB1, 0xF, 0xF, true);
    v += __builtin_amdgcn_update_dpp(0, v, 0x4E, 0xF, 0xF, true);
    v += __builtin_amdgcn_update_dpp(0, v, 0x141, 0xF, 0xF, true);
    v += __builtin_amdgcn_update_dpp(0, v, 0x140, 0xF, 0xF, true);
    return v;
}
__device__ __forceinline__ int dot16_i8(const u32x4 a, const u32x4 x) {
    int d = __builtin_amdgcn_sdot4((int)a.x, (int)x.x, 0, false); d = __builtin_amdgcn_sdot4((int)a.y, (int)x.y, d, false);
    d = __builtin_amdgcn_sdot4((int)a.z, (int)x.z, d, false); return __builtin_amdgcn_sdot4((int)a.w, (int)x.w, d, false);
}
__device__ __forceinline__ void peer_u_phase(LAS unsigned char* lds, const unsigned char* UQs, const unsigned char* XQs, const int* sel_e, int* pd, int xi, int nx, int rank, int nloc) {
    const int tid_ = phase_tid(), lane = tid_ & 63, wid = phase_wid(tid_), r = lane >> 4, i = lane & 15;
    LAS int* esb = (LAS int*)(lds + wid * 2048);
    const int wx = rank * NWAVES + wid, nwx = nloc * NWAVES;
    if (wx >= S_) return;
    const int NT = (S_ - wx + nwx - 1) / nwx;
    for (int j = xi; j < 8; j += nx) {
        const unsigned char* Uj = UQs + (size_t)j * 16384 * 256; const unsigned li = 16u * (unsigned)i;
        const unsigned char* Xj = XQs + (size_t)j * S_ * 256 + 16 * i;
        u32x4 A[16], B[16];
        int ma, mb; u32x4 xc, xn;
        {
            const int t0 = wx, t1 = (NT > 1) ? wx + nwx : wx;
            ma = sel_e[(size_t)t0 * 128 + lane]; mb = sel_e[(size_t)t0 * 128 + 64 + lane]; xc = *(const u32x4*)(Xj + (size_t)t0 * 256);
            esb[lane] = ma; esb[64 + lane] = mb;
            asm volatile("" ::: "memory");
#pragma unroll
            for (int it = 0; it < 16; ++it) A[it] = *(const u32x4*)(Uj + ((unsigned)esb[4 * it + r] * 256u + li));
#pragma unroll
            for (int it = 0; it < 16; ++it) B[it] = *(const u32x4*)(Uj + ((unsigned)esb[64 + 4 * it + r] * 256u + li));
            ma = sel_e[(size_t)t1 * 128 + lane]; mb = sel_e[(size_t)t1 * 128 + 64 + lane]; xn = *(const u32x4*)(Xj + (size_t)t1 * 256);
        }
        for (int n = 0; n < NT; ++n) {
            const int t = wx + n * nwx;
            const int t2 = (n + 2 < NT) ? t + 2 * nwx : t;
            LAS int* esn = esb + ((n + 1) & 1) * 128;
            esn[lane] = ma; esn[64 + lane] = mb;
            const u32x4 xnn = xn;
            asm volatile("" ::: "memory");
            ma = sel_e[(size_t)t2 * 128 + lane]; mb = sel_e[(size_t)t2 * 128 + 64 + lane]; xn = *(const u32x4*)(Xj + (size_t)t2 * 256);
            int keepA = 0, keepB = 0;
#pragma unroll
            for (int it = 0; it < 16; ++it) { const int d = row16_sum_i(dot16_i8(A[it], xc)); keepA = (i == it) ? d : keepA; }
            asm volatile("" : "+v"(keepA) :: "memory");
#pragma unroll
            for (int it = 0; it < 16; ++it) A[it] = *(const u32x4*)(Uj + ((unsigned)esn[4 * it + r] * 256u + li));
            asm volatile("" ::: "memory");
#pragma unroll
            for (int it = 0; it < 16; ++it) { const int d = row16_sum_i(dot16_i8(B[it], xc)); keepB = (i == it) ? d : keepB; }
            asm volatile("" : "+v"(keepB) :: "memory");
#pragma unroll
            for (int it = 0; it < 16; ++it) B[it] = *(const u32x4*)(Uj + ((unsigned)esn[64 + 4 * it + r] * 256u + li));
            asm volatile("" ::: "memory");
            int* pp = pd + ((size_t)t * 8 + j) * 128 + 4 * i + r;
            pp[0] = keepA; pp[64] = keepB;
            xc = xnn;
        }
    }
}
typedef float f32x2 __attribute__((ext_vector_type(2)));
__device__ __forceinline__ void acc16_fp8(f32x2 (&acc)[8], const u32x4 v, float c) {
    const int w[4] = {(int)v.x, (int)v.y, (int)v.z, (int)v.w};
    const f32x2 cc = {c, c};
#pragma unroll
    for (int q = 0; q < 4; ++q) {
        const f32x2 lo = __builtin_amdgcn_cvt_pk_f32_fp8(w[q], false), hi = __builtin_amdgcn_cvt_pk_f32_fp8(w[q], true);
        acc[2 * q] = __builtin_elementwise_fma(cc, lo, acc[2 * q]); acc[2 * q + 1] = __builtin_elementwise_fma(cc, hi, acc[2 * q + 1]);
    }
}
__device__ __forceinline__ void peer_coef_phase(const float* sel_g, const float* sel_su, const int* pd, const float* SX, float* coef, int G, int b) {
    const int tid_ = phase_tid(), lane = tid_ & 63, wid = phase_wid(tid_);
    const int gw = b * NWAVES + wid, NGW = G * NWAVES;
    for (int t = gw; t < S_; t += NGW) {
        const float* gp = sel_g + (size_t)t * 128 + lane; const float* up = sel_su + (size_t)t * 128 + lane; const int* pp = pd + (size_t)t * 1024 + lane;
        const float sxt = SX[t];
#pragma unroll
        for (int hh = 0; hh < 2; ++hh) {
            int ds = 0;
#pragma unroll
            for (int jj = 0; jj < 8; ++jj) ds += pp[jj * 128 + 64 * hh];
            coef[(size_t)t * 128 + 64 * hh + lane] = gp[64 * hh] * gelu_tanh((float)ds * (up[64 * hh] * sxt));
        }
    }
}
struct PeerMeta { int e[2]; float c[2]; };
__device__ __forceinline__ void peer_meta_load(PeerMeta& m, const int* sel_e, const float* coef, int t, int lane) {
    const int* ep = sel_e + (size_t)t * 128 + lane; const float* cp = coef + (size_t)t * 128 + lane;
    m.e[0] = ep[0]; m.e[1] = ep[64]; m.c[0] = cp[0]; m.c[1] = cp[64];
}
template <int STRIP>
__device__ __forceinline__ void peer_v_phase(LAS unsigned char* lds, const unsigned char* VQs, const int* sel_e, const float* coef,
                                             bf16_t* zs, int xi, int nx, int rank, int nloc) {
    const int tid_ = phase_tid(), lane = tid_ & 63, wid = phase_wid(tid_), r = lane >> 4, i = lane & 15;
    LAS int* esb = (LAS int*)(lds + wid * 2048); LAS float* csb = (LAS float*)(lds + wid * 2048 + 1024);
    const int wx = rank * NWAVES + wid, nwx = nloc * NWAVES;
    if (wx >= S_) return;
    const int NT = (S_ - wx + nwx - 1) / nwx;
    for (int j = xi; j < 8; j += nx) {
        const unsigned char* Vj = VQs + (size_t)j * 16384 * 256; const unsigned li = 16u * (unsigned)i;
        u32x4 A[16], B[16];
        PeerMeta m;
        {
            peer_meta_load(m, sel_e, coef, wx, lane);
#pragma unroll
            for (int hh = 0; hh < 2; ++hh) { const int k = 64 * hh + lane; esb[k] = m.e[hh]; csb[k] = m.c[hh]; }
            asm volatile("" ::: "memory");
#pragma unroll
            for (int it = 0; it < 16; ++it) A[it] = *(const u32x4*)(Vj + ((unsigned)esb[4 * it + r] * 256u + li));
#pragma unroll
            for (int it = 0; it < 16; ++it) B[it] = *(const u32x4*)(Vj + ((unsigned)esb[64 + 4 * it + r] * 256u + li));
            peer_meta_load(m, sel_e, coef, (NT > 1) ? wx + nwx : wx, lane);
        }
        for (int n = 0; n < NT; ++n) {
            const int t = wx + n * nwx;
            const int t2 = (n + 2 < NT) ? t + 2 * nwx : t;
            LAS int* esn = esb + ((n + 1) & 1) * 128; LAS float* csn = csb + ((n + 1) & 1) * 128;
            const LAS float* csc = csb + (n & 1) * 128;
            esn[lane] = m.e[0]; esn[64 + lane] = m.e[1];
            asm volatile("" ::: "memory");
            f32x2 acc2[8];
#pragma unroll
            for (int q = 0; q < 8; ++q) acc2[q] = (f32x2){0.f, 0.f};
#pragma unroll
            for (int it = 0; it < 16; ++it) { if (STRIP == 1) { acc2[it & 7].x += __uint_as_float(A[it].x ^ A[it].y ^ A[it].z ^ A[it].w) * csc[4 * it + r]; } else acc16_fp8(acc2, A[it], csc[4 * it + r]); }
            asm volatile("" : "+v"(acc2[0]), "+v"(acc2[1]), "+v"(acc2[2]), "+v"(acc2[3]), "+v"(acc2[4]), "+v"(acc2[5]), "+v"(acc2[6]), "+v"(acc2[7]) :: "memory");
#pragma unroll
            for (int it = 0; it < 16; ++it) A[it] = *(const u32x4*)(Vj + ((unsigned)esn[4 * it + r] * 256u + li));
            asm volatile("" ::: "memory");
#pragma unroll
            for (int it = 0; it < 16; ++it) { if (STRIP == 1) { acc2[it & 7].y += __uint_as_float(B[it].x ^ B[it].y ^ B[it].z ^ B[it].w) * csc[64 + 4 * it + r]; } else acc16_fp8(acc2, B[it], csc[64 + 4 * it + r]); }
            asm volatile("" : "+v"(acc2[0]), "+v"(acc2[1]), "+v"(acc2[2]), "+v"(acc2[3]), "+v"(acc2[4]), "+v"(acc2[5]), "+v"(acc2[6]), "+v"(acc2[7]) :: "memory");
#pragma unroll
            for (int it = 0; it < 16; ++it) B[it] = *(const u32x4*)(Vj + ((unsigned)esn[64 + 4 * it + r] * 256u + li));
            asm volatile("" ::: "memory");
            csn[lane] = m.c[0]; csn[64 + lane] = m.c[1];
            peer_meta_load(m, sel_e, coef, t2, lane);
            float acc[16];
#pragma unroll
            for (int q = 0; q < 8; ++q) { acc[2 * q] = acc2[q].x; acc[2 * q + 1] = acc2[q].y; }
#pragma unroll
            for (int q = 0; q < 16; ++q) { float a = acc[q]; a += __shfl_xor(a, 16); a += __shfl_xor(a, 32); acc[q] = a; }
            if (r == 0) {
                bf16_t* zp = zs + (size_t)t * D_ + 256 * j + 16 * i;
                *(u32x4*)zp = (u32x4){pk2(acc[0], acc[1]), pk2(acc[2], acc[3]), pk2(acc[4], acc[5]), pk2(acc[6], acc[7])};
                *(u32x4*)(zp + 8) = (u32x4){pk2(acc[8], acc[9]), pk2(acc[10], acc[11]), pk2(acc[12], acc[13]), pk2(acc[14], acc[15])};
            }
            asm volatile("" ::: "memory");
        }
    }
}
__device__ __forceinline__ void ln2_phase(const bf16_t* h1b, const bf16_t* zs, float* out, const float* gam, const float* bet, int G, int b) {
    const int tid_ = phase_tid(), lane = tid_ & 63, wid = phase_wid(tid_);
    const int gw = b * NWAVES + wid, NGW = G * NWAVES;
    for (int row = gw; row < S_; row += NGW) {
        f32x4 v[8]; float sum = 0.f;
#pragma unroll
        for (int j = 0; j < 8; ++j) {
            const u32x2 hw = *(const u32x2*)(h1b + (size_t)row * D_ + 256 * j + 4 * lane), zw = *(const u32x2*)(zs + (size_t)row * D_ + 256 * j + 4 * lane);
            v[j] = (f32x4){DN_ALPHA * bflo(hw.x) + bflo(zw.x), DN_ALPHA * bfhi(hw.x) + bfhi(zw.x), DN_ALPHA * bflo(hw.y) + bflo(zw.y), DN_ALPHA * bfhi(hw.y) + bfhi(zw.y)};
            sum += (v[j].x + v[j].y) + (v[j].z + v[j].w);
        }
        const float mean = wave_sum(sum) * (1.0f / D_); float sq = 0.f;
#pragma unroll
        for (int j = 0; j < 8; ++j) { v[j] = v[j] - mean; sq += (v[j].x * v[j].x + v[j].y * v[j].y) + (v[j].z * v[j].z + v[j].w * v[j].w); }
        const float rstd = 1.0f / sqrtf(wave_sum(sq) * (1.0f / D_) + LN_EPS);
#pragma unroll
        for (int j = 0; j < 8; ++j) {
            const f32x4 gg = *(const f32x4*)(gam + 256 * j + 4 * lane), bb = *(const f32x4*)(bet + 256 * j + 4 * lane);
            *(f32x4*)(out + (size_t)row * D_ + 256 * j + 4 * lane) = v[j] * rstd * gg + bb;
        }
    }
}
#ifndef PROBE_PHASE
#define PROBE_PHASE -1
#endif
constexpr int LDSCTL_OFF = 163328, MISC_OFF = LDSCTL_OFF;
constexpr int CW_BAR = 1024;
constexpr size_t CTL_ZERO_BYTES = 64 * 1024;
static_assert((CW_BAR + XCD_BAR_WORDS) * 4 <= (int)CTL_ZERO_BYTES && MISC_OFF + 128 <= LDS_BYTES, "control words");

__global__ void __launch_bounds__(NTHREADS, 2) mega_fwd(Ptrs P) {
    extern __shared__ __attribute__((aligned(16))) unsigned char lds_raw[];
    LAS unsigned char* lds = (LAS unsigned char*)lds_raw;
    unsigned char* ws = P.ws;
    const int G = gridDim.x, b = blockIdx.x;
    for (int u = threadIdx.x; u < (LDS_BYTES - LDSCTL_OFF) / 4; u += NTHREADS) ((LAS unsigned*)(lds + LDSCTL_OFF))[u] = 0u;
    __syncthreads();
    volatile LAS unsigned* MISC = (volatile LAS unsigned*)(lds + MISC_OFF);
    XcdBarrier bar; bar.bar = (unsigned*)(ws + WS_CTL) + CW_BAR; bar.x = xb_xcc_id(); bar.st = MISC + 8;
    if (threadIdx.x == 0) MISC[10] = xb_add(&bar.bar[XB_XCNT(bar.x)], 1u);

    bf16_t* const proj = (bf16_t*)(ws + WS_PROJ); float* const gst = (float*)(ws + WS_GST); bf16_t* const ycat = (bf16_t*)(ws + WS_YCAT);
    const float* const cosT = (const float*)(ws + WS_COS); const float* const sinT = (const float*)(ws + WS_SIN);
    float* const sumA = (float*)(ws + WS_SUMA); float* const sumH = (float*)(ws + WS_SUMH); float* const Hin = (float*)(ws + WS_HIN);
    const bf16_t* const wraT = (const bf16_t*)(ws + WS_WRA_T); const bf16_t* const wriT = (const bf16_t*)(ws + WS_WRI_T);

#define NREP(k) ((PROBE_PHASE == (k)) ? 2 : 1)
    for (int r_ = 0; r_ < NREP(0); ++r_) { prologue_phase(lds, P, G, b); xcd_barrier(bar); }
    if (threadIdx.x == 0) { unsigned xi_ = 0; for (unsigned jx = 0; jx < bar.x; ++jx) xi_ += xb_ld(&bar.bar[XB_XCNT(jx)]) > 0u ? 1u : 0u; MISC[11] = xi_; }
    __syncthreads();
    const int x_nloc = __builtin_amdgcn_readfirstlane((int)MISC[8]), x_nx = __builtin_amdgcn_readfirstlane((int)MISC[9]), x_rank = __builtin_amdgcn_readfirstlane((int)MISC[10]), x_xi = __builtin_amdgcn_readfirstlane((int)MISC[11]);
#define RUN_P1 { pg8::Gemm g{(const pg8::bf16_t*)(ws + WS_XB), (const pg8::bf16_t*)(ws + WS_WIN_T), S_, INC, D_}; \
        pg8::StaticOrder S; S.init(S_, INC, G, b); \
        pg8::EpiBf16<0> E{(pg8::bf16_t*)proj, INC, nullptr, 0, 0, 1.f}; \
        pg8::gemm_phase<pg8::EpiBf16<0>, pg8::StaticOrder, true, true>(lds, g, S, E); \
        xcd_barrier(bar); }
    RUN_P1
#if PROBE_PHASE == 1
    RUN_P1
#endif
    for (int r2_ = 0; r2_ < NREP(22); ++r2_) {
    for (int r_ = 0; r_ < NREP(2); ++r_) { ret_r1_phase(lds, proj, cosT, sinT, gst, G, b); if (PROBE_PHASE >= 0) xcd_barrier(bar); }
    for (int r_ = 0; r_ < NREP(3); ++r_) { lru_phase<0>(lds, proj, P, wraT, wriT, sumA, sumH, Hin, ycat, G, b); xcd_barrier(bar); }
    scan_phase(gst, sumA, sumH, Hin, G, b);
    xcd_barrier(bar);
    }
    for (int r_ = 0; r_ < NREP(4); ++r_) { ret_r3_phase(lds, proj, cosT, sinT, gst, ycat, G, b); if (PROBE_PHASE >= 0) xcd_barrier(bar); }
    for (int r_ = 0; r_ < NREP(5); ++r_) { lru_phase<1>(lds, proj, P, wraT, wriT, sumA, sumH, Hin, ycat, G, b); xcd_barrier(bar); }
#define RUN_P3 { pg8::Gemm g{(const pg8::bf16_t*)ycat, (const pg8::bf16_t*)(ws + WS_WOUT_T), S_, D_, D_}; \
        pg8::StaticOrder S; S.init(S_, D_, G, b); \
        pg8::EpiResBf16 E{P.x, (pg8::bf16_t*)(ws + WS_Z1B), D_, DN_ALPHA}; \
        pg8::gemm_phase<pg8::EpiResBf16, pg8::StaticOrder, true, true>(lds, g, S, E); \
        xcd_barrier(bar); }
    RUN_P3
#if PROBE_PHASE == 6
    RUN_P3
#endif
    ln1_phase((const bf16_t*)(ws + WS_Z1B), (bf16_t*)(ws + WS_H1B), (unsigned*)(ws + WS_XQ), (float*)(ws + WS_SX), P.ln1_g, P.ln1_b, G, b);
    xcd_barrier(bar);
#if PROBE_PHASE == 66
    RUN_P3
    ln1_phase((const bf16_t*)(ws + WS_Z1B), (bf16_t*)(ws + WS_H1B), (unsigned*)(ws + WS_XQ), (float*)(ws + WS_SX), P.ln1_g, P.ln1_b, G, b);
    xcd_barrier(bar);
#endif
#define RUN_P5 { pg8::Gemm g{(const pg8::bf16_t*)(ws + WS_H1B), (const pg8::bf16_t*)(ws + WS_WPQ_T), S_, D_, D_}; \
        pg8::StaticOrder S; S.init(S_, D_, G, b); \
        pg8::EpiBf16<0> E{(pg8::bf16_t*)(ws + WS_QP), D_, nullptr, 0, 0, 1.f}; \
        pg8::gemm_phase<pg8::EpiBf16<0>, pg8::StaticOrder, true, true>(lds, g, S, E); \
        xcd_barrier(bar); }
    RUN_P5
#if PROBE_PHASE == 7
    RUN_P5
#endif
    for (int r_ = 0; r_ < NREP(8); ++r_) { topk_phase(lds, (const bf16_t*)(ws + WS_QP), (const bf16_t*)(ws + WS_KEYS), (const float*)(ws + WS_SU), (const float*)(ws + WS_SV), (int*)(ws + WS_SELE), (float*)(ws + WS_SELG), (float*)(ws + WS_SELU), G, b); xcd_barrier(bar); }
    for (int r_ = 0; r_ < NREP(9); ++r_) { peer_u_phase(lds, (const unsigned char*)(ws + WS_UQ), (const unsigned char*)(ws + WS_XQ), (const int*)(ws + WS_SELE), (int*)(ws + WS_PD), x_xi, x_nx, x_rank, x_nloc); xcd_barrier(bar); }
    for (int r_ = 0; r_ < NREP(13); ++r_) { peer_coef_phase((const float*)(ws + WS_SELG), (const float*)(ws + WS_SELU), (const int*)(ws + WS_PD), (const float*)(ws + WS_SX), (float*)(ws + WS_COEF), G, b); xcd_barrier(bar); }
    for (int r_ = 0; r_ < NREP(10); ++r_) { peer_v_phase<0>(lds, (const unsigned char*)(ws + WS_VQ), (const int*)(ws + WS_SELE), (const float*)(ws + WS_COEF),
                     (bf16_t*)(ws + WS_ZS), x_xi, x_nx, x_rank, x_nloc); xcd_barrier(bar); }
#if PROBE_PHASE == 12
    peer_v_phase<1>(lds, (const unsigned char*)(ws + WS_VQ), (const int*)(ws + WS_SELE), (const float*)(ws + WS_COEF),
                     (bf16_t*)(ws + 248 * MiB), x_xi, x_nx, x_rank, x_nloc); xcd_barrier(bar);
#endif
    for (int r_ = 0; r_ < NREP(11); ++r_) ln2_phase((const bf16_t*)(ws + WS_H1B), (const bf16_t*)(ws + WS_ZS), P.out, P.ln2_g, P.ln2_b, G, b);
}

extern "C" void kernel_launch(void* const* d_in, const int* in_sizes, int n_in, void* d_out, int out_size, void* d_ws, size_t ws_size, hipStream_t stream) {
    static int grid = 0;
    if (grid == 0) {
        if (n_in != 19 || in_sizes[0] != S_ * D_ || out_size != S_ * D_ || ws_size < WS_END) {
            fprintf(stderr, "kernel_launch: unexpected shapes: n_in %d in0 %d out %d ws %zu (need >= %zu)\n", n_in, n_in > 0 ? in_sizes[0] : -1, out_size, ws_size, (size_t)WS_END); grid = -1; return; }
        int dev = 0, cus = 0, per_cu = 0;
        if (hipGetDevice(&dev) != hipSuccess || hipDeviceGetAttribute(&cus, hipDeviceAttributeMultiprocessorCount, dev) != hipSuccess) { grid = -1; return; }
        if (hipFuncSetAttribute((const void*)mega_fwd, hipFuncAttributeMaxDynamicSharedMemorySize, LDS_BYTES) != hipSuccess) { fprintf(stderr, "kernel_launch: hipFuncSetAttribute failed\n"); grid = -1; return; }
        if (hipOccupancyMaxActiveBlocksPerMultiprocessor(&per_cu, (const void*)mega_fwd, NTHREADS, LDS_BYTES) != hipSuccess || per_cu < 1) {
            fprintf(stderr, "kernel_launch: occupancy query reports %d workgroups per CU; nothing launched\n", per_cu); (void)hipGetLastError(); grid = -1; return; }
        grid = cus;
    }
    if (grid < 0) return;
    Ptrs P{};
    P.x = (const float*)d_in[0]; P.pos = (const int*)d_in[1]; P.w_in = (const float*)d_in[2]; P.w_out = (const float*)d_in[3]; P.conv_w = (const float*)d_in[4]; P.conv_b = (const float*)d_in[5];
    P.w_ra = (const float*)d_in[6]; P.b_ra = (const float*)d_in[7]; P.w_ri = (const float*)d_in[8]; P.b_ri = (const float*)d_in[9]; P.lam = (const float*)d_in[10];
    P.ln1_g = (const float*)d_in[11]; P.ln1_b = (const float*)d_in[12]; P.w_pq = (const float*)d_in[13]; P.sub_keys = (const float*)d_in[14]; P.peer_u = (const float*)d_in[15]; P.peer_v = (const float*)d_in[16];
    P.ln2_g = (const float*)d_in[17]; P.ln2_b = (const float*)d_in[18]; P.out = (float*)d_out; P.ws = (unsigned char*)d_ws;
    if (hipMemsetAsync((char*)d_ws + WS_CTL, 0, CTL_ZERO_BYTES, stream) != hipSuccess) { fprintf(stderr, "kernel_launch: hipMemsetAsync failed\n"); return; }
    void* args[] = {&P};
    const hipError_t e = hipLaunchCooperativeKernel((const void*)mega_fwd, dim3(grid), dim3(NTHREADS), args, LDS_BYTES, stream);
    if (e != hipSuccess) fprintf(stderr, "kernel_launch: cooperative launch failed: %s (grid %d)\n", hipGetErrorString(e), grid);
}
```

```cpp
#include <hip/hip_runtime.h>
#include <cstdio>
#include <cstdint>
#include <cmath>

namespace pg8 {
#define PG8_LAS __attribute__((address_space(3)))
typedef unsigned short bf16_t;
typedef short bf16x8 __attribute__((ext_vector_type(8)));
typedef float f32x4 __attribute__((ext_vector_type(4)));
typedef unsigned u32x4 __attribute__((ext_vector_type(4)));
constexpr int BM = 256, BK = 64, HALF = 128, HTB = HALF * BK * 2  , STAGE_BYTES = 8 * HTB, NXCD = 8, WGM = 8;

__host__ __device__ __forceinline__ int lds_byte(int r, int c) { const int st = (r >> 4) * 2 + (c >> 5), rr = r & 15, cc = c & 31, ob = rr * 64 + cc * 2; return st * 1024 + (ob ^ (((ob >> 9) & 1) << 5)); }
__host__ __device__ __forceinline__ void stage_rc(int b, int& R, int& C) { const int st = b / 1024, sb = b % 1024, swz = sb ^ (((sb >> 9) & 1) << 5); R = (st >> 1) * 16 + swz / 64; C = (st & 1) * 32 + (swz % 64) / 2; }
__host__ __device__ __forceinline__ int perm32(int rho) { const int n = rho >> 4, i = rho & 15; return 8 * (i >> 2) + 4 * n + (i & 3); }

struct Unit { int pm, pn; };
struct Gemm { const bf16_t* A; const bf16_t* Bt; int M, N, K; };

struct StaticOrder {
    int nM, nN, nwg, G, c;
    __host__ __device__ void init(int M, int N, int G_, int c_) { nM = M / BM; nN = N / BM; nwg = nM * nN; G = G_; c = c_; }
    __host__ __device__ bool next(int i, Unit& u) const {
        const long L = (long)i * G + c; if (L >= nwg) return false;
        int wgid = (int)L; { const int q = nwg / NXCD, r = nwg % NXCD, xcd = wgid % NXCD, off = wgid / NXCD; wgid = (xcd < r ? xcd * (q + 1) : r * (q + 1) + (xcd - r) * q) + off; }
        const int nig = WGM * nN, gid = wgid / nig, fm = gid * WGM, gsz = (nM - fm) < WGM ? (nM - fm) : WGM;
        u.pm = fm + ((wgid % nig) % gsz); u.pn = (wgid % nig) / gsz; return true;
    }
    __device__ __forceinline__ void a_ready(const Unit&) const {}
    __device__ __forceinline__ void done(const Unit&) const {}
};

__device__ __forceinline__ unsigned cvt_pk_bf16(float lo, float hi) { unsigned r; asm volatile("v_cvt_pk_bf16_f32 %0, %1, %2" : "=v"(r) : "v"(lo), "v"(hi)); return r; }
typedef float f32x2 __attribute__((ext_vector_type(2)));
__device__ __forceinline__ f32x2 gelu_pk(f32x2 v) {
    const f32x2 av = __builtin_elementwise_abs(v), d = av * 0.2316418882f + 1.0f;
    f32x2 t; t.x = __builtin_amdgcn_rcpf(d.x); t.y = __builtin_amdgcn_rcpf(d.y);
    f32x2 q = t * 0.5307027145f + (-0.7265760135f); q = q * t + 0.7107068705f; q = q * t + (-0.142248368f); q = q * t + 0.127414796f; q = q * t;
    const f32x2 s = (v * v) * (-0.72134752044f);
    f32x2 e; e.x = __builtin_amdgcn_exp2f(s.x); e.y = __builtin_amdgcn_exp2f(s.y);
    const f32x2 m = v * (q * e), r = v - m;
    f32x2 o; o.x = v.x < 0.f ? m.x : r.x; o.y = v.y < 0.f ? m.y : r.y; return o;
}

template <int ACT  > struct EpiBf16 {
    static constexpr bool PERM = true, AFTER_DRAIN = false; static_assert(ACT == 0 || ACT == 1, "EpiBf16: ACT is 0 (none) or 1 (gelu_pk)");
    bf16_t* O; int ldc; const float* bias; int split_cols; size_t split_stride; float scale0;
    __device__ __forceinline__ void operator()(const f32x4 (&acc)[2][2][4][2], const Unit& u, int wr, int wc, int fr, int fq) const {
        const int row0 = u.pm * BM + wr * 64 + fr; int colt = u.pn * BM; bf16_t* base = O;
        float sc = 1.f; if (split_cols) { const int t = colt / split_cols; base += (size_t)t * split_stride; colt -= t * split_cols; if (t == 0) sc = scale0; }
        const int col0 = colt + wc * 32 + 8 * fq, bcol0 = u.pn * BM + wc * 32 + 8 * fq;
        f32x4 bv[2][2];
#pragma unroll
        for (int bj = 0; bj < 2; ++bj)
#pragma unroll
            for (int n = 0; n < 2; ++n) bv[bj][n] = bias ? *(const f32x4*)(bias + bcol0 + bj * HALF + 4 * n) : (f32x4){0.f, 0.f, 0.f, 0.f};
#pragma unroll
        for (int ai = 0; ai < 2; ++ai)
#pragma unroll
            for (int m = 0; m < 4; ++m) { bf16_t* rowp = base + (size_t)(row0 + ai * HALF + m * 16) * ldc + col0;
#pragma unroll
                for (int bj = 0; bj < 2; ++bj) { f32x4 v0 = acc[ai][bj][m][0] + bv[bj][0], v1 = acc[ai][bj][m][1] + bv[bj][1];
                    if (ACT == 1) { f32x2 a = gelu_pk((f32x2){v0[0], v0[1]}), b = gelu_pk((f32x2){v0[2], v0[3]}), c = gelu_pk((f32x2){v1[0], v1[1]}), d = gelu_pk((f32x2){v1[2], v1[3]});
                        v0 = (f32x4){a.x, a.y, b.x, b.y}; v1 = (f32x4){c.x, c.y, d.x, d.y}; }
                    v0 = v0 * sc; v1 = v1 * sc; u32x4 w; w.x = cvt_pk_bf16(v0[0], v0[1]); w.y = cvt_pk_bf16(v0[2], v0[3]); w.z = cvt_pk_bf16(v1[0], v1[1]); w.w = cvt_pk_bf16(v1[2], v1[3]);
                    *(u32x4*)(rowp + bj * HALF) = w; } }
    }
};
struct EpiResF32 {
    static constexpr bool PERM = false, AFTER_DRAIN = false;
    const float* base; float* out; int ldc; float alpha;
    __device__ __forceinline__ void operator()(const f32x4 (&acc)[2][2][4][2], const Unit& u, int wr, int wc, int fr, int fq) const {
        const int row0 = u.pm * BM + wr * 64 + fr, col0 = u.pn * BM + wc * 32 + 4 * fq;
#pragma unroll
        for (int ai = 0; ai < 2; ++ai)
#pragma unroll
            for (int m = 0; m < 4; ++m) { const size_t off = (size_t)(row0 + ai * HALF + m * 16) * ldc + col0;
#pragma unroll
                for (int bj = 0; bj < 2; ++bj)
#pragma unroll
                    for (int n = 0; n < 2; ++n) { const f32x4 bs = *(const f32x4*)(base + off + bj * HALF + n * 16); *(f32x4*)(out + off + bj * HALF + n * 16) = bs * alpha + acc[ai][bj][m][n]; }
                asm volatile("" ::: "memory"); }
    }
};

struct EpiResBf16 {
    static constexpr bool PERM = true, AFTER_DRAIN = false;
    const bf16_t* base; bf16_t* O; int ldc; float alpha;
    __device__ __forceinline__ void operator()(const f32x4 (&acc)[2][2][4][2], const Unit& u, int wr, int wc, int fr, int fq) const {
        const int row0 = u.pm * BM + wr * 64 + fr, col0 = u.pn * BM + wc * 32 + 8 * fq;
#pragma unroll
        for (int ai = 0; ai < 2; ++ai)
#pragma unroll
            for (int m = 0; m < 4; ++m) { const size_t off = (size_t)(row0 + ai * HALF + m * 16) * ldc + col0;
#pragma unroll
                for (int bj = 0; bj < 2; ++bj) {
                    const u32x4 bw = *(const u32x4*)(base + off + bj * HALF);
                    const f32x4 b0 = (f32x4){__uint_as_float(bw.x << 16), __uint_as_float(bw.x & 0xffff0000u), __uint_as_float(bw.y << 16), __uint_as_float(bw.y & 0xffff0000u)};
                    const f32x4 b1 = (f32x4){__uint_as_float(bw.z << 16), __uint_as_float(bw.z & 0xffff0000u), __uint_as_float(bw.w << 16), __uint_as_float(bw.w & 0xffff0000u)};
                    const f32x4 v0 = b0 * alpha + acc[ai][bj][m][0], v1 = b1 * alpha + acc[ai][bj][m][1];
                    u32x4 w; w.x = cvt_pk_bf16(v0[0], v0[1]); w.y = cvt_pk_bf16(v0[2], v0[3]); w.z = cvt_pk_bf16(v1[0], v1[1]); w.w = cvt_pk_bf16(v1[2], v1[3]);
                    *(u32x4*)(O + off + bj * HALF) = w; }
                asm volatile("" ::: "memory"); }
    }
};
template <class Epi, class Sched, bool ALIGN_EPI = false, bool SP2 = false>
__device__ __forceinline__ void gemm_phase(PG8_LAS unsigned char* lds, const Gemm g, const Sched& S, const Epi& E) {
    const int tid = threadIdx.x, wid = __builtin_amdgcn_readfirstlane(tid >> 6), lane = tid & 63, wr = wid >> 2, wc = wid & 3, fr = lane & 15, fq = lane >> 4;
    const int K = g.K, nt = K / BK;
    unsigned voffA[2], voffB[2];
#pragma unroll
    for (int i = 0; i < 2; ++i) { int R, C; stage_rc(tid * 16 + i * 8192, R, C); const int Rb = Epi::PERM ? ((R & ~31) + perm32(R & 31)) : R;
        voffA[i] = (unsigned)(R * K + C) * 2u; voffB[i] = (unsigned)(Rb * K + C) * 2u; }
    const size_t kstep = (size_t)(BK * 2);
    const size_t hstep = (size_t)HALF * K * 2;
    const size_t tstep = 2 * hstep;
    const unsigned ldsw = (unsigned)wid * 1024u;
    const int aoff = lds_byte(wr * 64 + fr, fq * 8), boff = lds_byte(wc * 32 + fr, fq * 8);
#define PG8_SA(b, h) (((b) * 2 + (h)) * HTB)
#define PG8_SB(b, h) ((4 + (b) * 2 + (h)) * HTB)
#define PG8_STAGE(bufoff, gbase, voff) do { _Pragma("unroll") for (int _i = 0; _i < 2; ++_i) \
        __builtin_amdgcn_global_load_lds((const unsigned*)((const char*)(gbase) + (voff)[_i]), (PG8_LAS unsigned*)(lds + (bufoff) + ldsw + _i * 8192), 16, 0, 0); } while (0)
#define PG8_LDA(dst, b, h) do { _Pragma("unroll") for (int m = 0; m < 4; ++m) _Pragma("unroll") for (int k = 0; k < 2; ++k) dst[m][k] = *(const PG8_LAS bf16x8*)(lds + PG8_SA(b, h) + aoff + m * 2048 + k * 1024); } while (0)
#define PG8_LDB(dst, b, h) do { _Pragma("unroll") for (int n = 0; n < 2; ++n) _Pragma("unroll") for (int k = 0; k < 2; ++k) dst[n][k] = *(const PG8_LAS bf16x8*)(lds + PG8_SB(b, h) + boff + n * 2048 + k * 1024); } while (0)
#define PG8_MMA(ai, bj, At, Bt) do { __builtin_amdgcn_s_setprio(1); _Pragma("unroll") for (int m = 0; m < 4; ++m) _Pragma("unroll") for (int n = 0; n < 2; ++n) _Pragma("unroll") for (int k = 0; k < 2; ++k) \
        acc[ai][bj][m][n] = __builtin_amdgcn_mfma_f32_16x16x32_bf16(Bt[n][k], At[m][k], acc[ai][bj][m][n], 0, 0, 0); __builtin_amdgcn_s_setprio(0); } while (0)
#define PG8_WAIT_V(n) asm volatile("s_waitcnt vmcnt(" #n ")" ::: "memory")
#define PG8_WAIT_L(n) asm volatile("s_waitcnt lgkmcnt(" #n ")" ::: "memory")
#define PG8_BAR __builtin_amdgcn_s_barrier()
#define PG8_SCHED __builtin_amdgcn_sched_barrier(0)
    Unit cur, nxt; int ui = 0;
    if (!S.next(0, cur)) return;
    f32x4 acc[2][2][4][2];
#pragma unroll
    for (int a = 0; a < 2; ++a)
#pragma unroll
        for (int b = 0; b < 2; ++b)
#pragma unroll
            for (int m = 0; m < 4; ++m)
#pragma unroll
                for (int n = 0; n < 2; ++n) acc[a][b][m][n] = (f32x4){0.f, 0.f, 0.f, 0.f};
    bf16x8 At[4][2], B0[2][2], B1[2][2];
    const char* cA = (const char*)g.A + (size_t)cur.pm * tstep; const char* cB = (const char*)g.Bt + (size_t)cur.pn * tstep;
    S.a_ready(cur);
    if constexpr (SP2) {
        PG8_STAGE(PG8_SB(0, 0), cB, voffB); PG8_STAGE(PG8_SB(0, 1), cB + hstep, voffB); PG8_STAGE(PG8_SA(0, 0), cA, voffA); PG8_STAGE(PG8_SA(0, 1), cA + hstep, voffA);
        if (wr == 1) PG8_BAR;
        PG8_WAIT_V(2); PG8_BAR;
        PG8_STAGE(PG8_SB(1, 0), cB + kstep, voffB); PG8_STAGE(PG8_SA(1, 0), cA + kstep, voffA); PG8_STAGE(PG8_SB(1, 1), cB + hstep + kstep, voffB);
        PG8_WAIT_V(6); PG8_BAR;
    } else {
        PG8_STAGE(PG8_SB(0, 0), cB, voffB); PG8_STAGE(PG8_SA(0, 0), cA, voffA); PG8_STAGE(PG8_SB(0, 1), cB + hstep, voffB); PG8_STAGE(PG8_SA(0, 1), cA + hstep, voffA);
        if (wr == 1) PG8_BAR;
        PG8_WAIT_V(4); PG8_BAR;
        PG8_STAGE(PG8_SB(1, 0), cB + kstep, voffB); PG8_STAGE(PG8_SA(1, 0), cA + kstep, voffA); PG8_STAGE(PG8_SB(1, 1), cB + hstep + kstep, voffB);
        PG8_WAIT_V(6); PG8_BAR;
    }
    for (;;) {
        const bool has_next = S.next(ui + 1, nxt);
        const char* nA = has_next ? (const char*)g.A + (size_t)nxt.pm * tstep : cA; const char* nB = has_next ? (const char*)g.Bt + (size_t)nxt.pn * tstep : cB;
        for (int t = 0; t < nt; t += 2) {
            const bool last = (t == nt - 2);
            const char* a1 = cA + (size_t)(t + 1) * kstep;
            const char* a2 = last ? nA : cA + (size_t)(t + 2) * kstep; const char* b2 = last ? nB : cB + (size_t)(t + 2) * kstep;
            const char* a3 = a2 + kstep; const char* b3 = b2 + kstep;
            if (last && has_next) S.a_ready(nxt);
            if constexpr (SP2) {
            PG8_LDB(B0, 0, 0); PG8_LDB(B1, 0, 1); PG8_SCHED; PG8_LDA(At, 0, 0); PG8_STAGE(PG8_SA(1, 1), a1 + hstep, voffA);
            PG8_WAIT_V(8); PG8_WAIT_L(0); PG8_BAR; PG8_MMA(0, 0, At, B0); PG8_MMA(0, 1, At, B1); PG8_BAR; PG8_SCHED;
            PG8_LDA(At, 0, 1); PG8_STAGE(PG8_SB(0, 0), b2, voffB); PG8_STAGE(PG8_SB(0, 1), b2 + hstep, voffB); PG8_STAGE(PG8_SA(0, 0), a2, voffA);
            PG8_WAIT_V(8); PG8_WAIT_L(0); PG8_BAR; PG8_MMA(1, 0, At, B0); PG8_MMA(1, 1, At, B1); PG8_BAR; PG8_SCHED;
            PG8_LDB(B0, 1, 0); PG8_LDB(B1, 1, 1); PG8_SCHED; PG8_LDA(At, 1, 0); PG8_STAGE(PG8_SA(0, 1), a2 + hstep, voffA);
            PG8_WAIT_V(8); PG8_WAIT_L(0); PG8_BAR; PG8_MMA(0, 0, At, B0); PG8_MMA(0, 1, At, B1); PG8_BAR; PG8_SCHED;
            PG8_LDA(At, 1, 1); PG8_STAGE(PG8_SB(1, 0), b3, voffB); PG8_STAGE(PG8_SB(1, 1), b3 + hstep, voffB); PG8_STAGE(PG8_SA(1, 0), a3, voffA);
            PG8_WAIT_V(8); PG8_WAIT_L(0); PG8_BAR; PG8_MMA(1, 0, At, B0); PG8_MMA(1, 1, At, B1); PG8_BAR; PG8_SCHED;
            } else {
            PG8_LDB(B0, 0, 0); PG8_SCHED; PG8_LDA(At, 0, 0); PG8_STAGE(PG8_SA(1, 1), a1 + hstep, voffA);
            PG8_WAIT_L(8); PG8_BAR; PG8_WAIT_L(0); PG8_MMA(0, 0, At, B0); PG8_BAR; PG8_SCHED;
            PG8_LDB(B1, 0, 1); PG8_STAGE(PG8_SB(0, 0), b2, voffB);
            PG8_BAR; PG8_WAIT_L(0); PG8_MMA(0, 1, At, B1); PG8_BAR;
            PG8_LDA(At, 0, 1); PG8_STAGE(PG8_SA(0, 0), a2, voffA);
            PG8_BAR; PG8_WAIT_L(0); PG8_MMA(1, 0, At, B0); PG8_BAR; PG8_SCHED;
            PG8_STAGE(PG8_SB(0, 1), b2 + hstep, voffB);
            PG8_WAIT_V(6); PG8_BAR; PG8_MMA(1, 1, At, B1); PG8_BAR;
            PG8_LDB(B0, 1, 0); PG8_SCHED; PG8_LDA(At, 1, 0); PG8_STAGE(PG8_SA(0, 1), a2 + hstep, voffA);
            PG8_WAIT_L(8); PG8_BAR; PG8_WAIT_L(0); PG8_MMA(0, 0, At, B0); PG8_BAR; PG8_SCHED;
            PG8_LDB(B1, 1, 1); PG8_STAGE(PG8_SB(1, 0), b3, voffB);
            PG8_BAR; PG8_WAIT_L(0); PG8_MMA(0, 1, At, B1); PG8_BAR;
            PG8_LDA(At, 1, 1); PG8_STAGE(PG8_SA(1, 0), a3, voffA);
            PG8_BAR; PG8_WAIT_L(0); PG8_MMA(1, 0, At, B0); PG8_BAR; PG8_SCHED;
            PG8_STAGE(PG8_SB(1, 1), b3 + hstep, voffB);
            PG8_WAIT_V(6); PG8_BAR; PG8_MMA(1, 1, At, B1); PG8_BAR;
            }
        }
        if constexpr (ALIGN_EPI) { if (wr == 0) PG8_BAR; }
        if constexpr (!Epi::AFTER_DRAIN) { E(acc, cur, wr, wc, fr, fq); S.done(cur); }
        if (!has_next) break;
#pragma unroll
        for (int a = 0; a < 2; ++a)
#pragma unroll
            for (int b = 0; b < 2; ++b)
#pragma unroll
                for (int m = 0; m < 4; ++m)
#pragma unroll
                    for (int n = 0; n < 2; ++n) acc[a][b][m][n] = (f32x4){0.f, 0.f, 0.f, 0.f};
        cur = nxt; cA = nA; cB = nB; ++ui;
        if constexpr (ALIGN_EPI) { if (wr == 1) PG8_BAR; }
    }
    PG8_WAIT_V(0);
    if constexpr (!ALIGN_EPI) { if (wr == 0) PG8_BAR; }
    PG8_BAR;
    if constexpr (Epi::AFTER_DRAIN) { E.fused(acc, cur, wr, wc, fr, fq, lds, wid, lane); S.done(cur); }
#undef PG8_SA
#undef PG8_SB
#undef PG8_STAGE
#undef PG8_LDA
#undef PG8_LDB
#undef PG8_MMA
#undef PG8_WAIT_V
#undef PG8_WAIT_L
#undef PG8_BAR
#undef PG8_SCHED
}
}
constexpr int S_ = 16384, D_ = 2048, INC = 6144, NH = 8, DH = 128, CH = 64, NCH = 256;
constexpr float DN_ALPHA = 1.189207115002721f;
constexpr float LN_EPS = 1e-5f, GN_EPS = 1e-6f;
constexpr int NWAVES = 8, NTHREADS = 512;
constexpr int LDS_BYTES = 163840;

constexpr size_t MiB = 1u << 20;
constexpr size_t WS_CTL = 0;
constexpr size_t WS_WOUT_T = 1 * MiB, WS_WPQ_T = 9 * MiB, WS_KEYS = 17 * MiB, WS_WRA_T = 17 * MiB + 512 * 1024, WS_WRI_T = 17 * MiB + 768 * 1024;
constexpr size_t WS_COS = 18 * MiB, WS_SIN = 22 * MiB, WS_SUMA = 26 * MiB, WS_SUMH = 27 * MiB, WS_HIN = 28 * MiB;
constexpr size_t WS_SU = 29 * MiB, WS_SV = 30 * MiB;
constexpr size_t WS_SX = 31 * MiB;
constexpr size_t WS_UQ = 32 * MiB, WS_VQ = 64 * MiB;
constexpr size_t WS_XQ = 96 * MiB;
constexpr size_t WS_PD = 328 * MiB, WS_ZS = 392 * MiB;
constexpr size_t WS_WIN_T = 160 * MiB, WS_XB = 184 * MiB, WS_GST = 160 * MiB, WS_H1B = 184 * MiB;
constexpr size_t WS_PROJ = 248 * MiB, WS_QP = 248 * MiB, WS_SELE = 312 * MiB, WS_SELG = 320 * MiB, WS_SELU = 456 * MiB, WS_COEF = 464 * MiB;
constexpr size_t WS_Z1B = 376 * MiB;
constexpr size_t WS_YCAT = 440 * MiB, WS_END = 504 * MiB;

#define LAS __attribute__((address_space(3)))
typedef unsigned short bf16_t;
typedef short bf16x8 __attribute__((ext_vector_type(8)));
typedef float f32x4 __attribute__((ext_vector_type(4)));
typedef unsigned u32x4 __attribute__((ext_vector_type(4)));
typedef unsigned u32x2 __attribute__((ext_vector_type(2)));

__device__ __forceinline__ unsigned f2bf(float f) { unsigned u = __float_as_uint(f); return (u + 0x7fffu + ((u >> 16) & 1u)) >> 16; }
__device__ __forceinline__ unsigned pk2(float lo, float hi) { return f2bf(lo) | (f2bf(hi) << 16); }
__device__ __forceinline__ float bflo(unsigned w) { return __uint_as_float(w << 16); }
__device__ __forceinline__ float bfhi(unsigned w) { return __uint_as_float(w & 0xffff0000u); }
__device__ __forceinline__ float bf2f(bf16_t b) { return __uint_as_float(((unsigned)b) << 16); }
__device__ __forceinline__ f32x4 mfma16(bf16x8 a, bf16x8 b, f32x4 c) { return __builtin_amdgcn_mfma_f32_16x16x32_bf16(a, b, c, 0, 0, 0); }
__device__ __forceinline__ float fexp_(float x) { return __builtin_amdgcn_exp2f(x * 1.4426950408889634f); }
__device__ __forceinline__ float sigmoidf_(float x) { return __builtin_amdgcn_rcpf(1.0f + fexp_(-x)); }
__device__ __forceinline__ float gelu_tanh(float x) { const float y = 0.7978845608028654f * (x + 0.044715f * x * x * x); return x * __builtin_amdgcn_rcpf(1.0f + fexp_(-2.0f * y)); }
__device__ __forceinline__ float wave_sum(float v) {
#pragma unroll
    for (int o = 1; o < 64; o <<= 1) v += __shfl_xor(v, o);
    return v;
}
__device__ __forceinline__ float wave_max(float v) {
#pragma unroll
    for (int o = 1; o < 64; o <<= 1) v = fmaxf(v, __shfl_xor(v, o));
    return v;
}
__device__ __forceinline__ int wave_sum_i(int v) {
#pragma unroll
    for (int o = 1; o < 64; o <<= 1) v += __shfl_xor(v, o);
    return v;
}
__device__ __forceinline__ int phase_tid() { int t = (int)threadIdx.x; asm volatile("" : "+v"(t)); return t; }
__device__ __forceinline__ int phase_wid(int tid) { return __builtin_amdgcn_readfirstlane(tid >> 6); }
__device__ __forceinline__ float head_log_gamma(int h) { return logf(1.0f - exp2f(-5.0f - (float)h)); }

__device__ __forceinline__ void transpose_item(const float* W, int K, int N, bf16_t* WT, LAS float* scr, int item, int lane) {
    const int nblk = N / 32, kb = item / nblk, nb = item % nblk, k0 = 64 * kb, n0 = 32 * nb;
    float tv[32];
#pragma unroll
    for (int i = 0; i < 32; ++i) { const int kk = 2 * i + (lane >> 5); tv[i] = W[(size_t)(k0 + kk) * N + n0 + (lane & 31)]; }
#pragma unroll
    for (int i = 0; i < 32; ++i) { const int kk = 2 * i + (lane >> 5); scr[kk * 33 + (lane & 31)] = tv[i]; }
    asm volatile("s_waitcnt lgkmcnt(0)" ::: "memory");
    const int c = lane & 7;
#pragma unroll
    for (int j = 0; j < 4; ++j) { const int n = (lane >> 3) + 8 * j; const LAS float* s = scr + (8 * c) * 33 + n;
        u32x4 o; o.x = pk2(s[0 * 33], s[1 * 33]); o.y = pk2(s[2 * 33], s[3 * 33]); o.z = pk2(s[4 * 33], s[5 * 33]); o.w = pk2(s[6 * 33], s[7 * 33]);
        *(u32x4*)(WT + (size_t)(n0 + n) * K + k0 + 8 * c) = o; }
    asm volatile("s_waitcnt lgkmcnt(0)" ::: "memory");
}
__device__ __forceinline__ void cvt_stream(const float* src, bf16_t* dst, size_t n8, size_t gtid, size_t gthreads) {
    size_t i = gtid;
    for (; i + 3 * gthreads < n8; i += 4 * gthreads) {
        f32x4 a[4], b[4];
#pragma unroll
        for (int u = 0; u < 4; ++u) { a[u] = __builtin_nontemporal_load((const f32x4*)src + 2 * (i + u * gthreads)); b[u] = __builtin_nontemporal_load((const f32x4*)src + 2 * (i + u * gthreads) + 1); }
#pragma unroll
        for (int u = 0; u < 4; ++u) { u32x4 o; o.x = pk2(a[u].x, a[u].y); o.y = pk2(a[u].z, a[u].w); o.z = pk2(b[u].x, b[u].y); o.w = pk2(b[u].z, b[u].w); ((u32x4*)dst)[i + u * gthreads] = o; }
    }
    for (; i < n8; i += gthreads) {
        const f32x4 a = ((const f32x4*)src)[2 * i], b = ((const f32x4*)src)[2 * i + 1];
        u32x4 o; o.x = pk2(a.x, a.y); o.y = pk2(a.z, a.w); o.z = pk2(b.x, b.y); o.w = pk2(b.z, b.w);
        ((u32x4*)dst)[i] = o;
    }
}
struct QRow { f32x4 v[8]; };
__device__ __forceinline__ void quant_issue(QRow& q, const float* table, int e, int lane) {
    const float* rp = table + (size_t)e * D_;
#pragma unroll
    for (int j = 0; j < 8; ++j) q.v[j] = __builtin_nontemporal_load((const f32x4*)(rp + 256 * j + 4 * lane));
}
template <int ISV>
__device__ __forceinline__ void quant_finish(const QRow& q, unsigned char* qtab, float* scales, int e, int lane) {
    float amax = 0.f;
#pragma unroll
    for (int j = 0; j < 8; ++j) amax = fmaxf(amax, fmaxf(fmaxf(fabsf(q.v[j].x), fabsf(q.v[j].y)), fmaxf(fabsf(q.v[j].z), fabsf(q.v[j].w))));
    amax = wave_max(amax);
    unsigned* qp = (unsigned*)qtab + (size_t)e * 64;
    if (ISV) {
        const float inv = amax > 0.f ? 416.0f / amax : 0.f;
        if (lane == 0) scales[e] = amax * (1.0f / 416.0f);
#pragma unroll
        for (int j = 0; j < 8; ++j) {
            int w = __builtin_amdgcn_cvt_pk_fp8_f32(q.v[j].x * inv, q.v[j].y * inv, 0, false);
            w = __builtin_amdgcn_cvt_pk_fp8_f32(q.v[j].z * inv, q.v[j].w * inv, w, true);
            qp[(size_t)j * 16384 * 64 + lane] = (unsigned)w;
        }
    } else {
        const float inv = amax > 0.f ? 127.0f / amax : 0.f;
        if (lane == 0) scales[e] = amax * (1.0f / 127.0f);
#pragma unroll
        for (int j = 0; j < 8; ++j) {
            const int a = (int)rintf(q.v[j].x * inv), bq = (int)rintf(q.v[j].y * inv), c = (int)rintf(q.v[j].z * inv), d = (int)rintf(q.v[j].w * inv);
            qp[(size_t)j * 16384 * 64 + lane] = (unsigned)(a & 255) | ((unsigned)(bq & 255) << 8) | ((unsigned)(c & 255) << 16) | ((unsigned)(d & 255) << 24);
        }
    }
}
struct Ptrs {
    const float *x; const int* pos; const float *w_in, *w_out, *conv_w, *conv_b, *w_ra, *b_ra, *w_ri, *b_ri, *lam, *ln1_g, *ln1_b, *w_pq, *sub_keys, *peer_u, *peer_v, *ln2_g, *ln2_b;
    float* out; unsigned char* ws;
};
__device__ __forceinline__ void prologue_phase(LAS unsigned char* lds, const Ptrs& P, int G, int b) {
    const int tid = phase_tid(), lane = tid & 63, wid = phase_wid(tid);
    LAS float* scr = (LAS float*)(lds + wid * 16384);
    const int gw = b * NWAVES + wid, NGW = G * NWAVES;
    unsigned char* ws = P.ws;
    constexpr int I_IN = (D_ / 64) * (INC / 32), I_SQ = (D_ / 64) * (D_ / 32), I_G = 2 * 4;
    constexpr int NITEMS = I_IN + 2 * I_SQ + 16 * I_G;
    for (int it = gw; it < NITEMS; it += NGW) {
        int r = it;
        if (r < I_IN) { transpose_item(P.w_in, D_, INC, (bf16_t*)(ws + WS_WIN_T), scr, r, lane); continue; } r -= I_IN;
        if (r < I_SQ) { transpose_item(P.w_out, D_, D_, (bf16_t*)(ws + WS_WOUT_T), scr, r, lane); continue; } r -= I_SQ;
        if (r < I_SQ) { transpose_item(P.w_pq, D_, D_, (bf16_t*)(ws + WS_WPQ_T), scr, r, lane); continue; } r -= I_SQ;
        if (r < 8 * I_G) { const int g = r / I_G; transpose_item(P.w_ra + g * 16384, 128, 128, (bf16_t*)(ws + WS_WRA_T) + g * 16384, scr, r % I_G, lane); continue; } r -= 8 * I_G;
        { const int g = r / I_G; transpose_item(P.w_ri + g * 16384, 128, 128, (bf16_t*)(ws + WS_WRI_T) + g * 16384, scr, r % I_G, lane); }
    }
    const size_t gtid = (size_t)b * NTHREADS + tid, gth = (size_t)G * NTHREADS;
    cvt_stream(P.x, (bf16_t*)(ws + WS_XB), (size_t)S_ * D_ / 8, gtid, gth);
    cvt_stream(P.sub_keys, (bf16_t*)(ws + WS_KEYS), (size_t)8 * 2 * 128 * 128 / 8, gtid, gth);
    float* cosT = (float*)(ws + WS_COS); float* sinT = (float*)(ws + WS_SIN);
    for (size_t i = gtid; i < (size_t)S_ * 64; i += gth) {
        const int s = (int)(i >> 6), f = (int)(i & 63);
        const float inv = powf(10000.0f, -(float)f / 64.0f);
        const float ang = (float)P.pos[s] * inv;
        float sn, cs; sincosf(ang, &sn, &cs);
        cosT[i] = cs; sinT[i] = sn;
    }
}
#define XB_TMO      128
#define XB_XCNT(j)  (256  + 64 * (j))
#define XB_XSUB(j)  (1280 + 64 * (j))
#define XB_XGEN(j)  (2304 + 64 * (j))
#define XB_TOP      3328
#define XB_TOPGEN   3392
#define XCD_BAR_WORDS 3456
#define XB_SPIN_CAP (1u << 18)

__device__ __forceinline__ unsigned xb_ld(unsigned* p)              { return __hip_atomic_load(p, __ATOMIC_RELAXED, __HIP_MEMORY_SCOPE_AGENT); }
__device__ __forceinline__ unsigned xb_add(unsigned* p, unsigned v) { return __hip_atomic_fetch_add(p, v, __ATOMIC_RELAXED, __HIP_MEMORY_SCOPE_AGENT); }
__device__ __forceinline__ unsigned xb_xcc_id() { return (unsigned)__builtin_amdgcn_s_getreg((3 << 11) | 20) & 0xFu; }
#define XB_SPIN(cond, bar) do { unsigned _sp = 0; while (cond) { __builtin_amdgcn_s_sleep(1); \
    if ((++_sp & 255u) == 0u) { if (xb_ld(&(bar)[XB_TMO])) break; if (_sp > XB_SPIN_CAP) { atomicAdd(&(bar)[XB_TMO], 1u); break; } } } } while (0)

struct XcdBarrier {
    unsigned* bar; unsigned x;
    volatile LAS unsigned* st;
};

__device__ __forceinline__ XcdBarrier xcd_barrier_post(unsigned* bar, volatile LAS unsigned* st) {
    XcdBarrier b; b.bar = bar; b.x = xb_xcc_id(); b.st = st;
    if (threadIdx.x == 0) (void)xb_add(&bar[XB_XCNT(b.x)], 1u);
    return b;
}
__device__ __forceinline__ void xcd_barrier_complete(unsigned* bar, unsigned x, unsigned& nloc, unsigned& nx) {
    const unsigned G = gridDim.x * gridDim.y * gridDim.z;
    unsigned sum, cnt, mine, sp = 0u;
    for (;;) {
        sum = 0u; cnt = 0u; mine = 0u;
#pragma unroll
        for (unsigned j = 0; j < 16; ++j) { const unsigned c = xb_ld(&bar[XB_XCNT(j)]); sum += c; cnt += (c > 0u) ? 1u : 0u; mine = (j == x) ? c : mine; }
        if (sum == G) break;
        __builtin_amdgcn_s_sleep(1);
        if ((++sp & 255u) == 0u) { if (xb_ld(&bar[XB_TMO])) break; if (sp > XB_SPIN_CAP) { atomicAdd(&bar[XB_TMO], 1u); break; } }
    }
    nloc = mine > 0u ? mine : 1u; nx = cnt > 0u ? cnt : 1u;
}

__device__ __forceinline__ void xcd_barrier(const XcdBarrier& b) {
    asm volatile("s_waitcnt vmcnt(0)" ::: "memory");
    __syncthreads();
    if (threadIdx.x == 0) {
        unsigned* bar = b.bar;
        __builtin_amdgcn_s_waitcnt(0);
        unsigned nloc = b.st[0], nx = b.st[1];
        if (nloc == 0u) { xcd_barrier_complete(bar, b.x, nloc, nx); b.st[0] = nloc; b.st[1] = nx; }
        const unsigned old = xb_add(&bar[XB_XSUB(b.x)], 1u);
        const unsigned gen = old / nloc;
        if (old + 1u == (gen + 1u) * nloc) {
            __builtin_amdgcn_fence(__ATOMIC_RELEASE, "agent");
            asm volatile("s_waitcnt vmcnt(0)" ::: "memory");
            const unsigned og = xb_add(&bar[XB_TOP], 1u);
            const unsigned tg = og / nx;
            if (og + 1u == (tg + 1u) * nx) xb_add(&bar[XB_TOPGEN], 1u);
            else XB_SPIN(xb_ld(&bar[XB_TOPGEN]) == tg, bar);
            __builtin_amdgcn_fence(__ATOMIC_ACQUIRE, "agent");
            xb_add(&bar[XB_XGEN(b.x)], 1u);
            asm volatile("s_waitcnt vmcnt(0)" ::: "memory");
        } else {
            XB_SPIN(xb_ld(&bar[XB_XGEN(b.x)]) == gen, bar);
            __builtin_amdgcn_fence(__ATOMIC_ACQUIRE, "agent");
            asm volatile("s_waitcnt vmcnt(0)" ::: "memory");
        }
    }
    __syncthreads();
}
__device__ __forceinline__ void rot8(const u32x4 x1, const u32x4 x2, const float* cp, const float* sp, float scale, float (&o1)[8], float (&o2)[8]) {
    const f32x4 c0 = *(const f32x4*)cp, c1 = *(const f32x4*)(cp + 4), s0 = *(const f32x4*)sp, s1 = *(const f32x4*)(sp + 4);
    const float cs[8] = {c0.x, c0.y, c0.z, c0.w, c1.x, c1.y, c1.z, c1.w}, sn[8] = {s0.x, s0.y, s0.z, s0.w, s1.x, s1.y, s1.z, s1.w};
    const unsigned w1[4] = {x1.x, x1.y, x1.z, x1.w}, w2[4] = {x2.x, x2.y, x2.z, x2.w};
#pragma unroll
    for (int j = 0; j < 8; ++j) {
        const float a = (j & 1) ? bfhi(w1[j >> 1]) : bflo(w1[j >> 1]);
        const float bb = (j & 1) ? bfhi(w2[j >> 1]) : bflo(w2[j >> 1]);
        o1[j] = (a * cs[j] - bb * sn[j]) * scale;
        o2[j] = (bb * cs[j] + a * sn[j]) * scale;
    }
}
struct RetPref { u32x4 q1, q2, k1, k2, v0, v1, g0, g1; f32x4 c0, c1, s0, s1; };
template <bool FULL>
__device__ __forceinline__ void ret_prefetch(RetPref& p, const bf16_t* proj, const float* cosT, const float* sinT, int s, int h, int tq) {
    const bf16_t* base = proj + (size_t)s * INC + h * 128;
    p.k1 = *(const u32x4*)(base + 1024 + tq * 8); p.k2 = *(const u32x4*)(base + 1024 + 64 + tq * 8);
    p.v0 = *(const u32x4*)(base + 2048 + tq * 16); p.v1 = *(const u32x4*)(base + 2048 + tq * 16 + 8);
    const float* cp = cosT + (size_t)s * 64 + tq * 8; const float* sp = sinT + (size_t)s * 64 + tq * 8;
    p.c0 = *(const f32x4*)cp; p.c1 = *(const f32x4*)(cp + 4); p.s0 = *(const f32x4*)sp; p.s1 = *(const f32x4*)(sp + 4);
    if (FULL) { p.q1 = *(const u32x4*)(base + tq * 8); p.q2 = *(const u32x4*)(base + 64 + tq * 8); p.g0 = *(const u32x4*)(base + 3072 + tq * 16); p.g1 = *(const u32x4*)(base + 3072 + tq * 16 + 8); }
}
__device__ __forceinline__ void rot8r(const u32x4 x1, const u32x4 x2, const RetPref& p, float scale, float (&o1)[8], float (&o2)[8]) {
    const float cs[8] = {p.c0.x, p.c0.y, p.c0.z, p.c0.w, p.c1.x, p.c1.y, p.c1.z, p.c1.w}, sn[8] = {p.s0.x, p.s0.y, p.s0.z, p.s0.w, p.s1.x, p.s1.y, p.s1.z, p.s1.w};
    const unsigned w1[4] = {x1.x, x1.y, x1.z, x1.w}, w2[4] = {x2.x, x2.y, x2.z, x2.w};
#pragma unroll
    for (int j = 0; j < 8; ++j) {
        const float a = (j & 1) ? bfhi(w1[j >> 1]) : bflo(w1[j >> 1]);
        const float bb = (j & 1) ? bfhi(w2[j >> 1]) : bflo(w2[j >> 1]);
        o1[j] = (a * cs[j] - bb * sn[j]) * scale;
        o2[j] = (bb * cs[j] + a * sn[j]) * scale;
    }
}
__device__ __forceinline__ void ret_stage_kv(const RetPref& p, LAS bf16_t* KT, LAS bf16_t* VT, int m, int tq, float kdec, float (&k1)[8], float (&k2)[8]) {
    rot8r(p.k1, p.k2, p, 1.0f, k1, k2);
#pragma unroll
    for (int j = 0; j < 8; ++j) { KT[(tq * 8 + j) * 72 + m] = (bf16_t)f2bf(k1[j] * kdec); KT[(64 + tq * 8 + j) * 72 + m] = (bf16_t)f2bf(k2[j] * kdec); }
    const unsigned yw[8] = {p.v0.x, p.v0.y, p.v0.z, p.v0.w, p.v1.x, p.v1.y, p.v1.z, p.v1.w};
#pragma unroll
    for (int j = 0; j < 8; ++j) { VT[(tq * 16 + 2 * j) * 72 + m] = (bf16_t)(yw[j] & 0xffffu); VT[(tq * 16 + 2 * j + 1) * 72 + m] = (bf16_t)(yw[j] >> 16); }
}
__device__ __forceinline__ void ret_state_update(f32x4 (&S)[8], const LAS bf16_t* KT, const LAS bf16_t* VT, float dec, int wid, int fr, int fq) {
#pragma unroll
    for (int tt = 0; tt < 8; ++tt) S[tt] = S[tt] * dec;
#pragma unroll
    for (int ks = 0; ks < 2; ++ks) {
        const bf16x8 bb = *(const LAS bf16x8*)(VT + (wid * 16 + fr) * 72 + ks * 32 + fq * 8);
#pragma unroll
        for (int tt = 0; tt < 8; ++tt) { const bf16x8 a = *(const LAS bf16x8*)(KT + (tt * 16 + fr) * 72 + ks * 32 + fq * 8); S[tt] = mfma16(a, bb, S[tt]); }
    }
}
__device__ __forceinline__ void ret_r1_phase(LAS unsigned char* lds, const bf16_t* proj, const float* cosT, const float* sinT, float* gst, int G, int b) {
    const int tid = phase_tid(), lane = tid & 63, wid = phase_wid(tid), fr = lane & 15, fq = lane >> 4;
    LAS bf16_t* KT = (LAS bf16_t*)lds;
    LAS bf16_t* VT = (LAS bf16_t*)(lds + 18432);
    const int m = tid >> 3, tq = tid & 7;
    for (int unit = b; unit < 32 * NH; unit += G) {
        const int gq = unit >> 3, h = unit & 7;
        const float log_g = head_log_gamma(h), dec = fexp_(64.0f * log_g), kdec = fexp_(log_g * (63.0f - (float)m));
        f32x4 S[8];
#pragma unroll
        for (int tt = 0; tt < 8; ++tt) S[tt] = (f32x4){0.f, 0.f, 0.f, 0.f};
        RetPref pn; ret_prefetch<false>(pn, proj, cosT, sinT, (gq * 8) * 64 + m, h, tq);
        for (int i = 0; i < 8; ++i) {
            float k1[8], k2[8];
            __syncthreads();
            ret_stage_kv(pn, KT, VT, m, tq, kdec, k1, k2);
            if (i + 1 < 8) ret_prefetch<false>(pn, proj, cosT, sinT, (gq * 8 + i + 1) * 64 + m, h, tq);
            __syncthreads();
            ret_state_update(S, KT, VT, dec, wid, fr, fq);
        }
        f32x4* op = (f32x4*)gst + ((size_t)unit * 64 + wid * 8) * 64 + lane;
#pragma unroll
        for (int tt = 0; tt < 8; ++tt) op[tt * 64] = S[tt];
    }
}
__device__ __forceinline__ void scan_phase(LAS unsigned char* lds, float* gst, const float* sumA, const float* sumH, float* Hin, int G, int b) {
    const int gtid = b * NTHREADS + phase_tid(), gth = G * NTHREADS;
    for (int p = gtid; p < 32768; p += gth) {
        const int h = p >> 12;
        const float dec8 = fexp_(512.0f * head_log_gamma(h));
        f32x4* ptr = (f32x4*)gst + p;
        f32x4 s = (f32x4){0.f, 0.f, 0.f, 0.f};
        for (int gq = 0; gq < 32; gq += 8) {
            f32x4 v[8];
#pragma unroll
            for (int j = 0; j < 8; ++j) v[j] = ptr[(size_t)(gq + j) * 32768];
#pragma unroll
            for (int j = 0; j < 8; ++j) { ptr[(size_t)(gq + j) * 32768] = s; s = s * dec8 + v[j]; }
        }
    }
    const int wg = G - 1 - b;
    if (wg < 16) {
        LAS float* SG = (LAS float*)lds;
        const int tid = phase_tid(), cl = tid & 63, sg = tid >> 6, c = wg * 64 + cl;
        float a[32], hh[32];
#pragma unroll
        for (int j = 0; j < 32; ++j) { a[j] = sumA[(sg * 32 + j) * 1024 + c]; hh[j] = sumH[(sg * 32 + j) * 1024 + c]; }
        float ap = 1.f, he = 0.f;
#pragma unroll
        for (int j = 0; j < 32; ++j) { he = a[j] * he + hh[j]; ap *= a[j]; }
        SG[sg * 64 + cl] = ap; SG[512 + sg * 64 + cl] = he;
        __syncthreads();
        float H = 0.f;
#pragma unroll
        for (int s2 = 0; s2 < 7; ++s2) if (s2 < sg) H = SG[s2 * 64 + cl] * H + SG[512 + s2 * 64 + cl];
#pragma unroll
        for (int j = 0; j < 32; ++j) { Hin[(sg * 32 + j) * 1024 + c] = H; H = a[j] * H + hh[j]; }
    }
}
__device__ __forceinline__ void ret_r3_phase(LAS unsigned char* lds, const bf16_t* proj, const float* cosT, const float* sinT, const float* gst, bf16_t* ycat, int G, int b) {
    const int tid = phase_tid(), lane = tid & 63, wid = phase_wid(tid), fr = lane & 15, fq = lane >> 4;
    LAS bf16_t* QS = (LAS bf16_t*)lds;
    LAS bf16_t* KS = (LAS bf16_t*)(lds + 17408);
    LAS bf16_t* KT = (LAS bf16_t*)(lds + 34816);
    LAS bf16_t* VT = (LAS bf16_t*)(lds + 53248);
    LAS bf16_t* PS = (LAS bf16_t*)(lds + 71680);
    LAS float*  OS = (LAS float*)(lds + 80896);
    const int m = tid >> 3, tq = tid & 7;
    for (int unit = b; unit < 32 * NH; unit += G) {
        const int gq = unit >> 3, h = unit & 7;
        const float log_g = head_log_gamma(h), dec = fexp_(64.0f * log_g), kdec = fexp_(log_g * (63.0f - (float)m));
        f32x4 S[8];
        {   const f32x4* ip = (const f32x4*)gst + ((size_t)unit * 64 + wid * 8) * 64 + lane;
#pragma unroll
            for (int tt = 0; tt < 8; ++tt) S[tt] = ip[tt * 64]; }
        RetPref pn; ret_prefetch<true>(pn, proj, cosT, sinT, (gq * 8) * 64 + m, h, tq);
        for (int i = 0; i < 8; ++i) {
            const int s = (gq * 8 + i) * 64 + m;
            const u32x4 gc0 = pn.g0, gc1 = pn.g1;
            {
                float o1[8], o2[8];
                rot8r(pn.q1, pn.q2, pn, 0.08838834764831845f, o1, o2);
                *(LAS u32x4*)(QS + m * 136 + tq * 8) = (u32x4){pk2(o1[0], o1[1]), pk2(o1[2], o1[3]), pk2(o1[4], o1[5]), pk2(o1[6], o1[7])};
                *(LAS u32x4*)(QS + m * 136 + 64 + tq * 8) = (u32x4){pk2(o2[0], o2[1]), pk2(o2[2], o2[3]), pk2(o2[4], o2[5]), pk2(o2[6], o2[7])};
                ret_stage_kv(pn, KT, VT, m, tq, kdec, o1, o2);
                *(LAS u32x4*)(KS + m * 136 + tq * 8) = (u32x4){pk2(o1[0], o1[1]), pk2(o1[2], o1[3]), pk2(o1[4], o1[5]), pk2(o1[6], o1[7])};
                *(LAS u32x4*)(KS + m * 136 + 64 + tq * 8) = (u32x4){pk2(o2[0], o2[1]), pk2(o2[2], o2[3]), pk2(o2[4], o2[5]), pk2(o2[6], o2[7])};
            }
            if (i + 1 < 8) ret_prefetch<true>(pn, proj, cosT, sinT, s + 64, h, tq);
            __syncthreads();
            f32x4 oacc[4];
            {
                const int ct = wid & 3, mt0 = (wid >> 2) * 2;
                f32x4 sacc[2] = {(f32x4){0.f, 0.f, 0.f, 0.f}, (f32x4){0.f, 0.f, 0.f, 0.f}};
#pragma unroll
                for (int ks = 0; ks < 4; ++ks) {
                    const bf16x8 a = *(const LAS bf16x8*)(QS + (ct * 16 + fr) * 136 + ks * 32 + fq * 8);
#pragma unroll
                    for (int j = 0; j < 2; ++j) { const bf16x8 bb = *(const LAS bf16x8*)(KS + ((mt0 + j) * 16 + fr) * 136 + ks * 32 + fq * 8); sacc[j] = mfma16(a, bb, sacc[j]); }
                }
#pragma unroll
                for (int j = 0; j < 2; ++j)
#pragma unroll
                    for (int r = 0; r < 4; ++r) { const int c = ct * 16 + fq * 4 + r, mm = (mt0 + j) * 16 + fr; const float dd = fabsf((float)(c - mm));
                        PS[c * 72 + mm] = (bf16_t)f2bf(sacc[j][r] * fexp_(log_g * dd)); }
                asm volatile("" ::: "memory");
#pragma unroll
                for (int c4 = 0; c4 < 4; ++c4) oacc[c4] = (f32x4){0.f, 0.f, 0.f, 0.f};
#pragma unroll
                for (int a4 = 0; a4 < 4; ++a4) {
                    u32x4 bw; bw.x = pk2(S[2 * a4][0], S[2 * a4][1]); bw.y = pk2(S[2 * a4][2], S[2 * a4][3]); bw.z = pk2(S[2 * a4 + 1][0], S[2 * a4 + 1][1]); bw.w = pk2(S[2 * a4 + 1][2], S[2 * a4 + 1][3]);
                    const bf16x8 bb = __builtin_bit_cast(bf16x8, bw);
#pragma unroll
                    for (int c4 = 0; c4 < 4; ++c4) {
                        const u32x2 lo = *(const LAS u32x2*)(QS + (c4 * 16 + fr) * 136 + a4 * 32 + fq * 4), hi = *(const LAS u32x2*)(QS + (c4 * 16 + fr) * 136 + a4 * 32 + 16 + fq * 4);
                        const bf16x8 a = __builtin_bit_cast(bf16x8, (u32x4){lo.x, lo.y, hi.x, hi.y});
                        oacc[c4] = mfma16(a, bb, oacc[c4]);
                    }
                    asm volatile("" ::: "memory");
                }
#pragma unroll
                for (int c4 = 0; c4 < 4; ++c4)
#pragma unroll
                    for (int r = 0; r < 4; ++r) oacc[c4][r] *= fexp_(log_g * (float)(c4 * 16 + fq * 4 + r + 1));
            }
            __syncthreads();
            {
#pragma unroll
                for (int ks = 0; ks < 2; ++ks) {
                    const bf16x8 bb = *(const LAS bf16x8*)(VT + (wid * 16 + fr) * 72 + ks * 32 + fq * 8);
#pragma unroll
                    for (int c4 = 0; c4 < 4; ++c4) { const bf16x8 a = *(const LAS bf16x8*)(PS + (c4 * 16 + fr) * 72 + ks * 32 + fq * 8); oacc[c4] = mfma16(a, bb, oacc[c4]); }
                }
#pragma unroll
                for (int c4 = 0; c4 < 4; ++c4)
#pragma unroll
                    for (int r = 0; r < 4; ++r) OS[(c4 * 16 + fq * 4 + r) * 132 + wid * 16 + fr] = oacc[c4][r];
                ret_state_update(S, KT, VT, dec, wid, fr, fq);
            }
            __syncthreads();
            {
                float v[16]; float sum = 0.f;
#pragma unroll
                for (int q = 0; q < 4; ++q) { const f32x4 t = *(const LAS f32x4*)(OS + m * 132 + tq * 16 + q * 4); v[4 * q] = t.x; v[4 * q + 1] = t.y; v[4 * q + 2] = t.z; v[4 * q + 3] = t.w; sum += (t.x + t.y) + (t.z + t.w); }
                sum += __shfl_xor(sum, 1); sum += __shfl_xor(sum, 2); sum += __shfl_xor(sum, 4);
                const float mean = sum * (1.0f / 128.0f); float sq = 0.f;
#pragma unroll
                for (int q = 0; q < 16; ++q) { v[q] -= mean; sq += v[q] * v[q]; }
                sq += __shfl_xor(sq, 1); sq += __shfl_xor(sq, 2); sq += __shfl_xor(sq, 4);
                const float rstd = 1.0f / sqrtf(sq * (1.0f / 128.0f) + GN_EPS);
                const unsigned gw[8] = {gc0.x, gc0.y, gc0.z, gc0.w, gc1.x, gc1.y, gc1.z, gc1.w};
                unsigned ow[8];
#pragma unroll
                for (int j = 0; j < 8; ++j) { const float ga = bflo(gw[j]), gb = bfhi(gw[j]);
                    ow[j] = pk2(ga * sigmoidf_(ga) * v[2 * j] * rstd, gb * sigmoidf_(gb) * v[2 * j + 1] * rstd); }
                bf16_t* yp = ycat + (size_t)s * D_ + h * 128 + tq * 16;
                *(u32x4*)yp = (u32x4){ow[0], ow[1], ow[2], ow[3]}; *(u32x4*)(yp + 8) = (u32x4){ow[4], ow[5], ow[6], ow[7]};
            }
        }
        __syncthreads();
    }
}
template <int MODE>
__device__ __forceinline__ void lru_phase(LAS unsigned char* lds, const bf16_t* proj, const Ptrs& P, const bf16_t* wraT, const bf16_t* wriT,
                                          float* sumA, float* sumH, const float* Hin, bf16_t* ycat, int G, int b) {
    const int tid = phase_tid(), lane = tid & 63, wid = phase_wid(tid), fr = lane & 15, fq = lane >> 4;
    LAS float*  XC  = (LAS float*)lds;
    LAS bf16_t* XCb = (LAS bf16_t*)(lds + 33792);
    LAS float*  AA  = (LAS float*)(lds + 51200);
    LAS float*  SEG = (LAS float*)(lds + 84992);
    LAS bf16_t* WR  = (LAS bf16_t*)(lds + 89088);
    LAS bf16_t* WI  = (LAS bf16_t*)(lds + 123904);
    LAS float*  BB  = XC;
    const int st = wid & 3, jt0 = (wid >> 2) * 4;
    const int m = tid >> 3, part = tid & 7, j0 = part * 16;
    const int sj = tid & 127, seg = tid >> 7;
    int gcur = -1;
    float bra[4], bri[4], ls[4]; float cw0[4], cw1[4], cb0 = 0.f, cb1 = 0.f;
    unsigned xnext[11]; u32x4 gnext[2] = {(u32x4){0u, 0u, 0u, 0u}, (u32x4){0u, 0u, 0u, 0u}}; float hnext = 0.f;
    auto issue = [&](int unit) {
        const int n = unit >> 3, c0 = (unit & 7) * 128;
        const int r0 = n * 64 + wid * 8 - 3;
#pragma unroll
        for (int q = 0; q < 11; ++q) { const int row = r0 + q; xnext[q] = row >= 0 ? *(const unsigned*)(proj + (size_t)row * INC + 4096 + c0 + 2 * lane) : 0u; }
        if (MODE == 1) {
            const bf16_t* gp = proj + (size_t)(n * 64 + m) * INC + 5120 + c0 + j0;
            gnext[0] = *(const u32x4*)gp; gnext[1] = *(const u32x4*)(gp + 8);
            hnext = Hin[n * 1024 + c0 + sj];
        }
    };
    if (b < NCH * 8) issue(b);
    for (int unit = b; unit < NCH * 8; unit += G) {
        const int n = unit >> 3, g = unit & 7, c0 = g * 128;
        if (g != gcur) {
            gcur = g;
            __syncthreads();
            {
                const int row = tid >> 2, pc = tid & 3;
#pragma unroll
                for (int q = 0; q < 4; ++q) { const int piece = pc * 4 + q;
                    *(LAS u32x4*)(WR + row * 136 + piece * 8) = *(const u32x4*)(wraT + (size_t)g * 16384 + row * 128 + piece * 8);
                    *(LAS u32x4*)(WI + row * 136 + piece * 8) = *(const u32x4*)(wriT + (size_t)g * 16384 + row * 128 + piece * 8); }
            }
#pragma unroll
            for (int j = 0; j < 4; ++j) {
                const int c = c0 + (jt0 + j) * 16 + fr;
                bra[j] = P.b_ra[c]; bri[j] = P.b_ri[c]; ls[j] = -8.0f * log1pf(expf(-P.lam[c]));
            }
#pragma unroll
            for (int kk = 0; kk < 4; ++kk) { cw0[kk] = P.conv_w[kk * 1024 + c0 + 2 * lane]; cw1[kk] = P.conv_w[kk * 1024 + c0 + 2 * lane + 1]; }
            cb0 = P.conv_b[c0 + 2 * lane]; cb1 = P.conv_b[c0 + 2 * lane + 1];
        }
        unsigned xcur[11];
#pragma unroll
        for (int q = 0; q < 11; ++q) xcur[q] = xnext[q];
        const u32x4 gc0 = gnext[0], gc1 = gnext[1]; const float hin0 = hnext;
        if (unit + G < NCH * 8) issue(unit + G);
        QRow qrow; const int qe = unit * 8 + wid;
        quant_issue(qrow, MODE == 1 ? P.peer_v : P.peer_u, qe, lane);
#pragma unroll
        for (int rr = 0; rr < 8; ++rr) {
            float x0 = cb0, x1 = cb1;
#pragma unroll
            for (int kk = 0; kk < 4; ++kk) { x0 += cw0[kk] * bflo(xcur[rr + kk]); x1 += cw1[kk] * bfhi(xcur[rr + kk]); }
            const int row = wid * 8 + rr;
            XC[row * 132 + 2 * lane] = x0; XC[row * 132 + 2 * lane + 1] = x1;
            *(LAS unsigned*)(XCb + row * 136 + 2 * lane) = pk2(x0, x1);
        }
        __syncthreads();
        {
            f32x4 ar[4], ai[4];
#pragma unroll
            for (int j = 0; j < 4; ++j) { ar[j] = (f32x4){0.f, 0.f, 0.f, 0.f}; ai[j] = (f32x4){0.f, 0.f, 0.f, 0.f}; }
#pragma unroll
            for (int ks = 0; ks < 4; ++ks) {
                const bf16x8 a = *(const LAS bf16x8*)(XCb + (st * 16 + fr) * 136 + ks * 32 + fq * 8);
#pragma unroll
                for (int j = 0; j < 4; ++j) { const int wo = ((jt0 + j) * 16 + fr) * 136 + ks * 32 + fq * 8;
                    ar[j] = mfma16(a, *(const LAS bf16x8*)(WR + wo), ar[j]); ai[j] = mfma16(a, *(const LAS bf16x8*)(WI + wo), ai[j]); }
            }
#pragma unroll
            for (int j = 0; j < 4; ++j) {
                const int col = (jt0 + j) * 16 + fr;
#pragma unroll
                for (int r = 0; r < 4; ++r) {
                    const int sl = st * 16 + fq * 4 + r;
                    const float rg = sigmoidf_(ar[j][r] + bra[j]), ig = sigmoidf_(ai[j][r] + bri[j]);
                    const float a = fexp_(rg * ls[j]);
                    const float bv = __builtin_amdgcn_sqrtf(fmaxf(1.0f - a * a, 0.f)) * (ig * XC[sl * 132 + col]);
                    AA[sl * 132 + col] = a; BB[sl * 132 + col] = bv;
                }
            }
        }
        __syncthreads();
        float ap = 1.f, he = 0.f;
#pragma unroll
        for (int q = 0; q < 16; ++q) { const float a = AA[(seg * 16 + q) * 132 + sj], bv = BB[(seg * 16 + q) * 132 + sj]; he = a * he + bv; ap *= a; }
        SEG[seg * 128 + sj] = ap; SEG[512 + seg * 128 + sj] = he;
        __syncthreads();
        float hin = (MODE == 1) ? hin0 : 0.f;
#pragma unroll
        for (int s2 = 0; s2 < 3; ++s2) if (s2 < seg) hin = SEG[s2 * 128 + sj] * hin + SEG[512 + s2 * 128 + sj];
        if (MODE == 0) {
            if (seg == 3) { sumA[n * 1024 + c0 + sj] = SEG[sj] * SEG[128 + sj] * SEG[256 + sj] * ap; sumH[n * 1024 + c0 + sj] = ap * hin + he; }
        } else {
            float hcur = hin;
#pragma unroll
            for (int q = 0; q < 16; ++q) { const int o = (seg * 16 + q) * 132 + sj; hcur = AA[o] * hcur + BB[o]; BB[o] = hcur; }
            __syncthreads();
            const unsigned gw[8] = {gc0.x, gc0.y, gc0.z, gc0.w, gc1.x, gc1.y, gc1.z, gc1.w};
            unsigned ow[8];
#pragma unroll
            for (int q = 0; q < 8; ++q) { const float h0 = BB[m * 132 + j0 + 2 * q], h1 = BB[m * 132 + j0 + 2 * q + 1];
                ow[q] = pk2(h0 * gelu_tanh(bflo(gw[q])), h1 * gelu_tanh(bfhi(gw[q]))); }
            bf16_t* yp = ycat + (size_t)(n * 64 + m) * D_ + 1024 + c0 + j0;
            *(u32x4*)yp = (u32x4){ow[0], ow[1], ow[2], ow[3]}; *(u32x4*)(yp + 8) = (u32x4){ow[4], ow[5], ow[6], ow[7]};
        }
        quant_finish<MODE>(qrow, P.ws + (MODE == 1 ? WS_VQ : WS_UQ), (float*)(P.ws + (MODE == 1 ? WS_SV : WS_SU)), qe, lane);
        __syncthreads();
    }
}
__device__ __forceinline__ void ln1_phase(const bf16_t* buf, bf16_t* h1b, unsigned* xqs, float* sx, const float* gam, const float* bet, int G, int b) {
    const int tid_ = phase_tid(), lane = tid_ & 63, wid = phase_wid(tid_);
    const int gw = b * NWAVES + wid, NGW = G * NWAVES;
    for (int row = gw; row < S_; row += NGW) {
        const bf16_t* rp = buf + (size_t)row * D_;
        f32x4 v[8]; float sum = 0.f;
#pragma unroll
        for (int j = 0; j < 8; ++j) { const u32x2 w = *(const u32x2*)(rp + 256 * j + 4 * lane); v[j] = (f32x4){bflo(w.x), bfhi(w.x), bflo(w.y), bfhi(w.y)}; sum += (v[j].x + v[j].y) + (v[j].z + v[j].w); }
        const float mean = wave_sum(sum) * (1.0f / D_); float sq = 0.f;
#pragma unroll
        for (int j = 0; j < 8; ++j) { v[j] = v[j] - mean; sq += (v[j].x * v[j].x + v[j].y * v[j].y) + (v[j].z * v[j].z + v[j].w * v[j].w); }
        const float rstd = 1.0f / sqrtf(wave_sum(sq) * (1.0f / D_) + LN_EPS);
        float amax = 0.f;
#pragma unroll
        for (int j = 0; j < 8; ++j) {
            const f32x4 gg = *(const f32x4*)(gam + 256 * j + 4 * lane), bb = *(const f32x4*)(bet + 256 * j + 4 * lane);
            v[j] = v[j] * rstd * gg + bb;
            *(u32x2*)(h1b + (size_t)row * D_ + 256 * j + 4 * lane) = (u32x2){pk2(v[j].x, v[j].y), pk2(v[j].z, v[j].w)};
            amax = fmaxf(amax, fmaxf(fmaxf(fabsf(v[j].x), fabsf(v[j].y)), fmaxf(fabsf(v[j].z), fabsf(v[j].w))));
        }
        amax = wave_max(amax);
        const float inv = amax > 0.f ? 127.0f / amax : 0.f;
        if (lane == 0) sx[row] = amax * (1.0f / 127.0f);
#pragma unroll
        for (int j = 0; j < 8; ++j) {
            const int a = (int)rintf(v[j].x * inv), bq = (int)rintf(v[j].y * inv), c = (int)rintf(v[j].z * inv), d = (int)rintf(v[j].w * inv);
            xqs[((size_t)j * S_ + row) * 64 + lane] = (unsigned)(a & 255) | ((unsigned)(bq & 255) << 8) | ((unsigned)(c & 255) << 16) | ((unsigned)(d & 255) << 24);
        }
    }
}
__device__ __forceinline__ unsigned mono(float f) { const unsigned u = __float_as_uint(f); return (u & 0x80000000u) ? ~u : (u ^ 0x80000000u); }
__device__ __forceinline__ float unmono(unsigned u) { return __uint_as_float((u & 0x80000000u) ? (u ^ 0x80000000u) : ~u); }
__device__ __forceinline__ unsigned umax_(unsigned a, unsigned b) { return a > b ? a : b; }
__device__ __forceinline__ constexpr int cand_i(int c) { return c < 16 ? 0 : c < 24 ? 1 : c < 29 ? 2 : c < 33 ? 3 : c < 36 ? 4 : c < 38 ? 5 : c < 40 ? 6 : c < 42 ? 7 : c - 34; }
__device__ __forceinline__ constexpr int cand_j(int c) { return c < 16 ? c : c < 24 ? c - 16 : c < 29 ? c - 24 : c < 33 ? c - 29 : c < 36 ? c - 33 : c < 38 ? c - 36 : c < 40 ? c - 38 : c < 42 ? c - 40 : 0; }

__device__ __forceinline__ unsigned umin_(unsigned a, unsigned b) { return a < b ? a : b; }
#define SN_CE(x, y) do { const unsigned hi_ = umax_(x, y), lo_ = umin_(x, y); x = hi_; y = lo_; } while (0)
#define SN_SORT16(a) do { SN_CE(a[0], a[1]); SN_CE(a[2], a[3]); SN_CE(a[0], a[2]); SN_CE(a[1], a[3]); SN_CE(a[1], a[2]); SN_CE(a[4], a[5]); SN_CE(a[6], a[7]); SN_CE(a[4], a[6]); SN_CE(a[5], a[7]); SN_CE(a[5], a[6]); SN_CE(a[0], a[4]); SN_CE(a[2], a[6]); SN_CE(a[2], a[4]); SN_CE(a[1], a[5]); SN_CE(a[3], a[7]); SN_CE(a[3], a[5]); SN_CE(a[1], a[2]); SN_CE(a[3], a[4]); SN_CE(a[5], a[6]); SN_CE(a[8], a[9]); SN_CE(a[10], a[11]); SN_CE(a[8], a[10]); SN_CE(a[9], a[11]); SN_CE(a[9], a[10]); SN_CE(a[12], a[13]); SN_CE(a[14], a[15]); SN_CE(a[12], a[14]); SN_CE(a[13], a[15]); SN_CE(a[13], a[14]); SN_CE(a[8], a[12]); SN_CE(a[10], a[14]); SN_CE(a[10], a[12]); SN_CE(a[9], a[13]); SN_CE(a[11], a[15]); SN_CE(a[11], a[13]); SN_CE(a[9], a[10]); SN_CE(a[11], a[12]); SN_CE(a[13], a[14]); SN_CE(a[0], a[8]); SN_CE(a[4], a[12]); SN_CE(a[4], a[8]); SN_CE(a[2], a[10]); SN_CE(a[6], a[14]); SN_CE(a[6], a[10]); SN_CE(a[2], a[4]); SN_CE(a[6], a[8]); SN_CE(a[10], a[12]); SN_CE(a[1], a[9]); SN_CE(a[5], a[13]); SN_CE(a[5], a[9]); SN_CE(a[3], a[11]); SN_CE(a[7], a[15]); SN_CE(a[7], a[11]); SN_CE(a[3], a[5]); SN_CE(a[7], a[9]); SN_CE(a[11], a[13]); SN_CE(a[1], a[2]); SN_CE(a[3], a[4]); SN_CE(a[5], a[6]); SN_CE(a[7], a[8]); SN_CE(a[9], a[10]); SN_CE(a[11], a[12]); SN_CE(a[13], a[14]); } while (0)
#define SN_BITONIC16(a) do { SN_CE(a[0], a[8]); SN_CE(a[1], a[9]); SN_CE(a[2], a[10]); SN_CE(a[3], a[11]); SN_CE(a[4], a[12]); SN_CE(a[5], a[13]); SN_CE(a[6], a[14]); SN_CE(a[7], a[15]); SN_CE(a[0], a[4]); SN_CE(a[1], a[5]); SN_CE(a[2], a[6]); SN_CE(a[3], a[7]); SN_CE(a[8], a[12]); SN_CE(a[9], a[13]); SN_CE(a[10], a[14]); SN_CE(a[11], a[15]); SN_CE(a[0], a[2]); SN_CE(a[1], a[3]); SN_CE(a[4], a[6]); SN_CE(a[5], a[7]); SN_CE(a[8], a[10]); SN_CE(a[9], a[11]); SN_CE(a[12], a[14]); SN_CE(a[13], a[15]); SN_CE(a[0], a[1]); SN_CE(a[2], a[3]); SN_CE(a[4], a[5]); SN_CE(a[6], a[7]); SN_CE(a[8], a[9]); SN_CE(a[10], a[11]); SN_CE(a[12], a[13]); SN_CE(a[14], a[15]); } while (0)

#define TOPK_XMERGE(T, mask) do { unsigned pt_[16]; \
    _Pragma("unroll") for (int i_ = 0; i_ < 16; ++i_) pt_[i_] = (unsigned)__shfl_xor((int)T[15 - i_], mask); \
    _Pragma("unroll") for (int i_ = 0; i_ < 16; ++i_) T[i_] = umax_(T[i_], pt_[i_]); \
    SN_BITONIC16(T); } while (0)
__device__ __forceinline__ void topk_phase(LAS unsigned char* lds, const bf16_t* qp, const bf16_t* keys, const float* SU, const float* SV, int* sel_e, float* sel_g, float* sel_su, int G, int b) {
    const int tid = phase_tid(), lane = tid & 63, wid = phase_wid(tid), fr = lane & 15, fq = lane >> 4;
    LAS unsigned* wl = (LAS unsigned*)(lds + wid * 4096 + fr * 256);
    for (int unit = b; unit < (S_ / 128) * 8; unit += G) {
        const int tt = unit >> 3, h = unit & 7;
        const int tok = tt * 128 + wid * 16 + fr;
        unsigned T[2][16];
#pragma unroll
        for (int p = 0; p < 2; ++p) {
            f32x4 acc[8];
#pragma unroll
            for (int mt = 0; mt < 8; ++mt) acc[mt] = (f32x4){0.f, 0.f, 0.f, 0.f};
            bf16x8 bq[4];
#pragma unroll
            for (int ks = 0; ks < 4; ++ks) bq[ks] = *(const bf16x8*)(qp + (size_t)tok * D_ + h * 256 + p * 128 + ks * 32 + fq * 8);
            const bf16_t* kb = keys + (size_t)(h * 2 + p) * 16384;
#pragma unroll
            for (int mt = 0; mt < 8; ++mt)
#pragma unroll
                for (int ks = 0; ks < 4; ++ks) { const bf16x8 a = *(const bf16x8*)(kb + (mt * 16 + fr) * 128 + ks * 32 + fq * 8); acc[mt] = mfma16(a, bq[ks], acc[mt]); }
            unsigned lo16[16];
#pragma unroll
            for (int mt = 0; mt < 4; ++mt)
#pragma unroll
                for (int r = 0; r < 4; ++r) {
                    T[p][mt * 4 + r] = (mono(acc[mt][r]) & ~127u) | (unsigned)(127 - (mt * 16 + fq * 4 + r));
                    lo16[mt * 4 + r] = (mono(acc[mt + 4][r]) & ~127u) | (unsigned)(127 - ((mt + 4) * 16 + fq * 4 + r));
                }
            SN_SORT16(T[p]); SN_SORT16(lo16);
#pragma unroll
            for (int i = 0; i < 16; ++i) T[p][i] = umax_(T[p][i], lo16[15 - i]);
            SN_BITONIC16(T[p]);
            TOPK_XMERGE(T[p], 16); TOPK_XMERGE(T[p], 32);
        }
        float v1[16], v2[16];
#pragma unroll
        for (int i = 0; i < 16; ++i) { v1[i] = unmono(T[0][i] & ~127u); v2[i] = unmono(T[1][i] & ~127u); }
        unsigned ck[16];
#pragma unroll
        for (int sidx = 0; sidx < 13; ++sidx) {
            unsigned keyk[4];
#pragma unroll
            for (int k = 0; k < 4; ++k) {
                const int c = 4 * sidx + k;
                if (c < 50) { const int ci = cand_i(c), cj = cand_j(c); keyk[k] = (mono(v1[ci] + v2[cj]) & ~255u) | (unsigned)(255 - (ci * 16 + cj)); }
                else keyk[k] = 0u;
            }
            ck[sidx] = fq == 0 ? keyk[0] : fq == 1 ? keyk[1] : fq == 2 ? keyk[2] : keyk[3];
        }
        ck[13] = 0u; ck[14] = 0u; ck[15] = 0u;
        SN_SORT16(ck);
        TOPK_XMERGE(ck, 16); TOPK_XMERGE(ck, 32);
        if (fq == 0) {
#pragma unroll
            for (int i = 0; i < 16; ++i) { wl[i] = T[0][i]; wl[16 + i] = T[1][i]; }
        }
        __syncthreads();
        {
            const float vmax = unmono(ck[0] & ~255u);
            float esum = 0.f;
#pragma unroll
            for (int k = 0; k < 16; ++k) esum += __expf(unmono(ck[k] & ~255u) - vmax);
            const float einv = 1.0f / esum;
#pragma unroll
            for (int kk = 0; kk < 4; ++kk) {
                const unsigned W = fq == 0 ? ck[kk] : fq == 1 ? ck[4 + kk] : fq == 2 ? ck[8 + kk] : ck[12 + kk];
                const int k = fq * 4 + kk;
                const unsigned id = 255u - (W & 255u);
                const unsigned e1 = 127u - (wl[id >> 4] & 127u), e2 = 127u - (wl[16 + (id & 15u)] & 127u);
                const size_t o = ((size_t)tok * 8 + h) * 16 + k;
                const unsigned ex = e1 * 128u + e2;
                sel_e[o] = (int)ex; sel_g[o] = __expf(unmono(W & ~255u) - vmax) * einv * SV[ex]; sel_su[o] = SU[ex];
            }
        }
        __syncthreads();
    }
}
__device__ __forceinline__ int row16_sum_i(int v) {
    v += __builtin_amdgcn_update_dpp(0, v, 0xB1, 0xF, 0xF, true);
    v += __builtin_amdgcn_update_dpp(0, v, 0x4E, 0xF, 0xF, true);
    v += __builtin_amdgcn_update_dpp(0, v, 0x141, 0xF, 0xF, true);
    v += __builtin_amdgcn_update_dpp(0, v, 0x140, 0xF, 0xF, true);
    return v;
}
__device__ __forceinline__ int dot16_i8(const u32x4 a, const u32x4 x) {
    int d = __builtin_amdgcn_sdot4((int)a.x, (int)x.x, 0, false); d = __builtin_amdgcn_sdot4((int)a.y, (int)x.y, d, false);
    d = __builtin_amdgcn_sdot4((int)a.z, (int)x.z, d, false); return __builtin_amdgcn_sdot4((int)a.w, (int)x.w, d, false);
}
__device__ __forceinline__ void peer_u_phase(LAS unsigned char* lds, const unsigned char* UQs, const unsigned char* XQs, const int* sel_e, int* pd, int xi, int nx, int rank, int nloc) {
    const int tid_ = phase_tid(), lane = tid_ & 63, wid = phase_wid(tid_), r = lane >> 4, i = lane & 15;
    LAS int* esb = (LAS int*)(lds + wid * 2048);
    const int wx = rank * NWAVES + wid, nwx = nloc * NWAVES;
    if (wx >= S_) return;
    const int NT = (S_ - wx + nwx - 1) / nwx;
    for (int j = xi; j < 8; j += nx) {
        const unsigned char* Uj = UQs + (size_t)j * 16384 * 256; const unsigned li = 16u * (unsigned)i;
        const unsigned char* Xj = XQs + (size_t)j * S_ * 256 + 16 * i;
        u32x4 A[16], B[16];
        int ma, mb; u32x4 xc, xn;
        {
            const int t0 = wx, t1 = (NT > 1) ? wx + nwx : wx;
            ma = sel_e[(size_t)t0 * 128 + lane]; mb = sel_e[(size_t)t0 * 128 + 64 + lane]; xc = *(const u32x4*)(Xj + (size_t)t0 * 256);
            esb[lane] = ma; esb[64 + lane] = mb;
            asm volatile("" ::: "memory");
#pragma unroll
            for (int it = 0; it < 16; ++it) A[it] = *(const u32x4*)(Uj + ((unsigned)esb[4 * it + r] * 256u + li));
#pragma unroll
            for (int it = 0; it < 16; ++it) B[it] = *(const u32x4*)(Uj + ((unsigned)esb[64 + 4 * it + r] * 256u + li));
            ma = sel_e[(size_t)t1 * 128 + lane]; mb = sel_e[(size_t)t1 * 128 + 64 + lane]; xn = *(const u32x4*)(Xj + (size_t)t1 * 256);
        }
        for (int n = 0; n < NT; ++n) {
            const int t = wx + n * nwx;
            const int t2 = (n + 2 < NT) ? t + 2 * nwx : t;
            LAS int* esn = esb + ((n + 1) & 1) * 128;
            esn[lane] = ma; esn[64 + lane] = mb;
            const u32x4 xnn = xn;
            asm volatile("" ::: "memory");
            ma = sel_e[(size_t)t2 * 128 + lane]; mb = sel_e[(size_t)t2 * 128 + 64 + lane]; xn = *(const u32x4*)(Xj + (size_t)t2 * 256);
            int keepA = 0, keepB = 0;
#pragma unroll
            for (int it = 0; it < 16; ++it) { const int d = row16_sum_i(dot16_i8(A[it], xc)); keepA = (i == it) ? d : keepA; }
            asm volatile("" : "+v"(keepA) :: "memory");
#pragma unroll
            for (int it = 0; it < 16; ++it) A[it] = *(const u32x4*)(Uj + ((unsigned)esn[4 * it + r] * 256u + li));
            asm volatile("" ::: "memory");
#pragma unroll
            for (int it = 0; it < 16; ++it) { const int d = row16_sum_i(dot16_i8(B[it], xc)); keepB = (i == it) ? d : keepB; }
            asm volatile("" : "+v"(keepB) :: "memory");
#pragma unroll
            for (int it = 0; it < 16; ++it) B[it] = *(const u32x4*)(Uj + ((unsigned)esn[64 + 4 * it + r] * 256u + li));
            asm volatile("" ::: "memory");
            int* pp = pd + ((size_t)t * 8 + j) * 128 + 4 * i + r;
            pp[0] = keepA; pp[64] = keepB;
            xc = xnn;
        }
    }
}
typedef float f32x2 __attribute__((ext_vector_type(2)));
__device__ __forceinline__ void acc16_fp8(f32x2 (&acc)[8], const u32x4 v, float c) {
    const int w[4] = {(int)v.x, (int)v.y, (int)v.z, (int)v.w};
    const f32x2 cc = {c, c};
#pragma unroll
    for (int q = 0; q < 4; ++q) {
        const f32x2 lo = __builtin_amdgcn_cvt_pk_f32_fp8(w[q], false), hi = __builtin_amdgcn_cvt_pk_f32_fp8(w[q], true);
        acc[2 * q] = __builtin_elementwise_fma(cc, lo, acc[2 * q]); acc[2 * q + 1] = __builtin_elementwise_fma(cc, hi, acc[2 * q + 1]);
    }
}
__device__ __forceinline__ void peer_coef_phase(const float* sel_g, const float* sel_su, const int* pd, const float* SX, float* coef, int G, int b) {
    const int tid_ = phase_tid(), lane = tid_ & 63, wid = phase_wid(tid_);
    const int gw = b * NWAVES + wid, NGW = G * NWAVES;
    for (int t = gw; t < S_; t += NGW) {
        const float* gp = sel_g + (size_t)t * 128 + lane; const float* up = sel_su + (size_t)t * 128 + lane; const int* pp = pd + (size_t)t * 1024 + lane;
        const float sxt = SX[t];
#pragma unroll
        for (int hh = 0; hh < 2; ++hh) {
            int ds = 0;
#pragma unroll
            for (int jj = 0; jj < 8; ++jj) ds += pp[jj * 128 + 64 * hh];
            coef[(size_t)t * 128 + 64 * hh + lane] = gp[64 * hh] * gelu_tanh((float)ds * (up[64 * hh] * sxt));
        }
    }
}
struct PeerMeta { int e[2]; float c[2]; };
__device__ __forceinline__ void peer_meta_load(PeerMeta& m, const int* sel_e, const float* coef, int t, int lane) {
    const int* ep = sel_e + (size_t)t * 128 + lane; const float* cp = coef + (size_t)t * 128 + lane;
    m.e[0] = ep[0]; m.e[1] = ep[64]; m.c[0] = cp[0]; m.c[1] = cp[64];
}
template <int STRIP>
__device__ __forceinline__ void peer_v_phase(LAS unsigned char* lds, const unsigned char* VQs, const int* sel_e, const float* coef,
                                             bf16_t* zs, int xi, int nx, int rank, int nloc) {
    const int tid_ = phase_tid(), lane = tid_ & 63, wid = phase_wid(tid_), r = lane >> 4, i = lane & 15;
    LAS int* esb = (LAS int*)(lds + wid * 2048); LAS float* csb = (LAS float*)(lds + wid * 2048 + 1024);
    const int wx = rank * NWAVES + wid, nwx = nloc * NWAVES;
    if (wx >= S_) return;
    const int NT = (S_ - wx + nwx - 1) / nwx;
    for (int j = xi; j < 8; j += nx) {
        const unsigned char* Vj = VQs + (size_t)j * 16384 * 256; const unsigned li = 16u * (unsigned)i;
        u32x4 A[16], B[16];
        PeerMeta m;
        {
            peer_meta_load(m, sel_e, coef, wx, lane);
#pragma unroll
            for (int hh = 0; hh < 2; ++hh) { const int k = 64 * hh + lane; esb[k] = m.e[hh]; csb[k] = m.c[hh]; }
            asm volatile("" ::: "memory");
#pragma unroll
            for (int it = 0; it < 16; ++it) A[it] = *(const u32x4*)(Vj + ((unsigned)esb[4 * it + r] * 256u + li));
#pragma unroll
            for (int it = 0; it < 16; ++it) B[it] = *(const u32x4*)(Vj + ((unsigned)esb[64 + 4 * it + r] * 256u + li));
            peer_meta_load(m, sel_e, coef, (NT > 1) ? wx + nwx : wx, lane);
        }
        for (int n = 0; n < NT; ++n) {
            const int t = wx + n * nwx;
            const int t2 = (n + 2 < NT) ? t + 2 * nwx : t;
            LAS int* esn = esb + ((n + 1) & 1) * 128; LAS float* csn = csb + ((n + 1) & 1) * 128;
            const LAS float* csc = csb + (n & 1) * 128;
            esn[lane] = m.e[0]; esn[64 + lane] = m.e[1];
            asm volatile("" ::: "memory");
            f32x2 acc2[8];
#pragma unroll
            for (int q = 0; q < 8; ++q) acc2[q] = (f32x2){0.f, 0.f};
#pragma unroll
            for (int it = 0; it < 16; ++it) { if (STRIP == 1) { acc2[it & 7].x += __uint_as_float(A[it].x ^ A[it].y ^ A[it].z ^ A[it].w) * csc[4 * it + r]; } else acc16_fp8(acc2, A[it], csc[4 * it + r]); }
            asm volatile("" : "+v"(acc2[0]), "+v"(acc2[1]), "+v"(acc2[2]), "+v"(acc2[3]), "+v"(acc2[4]), "+v"(acc2[5]), "+v"(acc2[6]), "+v"(acc2[7]) :: "memory");
#pragma unroll
            for (int it = 0; it < 16; ++it) A[it] = *(const u32x4*)(Vj + ((unsigned)esn[4 * it + r] * 256u + li));
            asm volatile("" ::: "memory");
#pragma unroll
            for (int it = 0; it < 16; ++it) { if (STRIP == 1) { acc2[it & 7].y += __uint_as_float(B[it].x ^ B[it].y ^ B[it].z ^ B[it].w) * csc[64 + 4 * it + r]; } else acc16_fp8(acc2, B[it], csc[64 + 4 * it + r]); }
            asm volatile("" : "+v"(acc2[0]), "+v"(acc2[1]), "+v"(acc2[2]), "+v"(acc2[3]), "+v"(acc2[4]), "+v"(acc2[5]), "+v"(acc2[6]), "+v"(acc2[7]) :: "memory");
#pragma unroll
            for (int it = 0; it < 16; ++it) B[it] = *(const u32x4*)(Vj + ((unsigned)esn[64 + 4 * it + r] * 256u + li));
            asm volatile("" ::: "memory");
            csn[lane] = m.c[0]; csn[64 + lane] = m.c[1];
            peer_meta_load(m, sel_e, coef, t2, lane);
            float acc[16];
#pragma unroll
            for (int q = 0; q < 8; ++q) { acc[2 * q] = acc2[q].x; acc[2 * q + 1] = acc2[q].y; }
#pragma unroll
            for (int q = 0; q < 16; ++q) { float a = acc[q]; a += __shfl_xor(a, 16); a += __shfl_xor(a, 32); acc[q] = a; }
            if (r == 0) {
                bf16_t* zp = zs + (size_t)t * D_ + 256 * j + 16 * i;
                *(u32x4*)zp = (u32x4){pk2(acc[0], acc[1]), pk2(acc[2], acc[3]), pk2(acc[4], acc[5]), pk2(acc[6], acc[7])};
                *(u32x4*)(zp + 8) = (u32x4){pk2(acc[8], acc[9]), pk2(acc[10], acc[11]), pk2(acc[12], acc[13]), pk2(acc[14], acc[15])};
            }
            asm volatile("" ::: "memory");
        }
    }
}
__device__ __forceinline__ void ln2_phase(const bf16_t* h1b, const bf16_t* zs, float* out, const float* gam, const float* bet, int G, int b) {
    const int tid_ = phase_tid(), lane = tid_ & 63, wid = phase_wid(tid_);
    const int gw = b * NWAVES + wid, NGW = G * NWAVES;
    for (int row = gw; row < S_; row += NGW) {
        f32x4 v[8]; float sum = 0.f;
#pragma unroll
        for (int j = 0; j < 8; ++j) {
            const u32x2 hw = *(const u32x2*)(h1b + (size_t)row * D_ + 256 * j + 4 * lane), zw = *(const u32x2*)(zs + (size_t)row * D_ + 256 * j + 4 * lane);
            v[j] = (f32x4){DN_ALPHA * bflo(hw.x) + bflo(zw.x), DN_ALPHA * bfhi(hw.x) + bfhi(zw.x), DN_ALPHA * bflo(hw.y) + bflo(zw.y), DN_ALPHA * bfhi(hw.y) + bfhi(zw.y)};
            sum += (v[j].x + v[j].y) + (v[j].z + v[j].w);
        }
        const float mean = wave_sum(sum) * (1.0f / D_); float sq = 0.f;
#pragma unroll
        for (int j = 0; j < 8; ++j) { v[j] = v[j] - mean; sq += (v[j].x * v[j].x + v[j].y * v[j].y) + (v[j].z * v[j].z + v[j].w * v[j].w); }
        const float rstd = 1.0f / sqrtf(wave_sum(sq) * (1.0f / D_) + LN_EPS);
#pragma unroll
        for (int j = 0; j < 8; ++j) {
            const f32x4 gg = *(const f32x4*)(gam + 256 * j + 4 * lane), bb = *(const f32x4*)(bet + 256 * j + 4 * lane);
            *(f32x4*)(out + (size_t)row * D_ + 256 * j + 4 * lane) = v[j] * rstd * gg + bb;
        }
    }
}
#ifndef PROBE_PHASE
#define PROBE_PHASE -1
#endif
constexpr int LDSCTL_OFF = 163328, MISC_OFF = LDSCTL_OFF;
constexpr int CW_BAR = 1024;
constexpr size_t CTL_ZERO_BYTES = 64 * 1024;
static_assert((CW_BAR + XCD_BAR_WORDS) * 4 <= (int)CTL_ZERO_BYTES && MISC_OFF + 128 <= LDS_BYTES, "control words");

__global__ void __launch_bounds__(NTHREADS, 2) mega_fwd(Ptrs P) {
    extern __shared__ __attribute__((aligned(16))) unsigned char lds_raw[];
    LAS unsigned char* lds = (LAS unsigned char*)lds_raw;
    unsigned char* ws = P.ws;
    const int G = gridDim.x, b = blockIdx.x;
    for (int u = threadIdx.x; u < (LDS_BYTES - LDSCTL_OFF) / 4; u += NTHREADS) ((LAS unsigned*)(lds + LDSCTL_OFF))[u] = 0u;
    __syncthreads();
    volatile LAS unsigned* MISC = (volatile LAS unsigned*)(lds + MISC_OFF);
    XcdBarrier bar; bar.bar = (unsigned*)(ws + WS_CTL) + CW_BAR; bar.x = xb_xcc_id(); bar.st = MISC + 8;
    if (threadIdx.x == 0) MISC[10] = xb_add(&bar.bar[XB_XCNT(bar.x)], 1u);

    bf16_t* const proj = (bf16_t*)(ws + WS_PROJ); float* const gst = (float*)(ws + WS_GST); bf16_t* const ycat = (bf16_t*)(ws + WS_YCAT);
    const float* const cosT = (const float*)(ws + WS_COS); const float* const sinT = (const float*)(ws + WS_SIN);
    float* const sumA = (float*)(ws + WS_SUMA); float* const sumH = (float*)(ws + WS_SUMH); float* const Hin = (float*)(ws + WS_HIN);
    const bf16_t* const wraT = (const bf16_t*)(ws + WS_WRA_T); const bf16_t* const wriT = (const bf16_t*)(ws + WS_WRI_T);

#define NREP(k) ((PROBE_PHASE == (k)) ? 2 : 1)
    for (int r_ = 0; r_ < NREP(0); ++r_) { prologue_phase(lds, P, G, b); xcd_barrier(bar); }
    if (threadIdx.x == 0) { unsigned xi_ = 0; for (unsigned jx = 0; jx < bar.x; ++jx) xi_ += xb_ld(&bar.bar[XB_XCNT(jx)]) > 0u ? 1u : 0u; MISC[11] = xi_; }
    __syncthreads();
    const int x_nloc = __builtin_amdgcn_readfirstlane((int)MISC[8]), x_nx = __builtin_amdgcn_readfirstlane((int)MISC[9]), x_rank = __builtin_amdgcn_readfirstlane((int)MISC[10]), x_xi = __builtin_amdgcn_readfirstlane((int)MISC[11]);
#define RUN_P1 { pg8::Gemm g{(const pg8::bf16_t*)(ws + WS_XB), (const pg8::bf16_t*)(ws + WS_WIN_T), S_, INC, D_}; \
        pg8::StaticOrder S; S.init(S_, INC, G, b); \
        pg8::EpiBf16<0> E{(pg8::bf16_t*)proj, INC, nullptr, 0, 0, 1.f}; \
        pg8::gemm_phase<pg8::EpiBf16<0>, pg8::StaticOrder, true, true>(lds, g, S, E); \
        xcd_barrier(bar); }
    RUN_P1
#if PROBE_PHASE == 1
    RUN_P1
#endif
    for (int r2_ = 0; r2_ < NREP(22); ++r2_) {
    for (int r_ = 0; r_ < NREP(2); ++r_) { ret_r1_phase(lds, proj, cosT, sinT, gst, G, b); if (PROBE_PHASE >= 0) xcd_barrier(bar); }
    for (int r_ = 0; r_ < NREP(3); ++r_) { lru_phase<0>(lds, proj, P, wraT, wriT, sumA, sumH, Hin, ycat, G, b); xcd_barrier(bar); }
    scan_phase(lds, gst, sumA, sumH, Hin, G, b);
    xcd_barrier(bar);
    }
    for (int r_ = 0; r_ < NREP(4); ++r_) { ret_r3_phase(lds, proj, cosT, sinT, gst, ycat, G, b); if (PROBE_PHASE >= 0) xcd_barrier(bar); }
    for (int r_ = 0; r_ < NREP(5); ++r_) { lru_phase<1>(lds, proj, P, wraT, wriT, sumA, sumH, Hin, ycat, G, b); xcd_barrier(bar); }
#define RUN_P3 { pg8::Gemm g{(const pg8::bf16_t*)ycat, (const pg8::bf16_t*)(ws + WS_WOUT_T), S_, D_, D_}; \
        pg8::StaticOrder S; S.init(S_, D_, G, b); \
        pg8::EpiResBf16 E{(const pg8::bf16_t*)(ws + WS_XB), (pg8::bf16_t*)(ws + WS_Z1B), D_, DN_ALPHA}; \
        pg8::gemm_phase<pg8::EpiResBf16, pg8::StaticOrder, true, true>(lds, g, S, E); \
        xcd_barrier(bar); }
    RUN_P3
#if PROBE_PHASE == 6
    RUN_P3
#endif
    ln1_phase((const bf16_t*)(ws + WS_Z1B), (bf16_t*)(ws + WS_H1B), (unsigned*)(ws + WS_XQ), (float*)(ws + WS_SX), P.ln1_g, P.ln1_b, G, b);
    xcd_barrier(bar);
#if PROBE_PHASE == 66
    RUN_P3
    ln1_phase((const bf16_t*)(ws + WS_Z1B), (bf16_t*)(ws + WS_H1B), (unsigned*)(ws + WS_XQ), (float*)(ws + WS_SX), P.ln1_g, P.ln1_b, G, b);
    xcd_barrier(bar);
#endif
#define RUN_P5 { pg8::Gemm g{(const pg8::bf16_t*)(ws + WS_H1B), (const pg8::bf16_t*)(ws + WS_WPQ_T), S_, D_, D_}; \
        pg8::StaticOrder S; S.init(S_, D_, G, b); \
        pg8::EpiBf16<0> E{(pg8::bf16_t*)(ws + WS_QP), D_, nullptr, 0, 0, 1.f}; \
        pg8::gemm_phase<pg8::EpiBf16<0>, pg8::StaticOrder, true, true>(lds, g, S, E); \
        xcd_barrier(bar); }
    RUN_P5
#if PROBE_PHASE == 7
    RUN_P5
#endif
    for (int r_ = 0; r_ < NREP(8); ++r_) { topk_phase(lds, (const bf16_t*)(ws + WS_QP), (const bf16_t*)(ws + WS_KEYS), (const float*)(ws + WS_SU), (const float*)(ws + WS_SV), (int*)(ws + WS_SELE), (float*)(ws + WS_SELG), (float*)(ws + WS_SELU), G, b); xcd_barrier(bar); }
    for (int r_ = 0; r_ < NREP(9); ++r_) { peer_u_phase(lds, (const unsigned char*)(ws + WS_UQ), (const unsigned char*)(ws + WS_XQ), (const int*)(ws + WS_SELE), (int*)(ws + WS_PD), x_xi, x_nx, x_rank, x_nloc); xcd_barrier(bar); }
    for (int r_ = 0; r_ < NREP(13); ++r_) { peer_coef_phase((const float*)(ws + WS_SELG), (const float*)(ws + WS_SELU), (const int*)(ws + WS_PD), (const float*)(ws + WS_SX), (float*)(ws + WS_COEF), G, b); xcd_barrier(bar); }
    for (int r_ = 0; r_ < NREP(10); ++r_) { peer_v_phase<0>(lds, (const unsigned char*)(ws + WS_VQ), (const int*)(ws + WS_SELE), (const float*)(ws + WS_COEF),
                     (bf16_t*)(ws + WS_ZS), x_xi, x_nx, x_rank, x_nloc); xcd_barrier(bar); }
#if PROBE_PHASE == 12
    peer_v_phase<1>(lds, (const unsigned char*)(ws + WS_VQ), (const int*)(ws + WS_SELE), (const float*)(ws + WS_COEF),
                     (bf16_t*)(ws + 248 * MiB), x_xi, x_nx, x_rank, x_nloc); xcd_barrier(bar);
#endif
    for (int r_ = 0; r_ < NREP(11); ++r_) ln2_phase((const bf16_t*)(ws + WS_H1B), (const bf16_t*)(ws + WS_ZS), P.out, P.ln2_g, P.ln2_b, G, b);
}

extern "C" void kernel_launch(void* const* d_in, const int* in_sizes, int n_in, void* d_out, int out_size, void* d_ws, size_t ws_size, hipStream_t stream) {
    static int grid = 0;
    if (grid == 0) {
        if (n_in != 19 || in_sizes[0] != S_ * D_ || out_size != S_ * D_ || ws_size < WS_END) {
            fprintf(stderr, "kernel_launch: unexpected shapes: n_in %d in0 %d out %d ws %zu (need >= %zu)\n", n_in, n_in > 0 ? in_sizes[0] : -1, out_size, ws_size, (size_t)WS_END); grid = -1; return; }
        int dev = 0, cus = 0, per_cu = 0;
        if (hipGetDevice(&dev) != hipSuccess || hipDeviceGetAttribute(&cus, hipDeviceAttributeMultiprocessorCount, dev) != hipSuccess) { grid = -1; return; }
        if (hipFuncSetAttribute((const void*)mega_fwd, hipFuncAttributeMaxDynamicSharedMemorySize, LDS_BYTES) != hipSuccess) { fprintf(stderr, "kernel_launch: hipFuncSetAttribute failed\n"); grid = -1; return; }
        if (hipOccupancyMaxActiveBlocksPerMultiprocessor(&per_cu, (const void*)mega_fwd, NTHREADS, LDS_BYTES) != hipSuccess || per_cu < 1) {
            fprintf(stderr, "kernel_launch: occupancy query reports %d workgroups per CU; nothing launched\n", per_cu); (void)hipGetLastError(); grid = -1; return; }
        grid = cus;
    }
    if (grid < 0) return;
    Ptrs P{};
    P.x = (const float*)d_in[0]; P.pos = (const int*)d_in[1]; P.w_in = (const float*)d_in[2]; P.w_out = (const float*)d_in[3]; P.conv_w = (const float*)d_in[4]; P.conv_b = (const float*)d_in[5];
    P.w_ra = (const float*)d_in[6]; P.b_ra = (const float*)d_in[7]; P.w_ri = (const float*)d_in[8]; P.b_ri = (const float*)d_in[9]; P.lam = (const float*)d_in[10];
    P.ln1_g = (const float*)d_in[11]; P.ln1_b = (const float*)d_in[12]; P.w_pq = (const float*)d_in[13]; P.sub_keys = (const float*)d_in[14]; P.peer_u = (const float*)d_in[15]; P.peer_v = (const float*)d_in[16];
    P.ln2_g = (const float*)d_in[17]; P.ln2_b = (const float*)d_in[18]; P.out = (float*)d_out; P.ws = (unsigned char*)d_ws;
    if (hipMemsetAsync((char*)d_ws + WS_CTL, 0, CTL_ZERO_BYTES, stream) != hipSuccess) { fprintf(stderr, "kernel_launch: hipMemsetAsync failed\n"); return; }
    void* args[] = {&P};
    const hipError_t e = hipLaunchCooperativeKernel((const void*)mega_fwd, dim3(grid), dim3(NTHREADS), args, LDS_BYTES, stream);
    if (e != hipSuccess) fprintf(stderr, "kernel_launch: cooperative launch failed: %s (grid %d)\n", hipGetErrorString(e), grid);
}
```

```cpp
#include <hip/hip_runtime.h>
#include <cstdio>
#include <cstdint>
#include <cmath>

namespace pg8 {
#define PG8_LAS __attribute__((address_space(3)))
typedef unsigned short bf16_t;
typedef short bf16x8 __attribute__((ext_vector_type(8)));
typedef float f32x4 __attribute__((ext_vector_type(4)));
typedef unsigned u32x4 __attribute__((ext_vector_type(4)));
constexpr int BM = 256, BK = 64, HALF = 128, HTB = HALF * BK * 2  , STAGE_BYTES = 8 * HTB, NXCD = 8, WGM = 8;

__host__ __device__ __forceinline__ int lds_byte(int r, int c) { const int st = (r >> 4) * 2 + (c >> 5), rr = r & 15, cc = c & 31, ob = rr * 64 + cc * 2; return st * 1024 + (ob ^ (((ob >> 9) & 1) << 5)); }
__host__ __device__ __forceinline__ void stage_rc(int b, int& R, int& C) { const int st = b / 1024, sb = b % 1024, swz = sb ^ (((sb >> 9) & 1) << 5); R = (st >> 1) * 16 + swz / 64; C = (st & 1) * 32 + (swz % 64) / 2; }
__host__ __device__ __forceinline__ int perm32(int rho) { const int n = rho >> 4, i = rho & 15; return 8 * (i >> 2) + 4 * n + (i & 3); }

struct Unit { int pm, pn; };
struct Gemm { const bf16_t* A; const bf16_t* Bt; int M, N, K; };

struct StaticOrder {
    int nM, nN, nwg, G, c;
    __host__ __device__ void init(int M, int N, int G_, int c_) { nM = M / BM; nN = N / BM; nwg = nM * nN; G = G_; c = c_; }
    __host__ __device__ bool next(int i, Unit& u) const {
        const long L = (long)i * G + c; if (L >= nwg) return false;
        int wgid = (int)L; { const int q = nwg / NXCD, r = nwg % NXCD, xcd = wgid % NXCD, off = wgid / NXCD; wgid = (xcd < r ? xcd * (q + 1) : r * (q + 1) + (xcd - r) * q) + off; }
        const int nig = WGM * nN, gid = wgid / nig, fm = gid * WGM, gsz = (nM - fm) < WGM ? (nM - fm) : WGM;
        u.pm = fm + ((wgid % nig) % gsz); u.pn = (wgid % nig) / gsz; return true;
    }
    __device__ __forceinline__ void a_ready(const Unit&) const {}
    __device__ __forceinline__ void done(const Unit&) const {}
};

__device__ __forceinline__ unsigned cvt_pk_bf16(float lo, float hi) { unsigned r; asm volatile("v_cvt_pk_bf16_f32 %0, %1, %2" : "=v"(r) : "v"(lo), "v"(hi)); return r; }
typedef float f32x2 __attribute__((ext_vector_type(2)));
__device__ __forceinline__ f32x2 gelu_pk(f32x2 v) {
    const f32x2 av = __builtin_elementwise_abs(v), d = av * 0.2316418882f + 1.0f;
    f32x2 t; t.x = __builtin_amdgcn_rcpf(d.x); t.y = __builtin_amdgcn_rcpf(d.y);
    f32x2 q = t * 0.5307027145f + (-0.7265760135f); q = q * t + 0.7107068705f; q = q * t + (-0.142248368f); q = q * t + 0.127414796f; q = q * t;
    const f32x2 s = (v * v) * (-0.72134752044f);
    f32x2 e; e.x = __builtin_amdgcn_exp2f(s.x); e.y = __builtin_amdgcn_exp2f(s.y);
    const f32x2 m = v * (q * e), r = v - m;
    f32x2 o; o.x = v.x < 0.f ? m.x : r.x; o.y = v.y < 0.f ? m.y : r.y; return o;
}

template <int ACT  > struct EpiBf16 {
    static constexpr bool PERM = true, AFTER_DRAIN = false; static_assert(ACT == 0 || ACT == 1, "EpiBf16: ACT is 0 (none) or 1 (gelu_pk)");
    bf16_t* O; int ldc; const float* bias; int split_cols; size_t split_stride; float scale0;
    __device__ __forceinline__ void operator()(const f32x4 (&acc)[2][2][4][2], const Unit& u, int wr, int wc, int fr, int fq) const {
        const int row0 = u.pm * BM + wr * 64 + fr; int colt = u.pn * BM; bf16_t* base = O;
        float sc = 1.f; if (split_cols) { const int t = colt / split_cols; base += (size_t)t * split_stride; colt -= t * split_cols; if (t == 0) sc = scale0; }
        const int col0 = colt + wc * 32 + 8 * fq, bcol0 = u.pn * BM + wc * 32 + 8 * fq;
        f32x4 bv[2][2];
#pragma unroll
        for (int bj = 0; bj < 2; ++bj)
#pragma unroll
            for (int n = 0; n < 2; ++n) bv[bj][n] = bias ? *(const f32x4*)(bias + bcol0 + bj * HALF + 4 * n) : (f32x4){0.f, 0.f, 0.f, 0.f};
#pragma unroll
        for (int ai = 0; ai < 2; ++ai)
#pragma unroll
            for (int m = 0; m < 4; ++m) { bf16_t* rowp = base + (size_t)(row0 + ai * HALF + m * 16) * ldc + col0;
#pragma unroll
                for (int bj = 0; bj < 2; ++bj) { f32x4 v0 = acc[ai][bj][m][0] + bv[bj][0], v1 = acc[ai][bj][m][1] + bv[bj][1];
                    if (ACT == 1) { f32x2 a = gelu_pk((f32x2){v0[0], v0[1]}), b = gelu_pk((f32x2){v0[2], v0[3]}), c = gelu_pk((f32x2){v1[0], v1[1]}), d = gelu_pk((f32x2){v1[2], v1[3]});
                        v0 = (f32x4){a.x, a.y, b.x, b.y}; v1 = (f32x4){c.x, c.y, d.x, d.y}; }
                    v0 = v0 * sc; v1 = v1 * sc; u32x4 w; w.x = cvt_pk_bf16(v0[0], v0[1]); w.y = cvt_pk_bf16(v0[2], v0[3]); w.z = cvt_pk_bf16(v1[0], v1[1]); w.w = cvt_pk_bf16(v1[2], v1[3]);
                    *(u32x4*)(rowp + bj * HALF) = w; } }
    }
};
struct EpiResF32 {
    static constexpr bool PERM = false, AFTER_DRAIN = false;
    const float* base; float* out; int ldc; float alpha;
    __device__ __forceinline__ void operator()(const f32x4 (&acc)[2][2][4][2], const Unit& u, int wr, int wc, int fr, int fq) const {
        const int row0 = u.pm * BM + wr * 64 + fr, col0 = u.pn * BM + wc * 32 + 4 * fq;
#pragma unroll
        for (int ai = 0; ai < 2; ++ai)
#pragma unroll
            for (int m = 0; m < 4; ++m) { const size_t off = (size_t)(row0 + ai * HALF + m * 16) * ldc + col0;
#pragma unroll
                for (int bj = 0; bj < 2; ++bj)
#pragma unroll
                    for (int n = 0; n < 2; ++n) { const f32x4 bs = *(const f32x4*)(base + off + bj * HALF + n * 16); *(f32x4*)(out + off + bj * HALF + n * 16) = bs * alpha + acc[ai][bj][m][n]; }
                asm volatile("" ::: "memory"); }
    }
};

struct EpiResBf16 {
    static constexpr bool PERM = true, AFTER_DRAIN = false;
    const bf16_t* base; bf16_t* O; int ldc; float alpha;
    __device__ __forceinline__ void operator()(const f32x4 (&acc)[2][2][4][2], const Unit& u, int wr, int wc, int fr, int fq) const {
        const int row0 = u.pm * BM + wr * 64 + fr, col0 = u.pn * BM + wc * 32 + 8 * fq;
#pragma unroll
        for (int ai = 0; ai < 2; ++ai)
#pragma unroll
            for (int m = 0; m < 4; ++m) { const size_t off = (size_t)(row0 + ai * HALF + m * 16) * ldc + col0;
#pragma unroll
                for (int bj = 0; bj < 2; ++bj) {
                    const u32x4 bw = *(const u32x4*)(base + off + bj * HALF);
                    const f32x4 b0 = (f32x4){__uint_as_float(bw.x << 16), __uint_as_float(bw.x & 0xffff0000u), __uint_as_float(bw.y << 16), __uint_as_float(bw.y & 0xffff0000u)};
                    const f32x4 b1 = (f32x4){__uint_as_float(bw.z << 16), __uint_as_float(bw.z & 0xffff0000u), __uint_as_float(bw.w << 16), __uint_as_float(bw.w & 0xffff0000u)};
                    const f32x4 v0 = b0 * alpha + acc[ai][bj][m][0], v1 = b1 * alpha + acc[ai][bj][m][1];
                    u32x4 w; w.x = cvt_pk_bf16(v0[0], v0[1]); w.y = cvt_pk_bf16(v0[2], v0[3]); w.z = cvt_pk_bf16(v1[0], v1[1]); w.w = cvt_pk_bf16(v1[2], v1[3]);
                    *(u32x4*)(O + off + bj * HALF) = w; }
                asm volatile("" ::: "memory"); }
    }
};
template <class Epi, class Sched, bool ALIGN_EPI = false, bool SP2 = false>
__device__ __forceinline__ void gemm_phase(PG8_LAS unsigned char* lds, const Gemm g, const Sched& S, const Epi& E) {
    const int tid = threadIdx.x, wid = __builtin_amdgcn_readfirstlane(tid >> 6), lane = tid & 63, wr = wid >> 2, wc = wid & 3, fr = lane & 15, fq = lane >> 4;
    const int K = g.K, nt = K / BK;
    unsigned voffA[2], voffB[2];
#pragma unroll
    for (int i = 0; i < 2; ++i) { int R, C; stage_rc(tid * 16 + i * 8192, R, C); const int Rb = Epi::PERM ? ((R & ~31) + perm32(R & 31)) : R;
        voffA[i] = (unsigned)(R * K + C) * 2u; voffB[i] = (unsigned)(Rb * K + C) * 2u; }
    const size_t kstep = (size_t)(BK * 2);
    const size_t hstep = (size_t)HALF * K * 2;
    const size_t tstep = 2 * hstep;
    const unsigned ldsw = (unsigned)wid * 1024u;
    const int aoff = lds_byte(wr * 64 + fr, fq * 8), boff = lds_byte(wc * 32 + fr, fq * 8);
#define PG8_SA(b, h) (((b) * 2 + (h)) * HTB)
#define PG8_SB(b, h) ((4 + (b) * 2 + (h)) * HTB)
#define PG8_STAGE(bufoff, gbase, voff) do { _Pragma("unroll") for (int _i = 0; _i < 2; ++_i) \
        __builtin_amdgcn_global_load_lds((const unsigned*)((const char*)(gbase) + (voff)[_i]), (PG8_LAS unsigned*)(lds + (bufoff) + ldsw + _i * 8192), 16, 0, 0); } while (0)
#define PG8_LDA(dst, b, h) do { _Pragma("unroll") for (int m = 0; m < 4; ++m) _Pragma("unroll") for (int k = 0; k < 2; ++k) dst[m][k] = *(const PG8_LAS bf16x8*)(lds + PG8_SA(b, h) + aoff + m * 2048 + k * 1024); } while (0)
#define PG8_LDB(dst, b, h) do { _Pragma("unroll") for (int n = 0; n < 2; ++n) _Pragma("unroll") for (int k = 0; k < 2; ++k) dst[n][k] = *(const PG8_LAS bf16x8*)(lds + PG8_SB(b, h) + boff + n * 2048 + k * 1024); } while (0)
#define PG8_MMA(ai, bj, At, Bt) do { __builtin_amdgcn_s_setprio(1); _Pragma("unroll") for (int m = 0; m < 4; ++m) _Pragma("unroll") for (int n = 0; n < 2; ++n) _Pragma("unroll") for (int k = 0; k < 2; ++k) \
        acc[ai][bj][m][n] = __builtin_amdgcn_mfma_f32_16x16x32_bf16(Bt[n][k], At[m][k], acc[ai][bj][m][n], 0, 0, 0); __builtin_amdgcn_s_setprio(0); } while (0)
#define PG8_WAIT_V(n) asm volatile("s_waitcnt vmcnt(" #n ")" ::: "memory")
#define PG8_WAIT_L(n) asm volatile("s_waitcnt lgkmcnt(" #n ")" ::: "memory")
#define PG8_BAR __builtin_amdgcn_s_barrier()
#define PG8_SCHED __builtin_amdgcn_sched_barrier(0)
    Unit cur, nxt; int ui = 0;
    if (!S.next(0, cur)) return;
    f32x4 acc[2][2][4][2];
#pragma unroll
    for (int a = 0; a < 2; ++a)
#pragma unroll
        for (int b = 0; b < 2; ++b)
#pragma unroll
            for (int m = 0; m < 4; ++m)
#pragma unroll
                for (int n = 0; n < 2; ++n) acc[a][b][m][n] = (f32x4){0.f, 0.f, 0.f, 0.f};
    bf16x8 At[4][2], B0[2][2], B1[2][2];
    const char* cA = (const char*)g.A + (size_t)cur.pm * tstep; const char* cB = (const char*)g.Bt + (size_t)cur.pn * tstep;
    S.a_ready(cur);
    if constexpr (SP2) {
        PG8_STAGE(PG8_SB(0, 0), cB, voffB); PG8_STAGE(PG8_SB(0, 1), cB + hstep, voffB); PG8_STAGE(PG8_SA(0, 0), cA, voffA); PG8_STAGE(PG8_SA(0, 1), cA + hstep, voffA);
        if (wr == 1) PG8_BAR;
        PG8_WAIT_V(2); PG8_BAR;
        PG8_STAGE(PG8_SB(1, 0), cB + kstep, voffB); PG8_STAGE(PG8_SA(1, 0), cA + kstep, voffA); PG8_STAGE(PG8_SB(1, 1), cB + hstep + kstep, voffB);
        PG8_WAIT_V(6); PG8_BAR;
    } else {
        PG8_STAGE(PG8_SB(0, 0), cB, voffB); PG8_STAGE(PG8_SA(0, 0), cA, voffA); PG8_STAGE(PG8_SB(0, 1), cB + hstep, voffB); PG8_STAGE(PG8_SA(0, 1), cA + hstep, voffA);
        if (wr == 1) PG8_BAR;
        PG8_WAIT_V(4); PG8_BAR;
        PG8_STAGE(PG8_SB(1, 0), cB + kstep, voffB); PG8_STAGE(PG8_SA(1, 0), cA + kstep, voffA); PG8_STAGE(PG8_SB(1, 1), cB + hstep + kstep, voffB);
        PG8_WAIT_V(6); PG8_BAR;
    }
    for (;;) {
        const bool has_next = S.next(ui + 1, nxt);
        const char* nA = has_next ? (const char*)g.A + (size_t)nxt.pm * tstep : cA; const char* nB = has_next ? (const char*)g.Bt + (size_t)nxt.pn * tstep : cB;
        for (int t = 0; t < nt; t += 2) {
            const bool last = (t == nt - 2);
            const char* a1 = cA + (size_t)(t + 1) * kstep;
            const char* a2 = last ? nA : cA + (size_t)(t + 2) * kstep; const char* b2 = last ? nB : cB + (size_t)(t + 2) * kstep;
            const char* a3 = a2 + kstep; const char* b3 = b2 + kstep;
            if (last && has_next) S.a_ready(nxt);
            if constexpr (SP2) {
            PG8_LDB(B0, 0, 0); PG8_LDB(B1, 0, 1); PG8_SCHED; PG8_LDA(At, 0, 0); PG8_STAGE(PG8_SA(1, 1), a1 + hstep, voffA);
            PG8_WAIT_V(8); PG8_WAIT_L(0); PG8_BAR; PG8_MMA(0, 0, At, B0); PG8_MMA(0, 1, At, B1); PG8_BAR; PG8_SCHED;
            PG8_LDA(At, 0, 1); PG8_STAGE(PG8_SB(0, 0), b2, voffB); PG8_STAGE(PG8_SB(0, 1), b2 + hstep, voffB); PG8_STAGE(PG8_SA(0, 0), a2, voffA);
            PG8_WAIT_V(8); PG8_WAIT_L(0); PG8_BAR; PG8_MMA(1, 0, At, B0); PG8_MMA(1, 1, At, B1); PG8_BAR; PG8_SCHED;
            PG8_LDB(B0, 1, 0); PG8_LDB(B1, 1, 1); PG8_SCHED; PG8_LDA(At, 1, 0); PG8_STAGE(PG8_SA(0, 1), a2 + hstep, voffA);
            PG8_WAIT_V(8); PG8_WAIT_L(0); PG8_BAR; PG8_MMA(0, 0, At, B0); PG8_MMA(0, 1, At, B1); PG8_BAR; PG8_SCHED;
            PG8_LDA(At, 1, 1); PG8_STAGE(PG8_SB(1, 0), b3, voffB); PG8_STAGE(PG8_SB(1, 1), b3 + hstep, voffB); PG8_STAGE(PG8_SA(1, 0), a3, voffA);
            PG8_WAIT_V(8); PG8_WAIT_L(0); PG8_BAR; PG8_MMA(1, 0, At, B0); PG8_MMA(1, 1, At, B1); PG8_BAR; PG8_SCHED;
            } else {
            PG8_LDB(B0, 0, 0); PG8_SCHED; PG8_LDA(At, 0, 0); PG8_STAGE(PG8_SA(1, 1), a1 + hstep, voffA);
            PG8_WAIT_L(8); PG8_BAR; PG8_WAIT_L(0); PG8_MMA(0, 0, At, B0); PG8_BAR; PG8_SCHED;
            PG8_LDB(B1, 0, 1); PG8_STAGE(PG8_SB(0, 0), b2, voffB);
            PG8_BAR; PG8_WAIT_L(0); PG8_MMA(0, 1, At, B1); PG8_BAR;
            PG8_LDA(At, 0, 1); PG8_STAGE(PG8_SA(0, 0), a2, voffA);
            PG8_BAR; PG8_WAIT_L(0); PG8_MMA(1, 0, At, B0); PG8_BAR; PG8_SCHED;
            PG8_STAGE(PG8_SB(0, 1), b2 + hstep, voffB);
            PG8_WAIT_V(6); PG8_BAR; PG8_MMA(1, 1, At, B1); PG8_BAR;
            PG8_LDB(B0, 1, 0); PG8_SCHED; PG8_LDA(At, 1, 0); PG8_STAGE(PG8_SA(0, 1), a2 + hstep, voffA);
            PG8_WAIT_L(8); PG8_BAR; PG8_WAIT_L(0); PG8_MMA(0, 0, At, B0); PG8_BAR; PG8_SCHED;
            PG8_LDB(B1, 1, 1); PG8_STAGE(PG8_SB(1, 0), b3, voffB);
            PG8_BAR; PG8_WAIT_L(0); PG8_MMA(0, 1, At, B1); PG8_BAR;
            PG8_LDA(At, 1, 1); PG8_STAGE(PG8_SA(1, 0), a3, voffA);
            PG8_BAR; PG8_WAIT_L(0); PG8_MMA(1, 0, At, B0); PG8_BAR; PG8_SCHED;
            PG8_STAGE(PG8_SB(1, 1), b3 + hstep, voffB);
            PG8_WAIT_V(6); PG8_BAR; PG8_MMA(1, 1, At, B1); PG8_BAR;
            }
        }
        if constexpr (ALIGN_EPI) { if (wr == 0) PG8_BAR; }
        if constexpr (!Epi::AFTER_DRAIN) { E(acc, cur, wr, wc, fr, fq); S.done(cur); }
        if (!has_next) break;
#pragma unroll
        for (int a = 0; a < 2; ++a)
#pragma unroll
            for (int b = 0; b < 2; ++b)
#pragma unroll
                for (int m = 0; m < 4; ++m)
#pragma unroll
                    for (int n = 0; n < 2; ++n) acc[a][b][m][n] = (f32x4){0.f, 0.f, 0.f, 0.f};
        cur = nxt; cA = nA; cB = nB; ++ui;
        if constexpr (ALIGN_EPI) { if (wr == 1) PG8_BAR; }
    }
    PG8_WAIT_V(0);
    if constexpr (!ALIGN_EPI) { if (wr == 0) PG8_BAR; }
    PG8_BAR;
    if constexpr (Epi::AFTER_DRAIN) { E.fused(acc, cur, wr, wc, fr, fq, lds, wid, lane); S.done(cur); }
#undef PG8_SA
#undef PG8_SB
#undef PG8_STAGE
#undef PG8_LDA
#undef PG8_LDB
#undef PG8_MMA
#undef PG8_WAIT_V
#undef PG8_WAIT_L
#undef PG8_BAR
#undef PG8_SCHED
}
}
constexpr int S_ = 16384, D_ = 2048, INC = 6144, NH = 8, DH = 128, CH = 64, NCH = 256;
constexpr float DN_ALPHA = 1.189207115002721f;
constexpr float LN_EPS = 1e-5f, GN_EPS = 1e-6f;
constexpr int NWAVES = 8, NTHREADS = 512;
constexpr int LDS_BYTES = 163840;

constexpr size_t MiB = 1u << 20;
constexpr size_t WS_CTL = 0;
constexpr size_t WS_WOUT_T = 1 * MiB, WS_WPQ_T = 9 * MiB, WS_KEYS = 17 * MiB, WS_WRA_T = 17 * MiB + 512 * 1024, WS_WRI_T = 17 * MiB + 768 * 1024;
constexpr size_t WS_COS = 18 * MiB, WS_SIN = 22 * MiB, WS_SUMA = 26 * MiB, WS_SUMH = 27 * MiB, WS_HIN = 28 * MiB;
constexpr size_t WS_SU = 29 * MiB, WS_SV = 30 * MiB;
constexpr size_t WS_SX = 31 * MiB;
constexpr size_t WS_UQ = 32 * MiB, WS_VQ = 64 * MiB;
constexpr size_t WS_XQ = 96 * MiB;
constexpr size_t WS_PD = 328 * MiB, WS_ZS = 392 * MiB;
constexpr size_t WS_WIN_T = 160 * MiB, WS_XB = 184 * MiB, WS_GST = 160 * MiB, WS_H1B = 184 * MiB;
constexpr size_t WS_PROJ = 248 * MiB, WS_QP = 248 * MiB, WS_SELE = 312 * MiB, WS_SELG = 320 * MiB, WS_SELU = 456 * MiB, WS_COEF = 464 * MiB;
constexpr size_t WS_Z1B = 376 * MiB;
constexpr size_t WS_YCAT = 440 * MiB, WS_END = 504 * MiB;

#define LAS __attribute__((address_space(3)))
typedef unsigned short bf16_t;
typedef short bf16x8 __attribute__((ext_vector_type(8)));
typedef float f32x4 __attribute__((ext_vector_type(4)));
typedef unsigned u32x4 __attribute__((ext_vector_type(4)));
typedef unsigned u32x2 __attribute__((ext_vector_type(2)));

__device__ __forceinline__ unsigned f2bf(float f) { unsigned u = __float_as_uint(f); return (u + 0x7fffu + ((u >> 16) & 1u)) >> 16; }
__device__ __forceinline__ unsigned pk2(float lo, float hi) { return f2bf(lo) | (f2bf(hi) << 16); }
__device__ __forceinline__ float bflo(unsigned w) { return __uint_as_float(w << 16); }
__device__ __forceinline__ float bfhi(unsigned w) { return __uint_as_float(w & 0xffff0000u); }
__device__ __forceinline__ float bf2f(bf16_t b) { return __uint_as_float(((unsigned)b) << 16); }
__device__ __forceinline__ f32x4 mfma16(bf16x8 a, bf16x8 b, f32x4 c) { return __builtin_amdgcn_mfma_f32_16x16x32_bf16(a, b, c, 0, 0, 0); }
__device__ __forceinline__ float fexp_(float x) { return __builtin_amdgcn_exp2f(x * 1.4426950408889634f); }
__device__ __forceinline__ float sigmoidf_(float x) { return __builtin_amdgcn_rcpf(1.0f + fexp_(-x)); }
__device__ __forceinline__ float gelu_tanh(float x) { const float y = 0.7978845608028654f * (x + 0.044715f * x * x * x); return x * __builtin_amdgcn_rcpf(1.0f + fexp_(-2.0f * y)); }
__device__ __forceinline__ float wave_sum(float v) {
#pragma unroll
    for (int o = 1; o < 64; o <<= 1) v += __shfl_xor(v, o);
    return v;
}
__device__ __forceinline__ float wave_max(float v) {
#pragma unroll
    for (int o = 1; o < 64; o <<= 1) v = fmaxf(v, __shfl_xor(v, o));
    return v;
}
__device__ __forceinline__ int wave_sum_i(int v) {
#pragma unroll
    for (int o = 1; o < 64; o <<= 1) v += __shfl_xor(v, o);
    return v;
}
__device__ __forceinline__ int phase_tid() { int t = (int)threadIdx.x; asm volatile("" : "+v"(t)); return t; }
__device__ __forceinline__ int phase_wid(int tid) { return __builtin_amdgcn_readfirstlane(tid >> 6); }
__device__ __forceinline__ float head_log_gamma(int h) { return logf(1.0f - exp2f(-5.0f - (float)h)); }

__device__ __forceinline__ void transpose_item(const float* W, int K, int N, bf16_t* WT, LAS float* scr, int item, int lane) {
    const int nblk = N / 32, kb = item / nblk, nb = item % nblk, k0 = 64 * kb, n0 = 32 * nb;
    float tv[32];
#pragma unroll
    for (int i = 0; i < 32; ++i) { const int kk = 2 * i + (lane >> 5); tv[i] = W[(size_t)(k0 + kk) * N + n0 + (lane & 31)]; }
#pragma unroll
    for (int i = 0; i < 32; ++i) { const int kk = 2 * i + (lane >> 5); scr[kk * 33 + (lane & 31)] = tv[i]; }
    asm volatile("s_waitcnt lgkmcnt(0)" ::: "memory");
    const int c = lane & 7;
#pragma unroll
    for (int j = 0; j < 4; ++j) { const int n = (lane >> 3) + 8 * j; const LAS float* s = scr + (8 * c) * 33 + n;
        u32x4 o; o.x = pk2(s[0 * 33], s[1 * 33]); o.y = pk2(s[2 * 33], s[3 * 33]); o.z = pk2(s[4 * 33], s[5 * 33]); o.w = pk2(s[6 * 33], s[7 * 33]);
        *(u32x4*)(WT + (size_t)(n0 + n) * K + k0 + 8 * c) = o; }
    asm volatile("s_waitcnt lgkmcnt(0)" ::: "memory");
}
__device__ __forceinline__ void cvt_stream(const float* src, bf16_t* dst, size_t n8, size_t gtid, size_t gthreads) {
    size_t i = gtid;
    for (; i + 3 * gthreads < n8; i += 4 * gthreads) {
        f32x4 a[4], b[4];
#pragma unroll
        for (int u = 0; u < 4; ++u) { a[u] = __builtin_nontemporal_load((const f32x4*)src + 2 * (i + u * gthreads)); b[u] = __builtin_nontemporal_load((const f32x4*)src + 2 * (i + u * gthreads) + 1); }
#pragma unroll
        for (int u = 0; u < 4; ++u) { u32x4 o; o.x = pk2(a[u].x, a[u].y); o.y = pk2(a[u].z, a[u].w); o.z = pk2(b[u].x, b[u].y); o.w = pk2(b[u].z, b[u].w); ((u32x4*)dst)[i + u * gthreads] = o; }
    }
    for (; i < n8; i += gthreads) {
        const f32x4 a = ((const f32x4*)src)[2 * i], b = ((const f32x4*)src)[2 * i + 1];
        u32x4 o; o.x = pk2(a.x, a.y); o.y = pk2(a.z, a.w); o.z = pk2(b.x, b.y); o.w = pk2(b.z, b.w);
        ((u32x4*)dst)[i] = o;
    }
}
struct QRow { f32x4 v[8]; };
__device__ __forceinline__ void quant_issue(QRow& q, const float* table, int e, int lane) {
    const float* rp = table + (size_t)e * D_;
#pragma unroll
    for (int j = 0; j < 8; ++j) q.v[j] = __builtin_nontemporal_load((const f32x4*)(rp + 256 * j + 4 * lane));
}
template <int ISV>
__device__ __forceinline__ void quant_finish(const QRow& q, unsigned char* qtab, float* scales, int e, int lane) {
    float amax = 0.f;
#pragma unroll
    for (int j = 0; j < 8; ++j) amax = fmaxf(amax, fmaxf(fmaxf(fabsf(q.v[j].x), fabsf(q.v[j].y)), fmaxf(fabsf(q.v[j].z), fabsf(q.v[j].w))));
    amax = wave_max(amax);
    unsigned* qp = (unsigned*)qtab + (size_t)e * 64;
    {
        const float inv = amax > 0.f ? 127.0f / amax : 0.f;
        if (lane == 0) scales[e] = amax * (1.0f / 127.0f);
#pragma unroll
        for (int j = 0; j < 8; ++j) {
            const int a = (int)rintf(q.v[j].x * inv), bq = (int)rintf(q.v[j].y * inv), c = (int)rintf(q.v[j].z * inv), d = (int)rintf(q.v[j].w * inv);
            qp[(size_t)j * 16384 * 64 + lane] = (unsigned)(a & 255) | ((unsigned)(bq & 255) << 8) | ((unsigned)(c & 255) << 16) | ((unsigned)(d & 255) << 24);
        }
    }
}
struct Ptrs {
    const float *x; const int* pos; const float *w_in, *w_out, *conv_w, *conv_b, *w_ra, *b_ra, *w_ri, *b_ri, *lam, *ln1_g, *ln1_b, *w_pq, *sub_keys, *peer_u, *peer_v, *ln2_g, *ln2_b;
    float* out; unsigned char* ws;
};
__device__ __forceinline__ void prologue_phase(LAS unsigned char* lds, const Ptrs& P, int G, int b) {
    const int tid = phase_tid(), lane = tid & 63, wid = phase_wid(tid);
    LAS float* scr = (LAS float*)(lds + wid * 16384);
    const int gw = b * NWAVES + wid, NGW = G * NWAVES;
    unsigned char* ws = P.ws;
    constexpr int I_IN = (D_ / 64) * (INC / 32), I_SQ = (D_ / 64) * (D_ / 32), I_G = 2 * 4;
    constexpr int NITEMS = I_IN + 2 * I_SQ + 16 * I_G;
    for (int it = gw; it < NITEMS; it += NGW) {
        int r = it;
        if (r < I_IN) { transpose_item(P.w_in, D_, INC, (bf16_t*)(ws + WS_WIN_T), scr, r, lane); continue; } r -= I_IN;
        if (r < I_SQ) { transpose_item(P.w_out, D_, D_, (bf16_t*)(ws + WS_WOUT_T), scr, r, lane); continue; } r -= I_SQ;
        if (r < I_SQ) { transpose_item(P.w_pq, D_, D_, (bf16_t*)(ws + WS_WPQ_T), scr, r, lane); continue; } r -= I_SQ;
        if (r < 8 * I_G) { const int g = r / I_G; transpose_item(P.w_ra + g * 16384, 128, 128, (bf16_t*)(ws + WS_WRA_T) + g * 16384, scr, r % I_G, lane); continue; } r -= 8 * I_G;
        { const int g = r / I_G; transpose_item(P.w_ri + g * 16384, 128, 128, (bf16_t*)(ws + WS_WRI_T) + g * 16384, scr, r % I_G, lane); }
    }
    const size_t gtid = (size_t)b * NTHREADS + tid, gth = (size_t)G * NTHREADS;
    cvt_stream(P.x, (bf16_t*)(ws + WS_XB), (size_t)S_ * D_ / 8, gtid, gth);
    cvt_stream(P.sub_keys, (bf16_t*)(ws + WS_KEYS), (size_t)8 * 2 * 128 * 128 / 8, gtid, gth);
    float* cosT = (float*)(ws + WS_COS); float* sinT = (float*)(ws + WS_SIN);
    for (size_t i = gtid; i < (size_t)S_ * 64; i += gth) {
        const int s = (int)(i >> 6), f = (int)(i & 63);
        const float inv = powf(10000.0f, -(float)f / 64.0f);
        const float ang = (float)P.pos[s] * inv;
        float sn, cs; sincosf(ang, &sn, &cs);
        cosT[i] = cs; sinT[i] = sn;
    }
}
#define XB_TMO      128
#define XB_XCNT(j)  (256  + 64 * (j))
#define XB_XSUB(j)  (1280 + 64 * (j))
#define XB_XGEN(j)  (2304 + 64 * (j))
#define XB_TOP      3328
#define XB_TOPGEN   3392
#define XCD_BAR_WORDS 3456
#define XB_SPIN_CAP (1u << 18)

__device__ __forceinline__ unsigned xb_ld(unsigned* p)              { return __hip_atomic_load(p, __ATOMIC_RELAXED, __HIP_MEMORY_SCOPE_AGENT); }
__device__ __forceinline__ unsigned xb_add(unsigned* p, unsigned v) { return __hip_atomic_fetch_add(p, v, __ATOMIC_RELAXED, __HIP_MEMORY_SCOPE_AGENT); }
__device__ __forceinline__ unsigned xb_xcc_id() { return (unsigned)__builtin_amdgcn_s_getreg((3 << 11) | 20) & 0xFu; }
#define XB_SPIN(cond, bar) do { unsigned _sp = 0; while (cond) { __builtin_amdgcn_s_sleep(1); \
    if ((++_sp & 255u) == 0u) { if (xb_ld(&(bar)[XB_TMO])) break; if (_sp > XB_SPIN_CAP) { atomicAdd(&(bar)[XB_TMO], 1u); break; } } } } while (0)

struct XcdBarrier {
    unsigned* bar; unsigned x;
    volatile LAS unsigned* st;
};

__device__ __forceinline__ XcdBarrier xcd_barrier_post(unsigned* bar, volatile LAS unsigned* st) {
    XcdBarrier b; b.bar = bar; b.x = xb_xcc_id(); b.st = st;
    if (threadIdx.x == 0) (void)xb_add(&bar[XB_XCNT(b.x)], 1u);
    return b;
}
__device__ __forceinline__ void xcd_barrier_complete(unsigned* bar, unsigned x, unsigned& nloc, unsigned& nx) {
    const unsigned G = gridDim.x * gridDim.y * gridDim.z;
    unsigned sum, cnt, mine, sp = 0u;
    for (;;) {
        sum = 0u; cnt = 0u; mine = 0u;
#pragma unroll
        for (unsigned j = 0; j < 16; ++j) { const unsigned c = xb_ld(&bar[XB_XCNT(j)]); sum += c; cnt += (c > 0u) ? 1u : 0u; mine = (j == x) ? c : mine; }
        if (sum == G) break;
        __builtin_amdgcn_s_sleep(1);
        if ((++sp & 255u) == 0u) { if (xb_ld(&bar[XB_TMO])) break; if (sp > XB_SPIN_CAP) { atomicAdd(&bar[XB_TMO], 1u); break; } }
    }
    nloc = mine > 0u ? mine : 1u; nx = cnt > 0u ? cnt : 1u;
}

__device__ __forceinline__ void xcd_barrier(const XcdBarrier& b) {
    asm volatile("s_waitcnt vmcnt(0)" ::: "memory");
    __syncthreads();
    if (threadIdx.x == 0) {
        unsigned* bar = b.bar;
        __builtin_amdgcn_s_waitcnt(0);
        unsigned nloc = b.st[0], nx = b.st[1];
        if (nloc == 0u) { xcd_barrier_complete(bar, b.x, nloc, nx); b.st[0] = nloc; b.st[1] = nx; }
        const unsigned old = xb_add(&bar[XB_XSUB(b.x)], 1u);
        const unsigned gen = old / nloc;
        if (old + 1u == (gen + 1u) * nloc) {
            __builtin_amdgcn_fence(__ATOMIC_RELEASE, "agent");
            asm volatile("s_waitcnt vmcnt(0)" ::: "memory");
            const unsigned og = xb_add(&bar[XB_TOP], 1u);
            const unsigned tg = og / nx;
            if (og + 1u == (tg + 1u) * nx) xb_add(&bar[XB_TOPGEN], 1u);
            else XB_SPIN(xb_ld(&bar[XB_TOPGEN]) == tg, bar);
            __builtin_amdgcn_fence(__ATOMIC_ACQUIRE, "agent");
            xb_add(&bar[XB_XGEN(b.x)], 1u);
            asm volatile("s_waitcnt vmcnt(0)" ::: "memory");
        } else {
            XB_SPIN(xb_ld(&bar[XB_XGEN(b.x)]) == gen, bar);
            __builtin_amdgcn_fence(__ATOMIC_ACQUIRE, "agent");
            asm volatile("s_waitcnt vmcnt(0)" ::: "memory");
        }
    }
    __syncthreads();
}
__device__ __forceinline__ void rot8(const u32x4 x1, const u32x4 x2, const float* cp, const float* sp, float scale, float (&o1)[8], float (&o2)[8]) {
    const f32x4 c0 = *(const f32x4*)cp, c1 = *(const f32x4*)(cp + 4), s0 = *(const f32x4*)sp, s1 = *(const f32x4*)(sp + 4);
    const float cs[8] = {c0.x, c0.y, c0.z, c0.w, c1.x, c1.y, c1.z, c1.w}, sn[8] = {s0.x, s0.y, s0.z, s0.w, s1.x, s1.y, s1.z, s1.w};
    const unsigned w1[4] = {x1.x, x1.y, x1.z, x1.w}, w2[4] = {x2.x, x2.y, x2.z, x2.w};
#pragma unroll
    for (int j = 0; j < 8; ++j) {
        const float a = (j & 1) ? bfhi(w1[j >> 1]) : bflo(w1[j >> 1]);
        const float bb = (j & 1) ? bfhi(w2[j >> 1]) : bflo(w2[j >> 1]);
        o1[j] = (a * cs[j] - bb * sn[j]) * scale;
        o2[j] = (bb * cs[j] + a * sn[j]) * scale;
    }
}
struct RetPref { u32x4 q1, q2, k1, k2, v0, v1, g0, g1; f32x4 c0, c1, s0, s1; };
template <bool FULL>
__device__ __forceinline__ void ret_prefetch(RetPref& p, const bf16_t* proj, const float* cosT, const float* sinT, int s, int h, int tq) {
    const bf16_t* base = proj + (size_t)s * INC + h * 128;
    p.k1 = *(const u32x4*)(base + 1024 + tq * 8); p.k2 = *(const u32x4*)(base + 1024 + 64 + tq * 8);
    p.v0 = *(const u32x4*)(base + 2048 + tq * 16); p.v1 = *(const u32x4*)(base + 2048 + tq * 16 + 8);
    const float* cp = cosT + (size_t)s * 64 + tq * 8; const float* sp = sinT + (size_t)s * 64 + tq * 8;
    p.c0 = *(const f32x4*)cp; p.c1 = *(const f32x4*)(cp + 4); p.s0 = *(const f32x4*)sp; p.s1 = *(const f32x4*)(sp + 4);
    if (FULL) { p.q1 = *(const u32x4*)(base + tq * 8); p.q2 = *(const u32x4*)(base + 64 + tq * 8); p.g0 = *(const u32x4*)(base + 3072 + tq * 16); p.g1 = *(const u32x4*)(base + 3072 + tq * 16 + 8); }
}
__device__ __forceinline__ void rot8r(const u32x4 x1, const u32x4 x2, const RetPref& p, float scale, float (&o1)[8], float (&o2)[8]) {
    const float cs[8] = {p.c0.x, p.c0.y, p.c0.z, p.c0.w, p.c1.x, p.c1.y, p.c1.z, p.c1.w}, sn[8] = {p.s0.x, p.s0.y, p.s0.z, p.s0.w, p.s1.x, p.s1.y, p.s1.z, p.s1.w};
    const unsigned w1[4] = {x1.x, x1.y, x1.z, x1.w}, w2[4] = {x2.x, x2.y, x2.z, x2.w};
#pragma unroll
    for (int j = 0; j < 8; ++j) {
        const float a = (j & 1) ? bfhi(w1[j >> 1]) : bflo(w1[j >> 1]);
        const float bb = (j & 1) ? bfhi(w2[j >> 1]) : bflo(w2[j >> 1]);
        o1[j] = (a * cs[j] - bb * sn[j]) * scale;
        o2[j] = (bb * cs[j] + a * sn[j]) * scale;
    }
}
__device__ __forceinline__ void ret_stage_kv(const RetPref& p, LAS bf16_t* KT, LAS bf16_t* VT, int m, int tq, float kdec, float (&k1)[8], float (&k2)[8]) {
    rot8r(p.k1, p.k2, p, 1.0f, k1, k2);
#pragma unroll
    for (int j = 0; j < 8; ++j) { KT[(tq * 8 + j) * 72 + m] = (bf16_t)f2bf(k1[j] * kdec); KT[(64 + tq * 8 + j) * 72 + m] = (bf16_t)f2bf(k2[j] * kdec); }
    const unsigned yw[8] = {p.v0.x, p.v0.y, p.v0.z, p.v0.w, p.v1.x, p.v1.y, p.v1.z, p.v1.w};
#pragma unroll
    for (int j = 0; j < 8; ++j) { VT[(tq * 16 + 2 * j) * 72 + m] = (bf16_t)(yw[j] & 0xffffu); VT[(tq * 16 + 2 * j + 1) * 72 + m] = (bf16_t)(yw[j] >> 16); }
}
__device__ __forceinline__ void ret_state_update(f32x4 (&S)[8], const LAS bf16_t* KT, const LAS bf16_t* VT, float dec, int wid, int fr, int fq) {
#pragma unroll
    for (int tt = 0; tt < 8; ++tt) S[tt] = S[tt] * dec;
#pragma unroll
    for (int ks = 0; ks < 2; ++ks) {
        const bf16x8 bb = *(const LAS bf16x8*)(VT + (wid * 16 + fr) * 72 + ks * 32 + fq * 8);
#pragma unroll
        for (int tt = 0; tt < 8; ++tt) { const bf16x8 a = *(const LAS bf16x8*)(KT + (tt * 16 + fr) * 72 + ks * 32 + fq * 8); S[tt] = mfma16(a, bb, S[tt]); }
    }
}
__device__ __forceinline__ void ret_r1_phase(LAS unsigned char* lds, const bf16_t* proj, const float* cosT, const float* sinT, float* gst, int G, int b) {
    const int tid = phase_tid(), lane = tid & 63, wid = phase_wid(tid), fr = lane & 15, fq = lane >> 4;
    LAS bf16_t* KT = (LAS bf16_t*)lds;
    LAS bf16_t* VT = (LAS bf16_t*)(lds + 18432);
    const int m = tid >> 3, tq = tid & 7;
    for (int unit = b; unit < 32 * NH; unit += G) {
        const int gq = unit >> 3, h = unit & 7;
        const float log_g = head_log_gamma(h), dec = fexp_(64.0f * log_g), kdec = fexp_(log_g * (63.0f - (float)m));
        f32x4 S[8];
#pragma unroll
        for (int tt = 0; tt < 8; ++tt) S[tt] = (f32x4){0.f, 0.f, 0.f, 0.f};
        RetPref pn; ret_prefetch<false>(pn, proj, cosT, sinT, (gq * 8) * 64 + m, h, tq);
        for (int i = 0; i < 8; ++i) {
            float k1[8], k2[8];
            __syncthreads();
            ret_stage_kv(pn, KT, VT, m, tq, kdec, k1, k2);
            if (i + 1 < 8) ret_prefetch<false>(pn, proj, cosT, sinT, (gq * 8 + i + 1) * 64 + m, h, tq);
            __syncthreads();
            ret_state_update(S, KT, VT, dec, wid, fr, fq);
        }
        f32x4* op = (f32x4*)gst + ((size_t)unit * 64 + wid * 8) * 64 + lane;
#pragma unroll
        for (int tt = 0; tt < 8; ++tt) op[tt * 64] = S[tt];
    }
}
__device__ __forceinline__ void scan_phase(LAS unsigned char* lds, float* gst, const float* sumA, const float* sumH, float* Hin, int G, int b) {
    const int gtid = b * NTHREADS + phase_tid(), gth = G * NTHREADS;
    for (int p = gtid; p < 32768; p += gth) {
        const int h = p >> 12;
        const float dec8 = fexp_(512.0f * head_log_gamma(h));
        f32x4* ptr = (f32x4*)gst + p;
        f32x4 s = (f32x4){0.f, 0.f, 0.f, 0.f};
        for (int gq = 0; gq < 32; gq += 8) {
            f32x4 v[8];
#pragma unroll
            for (int j = 0; j < 8; ++j) v[j] = ptr[(size_t)(gq + j) * 32768];
#pragma unroll
            for (int j = 0; j < 8; ++j) { ptr[(size_t)(gq + j) * 32768] = s; s = s * dec8 + v[j]; }
        }
    }
    const int wg = G - 1 - b;
    if (wg < 16) {
        LAS float* SG = (LAS float*)lds;
        const int tid = phase_tid(), cl = tid & 63, sg = tid >> 6, c = wg * 64 + cl;
        float a[32], hh[32];
#pragma unroll
        for (int j = 0; j < 32; ++j) { a[j] = sumA[(sg * 32 + j) * 1024 + c]; hh[j] = sumH[(sg * 32 + j) * 1024 + c]; }
        float ap = 1.f, he = 0.f;
#pragma unroll
        for (int j = 0; j < 32; ++j) { he = a[j] * he + hh[j]; ap *= a[j]; }
        SG[sg * 64 + cl] = ap; SG[512 + sg * 64 + cl] = he;
        __syncthreads();
        float H = 0.f;
#pragma unroll
        for (int s2 = 0; s2 < 7; ++s2) if (s2 < sg) H = SG[s2 * 64 + cl] * H + SG[512 + s2 * 64 + cl];
#pragma unroll
        for (int j = 0; j < 32; ++j) { Hin[(sg * 32 + j) * 1024 + c] = H; H = a[j] * H + hh[j]; }
    }
}
__device__ __forceinline__ void ret_r3_phase(LAS unsigned char* lds, const bf16_t* proj, const float* cosT, const float* sinT, const float* gst, bf16_t* ycat, int G, int b) {
    const int tid = phase_tid(), lane = tid & 63, wid = phase_wid(tid), fr = lane & 15, fq = lane >> 4;
    LAS bf16_t* QS = (LAS bf16_t*)lds;
    LAS bf16_t* KS = (LAS bf16_t*)(lds + 17408);
    LAS bf16_t* KT = (LAS bf16_t*)(lds + 34816);
    LAS bf16_t* VT = (LAS bf16_t*)(lds + 53248);
    LAS bf16_t* PS = (LAS bf16_t*)(lds + 71680);
    LAS float*  OS = (LAS float*)(lds + 80896);
    const int m = tid >> 3, tq = tid & 7;
    for (int unit = b; unit < 32 * NH; unit += G) {
        const int gq = unit >> 3, h = unit & 7;
        const float log_g = head_log_gamma(h), dec = fexp_(64.0f * log_g), kdec = fexp_(log_g * (63.0f - (float)m));
        f32x4 S[8];
        {   const f32x4* ip = (const f32x4*)gst + ((size_t)unit * 64 + wid * 8) * 64 + lane;
#pragma unroll
            for (int tt = 0; tt < 8; ++tt) S[tt] = ip[tt * 64]; }
        RetPref pn; ret_prefetch<true>(pn, proj, cosT, sinT, (gq * 8) * 64 + m, h, tq);
        for (int i = 0; i < 8; ++i) {
            const int s = (gq * 8 + i) * 64 + m;
            const u32x4 gc0 = pn.g0, gc1 = pn.g1;
            {
                float o1[8], o2[8];
                rot8r(pn.q1, pn.q2, pn, 0.08838834764831845f, o1, o2);
                *(LAS u32x4*)(QS + m * 136 + tq * 8) = (u32x4){pk2(o1[0], o1[1]), pk2(o1[2], o1[3]), pk2(o1[4], o1[5]), pk2(o1[6], o1[7])};
                *(LAS u32x4*)(QS + m * 136 + 64 + tq * 8) = (u32x4){pk2(o2[0], o2[1]), pk2(o2[2], o2[3]), pk2(o2[4], o2[5]), pk2(o2[6], o2[7])};
                ret_stage_kv(pn, KT, VT, m, tq, kdec, o1, o2);
                *(LAS u32x4*)(KS + m * 136 + tq * 8) = (u32x4){pk2(o1[0], o1[1]), pk2(o1[2], o1[3]), pk2(o1[4], o1[5]), pk2(o1[6], o1[7])};
                *(LAS u32x4*)(KS + m * 136 + 64 + tq * 8) = (u32x4){pk2(o2[0], o2[1]), pk2(o2[2], o2[3]), pk2(o2[4], o2[5]), pk2(o2[6], o2[7])};
            }
            if (i + 1 < 8) ret_prefetch<true>(pn, proj, cosT, sinT, s + 64, h, tq);
            __syncthreads();
            f32x4 oacc[4];
            {
                const int ct = wid & 3, mt0 = (wid >> 2) * 2;
                f32x4 sacc[2] = {(f32x4){0.f, 0.f, 0.f, 0.f}, (f32x4){0.f, 0.f, 0.f, 0.f}};
#pragma unroll
                for (int ks = 0; ks < 4; ++ks) {
                    const bf16x8 a = *(const LAS bf16x8*)(QS + (ct * 16 + fr) * 136 + ks * 32 + fq * 8);
#pragma unroll
                    for (int j = 0; j < 2; ++j) { const bf16x8 bb = *(const LAS bf16x8*)(KS + ((mt0 + j) * 16 + fr) * 136 + ks * 32 + fq * 8); sacc[j] = mfma16(a, bb, sacc[j]); }
                }
#pragma unroll
                for (int j = 0; j < 2; ++j)
#pragma unroll
                    for (int r = 0; r < 4; ++r) { const int c = ct * 16 + fq * 4 + r, mm = (mt0 + j) * 16 + fr; const float dd = fabsf((float)(c - mm));
                        PS[c * 72 + mm] = (bf16_t)f2bf(sacc[j][r] * fexp_(log_g * dd)); }
                asm volatile("" ::: "memory");
#pragma unroll
                for (int c4 = 0; c4 < 4; ++c4) oacc[c4] = (f32x4){0.f, 0.f, 0.f, 0.f};
#pragma unroll
                for (int a4 = 0; a4 < 4; ++a4) {
                    u32x4 bw; bw.x = pk2(S[2 * a4][0], S[2 * a4][1]); bw.y = pk2(S[2 * a4][2], S[2 * a4][3]); bw.z = pk2(S[2 * a4 + 1][0], S[2 * a4 + 1][1]); bw.w = pk2(S[2 * a4 + 1][2], S[2 * a4 + 1][3]);
                    const bf16x8 bb = __builtin_bit_cast(bf16x8, bw);
#pragma unroll
                    for (int c4 = 0; c4 < 4; ++c4) {
                        const u32x2 lo = *(const LAS u32x2*)(QS + (c4 * 16 + fr) * 136 + a4 * 32 + fq * 4), hi = *(const LAS u32x2*)(QS + (c4 * 16 + fr) * 136 + a4 * 32 + 16 + fq * 4);
                        const bf16x8 a = __builtin_bit_cast(bf16x8, (u32x4){lo.x, lo.y, hi.x, hi.y});
                        oacc[c4] = mfma16(a, bb, oacc[c4]);
                    }
                    asm volatile("" ::: "memory");
                }
#pragma unroll
                for (int c4 = 0; c4 < 4; ++c4)
#pragma unroll
                    for (int r = 0; r < 4; ++r) oacc[c4][r] *= fexp_(log_g * (float)(c4 * 16 + fq * 4 + r + 1));
            }
            __syncthreads();
            {
#pragma unroll
                for (int ks = 0; ks < 2; ++ks) {
                    const bf16x8 bb = *(const LAS bf16x8*)(VT + (wid * 16 + fr) * 72 + ks * 32 + fq * 8);
#pragma unroll
                    for (int c4 = 0; c4 < 4; ++c4) { const bf16x8 a = *(const LAS bf16x8*)(PS + (c4 * 16 + fr) * 72 + ks * 32 + fq * 8); oacc[c4] = mfma16(a, bb, oacc[c4]); }
                }
#pragma unroll
                for (int c4 = 0; c4 < 4; ++c4)
#pragma unroll
                    for (int r = 0; r < 4; ++r) OS[(c4 * 16 + fq * 4 + r) * 132 + wid * 16 + fr] = oacc[c4][r];
                ret_state_update(S, KT, VT, dec, wid, fr, fq);
            }
            __syncthreads();
            {
                float v[16]; float sum = 0.f;
#pragma unroll
                for (int q = 0; q < 4; ++q) { const f32x4 t = *(const LAS f32x4*)(OS + m * 132 + tq * 16 + q * 4); v[4 * q] = t.x; v[4 * q + 1] = t.y; v[4 * q + 2] = t.z; v[4 * q + 3] = t.w; sum += (t.x + t.y) + (t.z + t.w); }
                sum += __shfl_xor(sum, 1); sum += __shfl_xor(sum, 2); sum += __shfl_xor(sum, 4);
                const float mean = sum * (1.0f / 128.0f); float sq = 0.f;
#pragma unroll
                for (int q = 0; q < 16; ++q) { v[q] -= mean; sq += v[q] * v[q]; }
                sq += __shfl_xor(sq, 1); sq += __shfl_xor(sq, 2); sq += __shfl_xor(sq, 4);
                const float rstd = 1.0f / sqrtf(sq * (1.0f / 128.0f) + GN_EPS);
                const unsigned gw[8] = {gc0.x, gc0.y, gc0.z, gc0.w, gc1.x, gc1.y, gc1.z, gc1.w};
                unsigned ow[8];
#pragma unroll
                for (int j = 0; j < 8; ++j) { const float ga = bflo(gw[j]), gb = bfhi(gw[j]);
                    ow[j] = pk2(ga * sigmoidf_(ga) * v[2 * j] * rstd, gb * sigmoidf_(gb) * v[2 * j + 1] * rstd); }
                bf16_t* yp = ycat + (size_t)s * D_ + h * 128 + tq * 16;
                *(u32x4*)yp = (u32x4){ow[0], ow[1], ow[2], ow[3]}; *(u32x4*)(yp + 8) = (u32x4){ow[4], ow[5], ow[6], ow[7]};
            }
        }
        __syncthreads();
    }
}
template <int MODE>
__device__ __forceinline__ void lru_phase(LAS unsigned char* lds, const bf16_t* proj, const Ptrs& P, const bf16_t* wraT, const bf16_t* wriT,
                                          float* sumA, float* sumH, const float* Hin, bf16_t* ycat, int G, int b) {
    const int tid = phase_tid(), lane = tid & 63, wid = phase_wid(tid), fr = lane & 15, fq = lane >> 4;
    LAS float*  XC  = (LAS float*)lds;
    LAS bf16_t* XCb = (LAS bf16_t*)(lds + 33792);
    LAS float*  AA  = (LAS float*)(lds + 51200);
    LAS float*  SEG = (LAS float*)(lds + 84992);
    LAS bf16_t* WR  = (LAS bf16_t*)(lds + 89088);
    LAS bf16_t* WI  = (LAS bf16_t*)(lds + 123904);
    LAS float*  BB  = XC;
    const int st = wid & 3, jt0 = (wid >> 2) * 4;
    const int m = tid >> 3, part = tid & 7, j0 = part * 16;
    const int sj = tid & 127, seg = tid >> 7;
    int gcur = -1;
    float bra[4], bri[4], ls[4]; float cw0[4], cw1[4], cb0 = 0.f, cb1 = 0.f;
    unsigned xnext[11]; u32x4 gnext[2] = {(u32x4){0u, 0u, 0u, 0u}, (u32x4){0u, 0u, 0u, 0u}}; float hnext = 0.f;
    auto issue = [&](int unit) {
        const int n = unit >> 3, c0 = (unit & 7) * 128;
        const int r0 = n * 64 + wid * 8 - 3;
#pragma unroll
        for (int q = 0; q < 11; ++q) { const int row = r0 + q; xnext[q] = row >= 0 ? *(const unsigned*)(proj + (size_t)row * INC + 4096 + c0 + 2 * lane) : 0u; }
        if (MODE == 1) {
            const bf16_t* gp = proj + (size_t)(n * 64 + m) * INC + 5120 + c0 + j0;
            gnext[0] = *(const u32x4*)gp; gnext[1] = *(const u32x4*)(gp + 8);
            hnext = Hin[n * 1024 + c0 + sj];
        }
    };
    if (b < NCH * 8) issue(b);
    for (int unit = b; unit < NCH * 8; unit += G) {
        const int n = unit >> 3, g = unit & 7, c0 = g * 128;
        if (g != gcur) {
            gcur = g;
            __syncthreads();
            {
                const int row = tid >> 2, pc = tid & 3;
#pragma unroll
                for (int q = 0; q < 4; ++q) { const int piece = pc * 4 + q;
                    *(LAS u32x4*)(WR + row * 136 + piece * 8) = *(const u32x4*)(wraT + (size_t)g * 16384 + row * 128 + piece * 8);
                    *(LAS u32x4*)(WI + row * 136 + piece * 8) = *(const u32x4*)(wriT + (size_t)g * 16384 + row * 128 + piece * 8); }
            }
#pragma unroll
            for (int j = 0; j < 4; ++j) {
                const int c = c0 + (jt0 + j) * 16 + fr;
                bra[j] = P.b_ra[c]; bri[j] = P.b_ri[c]; ls[j] = -8.0f * log1pf(expf(-P.lam[c]));
            }
#pragma unroll
            for (int kk = 0; kk < 4; ++kk) { cw0[kk] = P.conv_w[kk * 1024 + c0 + 2 * lane]; cw1[kk] = P.conv_w[kk * 1024 + c0 + 2 * lane + 1]; }
            cb0 = P.conv_b[c0 + 2 * lane]; cb1 = P.conv_b[c0 + 2 * lane + 1];
        }
        unsigned xcur[11];
#pragma unroll
        for (int q = 0; q < 11; ++q) xcur[q] = xnext[q];
        const u32x4 gc0 = gnext[0], gc1 = gnext[1]; const float hin0 = hnext;
        if (unit + G < NCH * 8) issue(unit + G);
        QRow qrow; const int qe = unit * 8 + wid;
        quant_issue(qrow, MODE == 1 ? P.peer_v : P.peer_u, qe, lane);
#pragma unroll
        for (int rr = 0; rr < 8; ++rr) {
            float x0 = cb0, x1 = cb1;
#pragma unroll
            for (int kk = 0; kk < 4; ++kk) { x0 += cw0[kk] * bflo(xcur[rr + kk]); x1 += cw1[kk] * bfhi(xcur[rr + kk]); }
            const int row = wid * 8 + rr;
            XC[row * 132 + 2 * lane] = x0; XC[row * 132 + 2 * lane + 1] = x1;
            *(LAS unsigned*)(XCb + row * 136 + 2 * lane) = pk2(x0, x1);
        }
        __syncthreads();
        {
            f32x4 ar[4], ai[4];
#pragma unroll
            for (int j = 0; j < 4; ++j) { ar[j] = (f32x4){0.f, 0.f, 0.f, 0.f}; ai[j] = (f32x4){0.f, 0.f, 0.f, 0.f}; }
#pragma unroll
            for (int ks = 0; ks < 4; ++ks) {
                const bf16x8 a = *(const LAS bf16x8*)(XCb + (st * 16 + fr) * 136 + ks * 32 + fq * 8);
#pragma unroll
                for (int j = 0; j < 4; ++j) { const int wo = ((jt0 + j) * 16 + fr) * 136 + ks * 32 + fq * 8;
                    ar[j] = mfma16(a, *(const LAS bf16x8*)(WR + wo), ar[j]); ai[j] = mfma16(a, *(const LAS bf16x8*)(WI + wo), ai[j]); }
            }
#pragma unroll
            for (int j = 0; j < 4; ++j) {
                const int col = (jt0 + j) * 16 + fr;
#pragma unroll
                for (int r = 0; r < 4; ++r) {
                    const int sl = st * 16 + fq * 4 + r;
                    const float rg = sigmoidf_(ar[j][r] + bra[j]), ig = sigmoidf_(ai[j][r] + bri[j]);
                    const float a = fexp_(rg * ls[j]);
                    const float bv = __builtin_amdgcn_sqrtf(fmaxf(1.0f - a * a, 0.f)) * (ig * XC[sl * 132 + col]);
                    AA[sl * 132 + col] = a; BB[sl * 132 + col] = bv;
                }
            }
        }
        __syncthreads();
        float ap = 1.f, he = 0.f;
#pragma unroll
        for (int q = 0; q < 16; ++q) { const float a = AA[(seg * 16 + q) * 132 + sj], bv = BB[(seg * 16 + q) * 132 + sj]; he = a * he + bv; ap *= a; }
        SEG[seg * 128 + sj] = ap; SEG[512 + seg * 128 + sj] = he;
        __syncthreads();
        float hin = (MODE == 1) ? hin0 : 0.f;
#pragma unroll
        for (int s2 = 0; s2 < 3; ++s2) if (s2 < seg) hin = SEG[s2 * 128 + sj] * hin + SEG[512 + s2 * 128 + sj];
        if (MODE == 0) {
            if (seg == 3) { sumA[n * 1024 + c0 + sj] = SEG[sj] * SEG[128 + sj] * SEG[256 + sj] * ap; sumH[n * 1024 + c0 + sj] = ap * hin + he; }
        } else {
            float hcur = hin;
#pragma unroll
            for (int q = 0; q < 16; ++q) { const int o = (seg * 16 + q) * 132 + sj; hcur = AA[o] * hcur + BB[o]; BB[o] = hcur; }
            __syncthreads();
            const unsigned gw[8] = {gc0.x, gc0.y, gc0.z, gc0.w, gc1.x, gc1.y, gc1.z, gc1.w};
            unsigned ow[8];
#pragma unroll
            for (int q = 0; q < 8; ++q) { const float h0 = BB[m * 132 + j0 + 2 * q], h1 = BB[m * 132 + j0 + 2 * q + 1];
                ow[q] = pk2(h0 * gelu_tanh(bflo(gw[q])), h1 * gelu_tanh(bfhi(gw[q]))); }
            bf16_t* yp = ycat + (size_t)(n * 64 + m) * D_ + 1024 + c0 + j0;
            *(u32x4*)yp = (u32x4){ow[0], ow[1], ow[2], ow[3]}; *(u32x4*)(yp + 8) = (u32x4){ow[4], ow[5], ow[6], ow[7]};
        }
        quant_finish<MODE>(qrow, P.ws + (MODE == 1 ? WS_VQ : WS_UQ), (float*)(P.ws + (MODE == 1 ? WS_SV : WS_SU)), qe, lane);
        __syncthreads();
    }
}
__device__ __forceinline__ void ln1_phase(const bf16_t* buf, bf16_t* h1b, unsigned* xqs, float* sx, const float* gam, const float* bet, int G, int b) {
    const int tid_ = phase_tid(), lane = tid_ & 63, wid = phase_wid(tid_);
    const int gw = b * NWAVES + wid, NGW = G * NWAVES;
    constexpr int R = 4;
    for (int row0 = gw; row0 < S_; row0 += R * NGW) {
        f32x4 v[R][8]; float sum[R], sq[R], amax[R];
#pragma unroll
        for (int q = 0; q < R; ++q) {
            const int row = min(row0 + q * NGW, S_ - 1);
            const bf16_t* rp = buf + (size_t)row * D_;
            sum[q] = 0.f;
#pragma unroll
            for (int j = 0; j < 8; ++j) { const u32x2 w = *(const u32x2*)(rp + 256 * j + 4 * lane); v[q][j] = (f32x4){bflo(w.x), bfhi(w.x), bflo(w.y), bfhi(w.y)}; sum[q] += (v[q][j].x + v[q][j].y) + (v[q][j].z + v[q][j].w); }
        }
#pragma unroll
        for (int q = 0; q < R; ++q) sum[q] = wave_sum(sum[q]) * (1.0f / D_);
#pragma unroll
        for (int q = 0; q < R; ++q) { sq[q] = 0.f;
#pragma unroll
            for (int j = 0; j < 8; ++j) { v[q][j] = v[q][j] - sum[q]; sq[q] += (v[q][j].x * v[q][j].x + v[q][j].y * v[q][j].y) + (v[q][j].z * v[q][j].z + v[q][j].w * v[q][j].w); } }
#pragma unroll
        for (int q = 0; q < R; ++q) sq[q] = 1.0f / sqrtf(wave_sum(sq[q]) * (1.0f / D_) + LN_EPS);
#pragma unroll
        for (int j = 0; j < 8; ++j) {
            const f32x4 gg = *(const f32x4*)(gam + 256 * j + 4 * lane), bb = *(const f32x4*)(bet + 256 * j + 4 * lane);
#pragma unroll
            for (int q = 0; q < R; ++q) v[q][j] = v[q][j] * sq[q] * gg + bb;
        }
#pragma unroll
        for (int q = 0; q < R; ++q) { amax[q] = 0.f;
#pragma unroll
            for (int j = 0; j < 8; ++j) amax[q] = fmaxf(amax[q], fmaxf(fmaxf(fabsf(v[q][j].x), fabsf(v[q][j].y)), fmaxf(fabsf(v[q][j].z), fabsf(v[q][j].w)))); }
#pragma unroll
        for (int q = 0; q < R; ++q) amax[q] = wave_max(amax[q]);
#pragma unroll
        for (int q = 0; q < R; ++q) {
            const int row = row0 + q * NGW;
            if (row < S_) {
                const float inv = amax[q] > 0.f ? 127.0f / amax[q] : 0.f;
                if (lane == 0) sx[row] = amax[q] * (1.0f / 127.0f);
#pragma unroll
                for (int j = 0; j < 8; ++j) {
                    *(u32x2*)(h1b + (size_t)row * D_ + 256 * j + 4 * lane) = (u32x2){pk2(v[q][j].x, v[q][j].y), pk2(v[q][j].z, v[q][j].w)};
                    const int a = (int)rintf(v[q][j].x * inv), bq = (int)rintf(v[q][j].y * inv), c = (int)rintf(v[q][j].z * inv), d = (int)rintf(v[q][j].w * inv);
                    xqs[((size_t)j * S_ + row) * 64 + lane] = (unsigned)(a & 255) | ((unsigned)(bq & 255) << 8) | ((unsigned)(c & 255) << 16) | ((unsigned)(d & 255) << 24);
                }
            }
        }
    }
}
__device__ __forceinline__ unsigned mono(float f) { const unsigned u = __float_as_uint(f); return (u & 0x80000000u) ? ~u : (u ^ 0x80000000u); }
__device__ __forceinline__ float unmono(unsigned u) { return __uint_as_float((u & 0x80000000u) ? (u ^ 0x80000000u) : ~u); }
__device__ __forceinline__ unsigned umax_(unsigned a, unsigned b) { return a > b ? a : b; }
__device__ __forceinline__ constexpr int cand_i(int c) { return c < 16 ? 0 : c < 24 ? 1 : c < 29 ? 2 : c < 33 ? 3 : c < 36 ? 4 : c < 38 ? 5 : c < 40 ? 6 : c < 42 ? 7 : c - 34; }
__device__ __forceinline__ constexpr int cand_j(int c) { return c < 16 ? c : c < 24 ? c - 16 : c < 29 ? c - 24 : c < 33 ? c - 29 : c < 36 ? c - 33 : c < 38 ? c - 36 : c < 40 ? c - 38 : c < 42 ? c - 40 : 0; }

__device__ __forceinline__ unsigned umin_(unsigned a, unsigned b) { return a < b ? a : b; }
#define SN_CE(x, y) do { const unsigned hi_ = umax_(x, y), lo_ = umin_(x, y); x = hi_; y = lo_; } while (0)
#define SN_SORT16(a) do { SN_CE(a[0], a[1]); SN_CE(a[2], a[3]); SN_CE(a[0], a[2]); SN_CE(a[1], a[3]); SN_CE(a[1], a[2]); SN_CE(a[4], a[5]); SN_CE(a[6], a[7]); SN_CE(a[4], a[6]); SN_CE(a[5], a[7]); SN_CE(a[5], a[6]); SN_CE(a[0], a[4]); SN_CE(a[2], a[6]); SN_CE(a[2], a[4]); SN_CE(a[1], a[5]); SN_CE(a[3], a[7]); SN_CE(a[3], a[5]); SN_CE(a[1], a[2]); SN_CE(a[3], a[4]); SN_CE(a[5], a[6]); SN_CE(a[8], a[9]); SN_CE(a[10], a[11]); SN_CE(a[8], a[10]); SN_CE(a[9], a[11]); SN_CE(a[9], a[10]); SN_CE(a[12], a[13]); SN_CE(a[14], a[15]); SN_CE(a[12], a[14]); SN_CE(a[13], a[15]); SN_CE(a[13], a[14]); SN_CE(a[8], a[12]); SN_CE(a[10], a[14]); SN_CE(a[10], a[12]); SN_CE(a[9], a[13]); SN_CE(a[11], a[15]); SN_CE(a[11], a[13]); SN_CE(a[9], a[10]); SN_CE(a[11], a[12]); SN_CE(a[13], a[14]); SN_CE(a[0], a[8]); SN_CE(a[4], a[12]); SN_CE(a[4], a[8]); SN_CE(a[2], a[10]); SN_CE(a[6], a[14]); SN_CE(a[6], a[10]); SN_CE(a[2], a[4]); SN_CE(a[6], a[8]); SN_CE(a[10], a[12]); SN_CE(a[1], a[9]); SN_CE(a[5], a[13]); SN_CE(a[5], a[9]); SN_CE(a[3], a[11]); SN_CE(a[7], a[15]); SN_CE(a[7], a[11]); SN_CE(a[3], a[5]); SN_CE(a[7], a[9]); SN_CE(a[11], a[13]); SN_CE(a[1], a[2]); SN_CE(a[3], a[4]); SN_CE(a[5], a[6]); SN_CE(a[7], a[8]); SN_CE(a[9], a[10]); SN_CE(a[11], a[12]); SN_CE(a[13], a[14]); } while (0)
#define SN_BITONIC16(a) do { SN_CE(a[0], a[8]); SN_CE(a[1], a[9]); SN_CE(a[2], a[10]); SN_CE(a[3], a[11]); SN_CE(a[4], a[12]); SN_CE(a[5], a[13]); SN_CE(a[6], a[14]); SN_CE(a[7], a[15]); SN_CE(a[0], a[4]); SN_CE(a[1], a[5]); SN_CE(a[2], a[6]); SN_CE(a[3], a[7]); SN_CE(a[8], a[12]); SN_CE(a[9], a[13]); SN_CE(a[10], a[14]); SN_CE(a[11], a[15]); SN_CE(a[0], a[2]); SN_CE(a[1], a[3]); SN_CE(a[4], a[6]); SN_CE(a[5], a[7]); SN_CE(a[8], a[10]); SN_CE(a[9], a[11]); SN_CE(a[12], a[14]); SN_CE(a[13], a[15]); SN_CE(a[0], a[1]); SN_CE(a[2], a[3]); SN_CE(a[4], a[5]); SN_CE(a[6], a[7]); SN_CE(a[8], a[9]); SN_CE(a[10], a[11]); SN_CE(a[12], a[13]); SN_CE(a[14], a[15]); } while (0)

#define TOPK_XMERGE(T, mask) do { unsigned pt_[16]; \
    _Pragma("unroll") for (int i_ = 0; i_ < 16; ++i_) pt_[i_] = (unsigned)__shfl_xor((int)T[15 - i_], mask); \
    _Pragma("unroll") for (int i_ = 0; i_ < 16; ++i_) T[i_] = umax_(T[i_], pt_[i_]); \
    SN_BITONIC16(T); } while (0)
__device__ __forceinline__ void topk_phase(LAS unsigned char* lds, const bf16_t* qp, const bf16_t* keys, const float* SU, const float* SV, int* sel_e, float* sel_g, float* sel_su, int G, int b) {
    const int tid = phase_tid(), lane = tid & 63, wid = phase_wid(tid), fr = lane & 15, fq = lane >> 4;
    LAS unsigned* wl = (LAS unsigned*)(lds + wid * 4096 + fr * 256);
    pg8::StaticOrder SO; SO.init(S_, D_, G, b);
    for (int ui = 0; ; ++ui) {
        pg8::Unit gu; if (!SO.next(ui >> 1, gu)) break;
        const int tt = gu.pm * 2 + (ui & 1), h = gu.pn;
        const int tok = tt * 128 + wid * 16 + fr;
        unsigned T[2][16];
#pragma unroll
        for (int p = 0; p < 2; ++p) {
            f32x4 acc[8];
#pragma unroll
            for (int mt = 0; mt < 8; ++mt) acc[mt] = (f32x4){0.f, 0.f, 0.f, 0.f};
            bf16x8 bq[4];
#pragma unroll
            for (int ks = 0; ks < 4; ++ks) bq[ks] = *(const bf16x8*)(qp + (size_t)tok * D_ + h * 256 + p * 128 + ks * 32 + fq * 8);
            const bf16_t* kb = keys + (size_t)(h * 2 + p) * 16384;
#pragma unroll
            for (int mt = 0; mt < 8; ++mt)
#pragma unroll
                for (int ks = 0; ks < 4; ++ks) { const bf16x8 a = *(const bf16x8*)(kb + (mt * 16 + fr) * 128 + ks * 32 + fq * 8); acc[mt] = mfma16(a, bq[ks], acc[mt]); }
            unsigned lo16[16];
#pragma unroll
            for (int mt = 0; mt < 4; ++mt)
#pragma unroll
                for (int r = 0; r < 4; ++r) {
                    T[p][mt * 4 + r] = (mono(acc[mt][r]) & ~127u) | (unsigned)(127 - (mt * 16 + fq * 4 + r));
                    lo16[mt * 4 + r] = (mono(acc[mt + 4][r]) & ~127u) | (unsigned)(127 - ((mt + 4) * 16 + fq * 4 + r));
                }
            SN_SORT16(T[p]); SN_SORT16(lo16);
#pragma unroll
            for (int i = 0; i < 16; ++i) T[p][i] = umax_(T[p][i], lo16[15 - i]);
            SN_BITONIC16(T[p]);
            TOPK_XMERGE(T[p], 16); TOPK_XMERGE(T[p], 32);
        }
        float v1[16], v2[16];
#pragma unroll
        for (int i = 0; i < 16; ++i) { v1[i] = unmono(T[0][i] & ~127u); v2[i] = unmono(T[1][i] & ~127u); }
        unsigned ck[16];
#pragma unroll
        for (int sidx = 0; sidx < 13; ++sidx) {
            unsigned keyk[4];
#pragma unroll
            for (int k = 0; k < 4; ++k) {
                const int c = 4 * sidx + k;
                if (c < 50) { const int ci = cand_i(c), cj = cand_j(c); keyk[k] = (mono(v1[ci] + v2[cj]) & ~255u) | (unsigned)(255 - (ci * 16 + cj)); }
                else keyk[k] = 0u;
            }
            ck[sidx] = fq == 0 ? keyk[0] : fq == 1 ? keyk[1] : fq == 2 ? keyk[2] : keyk[3];
        }
        ck[13] = 0u; ck[14] = 0u; ck[15] = 0u;
        SN_SORT16(ck);
        TOPK_XMERGE(ck, 16); TOPK_XMERGE(ck, 32);
        if (fq == 0) {
#pragma unroll
            for (int i = 0; i < 16; ++i) { wl[i] = T[0][i]; wl[16 + i] = T[1][i]; }
        }
        __syncthreads();
        {
            const float vmax = unmono(ck[0] & ~255u);
            float esum = 0.f;
#pragma unroll
            for (int k = 0; k < 16; ++k) esum += __expf(unmono(ck[k] & ~255u) - vmax);
            const float einv = 1.0f / esum;
#pragma unroll
            for (int kk = 0; kk < 4; ++kk) {
                const unsigned W = fq == 0 ? ck[kk] : fq == 1 ? ck[4 + kk] : fq == 2 ? ck[8 + kk] : ck[12 + kk];
                const int k = fq * 4 + kk;
                const unsigned id = 255u - (W & 255u);
                const unsigned e1 = 127u - (wl[id >> 4] & 127u), e2 = 127u - (wl[16 + (id & 15u)] & 127u);
                const size_t o = ((size_t)tok * 8 + h) * 16 + k;
                const unsigned ex = e1 * 128u + e2;
                sel_e[o] = (int)ex; sel_g[o] = __expf(unmono(W & ~255u) - vmax) * einv * SV[ex]; sel_su[o] = SU[ex];
            }
        }
        __syncthreads();
    }
}
__device__ __forceinline__ int row16_sum_i(int v) {
    v += __builtin_amdgcn_update_dpp(0, v, 0xB1, 0xF, 0xF, true);
    v += __builtin_amdgcn_update_dpp(0, v, 0x4E, 0xF, 0xF, true);
    v += __builtin_amdgcn_update_dpp(0, v, 0x141, 0xF, 0xF, true);
    v += __builtin_amdgcn_update_dpp(0, v, 0x140, 0xF, 0xF, true);
    return v;
}
__device__ __forceinline__ int dot16_i8(const u32x4 a, const u32x4 x) {
    int d = __builtin_amdgcn_sdot4((int)a.x, (int)x.x, 0, false); d = __builtin_amdgcn_sdot4((int)a.y, (int)x.y, d, false);
    d = __builtin_amdgcn_sdot4((int)a.z, (int)x.z, d, false); return __builtin_amdgcn_sdot4((int)a.w, (int)x.w, d, false);
}
__device__ __forceinline__ void peer_u_phase(LAS unsigned char* lds, const unsigned char* UQs, const unsigned char* XQs, const int* sel_e, int* pd, int xi, int nx, int rank, int nloc) {
    const int tid_ = phase_tid(), lane = tid_ & 63, wid = phase_wid(tid_), r = lane >> 4, i = lane & 15;
    LAS int* esb = (LAS int*)(lds + wid * 2048);
    const int wx = rank * NWAVES + wid, nwx = nloc * NWAVES;
    if (wx >= S_) return;
    const int NT = (S_ - wx + nwx - 1) / nwx;
    for (int j = xi; j < 8; j += nx) {
        const unsigned char* Uj = UQs + (size_t)j * 16384 * 256; const unsigned li = 16u * (unsigned)i;
        const unsigned char* Xj = XQs + (size_t)j * S_ * 256 + 16 * i;
        u32x4 A[16], B[16];
        int ma, mb; u32x4 xc, xn;
        {
            const int t0 = wx, t1 = (NT > 1) ? wx + nwx : wx;
            ma = sel_e[(size_t)t0 * 128 + lane]; mb = sel_e[(size_t)t0 * 128 + 64 + lane]; xc = *(const u32x4*)(Xj + (size_t)t0 * 256);
            esb[lane] = ma; esb[64 + lane] = mb;
            asm volatile("" ::: "memory");
            ma = sel_e[(size_t)t1 * 128 + lane]; mb = sel_e[(size_t)t1 * 128 + 64 + lane]; xn = *(const u32x4*)(Xj + (size_t)t1 * 256);
            asm volatile("" ::: "memory");
#pragma unroll
            for (int it = 0; it < 16; ++it) A[it] = *(const u32x4*)(Uj + ((unsigned)esb[4 * it + r] * 256u + li));
#pragma unroll
            for (int it = 0; it < 16; ++it) B[it] = *(const u32x4*)(Uj + ((unsigned)esb[64 + 4 * it + r] * 256u + li));
        }
        for (int n = 0; n < NT; ++n) {
            const int t = wx + n * nwx;
            const int t2 = (n + 2 < NT) ? t + 2 * nwx : t;
            LAS int* esn = esb + ((n + 1) & 1) * 128;
            esn[lane] = ma; esn[64 + lane] = mb;
            const u32x4 xnn = xn;
            asm volatile("" ::: "memory");
            ma = sel_e[(size_t)t2 * 128 + lane]; mb = sel_e[(size_t)t2 * 128 + 64 + lane]; xn = *(const u32x4*)(Xj + (size_t)t2 * 256);
            int keepA = 0, keepB = 0;
#pragma unroll
            for (int it = 0; it < 16; ++it) { const int d = row16_sum_i(dot16_i8(A[it], xc)); keepA = (i == it) ? d : keepA; }
            asm volatile("" : "+v"(keepA) :: "memory");
#pragma unroll
            for (int it = 0; it < 16; ++it) A[it] = *(const u32x4*)(Uj + ((unsigned)esn[4 * it + r] * 256u + li));
            asm volatile("" ::: "memory");
#pragma unroll
            for (int it = 0; it < 16; ++it) { const int d = row16_sum_i(dot16_i8(B[it], xc)); keepB = (i == it) ? d : keepB; }
            asm volatile("" : "+v"(keepB) :: "memory");
#pragma unroll
            for (int it = 0; it < 16; ++it) B[it] = *(const u32x4*)(Uj + ((unsigned)esn[64 + 4 * it + r] * 256u + li));
            asm volatile("" ::: "memory");
            int* pp = pd + ((size_t)t * 8 + j) * 128 + 4 * i + r;
            pp[0] = keepA; pp[64] = keepB;
            xc = xnn;
        }
    }
}
typedef float f32x2 __attribute__((ext_vector_type(2)));
__device__ __forceinline__ void acc16_fp8(f32x2 (&acc)[8], const u32x4 v, float c) {
    const int w[4] = {(int)v.x, (int)v.y, (int)v.z, (int)v.w};
    const f32x2 cc = {c, c};
#pragma unroll
    for (int q = 0; q < 4; ++q) {
        const f32x2 lo = __builtin_amdgcn_cvt_pk_f32_fp8(w[q], false), hi = __builtin_amdgcn_cvt_pk_f32_fp8(w[q], true);
        acc[2 * q] = __builtin_elementwise_fma(cc, lo, acc[2 * q]); acc[2 * q + 1] = __builtin_elementwise_fma(cc, hi, acc[2 * q + 1]);
    }
}
__device__ __forceinline__ void peer_coef_phase(const float* sel_g, const float* sel_su, const int* pd, const float* SX, float* coef, int G, int b) {
    const int tid_ = phase_tid(), lane = tid_ & 63, wid = phase_wid(tid_);
    const int gw = b * NWAVES + wid, NGW = G * NWAVES;
    for (int t = gw; t < S_; t += NGW) {
        const float* gp = sel_g + (size_t)t * 128 + lane; const float* up = sel_su + (size_t)t * 128 + lane; const int* pp = pd + (size_t)t * 1024 + lane;
        const float sxt = SX[t];
#pragma unroll
        for (int hh = 0; hh < 2; ++hh) {
            int ds = 0;
#pragma unroll
            for (int jj = 0; jj < 8; ++jj) ds += pp[jj * 128 + 64 * hh];
            coef[(size_t)t * 128 + 64 * hh + lane] = gp[64 * hh] * gelu_tanh((float)ds * (up[64 * hh] * sxt));
        }
    }
}
struct PeerMeta { int e[2]; float c[2]; };
__device__ __forceinline__ void peer_meta_load(PeerMeta& m, const int* sel_e, const float* coef, int t, int lane) {
    const int* ep = sel_e + (size_t)t * 128 + lane; const float* cp = coef + (size_t)t * 128 + lane;
    m.e[0] = ep[0]; m.e[1] = ep[64]; m.c[0] = cp[0]; m.c[1] = cp[64];
}
__device__ __forceinline__ void tr4x4(unsigned r0, unsigned r1, unsigned r2, unsigned r3, unsigned (&c)[4]) {
    const unsigned t0 = __builtin_amdgcn_perm(r1, r0, 0x05010400u), t1 = __builtin_amdgcn_perm(r1, r0, 0x07030602u);
    const unsigned t2 = __builtin_amdgcn_perm(r3, r2, 0x05010400u), t3 = __builtin_amdgcn_perm(r3, r2, 0x07030602u);
    c[0] = __builtin_amdgcn_perm(t2, t0, 0x05040100u); c[1] = __builtin_amdgcn_perm(t2, t0, 0x07060302u);
    c[2] = __builtin_amdgcn_perm(t3, t1, 0x05040100u); c[3] = __builtin_amdgcn_perm(t3, t1, 0x07060302u);
}
__device__ __forceinline__ void acc_group_i8(int (&ah)[16], int (&al)[16], const u32x4 (&R)[16], int gg, unsigned CH, unsigned CL) {
    const unsigned w0[4] = {R[4 * gg].x, R[4 * gg].y, R[4 * gg].z, R[4 * gg].w}, w1[4] = {R[4 * gg + 1].x, R[4 * gg + 1].y, R[4 * gg + 1].z, R[4 * gg + 1].w};
    const unsigned w2[4] = {R[4 * gg + 2].x, R[4 * gg + 2].y, R[4 * gg + 2].z, R[4 * gg + 2].w}, w3[4] = {R[4 * gg + 3].x, R[4 * gg + 3].y, R[4 * gg + 3].z, R[4 * gg + 3].w};
#pragma unroll
    for (int q = 0; q < 4; ++q) {
        unsigned c[4]; tr4x4(w0[q], w1[q], w2[q], w3[q], c);
#pragma unroll
        for (int cc = 0; cc < 4; ++cc) { ah[4 * q + cc] = __builtin_amdgcn_sdot4((int)c[cc], (int)CH, ah[4 * q + cc], false); al[4 * q + cc] = __builtin_amdgcn_sdot4((int)c[cc], (int)CL, al[4 * q + cc], false); }
    }
}
__device__ __forceinline__ void peer_stage_lists(const PeerMeta& m, LAS int* es, LAS unsigned char* chB, LAS unsigned char* clB, LAS float* scp, int lane) {
    es[lane] = m.e[0]; es[64 + lane] = m.e[1];
    const float cmax = wave_max(fmaxf(fabsf(m.c[0]), fabsf(m.c[1])));
    const float inv = cmax > 0.f ? 16256.0f / cmax : 0.f;
    if (lane == 0) scp[0] = cmax * (1.0f / 16256.0f);
#pragma unroll
    for (int hh = 0; hh < 2; ++hh) {
        const int k = 64 * hh + lane;
        const int q = (int)rintf(m.c[hh] * inv), h = (q + 64) >> 7, l = q - 128 * h;
        const int idx = (k >> 4) * 16 + (k & 3) * 4 + ((k >> 2) & 3);
        chB[idx] = (unsigned char)(h & 255); clB[idx] = (unsigned char)(l & 255);
    }
}
template <int STRIP>
__device__ __forceinline__ void peer_v_phase(LAS unsigned char* lds, const unsigned char* VQs, const int* sel_e, const float* coef,
                                             bf16_t* zs, int xi, int nx, int rank, int nloc) {
    const int tid_ = phase_tid(), lane = tid_ & 63, wid = phase_wid(tid_), r = lane >> 4, i = lane & 15;
    LAS unsigned char* wl = lds + wid * 2048;
    LAS int* esb = (LAS int*)wl;
    const int wx = rank * NWAVES + wid, nwx = nloc * NWAVES;
    if (wx >= S_) return;
    const int NT = (S_ - wx + nwx - 1) / nwx;
    for (int j = xi; j < 8; j += nx) {
        const unsigned char* Vj = VQs + (size_t)j * 16384 * 256; const unsigned li = 16u * (unsigned)i;
        u32x4 A[16], B[16];
        PeerMeta m;
        {
            peer_meta_load(m, sel_e, coef, wx, lane);
            peer_stage_lists(m, esb, wl + 1024, wl + 1280, (LAS float*)(wl + 1536), lane);
            asm volatile("" ::: "memory");
            peer_meta_load(m, sel_e, coef, (NT > 1) ? wx + nwx : wx, lane);
            asm volatile("" ::: "memory");
#pragma unroll
            for (int it = 0; it < 16; ++it) A[it] = *(const u32x4*)(Vj + ((unsigned)esb[4 * it + r] * 256u + li));
#pragma unroll
            for (int it = 0; it < 16; ++it) B[it] = *(const u32x4*)(Vj + ((unsigned)esb[64 + 4 * it + r] * 256u + li));
        }
        for (int n = 0; n < NT; ++n) {
            const int t = wx + n * nwx;
            const int t2 = (n + 2 < NT) ? t + 2 * nwx : t;
            const int pc = n & 1, pn = pc ^ 1;
            LAS int* esn = esb + pn * 128;
            const LAS unsigned* chc = (const LAS unsigned*)(wl + 1024 + pc * 128); const LAS unsigned* clc = (const LAS unsigned*)(wl + 1280 + pc * 128);
            peer_stage_lists(m, esn, wl + 1024 + pn * 128, wl + 1280 + pn * 128, (LAS float*)(wl + 1536) + pn, lane);
            asm volatile("" ::: "memory");
            peer_meta_load(m, sel_e, coef, t2, lane);
            int ah[16], al[16];
#pragma unroll
            for (int q = 0; q < 16; ++q) { ah[q] = 0; al[q] = 0; }
#pragma unroll
            for (int gg = 0; gg < 4; ++gg) { if (STRIP == 1) { ah[gg] += (int)(A[4 * gg].x ^ A[4 * gg + 1].y ^ A[4 * gg + 2].z ^ A[4 * gg + 3].w ^ chc[gg * 4 + r]); } else acc_group_i8(ah, al, A, gg, chc[gg * 4 + r], clc[gg * 4 + r]); }
            asm volatile("" : "+v"(ah[0]), "+v"(ah[1]), "+v"(ah[2]), "+v"(ah[3]), "+v"(ah[4]), "+v"(ah[5]), "+v"(ah[6]), "+v"(ah[7]), "+v"(ah[8]), "+v"(ah[9]), "+v"(ah[10]), "+v"(ah[11]), "+v"(ah[12]), "+v"(ah[13]), "+v"(ah[14]), "+v"(ah[15]) :: "memory");
            asm volatile("" : "+v"(al[0]), "+v"(al[1]), "+v"(al[2]), "+v"(al[3]), "+v"(al[4]), "+v"(al[5]), "+v"(al[6]), "+v"(al[7]), "+v"(al[8]), "+v"(al[9]), "+v"(al[10]), "+v"(al[11]), "+v"(al[12]), "+v"(al[13]), "+v"(al[14]), "+v"(al[15]) :: "memory");
#pragma unroll
            for (int it = 0; it < 16; ++it) A[it] = *(const u32x4*)(Vj + ((unsigned)esn[4 * it + r] * 256u + li));
            asm volatile("" ::: "memory");
#pragma unroll
            for (int gg = 0; gg < 4; ++gg) { if (STRIP == 1) { al[gg] += (int)(B[4 * gg].x ^ B[4 * gg + 1].y ^ B[4 * gg + 2].z ^ B[4 * gg + 3].w ^ chc[(4 + gg) * 4 + r]); } else acc_group_i8(ah, al, B, gg, chc[(4 + gg) * 4 + r], clc[(4 + gg) * 4 + r]); }
            asm volatile("" : "+v"(ah[0]), "+v"(ah[1]), "+v"(ah[2]), "+v"(ah[3]), "+v"(ah[4]), "+v"(ah[5]), "+v"(ah[6]), "+v"(ah[7]), "+v"(ah[8]), "+v"(ah[9]), "+v"(ah[10]), "+v"(ah[11]), "+v"(ah[12]), "+v"(ah[13]), "+v"(ah[14]), "+v"(ah[15]) :: "memory");
            asm volatile("" : "+v"(al[0]), "+v"(al[1]), "+v"(al[2]), "+v"(al[3]), "+v"(al[4]), "+v"(al[5]), "+v"(al[6]), "+v"(al[7]), "+v"(al[8]), "+v"(al[9]), "+v"(al[10]), "+v"(al[11]), "+v"(al[12]), "+v"(al[13]), "+v"(al[14]), "+v"(al[15]) :: "memory");
#pragma unroll
            for (int it = 0; it < 16; ++it) B[it] = *(const u32x4*)(Vj + ((unsigned)esn[64 + 4 * it + r] * 256u + li));
            asm volatile("" ::: "memory");
            const float sc = ((const LAS float*)(wl + 1536))[pc];
            float acc[16];
#pragma unroll
            for (int q = 0; q < 16; ++q) { float a = (float)(128 * ah[q] + al[q]); a += __shfl_xor(a, 16); a += __shfl_xor(a, 32); acc[q] = a * sc; }
            if (r == 0) {
                bf16_t* zp = zs + (size_t)t * D_ + 256 * j + 16 * i;
                *(u32x4*)zp = (u32x4){pk2(acc[0], acc[1]), pk2(acc[2], acc[3]), pk2(acc[4], acc[5]), pk2(acc[6], acc[7])};
                *(u32x4*)(zp + 8) = (u32x4){pk2(acc[8], acc[9]), pk2(acc[10], acc[11]), pk2(acc[12], acc[13]), pk2(acc[14], acc[15])};
            }
            asm volatile("" ::: "memory");
        }
    }
}
__device__ __forceinline__ void ln2_phase(const bf16_t* h1b, const bf16_t* zs, float* out, const float* gam, const float* bet, int G, int b) {
    const int tid_ = phase_tid(), lane = tid_ & 63, wid = phase_wid(tid_);
    const int gw = b * NWAVES + wid, NGW = G * NWAVES;
    constexpr int R = 1;
    for (int row0 = gw; row0 < S_; row0 += R * NGW) {
        f32x4 v[R][8]; float sum[R], sq[R];
#pragma unroll
        for (int q = 0; q < R; ++q) {
            const int row = min(row0 + q * NGW, S_ - 1);
            sum[q] = 0.f;
#pragma unroll
            for (int j = 0; j < 8; ++j) {
                const u32x2 hw = *(const u32x2*)(h1b + (size_t)row * D_ + 256 * j + 4 * lane), zw = *(const u32x2*)(zs + (size_t)row * D_ + 256 * j + 4 * lane);
                v[q][j] = (f32x4){DN_ALPHA * bflo(hw.x) + bflo(zw.x), DN_ALPHA * bfhi(hw.x) + bfhi(zw.x), DN_ALPHA * bflo(hw.y) + bflo(zw.y), DN_ALPHA * bfhi(hw.y) + bfhi(zw.y)};
                sum[q] += (v[q][j].x + v[q][j].y) + (v[q][j].z + v[q][j].w);
            }
        }
#pragma unroll
        for (int q = 0; q < R; ++q) sum[q] = wave_sum(sum[q]) * (1.0f / D_);
#pragma unroll
        for (int q = 0; q < R; ++q) { sq[q] = 0.f;
#pragma unroll
            for (int j = 0; j < 8; ++j) { v[q][j] = v[q][j] - sum[q]; sq[q] += (v[q][j].x * v[q][j].x + v[q][j].y * v[q][j].y) + (v[q][j].z * v[q][j].z + v[q][j].w * v[q][j].w); } }
#pragma unroll
        for (int q = 0; q < R; ++q) sq[q] = 1.0f / sqrtf(wave_sum(sq[q]) * (1.0f / D_) + LN_EPS);
#pragma unroll
        for (int j = 0; j < 8; ++j) {
            const f32x4 gg = *(const f32x4*)(gam + 256 * j + 4 * lane), bb = *(const f32x4*)(bet + 256 * j + 4 * lane);
#pragma unroll
            for (int q = 0; q < R; ++q) { const int row = row0 + q * NGW; if (row < S_) *(f32x4*)(out + (size_t)row * D_ + 256 * j + 4 * lane) = v[q][j] * sq[q] * gg + bb; }
        }
    }
}
#ifndef PROBE_PHASE
#define PROBE_PHASE -1
#endif
constexpr int LDSCTL_OFF = 163328, MISC_OFF = LDSCTL_OFF;
constexpr int CW_BAR = 1024;
constexpr size_t CTL_ZERO_BYTES = 64 * 1024;
static_assert((CW_BAR + XCD_BAR_WORDS) * 4 <= (int)CTL_ZERO_BYTES && MISC_OFF + 128 <= LDS_BYTES, "control words");

__global__ void __launch_bounds__(NTHREADS, 2) mega_fwd(Ptrs P) {
    extern __shared__ __attribute__((aligned(16))) unsigned char lds_raw[];
    LAS unsigned char* lds = (LAS unsigned char*)lds_raw;
    unsigned char* ws = P.ws;
    const int G = gridDim.x, b = blockIdx.x;
    for (int u = threadIdx.x; u < (LDS_BYTES - LDSCTL_OFF) / 4; u += NTHREADS) ((LAS unsigned*)(lds + LDSCTL_OFF))[u] = 0u;
    __syncthreads();
    volatile LAS unsigned* MISC = (volatile LAS unsigned*)(lds + MISC_OFF);
    XcdBarrier bar; bar.bar = (unsigned*)(ws + WS_CTL) + CW_BAR; bar.x = xb_xcc_id(); bar.st = MISC + 8;
    if (threadIdx.x == 0) MISC[10] = xb_add(&bar.bar[XB_XCNT(bar.x)], 1u);

    bf16_t* const proj = (bf16_t*)(ws + WS_PROJ); float* const gst = (float*)(ws + WS_GST); bf16_t* const ycat = (bf16_t*)(ws + WS_YCAT);
    const float* const cosT = (const float*)(ws + WS_COS); const float* const sinT = (const float*)(ws + WS_SIN);
    float* const sumA = (float*)(ws + WS_SUMA); float* const sumH = (float*)(ws + WS_SUMH); float* const Hin = (float*)(ws + WS_HIN);
    const bf16_t* const wraT = (const bf16_t*)(ws + WS_WRA_T); const bf16_t* const wriT = (const bf16_t*)(ws + WS_WRI_T);

#define NREP(k) ((PROBE_PHASE == (k)) ? 2 : 1)
    for (int r_ = 0; r_ < NREP(0); ++r_) { prologue_phase(lds, P, G, b); xcd_barrier(bar); }
    if (threadIdx.x == 0) { unsigned xi_ = 0; for (unsigned jx = 0; jx < bar.x; ++jx) xi_ += xb_ld(&bar.bar[XB_XCNT(jx)]) > 0u ? 1u : 0u; MISC[11] = xi_; }
    __syncthreads();
    const int x_nloc = __builtin_amdgcn_readfirstlane((int)MISC[8]), x_nx = __builtin_amdgcn_readfirstlane((int)MISC[9]), x_rank = __builtin_amdgcn_readfirstlane((int)MISC[10]), x_xi = __builtin_amdgcn_readfirstlane((int)MISC[11]);
#define RUN_P1 { pg8::Gemm g{(const pg8::bf16_t*)(ws + WS_XB), (const pg8::bf16_t*)(ws + WS_WIN_T), S_, INC, D_}; \
        pg8::StaticOrder S; S.init(S_, INC, G, b); \
        pg8::EpiBf16<0> E{(pg8::bf16_t*)proj, INC, nullptr, 0, 0, 1.f}; \
        pg8::gemm_phase<pg8::EpiBf16<0>, pg8::StaticOrder, true, true>(lds, g, S, E); \
        xcd_barrier(bar); }
    RUN_P1
#if PROBE_PHASE == 1
    RUN_P1
#endif
    for (int r2_ = 0; r2_ < NREP(22); ++r2_) {
    for (int r_ = 0; r_ < NREP(2); ++r_) { ret_r1_phase(lds, proj, cosT, sinT, gst, G, b); if (PROBE_PHASE >= 0) xcd_barrier(bar); }
    for (int r_ = 0; r_ < NREP(3); ++r_) { lru_phase<0>(lds, proj, P, wraT, wriT, sumA, sumH, Hin, ycat, G, b); xcd_barrier(bar); }
    scan_phase(lds, gst, sumA, sumH, Hin, G, b);
    xcd_barrier(bar);
    }
    for (int r_ = 0; r_ < NREP(4); ++r_) { ret_r3_phase(lds, proj, cosT, sinT, gst, ycat, G, b); if (PROBE_PHASE >= 0) xcd_barrier(bar); }
    for (int r_ = 0; r_ < NREP(5); ++r_) { lru_phase<1>(lds, proj, P, wraT, wriT, sumA, sumH, Hin, ycat, G, b); xcd_barrier(bar); }
#define RUN_P3 { pg8::Gemm g{(const pg8::bf16_t*)ycat, (const pg8::bf16_t*)(ws + WS_WOUT_T), S_, D_, D_}; \
        pg8::StaticOrder S; S.init(S_, D_, G, b); \
        pg8::EpiResBf16 E{(const pg8::bf16_t*)(ws + WS_XB), (pg8::bf16_t*)(ws + WS_Z1B), D_, DN_ALPHA}; \
        pg8::gemm_phase<pg8::EpiResBf16, pg8::StaticOrder, true, true>(lds, g, S, E); \
        xcd_barrier(bar); }
    RUN_P3
#if PROBE_PHASE == 6
    RUN_P3
#endif
    ln1_phase((const bf16_t*)(ws + WS_Z1B), (bf16_t*)(ws + WS_H1B), (unsigned*)(ws + WS_XQ), (float*)(ws + WS_SX), P.ln1_g, P.ln1_b, G, b);
    xcd_barrier(bar);
#if PROBE_PHASE == 67
    ln1_phase((const bf16_t*)(ws + WS_Z1B), (bf16_t*)(ws + WS_H1B), (unsigned*)(ws + WS_XQ), (float*)(ws + WS_SX), P.ln1_g, P.ln1_b, G, b);
    xcd_barrier(bar);
#endif
#if PROBE_PHASE == 66
    RUN_P3
    ln1_phase((const bf16_t*)(ws + WS_Z1B), (bf16_t*)(ws + WS_H1B), (unsigned*)(ws + WS_XQ), (float*)(ws + WS_SX), P.ln1_g, P.ln1_b, G, b);
    xcd_barrier(bar);
#endif
#define RUN_P5 { pg8::Gemm g{(const pg8::bf16_t*)(ws + WS_H1B), (const pg8::bf16_t*)(ws + WS_WPQ_T), S_, D_, D_}; \
        pg8::StaticOrder S; S.init(S_, D_, G, b); \
        pg8::EpiBf16<0> E{(pg8::bf16_t*)(ws + WS_QP), D_, nullptr, 0, 0, 1.f}; \
        pg8::gemm_phase<pg8::EpiBf16<0>, pg8::StaticOrder, true, true>(lds, g, S, E); \
        if (PROBE_PHASE >= 0) xcd_barrier(bar); else { asm volatile("s_waitcnt vmcnt(0)" ::: "memory"); __syncthreads(); } }
    RUN_P5
#if PROBE_PHASE == 7
    RUN_P5
#endif
    for (int r_ = 0; r_ < NREP(8); ++r_) { topk_phase(lds, (const bf16_t*)(ws + WS_QP), (const bf16_t*)(ws + WS_KEYS), (const float*)(ws + WS_SU), (const float*)(ws + WS_SV), (int*)(ws + WS_SELE), (float*)(ws + WS_SELG), (float*)(ws + WS_SELU), G, b); xcd_barrier(bar); }
    for (int r_ = 0; r_ < NREP(9); ++r_) { peer_u_phase(lds, (const unsigned char*)(ws + WS_UQ), (const unsigned char*)(ws + WS_XQ), (const int*)(ws + WS_SELE), (int*)(ws + WS_PD), x_xi, x_nx, x_rank, x_nloc); xcd_barrier(bar); }
    for (int r_ = 0; r_ < NREP(13); ++r_) { peer_coef_phase((const float*)(ws + WS_SELG), (const float*)(ws + WS_SELU), (const int*)(ws + WS_PD), (const float*)(ws + WS_SX), (float*)(ws + WS_COEF), G, b); xcd_barrier(bar); }
    for (int r_ = 0; r_ < NREP(10); ++r_) { peer_v_phase<0>(lds, (const unsigned char*)(ws + WS_VQ), (const int*)(ws + WS_SELE), (const float*)(ws + WS_COEF),
                     (bf16_t*)(ws + WS_ZS), x_xi, x_nx, x_rank, x_nloc); xcd_barrier(bar); }
#if PROBE_PHASE == 12 || PROBE_PHASE == 14
    peer_v_phase<(PROBE_PHASE == 12 ? 1 : 2)>(lds, (const unsigned char*)(ws + WS_VQ), (const int*)(ws + WS_SELE), (const float*)(ws + WS_COEF),
                     (bf16_t*)(ws + 248 * MiB), x_xi, x_nx, x_rank, x_nloc); xcd_barrier(bar);
#endif
#if PROBE_PHASE == 90
    for (int r_ = 0; r_ < 10; ++r_) xcd_barrier(bar);
#endif
    for (int r_ = 0; r_ < NREP(11); ++r_) ln2_phase((const bf16_t*)(ws + WS_H1B), (const bf16_t*)(ws + WS_ZS), P.out, P.ln2_g, P.ln2_b, G, b);
}

extern "C" void kernel_launch(void* const* d_in, const int* in_sizes, int n_in, void* d_out, int out_size, void* d_ws, size_t ws_size, hipStream_t stream) {
    static int grid = 0;
    if (grid == 0) {
        if (n_in != 19 || in_sizes[0] != S_ * D_ || out_size != S_ * D_ || ws_size < WS_END) {
            fprintf(stderr, "kernel_launch: unexpected shapes: n_in %d in0 %d out %d ws %zu (need >= %zu)\n", n_in, n_in > 0 ? in_sizes[0] : -1, out_size, ws_size, (size_t)WS_END); grid = -1; return; }
        int dev = 0, cus = 0, per_cu = 0;
        if (hipGetDevice(&dev) != hipSuccess || hipDeviceGetAttribute(&cus, hipDeviceAttributeMultiprocessorCount, dev) != hipSuccess) { grid = -1; return; }
        if (hipFuncSetAttribute((const void*)mega_fwd, hipFuncAttributeMaxDynamicSharedMemorySize, LDS_BYTES) != hipSuccess) { fprintf(stderr, "kernel_launch: hipFuncSetAttribute failed\n"); grid = -1; return; }
        if (hipOccupancyMaxActiveBlocksPerMultiprocessor(&per_cu, (const void*)mega_fwd, NTHREADS, LDS_BYTES) != hipSuccess || per_cu < 1) {
            fprintf(stderr, "kernel_launch: occupancy query reports %d workgroups per CU; nothing launched\n", per_cu); (void)hipGetLastError(); grid = -1; return; }
        grid = cus;
    }
    if (grid < 0) return;
    Ptrs P{};
    P.x = (const float*)d_in[0]; P.pos = (const int*)d_in[1]; P.w_in = (const float*)d_in[2]; P.w_out = (const float*)d_in[3]; P.conv_w = (const float*)d_in[4]; P.conv_b = (const float*)d_in[5];
    P.w_ra = (const float*)d_in[6]; P.b_ra = (const float*)d_in[7]; P.w_ri = (const float*)d_in[8]; P.b_ri = (const float*)d_in[9]; P.lam = (const float*)d_in[10];
    P.ln1_g = (const float*)d_in[11]; P.ln1_b = (const float*)d_in[12]; P.w_pq = (const float*)d_in[13]; P.sub_keys = (const float*)d_in[14]; P.peer_u = (const float*)d_in[15]; P.peer_v = (const float*)d_in[16];
    P.ln2_g = (const float*)d_in[17]; P.ln2_b = (const float*)d_in[18]; P.out = (float*)d_out; P.ws = (unsigned char*)d_ws;
    if (hipMemsetAsync((char*)d_ws + WS_CTL, 0, CTL_ZERO_BYTES, stream) != hipSuccess) { fprintf(stderr, "kernel_launch: hipMemsetAsync failed\n"); return; }
    void* args[] = {&P};
    const hipError_t e = hipLaunchCooperativeKernel((const void*)mega_fwd, dim3(grid), dim3(NTHREADS), args, LDS_BYTES, stream);
    if (e != hipSuccess) fprintf(stderr, "kernel_launch: cooperative launch failed: %s (grid %d)\n", hipGetErrorString(e), grid);
}
```

```cpp
#include <hip/hip_runtime.h>
#include <cstdio>
#include <cstdint>
#include <cmath>

namespace pg8 {
#define PG8_LAS __attribute__((address_space(3)))
typedef unsigned short bf16_t;
typedef short bf16x8 __attribute__((ext_vector_type(8)));
typedef float f32x4 __attribute__((ext_vector_type(4)));
typedef unsigned u32x4 __attribute__((ext_vector_type(4)));
constexpr int BM = 256, BK = 64, HALF = 128, HTB = HALF * BK * 2  , STAGE_BYTES = 8 * HTB, NXCD = 8, WGM = 8;

__host__ __device__ __forceinline__ int lds_byte(int r, int c) { const int st = (r >> 4) * 2 + (c >> 5), rr = r & 15, cc = c & 31, ob = rr * 64 + cc * 2; return st * 1024 + (ob ^ (((ob >> 9) & 1) << 5)); }
__host__ __device__ __forceinline__ void stage_rc(int b, int& R, int& C) { const int st = b / 1024, sb = b % 1024, swz = sb ^ (((sb >> 9) & 1) << 5); R = (st >> 1) * 16 + swz / 64; C = (st & 1) * 32 + (swz % 64) / 2; }
__host__ __device__ __forceinline__ int perm32(int rho) { const int n = rho >> 4, i = rho & 15; return 8 * (i >> 2) + 4 * n + (i & 3); }

struct Unit { int pm, pn; };
struct Gemm { const bf16_t* A; const bf16_t* Bt; int M, N, K; };

struct StaticOrder {
    int nM, nN, nwg, G, c;
    __host__ __device__ void init(int M, int N, int G_, int c_) { nM = M / BM; nN = N / BM; nwg = nM * nN; G = G_; c = c_; }
    __host__ __device__ bool next(int i, Unit& u) const {
        const long L = (long)i * G + c; if (L >= nwg) return false;
        int wgid = (int)L; { const int q = nwg / NXCD, r = nwg % NXCD, xcd = wgid % NXCD, off = wgid / NXCD; wgid = (xcd < r ? xcd * (q + 1) : r * (q + 1) + (xcd - r) * q) + off; }
        const int nig = WGM * nN, gid = wgid / nig, fm = gid * WGM, gsz = (nM - fm) < WGM ? (nM - fm) : WGM;
        u.pm = fm + ((wgid % nig) % gsz); u.pn = (wgid % nig) / gsz; return true;
    }
    __device__ __forceinline__ void a_ready(const Unit&) const {}
    __device__ __forceinline__ void done(const Unit&) const {}
};

__device__ __forceinline__ unsigned cvt_pk_bf16(float lo, float hi) { unsigned r; asm volatile("v_cvt_pk_bf16_f32 %0, %1, %2" : "=v"(r) : "v"(lo), "v"(hi)); return r; }
typedef float f32x2 __attribute__((ext_vector_type(2)));
__device__ __forceinline__ f32x2 gelu_pk(f32x2 v) {
    const f32x2 av = __builtin_elementwise_abs(v), d = av * 0.2316418882f + 1.0f;
    f32x2 t; t.x = __builtin_amdgcn_rcpf(d.x); t.y = __builtin_amdgcn_rcpf(d.y);
    f32x2 q = t * 0.5307027145f + (-0.7265760135f); q = q * t + 0.7107068705f; q = q * t + (-0.142248368f); q = q * t + 0.127414796f; q = q * t;
    const f32x2 s = (v * v) * (-0.72134752044f);
    f32x2 e; e.x = __builtin_amdgcn_exp2f(s.x); e.y = __builtin_amdgcn_exp2f(s.y);
    const f32x2 m = v * (q * e), r = v - m;
    f32x2 o; o.x = v.x < 0.f ? m.x : r.x; o.y = v.y < 0.f ? m.y : r.y; return o;
}

template <int ACT  > struct EpiBf16 {
    static constexpr bool PERM = true, AFTER_DRAIN = false; static_assert(ACT == 0 || ACT == 1, "EpiBf16: ACT is 0 (none) or 1 (gelu_pk)");
    bf16_t* O; int ldc; const float* bias; int split_cols; size_t split_stride; float scale0;
    __device__ __forceinline__ void operator()(const f32x4 (&acc)[2][2][4][2], const Unit& u, int wr, int wc, int fr, int fq) const {
        const int row0 = u.pm * BM + wr * 64 + fr; int colt = u.pn * BM; bf16_t* base = O;
        float sc = 1.f; if (split_cols) { const int t = colt / split_cols; base += (size_t)t * split_stride; colt -= t * split_cols; if (t == 0) sc = scale0; }
        const int col0 = colt + wc * 32 + 8 * fq, bcol0 = u.pn * BM + wc * 32 + 8 * fq;
        f32x4 bv[2][2];
#pragma unroll
        for (int bj = 0; bj < 2; ++bj)
#pragma unroll
            for (int n = 0; n < 2; ++n) bv[bj][n] = bias ? *(const f32x4*)(bias + bcol0 + bj * HALF + 4 * n) : (f32x4){0.f, 0.f, 0.f, 0.f};
#pragma unroll
        for (int ai = 0; ai < 2; ++ai)
#pragma unroll
            for (int m = 0; m < 4; ++m) { bf16_t* rowp = base + (size_t)(row0 + ai * HALF + m * 16) * ldc + col0;
#pragma unroll
                for (int bj = 0; bj < 2; ++bj) { f32x4 v0 = acc[ai][bj][m][0] + bv[bj][0], v1 = acc[ai][bj][m][1] + bv[bj][1];
                    if (ACT == 1) { f32x2 a = gelu_pk((f32x2){v0[0], v0[1]}), b = gelu_pk((f32x2){v0[2], v0[3]}), c = gelu_pk((f32x2){v1[0], v1[1]}), d = gelu_pk((f32x2){v1[2], v1[3]});
                        v0 = (f32x4){a.x, a.y, b.x, b.y}; v1 = (f32x4){c.x, c.y, d.x, d.y}; }
                    v0 = v0 * sc; v1 = v1 * sc; u32x4 w; w.x = cvt_pk_bf16(v0[0], v0[1]); w.y = cvt_pk_bf16(v0[2], v0[3]); w.z = cvt_pk_bf16(v1[0], v1[1]); w.w = cvt_pk_bf16(v1[2], v1[3]);
                    *(u32x4*)(rowp + bj * HALF) = w; } }
    }
};
struct EpiResF32 {
    static constexpr bool PERM = false, AFTER_DRAIN = false;
    const float* base; float* out; int ldc; float alpha;
    __device__ __forceinline__ void operator()(const f32x4 (&acc)[2][2][4][2], const Unit& u, int wr, int wc, int fr, int fq) const {
        const int row0 = u.pm * BM + wr * 64 + fr, col0 = u.pn * BM + wc * 32 + 4 * fq;
#pragma unroll
        for (int ai = 0; ai < 2; ++ai)
#pragma unroll
            for (int m = 0; m < 4; ++m) { const size_t off = (size_t)(row0 + ai * HALF + m * 16) * ldc + col0;
#pragma unroll
                for (int bj = 0; bj < 2; ++bj)
#pragma unroll
                    for (int n = 0; n < 2; ++n) { const f32x4 bs = *(const f32x4*)(base + off + bj * HALF + n * 16); *(f32x4*)(out + off + bj * HALF + n * 16) = bs * alpha + acc[ai][bj][m][n]; }
                asm volatile("" ::: "memory"); }
    }
};

struct EpiResBf16 {
    static constexpr bool PERM = true, AFTER_DRAIN = false;
    const bf16_t* base; bf16_t* O; int ldc; float alpha;
    __device__ __forceinline__ void operator()(const f32x4 (&acc)[2][2][4][2], const Unit& u, int wr, int wc, int fr, int fq) const {
        const int row0 = u.pm * BM + wr * 64 + fr, col0 = u.pn * BM + wc * 32 + 8 * fq;
#pragma unroll
        for (int ai = 0; ai < 2; ++ai)
#pragma unroll
            for (int m = 0; m < 4; ++m) { const size_t off = (size_t)(row0 + ai * HALF + m * 16) * ldc + col0;
#pragma unroll
                for (int bj = 0; bj < 2; ++bj) {
                    const u32x4 bw = *(const u32x4*)(base + off + bj * HALF);
                    const f32x4 b0 = (f32x4){__uint_as_float(bw.x << 16), __uint_as_float(bw.x & 0xffff0000u), __uint_as_float(bw.y << 16), __uint_as_float(bw.y & 0xffff0000u)};
                    const f32x4 b1 = (f32x4){__uint_as_float(bw.z << 16), __uint_as_float(bw.z & 0xffff0000u), __uint_as_float(bw.w << 16), __uint_as_float(bw.w & 0xffff0000u)};
                    const f32x4 v0 = b0 * alpha + acc[ai][bj][m][0], v1 = b1 * alpha + acc[ai][bj][m][1];
                    u32x4 w; w.x = cvt_pk_bf16(v0[0], v0[1]); w.y = cvt_pk_bf16(v0[2], v0[3]); w.z = cvt_pk_bf16(v1[0], v1[1]); w.w = cvt_pk_bf16(v1[2], v1[3]);
                    *(u32x4*)(O + off + bj * HALF) = w; }
                asm volatile("" ::: "memory"); }
    }
};
template <class Epi, class Sched, bool ALIGN_EPI = false, bool SP2 = false>
__device__ __forceinline__ void gemm_phase(PG8_LAS unsigned char* lds, const Gemm g, const Sched& S, const Epi& E) {
    const int tid = threadIdx.x, wid = __builtin_amdgcn_readfirstlane(tid >> 6), lane = tid & 63, wr = wid >> 2, wc = wid & 3, fr = lane & 15, fq = lane >> 4;
    const int K = g.K, nt = K / BK;
    unsigned voffA[2], voffB[2];
#pragma unroll
    for (int i = 0; i < 2; ++i) { int R, C; stage_rc(tid * 16 + i * 8192, R, C); const int Rb = Epi::PERM ? ((R & ~31) + perm32(R & 31)) : R;
        voffA[i] = (unsigned)(R * K + C) * 2u; voffB[i] = (unsigned)(Rb * K + C) * 2u; }
    const size_t kstep = (size_t)(BK * 2);
    const size_t hstep = (size_t)HALF * K * 2;
    const size_t tstep = 2 * hstep;
    const unsigned ldsw = (unsigned)wid * 1024u;
    const int aoff = lds_byte(wr * 64 + fr, fq * 8), boff = lds_byte(wc * 32 + fr, fq * 8);
#define PG8_SA(b, h) (((b) * 2 + (h)) * HTB)
#define PG8_SB(b, h) ((4 + (b) * 2 + (h)) * HTB)
#define PG8_STAGE(bufoff, gbase, voff) do { _Pragma("unroll") for (int _i = 0; _i < 2; ++_i) \
        __builtin_amdgcn_global_load_lds((const unsigned*)((const char*)(gbase) + (voff)[_i]), (PG8_LAS unsigned*)(lds + (bufoff) + ldsw + _i * 8192), 16, 0, 0); } while (0)
#define PG8_LDA(dst, b, h) do { _Pragma("unroll") for (int m = 0; m < 4; ++m) _Pragma("unroll") for (int k = 0; k < 2; ++k) dst[m][k] = *(const PG8_LAS bf16x8*)(lds + PG8_SA(b, h) + aoff + m * 2048 + k * 1024); } while (0)
#define PG8_LDB(dst, b, h) do { _Pragma("unroll") for (int n = 0; n < 2; ++n) _Pragma("unroll") for (int k = 0; k < 2; ++k) dst[n][k] = *(const PG8_LAS bf16x8*)(lds + PG8_SB(b, h) + boff + n * 2048 + k * 1024); } while (0)
#define PG8_MMA(ai, bj, At, Bt) do { __builtin_amdgcn_s_setprio(1); _Pragma("unroll") for (int m = 0; m < 4; ++m) _Pragma("unroll") for (int n = 0; n < 2; ++n) _Pragma("unroll") for (int k = 0; k < 2; ++k) \
        acc[ai][bj][m][n] = __builtin_amdgcn_mfma_f32_16x16x32_bf16(Bt[n][k], At[m][k], acc[ai][bj][m][n], 0, 0, 0); __builtin_amdgcn_s_setprio(0); } while (0)
#define PG8_WAIT_V(n) asm volatile("s_waitcnt vmcnt(" #n ")" ::: "memory")
#define PG8_WAIT_L(n) asm volatile("s_waitcnt lgkmcnt(" #n ")" ::: "memory")
#define PG8_BAR __builtin_amdgcn_s_barrier()
#define PG8_SCHED __builtin_amdgcn_sched_barrier(0)
    Unit cur, nxt; int ui = 0;
    if (!S.next(0, cur)) return;
    f32x4 acc[2][2][4][2];
#pragma unroll
    for (int a = 0; a < 2; ++a)
#pragma unroll
        for (int b = 0; b < 2; ++b)
#pragma unroll
            for (int m = 0; m < 4; ++m)
#pragma unroll
                for (int n = 0; n < 2; ++n) acc[a][b][m][n] = (f32x4){0.f, 0.f, 0.f, 0.f};
    bf16x8 At[4][2], B0[2][2], B1[2][2];
    const char* cA = (const char*)g.A + (size_t)cur.pm * tstep; const char* cB = (const char*)g.Bt + (size_t)cur.pn * tstep;
    S.a_ready(cur);
    if constexpr (SP2) {
        PG8_STAGE(PG8_SB(0, 0), cB, voffB); PG8_STAGE(PG8_SB(0, 1), cB + hstep, voffB); PG8_STAGE(PG8_SA(0, 0), cA, voffA); PG8_STAGE(PG8_SA(0, 1), cA + hstep, voffA);
        if (wr == 1) PG8_BAR;
        PG8_WAIT_V(2); PG8_BAR;
        PG8_STAGE(PG8_SB(1, 0), cB + kstep, voffB); PG8_STAGE(PG8_SA(1, 0), cA + kstep, voffA); PG8_STAGE(PG8_SB(1, 1), cB + hstep + kstep, voffB);
        PG8_WAIT_V(6); PG8_BAR;
    } else {
        PG8_STAGE(PG8_SB(0, 0), cB, voffB); PG8_STAGE(PG8_SA(0, 0), cA, voffA); PG8_STAGE(PG8_SB(0, 1), cB + hstep, voffB); PG8_STAGE(PG8_SA(0, 1), cA + hstep, voffA);
        if (wr == 1) PG8_BAR;
        PG8_WAIT_V(4); PG8_BAR;
        PG8_STAGE(PG8_SB(1, 0), cB + kstep, voffB); PG8_STAGE(PG8_SA(1, 0), cA + kstep, voffA); PG8_STAGE(PG8_SB(1, 1), cB + hstep + kstep, voffB);
        PG8_WAIT_V(6); PG8_BAR;
    }
    for (;;) {
        const bool has_next = S.next(ui + 1, nxt);
        const char* nA = has_next ? (const char*)g.A + (size_t)nxt.pm * tstep : cA; const char* nB = has_next ? (const char*)g.Bt + (size_t)nxt.pn * tstep : cB;
        for (int t = 0; t < nt; t += 2) {
            const bool last = (t == nt - 2);
            const char* a1 = cA + (size_t)(t + 1) * kstep;
            const char* a2 = last ? nA : cA + (size_t)(t + 2) * kstep; const char* b2 = last ? nB : cB + (size_t)(t + 2) * kstep;
            const char* a3 = a2 + kstep; const char* b3 = b2 + kstep;
            if (last && has_next) S.a_ready(nxt);
            if constexpr (SP2) {
            PG8_LDB(B0, 0, 0); PG8_LDB(B1, 0, 1); PG8_SCHED; PG8_LDA(At, 0, 0); PG8_STAGE(PG8_SA(1, 1), a1 + hstep, voffA);
            PG8_WAIT_V(8); PG8_WAIT_L(0); PG8_BAR; PG8_MMA(0, 0, At, B0); PG8_MMA(0, 1, At, B1); PG8_BAR; PG8_SCHED;
            PG8_LDA(At, 0, 1); PG8_STAGE(PG8_SB(0, 0), b2, voffB); PG8_STAGE(PG8_SB(0, 1), b2 + hstep, voffB); PG8_STAGE(PG8_SA(0, 0), a2, voffA);
            PG8_WAIT_V(8); PG8_WAIT_L(0); PG8_BAR; PG8_MMA(1, 0, At, B0); PG8_MMA(1, 1, At, B1); PG8_BAR; PG8_SCHED;
            PG8_LDB(B0, 1, 0); PG8_LDB(B1, 1, 1); PG8_SCHED; PG8_LDA(At, 1, 0); PG8_STAGE(PG8_SA(0, 1), a2 + hstep, voffA);
            PG8_WAIT_V(8); PG8_WAIT_L(0); PG8_BAR; PG8_MMA(0, 0, At, B0); PG8_MMA(0, 1, At, B1); PG8_BAR; PG8_SCHED;
            PG8_LDA(At, 1, 1); PG8_STAGE(PG8_SB(1, 0), b3, voffB); PG8_STAGE(PG8_SB(1, 1), b3 + hstep, voffB); PG8_STAGE(PG8_SA(1, 0), a3, voffA);
            PG8_WAIT_V(8); PG8_WAIT_L(0); PG8_BAR; PG8_MMA(1, 0, At, B0); PG8_MMA(1, 1, At, B1); PG8_BAR; PG8_SCHED;
            } else {
            PG8_LDB(B0, 0, 0); PG8_SCHED; PG8_LDA(At, 0, 0); PG8_STAGE(PG8_SA(1, 1), a1 + hstep, voffA);
            PG8_WAIT_L(8); PG8_BAR; PG8_WAIT_L(0); PG8_MMA(0, 0, At, B0); PG8_BAR; PG8_SCHED;
            PG8_LDB(B1, 0, 1); PG8_STAGE(PG8_SB(0, 0), b2, voffB);
            PG8_BAR; PG8_WAIT_L(0); PG8_MMA(0, 1, At, B1); PG8_BAR;
            PG8_LDA(At, 0, 1); PG8_STAGE(PG8_SA(0, 0), a2, voffA);
            PG8_BAR; PG8_WAIT_L(0); PG8_MMA(1, 0, At, B0); PG8_BAR; PG8_SCHED;
            PG8_STAGE(PG8_SB(0, 1), b2 + hstep, voffB);
            PG8_WAIT_V(6); PG8_BAR; PG8_MMA(1, 1, At, B1); PG8_BAR;
            PG8_LDB(B0, 1, 0); PG8_SCHED; PG8_LDA(At, 1, 0); PG8_STAGE(PG8_SA(0, 1), a2 + hstep, voffA);
            PG8_WAIT_L(8); PG8_BAR; PG8_WAIT_L(0); PG8_MMA(0, 0, At, B0); PG8_BAR; PG8_SCHED;
            PG8_LDB(B1, 1, 1); PG8_STAGE(PG8_SB(1, 0), b3, voffB);
            PG8_BAR; PG8_WAIT_L(0); PG8_MMA(0, 1, At, B1); PG8_BAR;
            PG8_LDA(At, 1, 1); PG8_STAGE(PG8_SA(1, 0), a3, voffA);
            PG8_BAR; PG8_WAIT_L(0); PG8_MMA(1, 0, At, B0); PG8_BAR; PG8_SCHED;
            PG8_STAGE(PG8_SB(1, 1), b3 + hstep, voffB);
            PG8_WAIT_V(6); PG8_BAR; PG8_MMA(1, 1, At, B1); PG8_BAR;
            }
        }
        if constexpr (ALIGN_EPI) { if (wr == 0) PG8_BAR; }
        if constexpr (!Epi::AFTER_DRAIN) { E(acc, cur, wr, wc, fr, fq); S.done(cur); }
        if (!has_next) break;
#pragma unroll
        for (int a = 0; a < 2; ++a)
#pragma unroll
            for (int b = 0; b < 2; ++b)
#pragma unroll
                for (int m = 0; m < 4; ++m)
#pragma unroll
                    for (int n = 0; n < 2; ++n) acc[a][b][m][n] = (f32x4){0.f, 0.f, 0.f, 0.f};
        cur = nxt; cA = nA; cB = nB; ++ui;
        if constexpr (ALIGN_EPI) { if (wr == 1) PG8_BAR; }
    }
    PG8_WAIT_V(0);
    if constexpr (!ALIGN_EPI) { if (wr == 0) PG8_BAR; }
    PG8_BAR;
    if constexpr (Epi::AFTER_DRAIN) { E.fused(acc, cur, wr, wc, fr, fq, lds, wid, lane); S.done(cur); }
#undef PG8_SA
#undef PG8_SB
#undef PG8_STAGE
#undef PG8_LDA
#undef PG8_LDB
#undef PG8_MMA
#undef PG8_WAIT_V
#undef PG8_WAIT_L
#undef PG8_BAR
#undef PG8_SCHED
}
}
constexpr int S_ = 16384, D_ = 2048, INC = 6144, NH = 8, DH = 128, CH = 64, NCH = 256;
constexpr float DN_ALPHA = 1.189207115002721f;
constexpr float LN_EPS = 1e-5f, GN_EPS = 1e-6f;
constexpr int NWAVES = 8, NTHREADS = 512;
constexpr int LDS_BYTES = 163840;

constexpr size_t MiB = 1u << 20;
constexpr size_t WS_CTL = 0;
constexpr size_t WS_WOUT_T = 1 * MiB, WS_WPQ_T = 9 * MiB, WS_KEYS = 17 * MiB, WS_WRA_T = 17 * MiB + 512 * 1024, WS_WRI_T = 17 * MiB + 768 * 1024;
constexpr size_t WS_COS = 18 * MiB, WS_SIN = 22 * MiB, WS_SUMA = 26 * MiB, WS_SUMH = 27 * MiB, WS_HIN = 28 * MiB;
constexpr size_t WS_SU = 29 * MiB, WS_SV = 30 * MiB;
constexpr size_t WS_SX = 31 * MiB;
constexpr size_t WS_UQ = 32 * MiB, WS_VQ = 64 * MiB;
constexpr size_t WS_XQ = 96 * MiB;
constexpr size_t WS_PD = 328 * MiB, WS_ZS = 392 * MiB;
constexpr size_t WS_WIN_T = 160 * MiB, WS_XB = 184 * MiB, WS_GST = 160 * MiB, WS_H1B = 184 * MiB;
constexpr size_t WS_PROJ = 248 * MiB, WS_QP = 248 * MiB, WS_SELE = 312 * MiB, WS_SELG = 320 * MiB, WS_SELU = 456 * MiB, WS_COEF = 464 * MiB;
constexpr size_t WS_Z1B = 376 * MiB;
constexpr size_t WS_YCAT = 440 * MiB, WS_END = 504 * MiB;

#define LAS __attribute__((address_space(3)))
typedef unsigned short bf16_t;
typedef short bf16x8 __attribute__((ext_vector_type(8)));
typedef float f32x4 __attribute__((ext_vector_type(4)));
typedef unsigned u32x4 __attribute__((ext_vector_type(4)));
typedef unsigned u32x2 __attribute__((ext_vector_type(2)));

__device__ __forceinline__ unsigned f2bf(float f) { unsigned u = __float_as_uint(f); return (u + 0x7fffu + ((u >> 16) & 1u)) >> 16; }
__device__ __forceinline__ unsigned pk2(float lo, float hi) { return f2bf(lo) | (f2bf(hi) << 16); }
__device__ __forceinline__ float bflo(unsigned w) { return __uint_as_float(w << 16); }
__device__ __forceinline__ float bfhi(unsigned w) { return __uint_as_float(w & 0xffff0000u); }
__device__ __forceinline__ float bf2f(bf16_t b) { return __uint_as_float(((unsigned)b) << 16); }
__device__ __forceinline__ f32x4 mfma16(bf16x8 a, bf16x8 b, f32x4 c) { return __builtin_amdgcn_mfma_f32_16x16x32_bf16(a, b, c, 0, 0, 0); }
__device__ __forceinline__ float fexp_(float x) { return __builtin_amdgcn_exp2f(x * 1.4426950408889634f); }
__device__ __forceinline__ float sigmoidf_(float x) { return __builtin_amdgcn_rcpf(1.0f + fexp_(-x)); }
__device__ __forceinline__ float gelu_tanh(float x) { const float y = 0.7978845608028654f * (x + 0.044715f * x * x * x); return x * __builtin_amdgcn_rcpf(1.0f + fexp_(-2.0f * y)); }
__device__ __forceinline__ float wave_sum(float v) {
#pragma unroll
    for (int o = 1; o < 64; o <<= 1) v += __shfl_xor(v, o);
    return v;
}
__device__ __forceinline__ float wave_max(float v) {
#pragma unroll
    for (int o = 1; o < 64; o <<= 1) v = fmaxf(v, __shfl_xor(v, o));
    return v;
}
__device__ __forceinline__ int wave_sum_i(int v) {
#pragma unroll
    for (int o = 1; o < 64; o <<= 1) v += __shfl_xor(v, o);
    return v;
}
__device__ __forceinline__ int phase_tid() { int t = (int)threadIdx.x; asm volatile("" : "+v"(t)); return t; }
__device__ __forceinline__ int phase_wid(int tid) { return __builtin_amdgcn_readfirstlane(tid >> 6); }
__device__ __forceinline__ float head_log_gamma(int h) { return logf(1.0f - exp2f(-5.0f - (float)h)); }

__device__ __forceinline__ void transpose_item(const float* W, int K, int N, bf16_t* WT, LAS float* scr, int item, int lane) {
    const int nblk = N / 32, kb = item / nblk, nb = item % nblk, k0 = 64 * kb, n0 = 32 * nb;
    float tv[32];
#pragma unroll
    for (int i = 0; i < 32; ++i) { const int kk = 2 * i + (lane >> 5); tv[i] = W[(size_t)(k0 + kk) * N + n0 + (lane & 31)]; }
#pragma unroll
    for (int i = 0; i < 32; ++i) { const int kk = 2 * i + (lane >> 5); scr[kk * 33 + (lane & 31)] = tv[i]; }
    asm volatile("s_waitcnt lgkmcnt(0)" ::: "memory");
    const int c = lane & 7;
#pragma unroll
    for (int j = 0; j < 4; ++j) { const int n = (lane >> 3) + 8 * j; const LAS float* s = scr + (8 * c) * 33 + n;
        u32x4 o; o.x = pk2(s[0 * 33], s[1 * 33]); o.y = pk2(s[2 * 33], s[3 * 33]); o.z = pk2(s[4 * 33], s[5 * 33]); o.w = pk2(s[6 * 33], s[7 * 33]);
        *(u32x4*)(WT + (size_t)(n0 + n) * K + k0 + 8 * c) = o; }
    asm volatile("s_waitcnt lgkmcnt(0)" ::: "memory");
}
__device__ __forceinline__ void cvt_stream(const float* src, bf16_t* dst, size_t n8, size_t gtid, size_t gthreads) {
    size_t i = gtid;
    for (; i + 3 * gthreads < n8; i += 4 * gthreads) {
        f32x4 a[4], b[4];
#pragma unroll
        for (int u = 0; u < 4; ++u) { a[u] = __builtin_nontemporal_load((const f32x4*)src + 2 * (i + u * gthreads)); b[u] = __builtin_nontemporal_load((const f32x4*)src + 2 * (i + u * gthreads) + 1); }
#pragma unroll
        for (int u = 0; u < 4; ++u) { u32x4 o; o.x = pk2(a[u].x, a[u].y); o.y = pk2(a[u].z, a[u].w); o.z = pk2(b[u].x, b[u].y); o.w = pk2(b[u].z, b[u].w); ((u32x4*)dst)[i + u * gthreads] = o; }
    }
    for (; i < n8; i += gthreads) {
        const f32x4 a = ((const f32x4*)src)[2 * i], b = ((const f32x4*)src)[2 * i + 1];
        u32x4 o; o.x = pk2(a.x, a.y); o.y = pk2(a.z, a.w); o.z = pk2(b.x, b.y); o.w = pk2(b.z, b.w);
        ((u32x4*)dst)[i] = o;
    }
}
struct QRow { f32x4 v[8]; };
__device__ __forceinline__ void quant_issue(QRow& q, const float* table, int e, int lane) {
    const float* rp = table + (size_t)e * D_;
#pragma unroll
    for (int j = 0; j < 8; ++j) q.v[j] = __builtin_nontemporal_load((const f32x4*)(rp + 256 * j + 4 * lane));
}
template <int ISV>
__device__ __forceinline__ void quant_finish(const QRow& q, unsigned char* qtab, float* scales, int e, int lane) {
    float amax = 0.f;
#pragma unroll
    for (int j = 0; j < 8; ++j) amax = fmaxf(amax, fmaxf(fmaxf(fabsf(q.v[j].x), fabsf(q.v[j].y)), fmaxf(fabsf(q.v[j].z), fabsf(q.v[j].w))));
    amax = wave_max(amax);
    unsigned* qp = (unsigned*)qtab + (size_t)e * 64;
    {
        const float inv = amax > 0.f ? 127.0f / amax : 0.f;
        if (lane == 0) scales[e] = amax * (1.0f / 127.0f);
#pragma unroll
        for (int j = 0; j < 8; ++j) {
            const int a = (int)rintf(q.v[j].x * inv), bq = (int)rintf(q.v[j].y * inv), c = (int)rintf(q.v[j].z * inv), d = (int)rintf(q.v[j].w * inv);
            qp[(size_t)j * 16384 * 64 + lane] = (unsigned)(a & 255) | ((unsigned)(bq & 255) << 8) | ((unsigned)(c & 255) << 16) | ((unsigned)(d & 255) << 24);
        }
    }
}
struct Ptrs {
    const float *x; const int* pos; const float *w_in, *w_out, *conv_w, *conv_b, *w_ra, *b_ra, *w_ri, *b_ri, *lam, *ln1_g, *ln1_b, *w_pq, *sub_keys, *peer_u, *peer_v, *ln2_g, *ln2_b;
    float* out; unsigned char* ws;
};
__device__ __forceinline__ void prologue_phase(LAS unsigned char* lds, const Ptrs& P, int G, int b) {
    const int tid = phase_tid(), lane = tid & 63, wid = phase_wid(tid);
    LAS float* scr = (LAS float*)(lds + wid * 16384);
    const int gw = b * NWAVES + wid, NGW = G * NWAVES;
    unsigned char* ws = P.ws;
    constexpr int I_IN = (D_ / 64) * (INC / 32), I_SQ = (D_ / 64) * (D_ / 32), I_G = 2 * 4;
    constexpr int NITEMS = I_IN + 2 * I_SQ + 16 * I_G;
    for (int it = gw; it < NITEMS; it += NGW) {
        int r = it;
        if (r < I_IN) { transpose_item(P.w_in, D_, INC, (bf16_t*)(ws + WS_WIN_T), scr, r, lane); continue; } r -= I_IN;
        if (r < I_SQ) { transpose_item(P.w_out, D_, D_, (bf16_t*)(ws + WS_WOUT_T), scr, r, lane); continue; } r -= I_SQ;
        if (r < I_SQ) { transpose_item(P.w_pq, D_, D_, (bf16_t*)(ws + WS_WPQ_T), scr, r, lane); continue; } r -= I_SQ;
        if (r < 8 * I_G) { const int g = r / I_G; transpose_item(P.w_ra + g * 16384, 128, 128, (bf16_t*)(ws + WS_WRA_T) + g * 16384, scr, r % I_G, lane); continue; } r -= 8 * I_G;
        { const int g = r / I_G; transpose_item(P.w_ri + g * 16384, 128, 128, (bf16_t*)(ws + WS_WRI_T) + g * 16384, scr, r % I_G, lane); }
    }
    const size_t gtid = (size_t)b * NTHREADS + tid, gth = (size_t)G * NTHREADS;
    cvt_stream(P.x, (bf16_t*)(ws + WS_XB), (size_t)S_ * D_ / 8, gtid, gth);
    cvt_stream(P.sub_keys, (bf16_t*)(ws + WS_KEYS), (size_t)8 * 2 * 128 * 128 / 8, gtid, gth);
    float* cosT = (float*)(ws + WS_COS); float* sinT = (float*)(ws + WS_SIN);
    for (size_t i = gtid; i < (size_t)S_ * 64; i += gth) {
        const int s = (int)(i >> 6), f = (int)(i & 63);
        const float inv = powf(10000.0f, -(float)f / 64.0f);
        const float ang = (float)P.pos[s] * inv;
        float sn, cs; sincosf(ang, &sn, &cs);
        cosT[i] = cs; sinT[i] = sn;
    }
}
#define XB_TMO      128
#define XB_XCNT(j)  (256  + 64 * (j))
#define XB_XSUB(j)  (1280 + 64 * (j))
#define XB_XGEN(j)  (2304 + 64 * (j))
#define XB_TOP      3328
#define XB_TOPGEN   3392
#define XCD_BAR_WORDS 3456
#define XB_SPIN_CAP (1u << 18)

__device__ __forceinline__ unsigned xb_ld(unsigned* p)              { return __hip_atomic_load(p, __ATOMIC_RELAXED, __HIP_MEMORY_SCOPE_AGENT); }
__device__ __forceinline__ unsigned xb_add(unsigned* p, unsigned v) { return __hip_atomic_fetch_add(p, v, __ATOMIC_RELAXED, __HIP_MEMORY_SCOPE_AGENT); }
__device__ __forceinline__ unsigned xb_xcc_id() { return (unsigned)__builtin_amdgcn_s_getreg((3 << 11) | 20) & 0xFu; }
#define XB_SPIN(cond, bar) do { unsigned _sp = 0; while (cond) { __builtin_amdgcn_s_sleep(1); \
    if ((++_sp & 255u) == 0u) { if (xb_ld(&(bar)[XB_TMO])) break; if (_sp > XB_SPIN_CAP) { atomicAdd(&(bar)[XB_TMO], 1u); break; } } } } while (0)

struct XcdBarrier {
    unsigned* bar; unsigned x;
    volatile LAS unsigned* st;
};

__device__ __forceinline__ XcdBarrier xcd_barrier_post(unsigned* bar, volatile LAS unsigned* st) {
    XcdBarrier b; b.bar = bar; b.x = xb_xcc_id(); b.st = st;
    if (threadIdx.x == 0) (void)xb_add(&bar[XB_XCNT(b.x)], 1u);
    return b;
}
__device__ __forceinline__ void xcd_barrier_complete(unsigned* bar, unsigned x, unsigned& nloc, unsigned& nx) {
    const unsigned G = gridDim.x * gridDim.y * gridDim.z;
    unsigned sum, cnt, mine, sp = 0u;
    for (;;) {
        sum = 0u; cnt = 0u; mine = 0u;
#pragma unroll
        for (unsigned j = 0; j < 16; ++j) { const unsigned c = xb_ld(&bar[XB_XCNT(j)]); sum += c; cnt += (c > 0u) ? 1u : 0u; mine = (j == x) ? c : mine; }
        if (sum == G) break;
        __builtin_amdgcn_s_sleep(1);
        if ((++sp & 255u) == 0u) { if (xb_ld(&bar[XB_TMO])) break; if (sp > XB_SPIN_CAP) { atomicAdd(&bar[XB_TMO], 1u); break; } }
    }
    nloc = mine > 0u ? mine : 1u; nx = cnt > 0u ? cnt : 1u;
}

__device__ __forceinline__ void xcd_barrier(const XcdBarrier& b) {
    asm volatile("s_waitcnt vmcnt(0)" ::: "memory");
    __syncthreads();
    if (threadIdx.x == 0) {
        unsigned* bar = b.bar;
        __builtin_amdgcn_s_waitcnt(0);
        unsigned nloc = b.st[0], nx = b.st[1];
        if (nloc == 0u) { xcd_barrier_complete(bar, b.x, nloc, nx); b.st[0] = nloc; b.st[1] = nx; }
        const unsigned old = xb_add(&bar[XB_XSUB(b.x)], 1u);
        const unsigned gen = old / nloc;
        if (old + 1u == (gen + 1u) * nloc) {
            __builtin_amdgcn_fence(__ATOMIC_RELEASE, "agent");
            asm volatile("s_waitcnt vmcnt(0)" ::: "memory");
            const unsigned og = xb_add(&bar[XB_TOP], 1u);
            const unsigned tg = og / nx;
            if (og + 1u == (tg + 1u) * nx) xb_add(&bar[XB_TOPGEN], 1u);
            else XB_SPIN(xb_ld(&bar[XB_TOPGEN]) == tg, bar);
            __builtin_amdgcn_fence(__ATOMIC_ACQUIRE, "agent");
            xb_add(&bar[XB_XGEN(b.x)], 1u);
            asm volatile("s_waitcnt vmcnt(0)" ::: "memory");
        } else {
            XB_SPIN(xb_ld(&bar[XB_XGEN(b.x)]) == gen, bar);
            __builtin_amdgcn_fence(__ATOMIC_ACQUIRE, "agent");
            asm volatile("s_waitcnt vmcnt(0)" ::: "memory");
        }
    }
    __syncthreads();
}
__device__ __forceinline__ void rot8(const u32x4 x1, const u32x4 x2, const float* cp, const float* sp, float scale, float (&o1)[8], float (&o2)[8]) {
    const f32x4 c0 = *(const f32x4*)cp, c1 = *(const f32x4*)(cp + 4), s0 = *(const f32x4*)sp, s1 = *(const f32x4*)(sp + 4);
    const float cs[8] = {c0.x, c0.y, c0.z, c0.w, c1.x, c1.y, c1.z, c1.w}, sn[8] = {s0.x, s0.y, s0.z, s0.w, s1.x, s1.y, s1.z, s1.w};
    const unsigned w1[4] = {x1.x, x1.y, x1.z, x1.w}, w2[4] = {x2.x, x2.y, x2.z, x2.w};
#pragma unroll
    for (int j = 0; j < 8; ++j) {
        const float a = (j & 1) ? bfhi(w1[j >> 1]) : bflo(w1[j >> 1]);
        const float bb = (j & 1) ? bfhi(w2[j >> 1]) : bflo(w2[j >> 1]);
        o1[j] = (a * cs[j] - bb * sn[j]) * scale;
        o2[j] = (bb * cs[j] + a * sn[j]) * scale;
    }
}
struct RetPref { u32x4 q1, q2, k1, k2, v0, v1, g0, g1; f32x4 c0, c1, s0, s1; };
template <bool FULL>
__device__ __forceinline__ void ret_prefetch(RetPref& p, const bf16_t* proj, const float* cosT, const float* sinT, int s, int h, int tq) {
    const bf16_t* base = proj + (size_t)s * INC + h * 128;
    p.k1 = *(const u32x4*)(base + 1024 + tq * 8); p.k2 = *(const u32x4*)(base + 1024 + 64 + tq * 8);
    p.v0 = *(const u32x4*)(base + 2048 + tq * 16); p.v1 = *(const u32x4*)(base + 2048 + tq * 16 + 8);
    const float* cp = cosT + (size_t)s * 64 + tq * 8; const float* sp = sinT + (size_t)s * 64 + tq * 8;
    p.c0 = *(const f32x4*)cp; p.c1 = *(const f32x4*)(cp + 4); p.s0 = *(const f32x4*)sp; p.s1 = *(const f32x4*)(sp + 4);
    if (FULL) { p.q1 = *(const u32x4*)(base + tq * 8); p.q2 = *(const u32x4*)(base + 64 + tq * 8); p.g0 = *(const u32x4*)(base + 3072 + tq * 16); p.g1 = *(const u32x4*)(base + 3072 + tq * 16 + 8); }
}
__device__ __forceinline__ void rot8r(const u32x4 x1, const u32x4 x2, const RetPref& p, float scale, float (&o1)[8], float (&o2)[8]) {
    const float cs[8] = {p.c0.x, p.c0.y, p.c0.z, p.c0.w, p.c1.x, p.c1.y, p.c1.z, p.c1.w}, sn[8] = {p.s0.x, p.s0.y, p.s0.z, p.s0.w, p.s1.x, p.s1.y, p.s1.z, p.s1.w};
    const unsigned w1[4] = {x1.x, x1.y, x1.z, x1.w}, w2[4] = {x2.x, x2.y, x2.z, x2.w};
#pragma unroll
    for (int j = 0; j < 8; ++j) {
        const float a = (j & 1) ? bfhi(w1[j >> 1]) : bflo(w1[j >> 1]);
        const float bb = (j & 1) ? bfhi(w2[j >> 1]) : bflo(w2[j >> 1]);
        o1[j] = (a * cs[j] - bb * sn[j]) * scale;
        o2[j] = (bb * cs[j] + a * sn[j]) * scale;
    }
}
__device__ __forceinline__ void ret_stage_kv(const RetPref& p, LAS bf16_t* KT, LAS bf16_t* VT, int m, int tq, float kdec, float (&k1)[8], float (&k2)[8]) {
    rot8r(p.k1, p.k2, p, 1.0f, k1, k2);
#pragma unroll
    for (int j = 0; j < 8; ++j) { KT[(tq * 8 + j) * 72 + m] = (bf16_t)f2bf(k1[j] * kdec); KT[(64 + tq * 8 + j) * 72 + m] = (bf16_t)f2bf(k2[j] * kdec); }
    const unsigned yw[8] = {p.v0.x, p.v0.y, p.v0.z, p.v0.w, p.v1.x, p.v1.y, p.v1.z, p.v1.w};
#pragma unroll
    for (int j = 0; j < 8; ++j) { VT[(tq * 16 + 2 * j) * 72 + m] = (bf16_t)(yw[j] & 0xffffu); VT[(tq * 16 + 2 * j + 1) * 72 + m] = (bf16_t)(yw[j] >> 16); }
}
__device__ __forceinline__ void ret_state_update(f32x4 (&S)[8], const LAS bf16_t* KT, const LAS bf16_t* VT, float dec, int wid, int fr, int fq) {
#pragma unroll
    for (int tt = 0; tt < 8; ++tt) S[tt] = S[tt] * dec;
#pragma unroll
    for (int ks = 0; ks < 2; ++ks) {
        const bf16x8 bb = *(const LAS bf16x8*)(VT + (wid * 16 + fr) * 72 + ks * 32 + fq * 8);
#pragma unroll
        for (int tt = 0; tt < 8; ++tt) { const bf16x8 a = *(const LAS bf16x8*)(KT + (tt * 16 + fr) * 72 + ks * 32 + fq * 8); S[tt] = mfma16(a, bb, S[tt]); }
    }
}
__device__ __forceinline__ void ret_r1_phase(LAS unsigned char* lds, const bf16_t* proj, const float* cosT, const float* sinT, float* gst, int G, int b) {
    const int tid = phase_tid(), lane = tid & 63, wid = phase_wid(tid), fr = lane & 15, fq = lane >> 4;
    LAS bf16_t* KT = (LAS bf16_t*)lds;
    LAS bf16_t* VT = (LAS bf16_t*)(lds + 18432);
    const int m = tid >> 3, tq = tid & 7;
    for (int unit = b; unit < 32 * NH; unit += G) {
        const int gq = unit >> 3, h = unit & 7;
        const float log_g = head_log_gamma(h), dec = fexp_(64.0f * log_g), kdec = fexp_(log_g * (63.0f - (float)m));
        f32x4 S[8];
#pragma unroll
        for (int tt = 0; tt < 8; ++tt) S[tt] = (f32x4){0.f, 0.f, 0.f, 0.f};
        RetPref pn; ret_prefetch<false>(pn, proj, cosT, sinT, (gq * 8) * 64 + m, h, tq);
        for (int i = 0; i < 8; ++i) {
            float k1[8], k2[8];
            __syncthreads();
            ret_stage_kv(pn, KT, VT, m, tq, kdec, k1, k2);
            if (i + 1 < 8) ret_prefetch<false>(pn, proj, cosT, sinT, (gq * 8 + i + 1) * 64 + m, h, tq);
            __syncthreads();
            ret_state_update(S, KT, VT, dec, wid, fr, fq);
        }
        f32x4* op = (f32x4*)gst + ((size_t)unit * 64 + wid * 8) * 64 + lane;
#pragma unroll
        for (int tt = 0; tt < 8; ++tt) op[tt * 64] = S[tt];
    }
}
__device__ __forceinline__ void scan_phase(LAS unsigned char* lds, float* gst, const float* sumA, const float* sumH, float* Hin, int G, int b) {
    const int gtid = b * NTHREADS + phase_tid(), gth = G * NTHREADS;
    for (int p = gtid; p < 32768; p += gth) {
        const int h = p >> 12;
        const float dec8 = fexp_(512.0f * head_log_gamma(h));
        f32x4* ptr = (f32x4*)gst + p;
        f32x4 s = (f32x4){0.f, 0.f, 0.f, 0.f};
        for (int gq = 0; gq < 32; gq += 8) {
            f32x4 v[8];
#pragma unroll
            for (int j = 0; j < 8; ++j) v[j] = ptr[(size_t)(gq + j) * 32768];
#pragma unroll
            for (int j = 0; j < 8; ++j) { ptr[(size_t)(gq + j) * 32768] = s; s = s * dec8 + v[j]; }
        }
    }
    const int wg = G - 1 - b;
    if (wg < 16) {
        LAS float* SG = (LAS float*)lds;
        const int tid = phase_tid(), cl = tid & 63, sg = tid >> 6, c = wg * 64 + cl;
        float a[32], hh[32];
#pragma unroll
        for (int j = 0; j < 32; ++j) { a[j] = sumA[(sg * 32 + j) * 1024 + c]; hh[j] = sumH[(sg * 32 + j) * 1024 + c]; }
        float ap = 1.f, he = 0.f;
#pragma unroll
        for (int j = 0; j < 32; ++j) { he = a[j] * he + hh[j]; ap *= a[j]; }
        SG[sg * 64 + cl] = ap; SG[512 + sg * 64 + cl] = he;
        __syncthreads();
        float H = 0.f;
#pragma unroll
        for (int s2 = 0; s2 < 7; ++s2) if (s2 < sg) H = SG[s2 * 64 + cl] * H + SG[512 + s2 * 64 + cl];
#pragma unroll
        for (int j = 0; j < 32; ++j) { Hin[(sg * 32 + j) * 1024 + c] = H; H = a[j] * H + hh[j]; }
    }
}
__device__ __forceinline__ void ret_r3_phase(LAS unsigned char* lds, const bf16_t* proj, const float* cosT, const float* sinT, const float* gst, bf16_t* ycat, int G, int b) {
    const int tid = phase_tid(), lane = tid & 63, wid = phase_wid(tid), fr = lane & 15, fq = lane >> 4;
    LAS bf16_t* QS = (LAS bf16_t*)lds;
    LAS bf16_t* KS = (LAS bf16_t*)(lds + 17408);
    LAS bf16_t* KT = (LAS bf16_t*)(lds + 34816);
    LAS bf16_t* VT = (LAS bf16_t*)(lds + 53248);
    LAS bf16_t* PS = (LAS bf16_t*)(lds + 71680);
    LAS float*  OS = (LAS float*)(lds + 80896);
    const int m = tid >> 3, tq = tid & 7;
    for (int unit = b; unit < 32 * NH; unit += G) {
        const int gq = unit >> 3, h = unit & 7;
        const float log_g = head_log_gamma(h), dec = fexp_(64.0f * log_g), kdec = fexp_(log_g * (63.0f - (float)m));
        f32x4 S[8];
        {   const f32x4* ip = (const f32x4*)gst + ((size_t)unit * 64 + wid * 8) * 64 + lane;
#pragma unroll
            for (int tt = 0; tt < 8; ++tt) S[tt] = ip[tt * 64]; }
        RetPref pn; ret_prefetch<true>(pn, proj, cosT, sinT, (gq * 8) * 64 + m, h, tq);
        for (int i = 0; i < 8; ++i) {
            const int s = (gq * 8 + i) * 64 + m;
            const u32x4 gc0 = pn.g0, gc1 = pn.g1;
            {
                float o1[8], o2[8];
                rot8r(pn.q1, pn.q2, pn, 0.08838834764831845f, o1, o2);
                *(LAS u32x4*)(QS + m * 136 + tq * 8) = (u32x4){pk2(o1[0], o1[1]), pk2(o1[2], o1[3]), pk2(o1[4], o1[5]), pk2(o1[6], o1[7])};
                *(LAS u32x4*)(QS + m * 136 + 64 + tq * 8) = (u32x4){pk2(o2[0], o2[1]), pk2(o2[2], o2[3]), pk2(o2[4], o2[5]), pk2(o2[6], o2[7])};
                ret_stage_kv(pn, KT, VT, m, tq, kdec, o1, o2);
                *(LAS u32x4*)(KS + m * 136 + tq * 8) = (u32x4){pk2(o1[0], o1[1]), pk2(o1[2], o1[3]), pk2(o1[4], o1[5]), pk2(o1[6], o1[7])};
                *(LAS u32x4*)(KS + m * 136 + 64 + tq * 8) = (u32x4){pk2(o2[0], o2[1]), pk2(o2[2], o2[3]), pk2(o2[4], o2[5]), pk2(o2[6], o2[7])};
            }
            if (i + 1 < 8) ret_prefetch<true>(pn, proj, cosT, sinT, s + 64, h, tq);
            __syncthreads();
            f32x4 oacc[4];
            {
                const int ct = wid & 3, mt0 = (wid >> 2) * 2;
                f32x4 sacc[2] = {(f32x4){0.f, 0.f, 0.f, 0.f}, (f32x4){0.f, 0.f, 0.f, 0.f}};
#pragma unroll
                for (int ks = 0; ks < 4; ++ks) {
                    const bf16x8 a = *(const LAS bf16x8*)(QS + (ct * 16 + fr) * 136 + ks * 32 + fq * 8);
#pragma unroll
                    for (int j = 0; j < 2; ++j) { const bf16x8 bb = *(const LAS bf16x8*)(KS + ((mt0 + j) * 16 + fr) * 136 + ks * 32 + fq * 8); sacc[j] = mfma16(a, bb, sacc[j]); }
                }
#pragma unroll
                for (int j = 0; j < 2; ++j)
#pragma unroll
                    for (int r = 0; r < 4; ++r) { const int c = ct * 16 + fq * 4 + r, mm = (mt0 + j) * 16 + fr; const float dd = fabsf((float)(c - mm));
                        PS[c * 72 + mm] = (bf16_t)f2bf(sacc[j][r] * fexp_(log_g * dd)); }
                asm volatile("" ::: "memory");
#pragma unroll
                for (int c4 = 0; c4 < 4; ++c4) oacc[c4] = (f32x4){0.f, 0.f, 0.f, 0.f};
#pragma unroll
                for (int a4 = 0; a4 < 4; ++a4) {
                    u32x4 bw; bw.x = pk2(S[2 * a4][0], S[2 * a4][1]); bw.y = pk2(S[2 * a4][2], S[2 * a4][3]); bw.z = pk2(S[2 * a4 + 1][0], S[2 * a4 + 1][1]); bw.w = pk2(S[2 * a4 + 1][2], S[2 * a4 + 1][3]);
                    const bf16x8 bb = __builtin_bit_cast(bf16x8, bw);
#pragma unroll
                    for (int c4 = 0; c4 < 4; ++c4) {
                        const u32x2 lo = *(const LAS u32x2*)(QS + (c4 * 16 + fr) * 136 + a4 * 32 + fq * 4), hi = *(const LAS u32x2*)(QS + (c4 * 16 + fr) * 136 + a4 * 32 + 16 + fq * 4);
                        const bf16x8 a = __builtin_bit_cast(bf16x8, (u32x4){lo.x, lo.y, hi.x, hi.y});
                        oacc[c4] = mfma16(a, bb, oacc[c4]);
                    }
                    asm volatile("" ::: "memory");
                }
#pragma unroll
                for (int c4 = 0; c4 < 4; ++c4)
#pragma unroll
                    for (int r = 0; r < 4; ++r) oacc[c4][r] *= fexp_(log_g * (float)(c4 * 16 + fq * 4 + r + 1));
            }
            __syncthreads();
            {
#pragma unroll
                for (int ks = 0; ks < 2; ++ks) {
                    const bf16x8 bb = *(const LAS bf16x8*)(VT + (wid * 16 + fr) * 72 + ks * 32 + fq * 8);
#pragma unroll
                    for (int c4 = 0; c4 < 4; ++c4) { const bf16x8 a = *(const LAS bf16x8*)(PS + (c4 * 16 + fr) * 72 + ks * 32 + fq * 8); oacc[c4] = mfma16(a, bb, oacc[c4]); }
                }
#pragma unroll
                for (int c4 = 0; c4 < 4; ++c4)
#pragma unroll
                    for (int r = 0; r < 4; ++r) OS[(c4 * 16 + fq * 4 + r) * 132 + wid * 16 + fr] = oacc[c4][r];
                ret_state_update(S, KT, VT, dec, wid, fr, fq);
            }
            __syncthreads();
            {
                float v[16]; float sum = 0.f;
#pragma unroll
                for (int q = 0; q < 4; ++q) { const f32x4 t = *(const LAS f32x4*)(OS + m * 132 + tq * 16 + q * 4); v[4 * q] = t.x; v[4 * q + 1] = t.y; v[4 * q + 2] = t.z; v[4 * q + 3] = t.w; sum += (t.x + t.y) + (t.z + t.w); }
                sum += __shfl_xor(sum, 1); sum += __shfl_xor(sum, 2); sum += __shfl_xor(sum, 4);
                const float mean = sum * (1.0f / 128.0f); float sq = 0.f;
#pragma unroll
                for (int q = 0; q < 16; ++q) { v[q] -= mean; sq += v[q] * v[q]; }
                sq += __shfl_xor(sq, 1); sq += __shfl_xor(sq, 2); sq += __shfl_xor(sq, 4);
                const float rstd = 1.0f / sqrtf(sq * (1.0f / 128.0f) + GN_EPS);
                const unsigned gw[8] = {gc0.x, gc0.y, gc0.z, gc0.w, gc1.x, gc1.y, gc1.z, gc1.w};
                unsigned ow[8];
#pragma unroll
                for (int j = 0; j < 8; ++j) { const float ga = bflo(gw[j]), gb = bfhi(gw[j]);
                    ow[j] = pk2(ga * sigmoidf_(ga) * v[2 * j] * rstd, gb * sigmoidf_(gb) * v[2 * j + 1] * rstd); }
                bf16_t* yp = ycat + (size_t)s * D_ + h * 128 + tq * 16;
                *(u32x4*)yp = (u32x4){ow[0], ow[1], ow[2], ow[3]}; *(u32x4*)(yp + 8) = (u32x4){ow[4], ow[5], ow[6], ow[7]};
            }
        }
        __syncthreads();
    }
}
template <int MODE>
__device__ __forceinline__ void lru_phase(LAS unsigned char* lds, const bf16_t* proj, const Ptrs& P, const bf16_t* wraT, const bf16_t* wriT,
                                          float* sumA, float* sumH, const float* Hin, bf16_t* ycat, int G, int b) {
    const int tid = phase_tid(), lane = tid & 63, wid = phase_wid(tid), fr = lane & 15, fq = lane >> 4;
    LAS float*  XC  = (LAS float*)lds;
    LAS bf16_t* XCb = (LAS bf16_t*)(lds + 33792);
    LAS float*  AA  = (LAS float*)(lds + 51200);
    LAS float*  SEG = (LAS float*)(lds + 84992);
    LAS bf16_t* WR  = (LAS bf16_t*)(lds + 89088);
    LAS bf16_t* WI  = (LAS bf16_t*)(lds + 123904);
    LAS float*  BB  = XC;
    const int st = wid & 3, jt0 = (wid >> 2) * 4;
    const int m = tid >> 3, part = tid & 7, j0 = part * 16;
    const int sj = tid & 127, seg = tid >> 7;
    int gcur = -1;
    float bra[4], bri[4], ls[4]; float cw0[4], cw1[4], cb0 = 0.f, cb1 = 0.f;
    unsigned xnext[11]; u32x4 gnext[2] = {(u32x4){0u, 0u, 0u, 0u}, (u32x4){0u, 0u, 0u, 0u}}; float hnext = 0.f;
    auto issue = [&](int unit) {
        const int n = unit >> 3, c0 = (unit & 7) * 128;
        const int r0 = n * 64 + wid * 8 - 3;
#pragma unroll
        for (int q = 0; q < 11; ++q) { const int row = r0 + q; xnext[q] = row >= 0 ? *(const unsigned*)(proj + (size_t)row * INC + 4096 + c0 + 2 * lane) : 0u; }
        if (MODE == 1) {
            const bf16_t* gp = proj + (size_t)(n * 64 + m) * INC + 5120 + c0 + j0;
            gnext[0] = *(const u32x4*)gp; gnext[1] = *(const u32x4*)(gp + 8);
            hnext = Hin[n * 1024 + c0 + sj];
        }
    };
    if (b < NCH * 8) issue(b);
    for (int unit = b; unit < NCH * 8; unit += G) {
        const int n = unit >> 3, g = unit & 7, c0 = g * 128;
        if (g != gcur) {
            gcur = g;
            __syncthreads();
            {
                const int row = tid >> 2, pc = tid & 3;
#pragma unroll
                for (int q = 0; q < 4; ++q) { const int piece = pc * 4 + q;
                    *(LAS u32x4*)(WR + row * 136 + piece * 8) = *(const u32x4*)(wraT + (size_t)g * 16384 + row * 128 + piece * 8);
                    *(LAS u32x4*)(WI + row * 136 + piece * 8) = *(const u32x4*)(wriT + (size_t)g * 16384 + row * 128 + piece * 8); }
            }
#pragma unroll
            for (int j = 0; j < 4; ++j) {
                const int c = c0 + (jt0 + j) * 16 + fr;
                bra[j] = P.b_ra[c]; bri[j] = P.b_ri[c]; ls[j] = -8.0f * log1pf(expf(-P.lam[c]));
            }
#pragma unroll
            for (int kk = 0; kk < 4; ++kk) { cw0[kk] = P.conv_w[kk * 1024 + c0 + 2 * lane]; cw1[kk] = P.conv_w[kk * 1024 + c0 + 2 * lane + 1]; }
            cb0 = P.conv_b[c0 + 2 * lane]; cb1 = P.conv_b[c0 + 2 * lane + 1];
        }
        unsigned xcur[11];
#pragma unroll
        for (int q = 0; q < 11; ++q) xcur[q] = xnext[q];
        const u32x4 gc0 = gnext[0], gc1 = gnext[1]; const float hin0 = hnext;
        if (unit + G < NCH * 8) issue(unit + G);
        QRow qrow; const int qe = unit * 8 + wid;
        quant_issue(qrow, MODE == 1 ? P.peer_v : P.peer_u, qe, lane);
#pragma unroll
        for (int rr = 0; rr < 8; ++rr) {
            float x0 = cb0, x1 = cb1;
#pragma unroll
            for (int kk = 0; kk < 4; ++kk) { x0 += cw0[kk] * bflo(xcur[rr + kk]); x1 += cw1[kk] * bfhi(xcur[rr + kk]); }
            const int row = wid * 8 + rr;
            XC[row * 132 + 2 * lane] = x0; XC[row * 132 + 2 * lane + 1] = x1;
            *(LAS unsigned*)(XCb + row * 136 + 2 * lane) = pk2(x0, x1);
        }
        __syncthreads();
        {
            f32x4 ar[4], ai[4];
#pragma unroll
            for (int j = 0; j < 4; ++j) { ar[j] = (f32x4){0.f, 0.f, 0.f, 0.f}; ai[j] = (f32x4){0.f, 0.f, 0.f, 0.f}; }
#pragma unroll
            for (int ks = 0; ks < 4; ++ks) {
                const bf16x8 a = *(const LAS bf16x8*)(XCb + (st * 16 + fr) * 136 + ks * 32 + fq * 8);
#pragma unroll
                for (int j = 0; j < 4; ++j) { const int wo = ((jt0 + j) * 16 + fr) * 136 + ks * 32 + fq * 8;
                    ar[j] = mfma16(a, *(const LAS bf16x8*)(WR + wo), ar[j]); ai[j] = mfma16(a, *(const LAS bf16x8*)(WI + wo), ai[j]); }
            }
#pragma unroll
            for (int j = 0; j < 4; ++j) {
                const int col = (jt0 + j) * 16 + fr;
#pragma unroll
                for (int r = 0; r < 4; ++r) {
                    const int sl = st * 16 + fq * 4 + r;
                    const float rg = sigmoidf_(ar[j][r] + bra[j]), ig = sigmoidf_(ai[j][r] + bri[j]);
                    const float a = fexp_(rg * ls[j]);
                    const float bv = __builtin_amdgcn_sqrtf(fmaxf(1.0f - a * a, 0.f)) * (ig * XC[sl * 132 + col]);
                    AA[sl * 132 + col] = a; BB[sl * 132 + col] = bv;
                }
            }
        }
        __syncthreads();
        float ap = 1.f, he = 0.f;
#pragma unroll
        for (int q = 0; q < 16; ++q) { const float a = AA[(seg * 16 + q) * 132 + sj], bv = BB[(seg * 16 + q) * 132 + sj]; he = a * he + bv; ap *= a; }
        SEG[seg * 128 + sj] = ap; SEG[512 + seg * 128 + sj] = he;
        __syncthreads();
        float hin = (MODE == 1) ? hin0 : 0.f;
#pragma unroll
        for (int s2 = 0; s2 < 3; ++s2) if (s2 < seg) hin = SEG[s2 * 128 + sj] * hin + SEG[512 + s2 * 128 + sj];
        if (MODE == 0) {
            if (seg == 3) { sumA[n * 1024 + c0 + sj] = SEG[sj] * SEG[128 + sj] * SEG[256 + sj] * ap; sumH[n * 1024 + c0 + sj] = ap * hin + he; }
        } else {
            float hcur = hin;
#pragma unroll
            for (int q = 0; q < 16; ++q) { const int o = (seg * 16 + q) * 132 + sj; hcur = AA[o] * hcur + BB[o]; BB[o] = hcur; }
            __syncthreads();
            const unsigned gw[8] = {gc0.x, gc0.y, gc0.z, gc0.w, gc1.x, gc1.y, gc1.z, gc1.w};
            unsigned ow[8];
#pragma unroll
            for (int q = 0; q < 8; ++q) { const float h0 = BB[m * 132 + j0 + 2 * q], h1 = BB[m * 132 + j0 + 2 * q + 1];
                ow[q] = pk2(h0 * gelu_tanh(bflo(gw[q])), h1 * gelu_tanh(bfhi(gw[q]))); }
            bf16_t* yp = ycat + (size_t)(n * 64 + m) * D_ + 1024 + c0 + j0;
            *(u32x4*)yp = (u32x4){ow[0], ow[1], ow[2], ow[3]}; *(u32x4*)(yp + 8) = (u32x4){ow[4], ow[5], ow[6], ow[7]};
        }
        quant_finish<MODE>(qrow, P.ws + (MODE == 1 ? WS_VQ : WS_UQ), (float*)(P.ws + (MODE == 1 ? WS_SV : WS_SU)), qe, lane);
        __syncthreads();
    }
}
__device__ __forceinline__ void ln1_phase(const bf16_t* buf, bf16_t* h1b, unsigned* xqs, float* sx, const float* gam, const float* bet, int G, int b) {
    const int tid_ = phase_tid(), lane = tid_ & 63, wid = phase_wid(tid_);
    const int gw = b * NWAVES + wid, NGW = G * NWAVES;
    constexpr int R = 4;
    for (int row0 = gw; row0 < S_; row0 += R * NGW) {
        f32x4 v[R][8]; float sum[R], sq[R], amax[R];
#pragma unroll
        for (int q = 0; q < R; ++q) {
            const int row = min(row0 + q * NGW, S_ - 1);
            const bf16_t* rp = buf + (size_t)row * D_;
            sum[q] = 0.f;
#pragma unroll
            for (int j = 0; j < 8; ++j) { const u32x2 w = *(const u32x2*)(rp + 256 * j + 4 * lane); v[q][j] = (f32x4){bflo(w.x), bfhi(w.x), bflo(w.y), bfhi(w.y)}; sum[q] += (v[q][j].x + v[q][j].y) + (v[q][j].z + v[q][j].w); }
        }
#pragma unroll
        for (int q = 0; q < R; ++q) sum[q] = wave_sum(sum[q]) * (1.0f / D_);
#pragma unroll
        for (int q = 0; q < R; ++q) { sq[q] = 0.f;
#pragma unroll
            for (int j = 0; j < 8; ++j) { v[q][j] = v[q][j] - sum[q]; sq[q] += (v[q][j].x * v[q][j].x + v[q][j].y * v[q][j].y) + (v[q][j].z * v[q][j].z + v[q][j].w * v[q][j].w); } }
#pragma unroll
        for (int q = 0; q < R; ++q) sq[q] = 1.0f / sqrtf(wave_sum(sq[q]) * (1.0f / D_) + LN_EPS);
#pragma unroll
        for (int j = 0; j < 8; ++j) {
            const f32x4 gg = *(const f32x4*)(gam + 256 * j + 4 * lane), bb = *(const f32x4*)(bet + 256 * j + 4 * lane);
#pragma unroll
            for (int q = 0; q < R; ++q) v[q][j] = v[q][j] * sq[q] * gg + bb;
        }
#pragma unroll
        for (int q = 0; q < R; ++q) { amax[q] = 0.f;
#pragma unroll
            for (int j = 0; j < 8; ++j) amax[q] = fmaxf(amax[q], fmaxf(fmaxf(fabsf(v[q][j].x), fabsf(v[q][j].y)), fmaxf(fabsf(v[q][j].z), fabsf(v[q][j].w)))); }
#pragma unroll
        for (int q = 0; q < R; ++q) amax[q] = wave_max(amax[q]);
#pragma unroll
        for (int q = 0; q < R; ++q) {
            const int row = row0 + q * NGW;
            if (row < S_) {
                const float inv = amax[q] > 0.f ? 127.0f / amax[q] : 0.f;
                if (lane == 0) sx[row] = amax[q] * (1.0f / 127.0f);
#pragma unroll
                for (int j = 0; j < 8; ++j) {
                    *(u32x2*)(h1b + (size_t)row * D_ + 256 * j + 4 * lane) = (u32x2){pk2(v[q][j].x, v[q][j].y), pk2(v[q][j].z, v[q][j].w)};
                    const int a = (int)rintf(v[q][j].x * inv), bq = (int)rintf(v[q][j].y * inv), c = (int)rintf(v[q][j].z * inv), d = (int)rintf(v[q][j].w * inv);
                    xqs[((size_t)j * S_ + row) * 64 + lane] = (unsigned)(a & 255) | ((unsigned)(bq & 255) << 8) | ((unsigned)(c & 255) << 16) | ((unsigned)(d & 255) << 24);
                }
            }
        }
    }
}
__device__ __forceinline__ unsigned mono(float f) { const unsigned u = __float_as_uint(f); return (u & 0x80000000u) ? ~u : (u ^ 0x80000000u); }
__device__ __forceinline__ float unmono(unsigned u) { return __uint_as_float((u & 0x80000000u) ? (u ^ 0x80000000u) : ~u); }
__device__ __forceinline__ unsigned umax_(unsigned a, unsigned b) { return a > b ? a : b; }
__device__ __forceinline__ constexpr int cand_i(int c) { return c < 16 ? 0 : c < 24 ? 1 : c < 29 ? 2 : c < 33 ? 3 : c < 36 ? 4 : c < 38 ? 5 : c < 40 ? 6 : c < 42 ? 7 : c - 34; }
__device__ __forceinline__ constexpr int cand_j(int c) { return c < 16 ? c : c < 24 ? c - 16 : c < 29 ? c - 24 : c < 33 ? c - 29 : c < 36 ? c - 33 : c < 38 ? c - 36 : c < 40 ? c - 38 : c < 42 ? c - 40 : 0; }

__device__ __forceinline__ unsigned umin_(unsigned a, unsigned b) { return a < b ? a : b; }
#define SN_CE(x, y) do { const unsigned hi_ = umax_(x, y), lo_ = umin_(x, y); x = hi_; y = lo_; } while (0)
#define SN_SORT16(a) do { SN_CE(a[0], a[1]); SN_CE(a[2], a[3]); SN_CE(a[0], a[2]); SN_CE(a[1], a[3]); SN_CE(a[1], a[2]); SN_CE(a[4], a[5]); SN_CE(a[6], a[7]); SN_CE(a[4], a[6]); SN_CE(a[5], a[7]); SN_CE(a[5], a[6]); SN_CE(a[0], a[4]); SN_CE(a[2], a[6]); SN_CE(a[2], a[4]); SN_CE(a[1], a[5]); SN_CE(a[3], a[7]); SN_CE(a[3], a[5]); SN_CE(a[1], a[2]); SN_CE(a[3], a[4]); SN_CE(a[5], a[6]); SN_CE(a[8], a[9]); SN_CE(a[10], a[11]); SN_CE(a[8], a[10]); SN_CE(a[9], a[11]); SN_CE(a[9], a[10]); SN_CE(a[12], a[13]); SN_CE(a[14], a[15]); SN_CE(a[12], a[14]); SN_CE(a[13], a[15]); SN_CE(a[13], a[14]); SN_CE(a[8], a[12]); SN_CE(a[10], a[14]); SN_CE(a[10], a[12]); SN_CE(a[9], a[13]); SN_CE(a[11], a[15]); SN_CE(a[11], a[13]); SN_CE(a[9], a[10]); SN_CE(a[11], a[12]); SN_CE(a[13], a[14]); SN_CE(a[0], a[8]); SN_CE(a[4], a[12]); SN_CE(a[4], a[8]); SN_CE(a[2], a[10]); SN_CE(a[6], a[14]); SN_CE(a[6], a[10]); SN_CE(a[2], a[4]); SN_CE(a[6], a[8]); SN_CE(a[10], a[12]); SN_CE(a[1], a[9]); SN_CE(a[5], a[13]); SN_CE(a[5], a[9]); SN_CE(a[3], a[11]); SN_CE(a[7], a[15]); SN_CE(a[7], a[11]); SN_CE(a[3], a[5]); SN_CE(a[7], a[9]); SN_CE(a[11], a[13]); SN_CE(a[1], a[2]); SN_CE(a[3], a[4]); SN_CE(a[5], a[6]); SN_CE(a[7], a[8]); SN_CE(a[9], a[10]); SN_CE(a[11], a[12]); SN_CE(a[13], a[14]); } while (0)
#define SN_BITONIC16(a) do { SN_CE(a[0], a[8]); SN_CE(a[1], a[9]); SN_CE(a[2], a[10]); SN_CE(a[3], a[11]); SN_CE(a[4], a[12]); SN_CE(a[5], a[13]); SN_CE(a[6], a[14]); SN_CE(a[7], a[15]); SN_CE(a[0], a[4]); SN_CE(a[1], a[5]); SN_CE(a[2], a[6]); SN_CE(a[3], a[7]); SN_CE(a[8], a[12]); SN_CE(a[9], a[13]); SN_CE(a[10], a[14]); SN_CE(a[11], a[15]); SN_CE(a[0], a[2]); SN_CE(a[1], a[3]); SN_CE(a[4], a[6]); SN_CE(a[5], a[7]); SN_CE(a[8], a[10]); SN_CE(a[9], a[11]); SN_CE(a[12], a[14]); SN_CE(a[13], a[15]); SN_CE(a[0], a[1]); SN_CE(a[2], a[3]); SN_CE(a[4], a[5]); SN_CE(a[6], a[7]); SN_CE(a[8], a[9]); SN_CE(a[10], a[11]); SN_CE(a[12], a[13]); SN_CE(a[14], a[15]); } while (0)

#define TOPK_XMERGE(T, mask) do { unsigned pt_[16]; \
    _Pragma("unroll") for (int i_ = 0; i_ < 16; ++i_) pt_[i_] = (unsigned)__shfl_xor((int)T[15 - i_], mask); \
    _Pragma("unroll") for (int i_ = 0; i_ < 16; ++i_) T[i_] = umax_(T[i_], pt_[i_]); \
    SN_BITONIC16(T); } while (0)
__device__ __forceinline__ void topk_phase(LAS unsigned char* lds, const bf16_t* qp, const bf16_t* keys, const float* SU, const float* SV, int* sel_e, float* sel_g, float* sel_su, int G, int b) {
    const int tid = phase_tid(), lane = tid & 63, wid = phase_wid(tid), fr = lane & 15, fq = lane >> 4;
    LAS unsigned* wl = (LAS unsigned*)(lds + wid * 4096 + fr * 256);
    pg8::StaticOrder SO; SO.init(S_, D_, G, b);
    for (int ui = 0; ; ++ui) {
        pg8::Unit gu; if (!SO.next(ui >> 1, gu)) break;
        const int tt = gu.pm * 2 + (ui & 1), h = gu.pn;
        const int tok = tt * 128 + wid * 16 + fr;
        unsigned T[2][16];
#pragma unroll
        for (int p = 0; p < 2; ++p) {
            f32x4 acc[8];
#pragma unroll
            for (int mt = 0; mt < 8; ++mt) acc[mt] = (f32x4){0.f, 0.f, 0.f, 0.f};
            bf16x8 bq[4];
#pragma unroll
            for (int ks = 0; ks < 4; ++ks) bq[ks] = *(const bf16x8*)(qp + (size_t)tok * D_ + h * 256 + p * 128 + ks * 32 + fq * 8);
            const bf16_t* kb = keys + (size_t)(h * 2 + p) * 16384;
#pragma unroll
            for (int mt = 0; mt < 8; ++mt)
#pragma unroll
                for (int ks = 0; ks < 4; ++ks) { const bf16x8 a = *(const bf16x8*)(kb + (mt * 16 + fr) * 128 + ks * 32 + fq * 8); acc[mt] = mfma16(a, bq[ks], acc[mt]); }
            unsigned lo16[16];
#pragma unroll
            for (int mt = 0; mt < 4; ++mt)
#pragma unroll
                for (int r = 0; r < 4; ++r) {
                    T[p][mt * 4 + r] = (mono(acc[mt][r]) & ~127u) | (unsigned)(127 - (mt * 16 + fq * 4 + r));
                    lo16[mt * 4 + r] = (mono(acc[mt + 4][r]) & ~127u) | (unsigned)(127 - ((mt + 4) * 16 + fq * 4 + r));
                }
            SN_SORT16(T[p]); SN_SORT16(lo16);
#pragma unroll
            for (int i = 0; i < 16; ++i) T[p][i] = umax_(T[p][i], lo16[15 - i]);
            SN_BITONIC16(T[p]);
            TOPK_XMERGE(T[p], 16); TOPK_XMERGE(T[p], 32);
        }
        float v1[16], v2[16];
#pragma unroll
        for (int i = 0; i < 16; ++i) { v1[i] = unmono(T[0][i] & ~127u); v2[i] = unmono(T[1][i] & ~127u); }
        unsigned ck[16];
#pragma unroll
        for (int sidx = 0; sidx < 13; ++sidx) {
            unsigned keyk[4];
#pragma unroll
            for (int k = 0; k < 4; ++k) {
                const int c = 4 * sidx + k;
                if (c < 50) { const int ci = cand_i(c), cj = cand_j(c); keyk[k] = (mono(v1[ci] + v2[cj]) & ~255u) | (unsigned)(255 - (ci * 16 + cj)); }
                else keyk[k] = 0u;
            }
            ck[sidx] = fq == 0 ? keyk[0] : fq == 1 ? keyk[1] : fq == 2 ? keyk[2] : keyk[3];
        }
        ck[13] = 0u; ck[14] = 0u; ck[15] = 0u;
        SN_SORT16(ck);
        TOPK_XMERGE(ck, 16); TOPK_XMERGE(ck, 32);
        if (fq == 0) {
#pragma unroll
            for (int i = 0; i < 16; ++i) { wl[i] = T[0][i]; wl[16 + i] = T[1][i]; }
        }
        __syncthreads();
        {
            const float vmax = unmono(ck[0] & ~255u);
            float esum = 0.f;
#pragma unroll
            for (int k = 0; k < 16; ++k) esum += __expf(unmono(ck[k] & ~255u) - vmax);
            const float einv = 1.0f / esum;
#pragma unroll
            for (int kk = 0; kk < 4; ++kk) {
                const unsigned W = fq == 0 ? ck[kk] : fq == 1 ? ck[4 + kk] : fq == 2 ? ck[8 + kk] : ck[12 + kk];
                const int k = fq * 4 + kk;
                const unsigned id = 255u - (W & 255u);
                const unsigned e1 = 127u - (wl[id >> 4] & 127u), e2 = 127u - (wl[16 + (id & 15u)] & 127u);
                const size_t o = ((size_t)tok * 8 + h) * 16 + k;
                const unsigned ex = e1 * 128u + e2;
                sel_e[o] = (int)ex; sel_g[o] = __expf(unmono(W & ~255u) - vmax) * einv * SV[ex]; sel_su[o] = SU[ex];
            }
        }
        __syncthreads();
    }
}
__device__ __forceinline__ int row16_sum_i(int v) {
    v += __builtin_amdgcn_update_dpp(0, v, 0xB1, 0xF, 0xF, true);
    v += __builtin_amdgcn_update_dpp(0, v, 0x4E, 0xF, 0xF, true);
    v += __builtin_amdgcn_update_dpp(0, v, 0x141, 0xF, 0xF, true);
    v += __builtin_amdgcn_update_dpp(0, v, 0x140, 0xF, 0xF, true);
    return v;
}
__device__ __forceinline__ int dot16_i8(const u32x4 a, const u32x4 x) {
    int d = __builtin_amdgcn_sdot4((int)a.x, (int)x.x, 0, false); d = __builtin_amdgcn_sdot4((int)a.y, (int)x.y, d, false);
    d = __builtin_amdgcn_sdot4((int)a.z, (int)x.z, d, false); return __builtin_amdgcn_sdot4((int)a.w, (int)x.w, d, false);
}
template <int EMASK>
__device__ __forceinline__ void peer_u_phase(LAS unsigned char* lds, const unsigned char* UQs, const unsigned char* XQs, const int* sel_e, int* pd, int xi, int nx, int rank, int nloc) {
    const int tid_ = phase_tid(), lane = tid_ & 63, wid = phase_wid(tid_), r = lane >> 4, i = lane & 15;
    LAS int* esb = (LAS int*)(lds + wid * 2048);
    const int wx = rank * NWAVES + wid, nwx = nloc * NWAVES;
    if (wx >= S_) return;
    const int NT = (S_ - wx + nwx - 1) / nwx;
    for (int j = xi; j < 8; j += nx) {
        const unsigned char* Uj = UQs + (size_t)j * 16384 * 256; const unsigned li = 16u * (unsigned)i;
        const unsigned char* Xj = XQs + (size_t)j * S_ * 256 + 16 * i;
        u32x4 A[16], B[16];
        int ma, mb; u32x4 xc, xn;
        {
            const int t0 = wx, t1 = (NT > 1) ? wx + nwx : wx;
            ma = sel_e[(size_t)t0 * 128 + lane]; mb = sel_e[(size_t)t0 * 128 + 64 + lane]; xc = *(const u32x4*)(Xj + (size_t)t0 * 256);
            esb[lane] = ma; esb[64 + lane] = mb;
            asm volatile("" ::: "memory");
            ma = sel_e[(size_t)t1 * 128 + lane]; mb = sel_e[(size_t)t1 * 128 + 64 + lane]; xn = *(const u32x4*)(Xj + (size_t)t1 * 256);
            asm volatile("" ::: "memory");
#pragma unroll
            for (int it = 0; it < 16; ++it) A[it] = *(const u32x4*)(Uj + (((unsigned)esb[4 * it + r] & (unsigned)EMASK) * 256u + li));
#pragma unroll
            for (int it = 0; it < 16; ++it) B[it] = *(const u32x4*)(Uj + (((unsigned)esb[64 + 4 * it + r] & (unsigned)EMASK) * 256u + li));
        }
        for (int n = 0; n < NT; ++n) {
            const int t = wx + n * nwx;
            const int t2 = (n + 2 < NT) ? t + 2 * nwx : t;
            LAS int* esn = esb + ((n + 1) & 1) * 128;
            esn[lane] = ma; esn[64 + lane] = mb;
            const u32x4 xnn = xn;
            asm volatile("" ::: "memory");
            ma = sel_e[(size_t)t2 * 128 + lane]; mb = sel_e[(size_t)t2 * 128 + 64 + lane]; xn = *(const u32x4*)(Xj + (size_t)t2 * 256);
            int keepA = 0, keepB = 0;
#pragma unroll
            for (int it = 0; it < 16; ++it) { const int d = row16_sum_i(dot16_i8(A[it], xc)); keepA = (i == it) ? d : keepA; }
            asm volatile("" : "+v"(keepA) :: "memory");
#pragma unroll
            for (int it = 0; it < 16; ++it) A[it] = *(const u32x4*)(Uj + (((unsigned)esn[4 * it + r] & (unsigned)EMASK) * 256u + li));
            asm volatile("" ::: "memory");
#pragma unroll
            for (int it = 0; it < 16; ++it) { const int d = row16_sum_i(dot16_i8(B[it], xc)); keepB = (i == it) ? d : keepB; }
            asm volatile("" : "+v"(keepB) :: "memory");
#pragma unroll
            for (int it = 0; it < 16; ++it) B[it] = *(const u32x4*)(Uj + (((unsigned)esn[64 + 4 * it + r] & (unsigned)EMASK) * 256u + li));
            asm volatile("" ::: "memory");
            int* pp = pd + ((size_t)t * 8 + j) * 128 + 4 * i + r;
            pp[0] = keepA; pp[64] = keepB;
            xc = xnn;
        }
    }
}
typedef float f32x2 __attribute__((ext_vector_type(2)));
__device__ __forceinline__ void acc16_fp8(f32x2 (&acc)[8], const u32x4 v, float c) {
    const int w[4] = {(int)v.x, (int)v.y, (int)v.z, (int)v.w};
    const f32x2 cc = {c, c};
#pragma unroll
    for (int q = 0; q < 4; ++q) {
        const f32x2 lo = __builtin_amdgcn_cvt_pk_f32_fp8(w[q], false), hi = __builtin_amdgcn_cvt_pk_f32_fp8(w[q], true);
        acc[2 * q] = __builtin_elementwise_fma(cc, lo, acc[2 * q]); acc[2 * q + 1] = __builtin_elementwise_fma(cc, hi, acc[2 * q + 1]);
    }
}
__device__ __forceinline__ void peer_coef_phase(const float* sel_g, const float* sel_su, const int* pd, const float* SX, float* coef, int G, int b) {
    const int tid_ = phase_tid(), lane = tid_ & 63, wid = phase_wid(tid_);
    const int gw = b * NWAVES + wid, NGW = G * NWAVES;
    for (int t = gw; t < S_; t += NGW) {
        const float* gp = sel_g + (size_t)t * 128 + lane; const float* up = sel_su + (size_t)t * 128 + lane; const int* pp = pd + (size_t)t * 1024 + lane;
        const float sxt = SX[t];
#pragma unroll
        for (int hh = 0; hh < 2; ++hh) {
            int ds = 0;
#pragma unroll
            for (int jj = 0; jj < 8; ++jj) ds += pp[jj * 128 + 64 * hh];
            coef[(size_t)t * 128 + 64 * hh + lane] = gp[64 * hh] * gelu_tanh((float)ds * (up[64 * hh] * sxt));
        }
    }
}
struct PeerMeta { int e[2]; float c[2]; };
__device__ __forceinline__ void peer_meta_load(PeerMeta& m, const int* sel_e, const float* coef, int t, int lane) {
    const int* ep = sel_e + (size_t)t * 128 + lane; const float* cp = coef + (size_t)t * 128 + lane;
    m.e[0] = ep[0]; m.e[1] = ep[64]; m.c[0] = cp[0]; m.c[1] = cp[64];
}
__device__ __forceinline__ void tr4x4(unsigned r0, unsigned r1, unsigned r2, unsigned r3, unsigned (&c)[4]) {
    const unsigned t0 = __builtin_amdgcn_perm(r1, r0, 0x05010400u), t1 = __builtin_amdgcn_perm(r1, r0, 0x07030602u);
    const unsigned t2 = __builtin_amdgcn_perm(r3, r2, 0x05010400u), t3 = __builtin_amdgcn_perm(r3, r2, 0x07030602u);
    c[0] = __builtin_amdgcn_perm(t2, t0, 0x05040100u); c[1] = __builtin_amdgcn_perm(t2, t0, 0x07060302u);
    c[2] = __builtin_amdgcn_perm(t3, t1, 0x05040100u); c[3] = __builtin_amdgcn_perm(t3, t1, 0x07060302u);
}
typedef int i32x4 __attribute__((ext_vector_type(4)));
__device__ __forceinline__ void acc_half_mfma(int (&ah)[16], const u32x4 (&R)[16], const LAS unsigned* ch4  , int r) {
    i32x4 Aop; Aop.x = (int)ch4[0 * 4 + r]; Aop.y = (int)ch4[1 * 4 + r]; Aop.z = (int)ch4[2 * 4 + r]; Aop.w = (int)ch4[3 * 4 + r];
#pragma unroll
    for (int q = 0; q < 4; ++q) {
        unsigned cg[4][4];
#pragma unroll
        for (int gg = 0; gg < 4; ++gg) {
            const unsigned w0 = q == 0 ? R[4 * gg].x : q == 1 ? R[4 * gg].y : q == 2 ? R[4 * gg].z : R[4 * gg].w;
            const unsigned w1 = q == 0 ? R[4 * gg + 1].x : q == 1 ? R[4 * gg + 1].y : q == 2 ? R[4 * gg + 1].z : R[4 * gg + 1].w;
            const unsigned w2 = q == 0 ? R[4 * gg + 2].x : q == 1 ? R[4 * gg + 2].y : q == 2 ? R[4 * gg + 2].z : R[4 * gg + 2].w;
            const unsigned w3 = q == 0 ? R[4 * gg + 3].x : q == 1 ? R[4 * gg + 3].y : q == 2 ? R[4 * gg + 3].z : R[4 * gg + 3].w;
            tr4x4(w0, w1, w2, w3, cg[gg]);
        }
#pragma unroll
        for (int cc = 0; cc < 4; ++cc) {
            i32x4 Bop; Bop.x = (int)cg[0][cc]; Bop.y = (int)cg[1][cc]; Bop.z = (int)cg[2][cc]; Bop.w = (int)cg[3][cc];
            const i32x4 d = __builtin_amdgcn_mfma_i32_16x16x64_i8(Aop, Bop, (i32x4){0, 0, 0, 0}, 0, 0, 0);
            ah[4 * q + cc] += d.x;
        }
    }
}
__device__ __forceinline__ void peer_stage_lists(const PeerMeta& m, LAS int* es, LAS unsigned char* chB, LAS unsigned char* clB, LAS float* scp, int lane) {
    es[lane] = m.e[0]; es[64 + lane] = m.e[1];
    const float cmax = wave_max(fmaxf(fabsf(m.c[0]), fabsf(m.c[1])));
    const float inv = cmax > 0.f ? 127.0f / cmax : 0.f;
    if (lane == 0) scp[0] = cmax * (1.0f / 127.0f);
#pragma unroll
    for (int hh = 0; hh < 2; ++hh) {
        const int k = 64 * hh + lane;
        const int h = (int)rintf(m.c[hh] * inv), l = 0;
        const int idx = (k >> 4) * 16 + (k & 3) * 4 + ((k >> 2) & 3);
        chB[idx] = (unsigned char)(h & 255); clB[idx] = (unsigned char)(l & 255);
    }
}
template <int STRIP>
__device__ __forceinline__ void peer_v_phase(LAS unsigned char* lds, const unsigned char* VQs, const int* sel_e, const float* coef,
                                             bf16_t* zs, int xi, int nx, int rank, int nloc) {
    const int tid_ = phase_tid(), lane = tid_ & 63, wid = phase_wid(tid_), r = lane >> 4, i = lane & 15;
    LAS unsigned char* wl = lds + wid * 2048;
    LAS int* esb = (LAS int*)wl;
    const int wx = rank * NWAVES + wid, nwx = nloc * NWAVES;
    if (wx >= S_) return;
    const int NT = (S_ - wx + nwx - 1) / nwx;
    for (int j = xi; j < 8; j += nx) {
        const unsigned char* Vj = VQs + (size_t)j * 16384 * 256; const unsigned li = 16u * (unsigned)i;
        u32x4 A[16], B[16];
        PeerMeta m;
        {
            peer_meta_load(m, sel_e, coef, wx, lane);
            peer_stage_lists(m, esb, wl + 1024, wl + 1280, (LAS float*)(wl + 1536), lane);
            asm volatile("" ::: "memory");
            peer_meta_load(m, sel_e, coef, (NT > 1) ? wx + nwx : wx, lane);
            asm volatile("" ::: "memory");
#pragma unroll
            for (int it = 0; it < 16; ++it) A[it] = *(const u32x4*)(Vj + ((unsigned)esb[4 * it + r] * 256u + li));
#pragma unroll
            for (int it = 0; it < 16; ++it) B[it] = *(const u32x4*)(Vj + ((unsigned)esb[64 + 4 * it + r] * 256u + li));
        }
        for (int n = 0; n < NT; ++n) {
            const int t = wx + n * nwx;
            const int t2 = (n + 2 < NT) ? t + 2 * nwx : t;
            const int pc = n & 1, pn = pc ^ 1;
            LAS int* esn = esb + pn * 128;
            const LAS unsigned* chc = (const LAS unsigned*)(wl + 1024 + pc * 128); const LAS unsigned* clc = (const LAS unsigned*)(wl + 1280 + pc * 128);
            peer_stage_lists(m, esn, wl + 1024 + pn * 128, wl + 1280 + pn * 128, (LAS float*)(wl + 1536) + pn, lane);
            asm volatile("" ::: "memory");
            peer_meta_load(m, sel_e, coef, t2, lane);
            int ah[16], al[16];
#pragma unroll
            for (int q = 0; q < 16; ++q) { ah[q] = 0; al[q] = 0; }
            if (STRIP == 1) { for (int gg = 0; gg < 4; ++gg) ah[gg] += (int)(A[4 * gg].x ^ A[4 * gg + 1].y ^ A[4 * gg + 2].z ^ A[4 * gg + 3].w ^ chc[gg * 4 + r]); } else acc_half_mfma(ah, A, chc, r);
            asm volatile("" : "+v"(ah[0]), "+v"(ah[1]), "+v"(ah[2]), "+v"(ah[3]), "+v"(ah[4]), "+v"(ah[5]), "+v"(ah[6]), "+v"(ah[7]), "+v"(ah[8]), "+v"(ah[9]), "+v"(ah[10]), "+v"(ah[11]), "+v"(ah[12]), "+v"(ah[13]), "+v"(ah[14]), "+v"(ah[15]) :: "memory");
            asm volatile("" : "+v"(al[0]), "+v"(al[1]), "+v"(al[2]), "+v"(al[3]), "+v"(al[4]), "+v"(al[5]), "+v"(al[6]), "+v"(al[7]), "+v"(al[8]), "+v"(al[9]), "+v"(al[10]), "+v"(al[11]), "+v"(al[12]), "+v"(al[13]), "+v"(al[14]), "+v"(al[15]) :: "memory");
#pragma unroll
            for (int it = 0; it < 16; ++it) A[it] = *(const u32x4*)(Vj + ((unsigned)esn[4 * it + r] * 256u + li));
            asm volatile("" ::: "memory");
            if (STRIP == 1) { for (int gg = 0; gg < 4; ++gg) al[gg] += (int)(B[4 * gg].x ^ B[4 * gg + 1].y ^ B[4 * gg + 2].z ^ B[4 * gg + 3].w ^ chc[(4 + gg) * 4 + r]); } else acc_half_mfma(ah, B, chc + 16, r);
            asm volatile("" : "+v"(ah[0]), "+v"(ah[1]), "+v"(ah[2]), "+v"(ah[3]), "+v"(ah[4]), "+v"(ah[5]), "+v"(ah[6]), "+v"(ah[7]), "+v"(ah[8]), "+v"(ah[9]), "+v"(ah[10]), "+v"(ah[11]), "+v"(ah[12]), "+v"(ah[13]), "+v"(ah[14]), "+v"(ah[15]) :: "memory");
            asm volatile("" : "+v"(al[0]), "+v"(al[1]), "+v"(al[2]), "+v"(al[3]), "+v"(al[4]), "+v"(al[5]), "+v"(al[6]), "+v"(al[7]), "+v"(al[8]), "+v"(al[9]), "+v"(al[10]), "+v"(al[11]), "+v"(al[12]), "+v"(al[13]), "+v"(al[14]), "+v"(al[15]) :: "memory");
#pragma unroll
            for (int it = 0; it < 16; ++it) B[it] = *(const u32x4*)(Vj + ((unsigned)esn[64 + 4 * it + r] * 256u + li));
            asm volatile("" ::: "memory");
            const float sc = ((const LAS float*)(wl + 1536))[pc];
            float acc[16];
#pragma unroll
            for (int q = 0; q < 16; ++q) acc[q] = (float)(ah[q] + (STRIP == 1 ? al[q] : 0)) * sc;
            if (r == 0) {
                bf16_t* zp = zs + (size_t)t * D_ + 256 * j + 16 * i;
                *(u32x4*)zp = (u32x4){pk2(acc[0], acc[1]), pk2(acc[2], acc[3]), pk2(acc[4], acc[5]), pk2(acc[6], acc[7])};
                *(u32x4*)(zp + 8) = (u32x4){pk2(acc[8], acc[9]), pk2(acc[10], acc[11]), pk2(acc[12], acc[13]), pk2(acc[14], acc[15])};
            }
            asm volatile("" ::: "memory");
        }
    }
}
__device__ __forceinline__ void ln2_phase(const bf16_t* h1b, const bf16_t* zs, float* out, const float* gam, const float* bet, int G, int b) {
    const int tid_ = phase_tid(), lane = tid_ & 63, wid = phase_wid(tid_);
    const int gw = b * NWAVES + wid, NGW = G * NWAVES;
    constexpr int R = 1;
    for (int row0 = gw; row0 < S_; row0 += R * NGW) {
        f32x4 v[R][8]; float sum[R], sq[R];
#pragma unroll
        for (int q = 0; q < R; ++q) {
            const int row = min(row0 + q * NGW, S_ - 1);
            sum[q] = 0.f;
#pragma unroll
            for (int j = 0; j < 8; ++j) {
                const u32x2 hw = *(const u32x2*)(h1b + (size_t)row * D_ + 256 * j + 4 * lane), zw = *(const u32x2*)(zs + (size_t)row * D_ + 256 * j + 4 * lane);
                v[q][j] = (f32x4){DN_ALPHA * bflo(hw.x) + bflo(zw.x), DN_ALPHA * bfhi(hw.x) + bfhi(zw.x), DN_ALPHA * bflo(hw.y) + bflo(zw.y), DN_ALPHA * bfhi(hw.y) + bfhi(zw.y)};
                sum[q] += (v[q][j].x + v[q][j].y) + (v[q][j].z + v[q][j].w);
            }
        }
#pragma unroll
        for (int q = 0; q < R; ++q) sum[q] = wave_sum(sum[q]) * (1.0f / D_);
#pragma unroll
        for (int q = 0; q < R; ++q) { sq[q] = 0.f;
#pragma unroll
            for (int j = 0; j < 8; ++j) { v[q][j] = v[q][j] - sum[q]; sq[q] += (v[q][j].x * v[q][j].x + v[q][j].y * v[q][j].y) + (v[q][j].z * v[q][j].z + v[q][j].w * v[q][j].w); } }
#pragma unroll
        for (int q = 0; q < R; ++q) sq[q] = 1.0f / sqrtf(wave_sum(sq[q]) * (1.0f / D_) + LN_EPS);
#pragma unroll
        for (int j = 0; j < 8; ++j) {
            const f32x4 gg = *(const f32x4*)(gam + 256 * j + 4 * lane), bb = *(const f32x4*)(bet + 256 * j + 4 * lane);
#pragma unroll
            for (int q = 0; q < R; ++q) { const int row = row0 + q * NGW; if (row < S_) *(f32x4*)(out + (size_t)row * D_ + 256 * j + 4 * lane) = v[q][j] * sq[q] * gg + bb; }
        }
    }
}
#ifndef PROBE_PHASE
#define PROBE_PHASE -1
#endif
constexpr int LDSCTL_OFF = 163328, MISC_OFF = LDSCTL_OFF;
constexpr int CW_BAR = 1024;
constexpr size_t CTL_ZERO_BYTES = 64 * 1024;
static_assert((CW_BAR + XCD_BAR_WORDS) * 4 <= (int)CTL_ZERO_BYTES && MISC_OFF + 128 <= LDS_BYTES, "control words");

__global__ void __launch_bounds__(NTHREADS, 2) mega_fwd(Ptrs P) {
    extern __shared__ __attribute__((aligned(16))) unsigned char lds_raw[];
    LAS unsigned char* lds = (LAS unsigned char*)lds_raw;
    unsigned char* ws = P.ws;
    const int G = gridDim.x, b = blockIdx.x;
    for (int u = threadIdx.x; u < (LDS_BYTES - LDSCTL_OFF) / 4; u += NTHREADS) ((LAS unsigned*)(lds + LDSCTL_OFF))[u] = 0u;
    __syncthreads();
    volatile LAS unsigned* MISC = (volatile LAS unsigned*)(lds + MISC_OFF);
    XcdBarrier bar; bar.bar = (unsigned*)(ws + WS_CTL) + CW_BAR; bar.x = xb_xcc_id(); bar.st = MISC + 8;
    if (threadIdx.x == 0) MISC[10] = xb_add(&bar.bar[XB_XCNT(bar.x)], 1u);

    bf16_t* const proj = (bf16_t*)(ws + WS_PROJ); float* const gst = (float*)(ws + WS_GST); bf16_t* const ycat = (bf16_t*)(ws + WS_YCAT);
    const float* const cosT = (const float*)(ws + WS_COS); const float* const sinT = (const float*)(ws + WS_SIN);
    float* const sumA = (float*)(ws + WS_SUMA); float* const sumH = (float*)(ws + WS_SUMH); float* const Hin = (float*)(ws + WS_HIN);
    const bf16_t* const wraT = (const bf16_t*)(ws + WS_WRA_T); const bf16_t* const wriT = (const bf16_t*)(ws + WS_WRI_T);

#define NREP(k) ((PROBE_PHASE == (k)) ? 2 : 1)
    for (int r_ = 0; r_ < NREP(0); ++r_) { prologue_phase(lds, P, G, b); xcd_barrier(bar); }
    if (threadIdx.x == 0) { unsigned xi_ = 0; for (unsigned jx = 0; jx < bar.x; ++jx) xi_ += xb_ld(&bar.bar[XB_XCNT(jx)]) > 0u ? 1u : 0u; MISC[11] = xi_; }
    __syncthreads();
    const int x_nloc = __builtin_amdgcn_readfirstlane((int)MISC[8]), x_nx = __builtin_amdgcn_readfirstlane((int)MISC[9]), x_rank = __builtin_amdgcn_readfirstlane((int)MISC[10]), x_xi = __builtin_amdgcn_readfirstlane((int)MISC[11]);
#define RUN_P1 { pg8::Gemm g{(const pg8::bf16_t*)(ws + WS_XB), (const pg8::bf16_t*)(ws + WS_WIN_T), S_, INC, D_}; \
        pg8::StaticOrder S; S.init(S_, INC, G, b); \
        pg8::EpiBf16<0> E{(pg8::bf16_t*)proj, INC, nullptr, 0, 0, 1.f}; \
        pg8::gemm_phase<pg8::EpiBf16<0>, pg8::StaticOrder, true, true>(lds, g, S, E); \
        xcd_barrier(bar); }
    RUN_P1
#if PROBE_PHASE == 1
    RUN_P1
#endif
    for (int r2_ = 0; r2_ < NREP(22); ++r2_) {
    for (int r_ = 0; r_ < NREP(2); ++r_) { ret_r1_phase(lds, proj, cosT, sinT, gst, G, b); if (PROBE_PHASE >= 0) xcd_barrier(bar); }
    for (int r_ = 0; r_ < NREP(3); ++r_) { lru_phase<0>(lds, proj, P, wraT, wriT, sumA, sumH, Hin, ycat, G, b); xcd_barrier(bar); }
    scan_phase(lds, gst, sumA, sumH, Hin, G, b);
    xcd_barrier(bar);
    }
    for (int r_ = 0; r_ < NREP(4); ++r_) { ret_r3_phase(lds, proj, cosT, sinT, gst, ycat, G, b); if (PROBE_PHASE >= 0) xcd_barrier(bar); }
    for (int r_ = 0; r_ < NREP(5); ++r_) { lru_phase<1>(lds, proj, P, wraT, wriT, sumA, sumH, Hin, ycat, G, b); xcd_barrier(bar); }
#define RUN_P3 { pg8::Gemm g{(const pg8::bf16_t*)ycat, (const pg8::bf16_t*)(ws + WS_WOUT_T), S_, D_, D_}; \
        pg8::StaticOrder S; S.init(S_, D_, G, b); \
        pg8::EpiResBf16 E{(const pg8::bf16_t*)(ws + WS_XB), (pg8::bf16_t*)(ws + WS_Z1B), D_, DN_ALPHA}; \
        pg8::gemm_phase<pg8::EpiResBf16, pg8::StaticOrder, true, true>(lds, g, S, E); \
        xcd_barrier(bar); }
    RUN_P3
#if PROBE_PHASE == 6
    RUN_P3
#endif
    ln1_phase((const bf16_t*)(ws + WS_Z1B), (bf16_t*)(ws + WS_H1B), (unsigned*)(ws + WS_XQ), (float*)(ws + WS_SX), P.ln1_g, P.ln1_b, G, b);
    xcd_barrier(bar);
#if PROBE_PHASE == 67
    ln1_phase((const bf16_t*)(ws + WS_Z1B), (bf16_t*)(ws + WS_H1B), (unsigned*)(ws + WS_XQ), (float*)(ws + WS_SX), P.ln1_g, P.ln1_b, G, b);
    xcd_barrier(bar);
#endif
#if PROBE_PHASE == 66
    RUN_P3
    ln1_phase((const bf16_t*)(ws + WS_Z1B), (bf16_t*)(ws + WS_H1B), (unsigned*)(ws + WS_XQ), (float*)(ws + WS_SX), P.ln1_g, P.ln1_b, G, b);
    xcd_barrier(bar);
#endif
#define RUN_P5 { pg8::Gemm g{(const pg8::bf16_t*)(ws + WS_H1B), (const pg8::bf16_t*)(ws + WS_WPQ_T), S_, D_, D_}; \
        pg8::StaticOrder S; S.init(S_, D_, G, b); \
        pg8::EpiBf16<0> E{(pg8::bf16_t*)(ws + WS_QP), D_, nullptr, 0, 0, 1.f}; \
        pg8::gemm_phase<pg8::EpiBf16<0>, pg8::StaticOrder, true, true>(lds, g, S, E); \
        if (PROBE_PHASE >= 0) xcd_barrier(bar); else { asm volatile("s_waitcnt vmcnt(0)" ::: "memory"); __syncthreads(); } }
    RUN_P5
#if PROBE_PHASE == 7
    RUN_P5
#endif
    for (int r_ = 0; r_ < NREP(8); ++r_) { topk_phase(lds, (const bf16_t*)(ws + WS_QP), (const bf16_t*)(ws + WS_KEYS), (const float*)(ws + WS_SU), (const float*)(ws + WS_SV), (int*)(ws + WS_SELE), (float*)(ws + WS_SELG), (float*)(ws + WS_SELU), G, b); xcd_barrier(bar); }
    for (int r_ = 0; r_ < NREP(9); ++r_) { peer_u_phase<0x3FFF>(lds, (const unsigned char*)(ws + WS_UQ), (const unsigned char*)(ws + WS_XQ), (const int*)(ws + WS_SELE), (int*)(ws + WS_PD), x_xi, x_nx, x_rank, x_nloc); xcd_barrier(bar); }
#if PROBE_PHASE == 15 || PROBE_PHASE == 16
    peer_u_phase<(PROBE_PHASE == 15 ? 0x1FFF : 0x0FFF)>(lds, (const unsigned char*)(ws + WS_UQ), (const unsigned char*)(ws + WS_XQ), (const int*)(ws + WS_SELE), (int*)(ws + 248 * MiB), x_xi, x_nx, x_rank, x_nloc); xcd_barrier(bar);
#endif
    for (int r_ = 0; r_ < NREP(13); ++r_) { peer_coef_phase((const float*)(ws + WS_SELG), (const float*)(ws + WS_SELU), (const int*)(ws + WS_PD), (const float*)(ws + WS_SX), (float*)(ws + WS_COEF), G, b); xcd_barrier(bar); }
    for (int r_ = 0; r_ < NREP(10); ++r_) { peer_v_phase<0>(lds, (const unsigned char*)(ws + WS_VQ), (const int*)(ws + WS_SELE), (const float*)(ws + WS_COEF),
                     (bf16_t*)(ws + WS_ZS), x_xi, x_nx, x_rank, x_nloc); xcd_barrier(bar); }
#if PROBE_PHASE == 12 || PROBE_PHASE == 14
    peer_v_phase<(PROBE_PHASE == 12 ? 1 : 2)>(lds, (const unsigned char*)(ws + WS_VQ), (const int*)(ws + WS_SELE), (const float*)(ws + WS_COEF),
                     (bf16_t*)(ws + 248 * MiB), x_xi, x_nx, x_rank, x_nloc); xcd_barrier(bar);
#endif
#if PROBE_PHASE == 90
    for (int r_ = 0; r_ < 10; ++r_) xcd_barrier(bar);
#endif
    for (int r_ = 0; r_ < NREP(11); ++r_) ln2_phase((const bf16_t*)(ws + WS_H1B), (const bf16_t*)(ws + WS_ZS), P.out, P.ln2_g, P.ln2_b, G, b);
}

extern "C" void kernel_launch(void* const* d_in, const int* in_sizes, int n_in, void* d_out, int out_size, void* d_ws, size_t ws_size, hipStream_t stream) {
    static int grid = 0;
    if (grid == 0) {
        if (n_in != 19 || in_sizes[0] != S_ * D_ || out_size != S_ * D_ || ws_size < WS_END) {
            fprintf(stderr, "kernel_launch: unexpected shapes: n_in %d in0 %d out %d ws %zu (need >= %zu)\n", n_in, n_in > 0 ? in_sizes[0] : -1, out_size, ws_size, (size_t)WS_END); grid = -1; return; }
        int dev = 0, cus = 0, per_cu = 0;
        if (hipGetDevice(&dev) != hipSuccess || hipDeviceGetAttribute(&cus, hipDeviceAttributeMultiprocessorCount, dev) != hipSuccess) { grid = -1; return; }
        if (hipFuncSetAttribute((const void*)mega_fwd, hipFuncAttributeMaxDynamicSharedMemorySize, LDS_BYTES) != hipSuccess) { fprintf(stderr, "kernel_launch: hipFuncSetAttribute failed\n"); grid = -1; return; }
        if (hipOccupancyMaxActiveBlocksPerMultiprocessor(&per_cu, (const void*)mega_fwd, NTHREADS, LDS_BYTES) != hipSuccess || per_cu < 1) {
            fprintf(stderr, "kernel_launch: occupancy query reports %d workgroups per CU; nothing launched\n", per_cu); (void)hipGetLastError(); grid = -1; return; }
        grid = cus;
    }
    if (grid < 0) return;
    Ptrs P{};
    P.x = (const float*)d_in[0]; P.pos = (const int*)d_in[1]; P.w_in = (const float*)d_in[2]; P.w_out = (const float*)d_in[3]; P.conv_w = (const float*)d_in[4]; P.conv_b = (const float*)d_in[5];
    P.w_ra = (const float*)d_in[6]; P.b_ra = (const float*)d_in[7]; P.w_ri = (const float*)d_in[8]; P.b_ri = (const float*)d_in[9]; P.lam = (const float*)d_in[10];
    P.ln1_g = (const float*)d_in[11]; P.ln1_b = (const float*)d_in[12]; P.w_pq = (const float*)d_in[13]; P.sub_keys = (const float*)d_in[14]; P.peer_u = (const float*)d_in[15]; P.peer_v = (const float*)d_in[16];
    P.ln2_g = (const float*)d_in[17]; P.ln2_b = (const float*)d_in[18]; P.out = (float*)d_out; P.ws = (unsigned char*)d_ws;
    if (hipMemsetAsync((char*)d_ws + WS_CTL, 0, CTL_ZERO_BYTES, stream) != hipSuccess) { fprintf(stderr, "kernel_launch: hipMemsetAsync failed\n"); return; }
    void* args[] = {&P};
    const hipError_t e = hipLaunchCooperativeKernel((const void*)mega_fwd, dim3(grid), dim3(NTHREADS), args, LDS_BYTES, stream);
    if (e != hipSuccess) fprintf(stderr, "kernel_launch: cooperative launch failed: %s (grid %d)\n", hipGetErrorString(e), grid);
}
```

```cpp
#include <hip/hip_runtime.h>
#include <cstdio>
#include <cstdint>
#include <cmath>

namespace pg8 {
#define PG8_LAS __attribute__((address_space(3)))
typedef unsigned short bf16_t;
typedef short bf16x8 __attribute__((ext_vector_type(8)));
typedef float f32x4 __attribute__((ext_vector_type(4)));
typedef unsigned u32x4 __attribute__((ext_vector_type(4)));
constexpr int BM = 256, BK = 64, HALF = 128, HTB = HALF * BK * 2  , STAGE_BYTES = 8 * HTB, NXCD = 8, WGM = 8;

__host__ __device__ __forceinline__ int lds_byte(int r, int c) { const int st = (r >> 4) * 2 + (c >> 5), rr = r & 15, cc = c & 31, ob = rr * 64 + cc * 2; return st * 1024 + (ob ^ (((ob >> 9) & 1) << 5)); }
__host__ __device__ __forceinline__ void stage_rc(int b, int& R, int& C) { const int st = b / 1024, sb = b % 1024, swz = sb ^ (((sb >> 9) & 1) << 5); R = (st >> 1) * 16 + swz / 64; C = (st & 1) * 32 + (swz % 64) / 2; }
__host__ __device__ __forceinline__ int perm32(int rho) { const int n = rho >> 4, i = rho & 15; return 8 * (i >> 2) + 4 * n + (i & 3); }

struct Unit { int pm, pn; };
struct Gemm { const bf16_t* A; const bf16_t* Bt; int M, N, K; };

struct StaticOrder {
    int nM, nN, nwg, G, c;
    __host__ __device__ void init(int M, int N, int G_, int c_) { nM = M / BM; nN = N / BM; nwg = nM * nN; G = G_; c = c_; }
    __host__ __device__ bool next(int i, Unit& u) const {
        const long L = (long)i * G + c; if (L >= nwg) return false;
        int wgid = (int)L; { const int q = nwg / NXCD, r = nwg % NXCD, xcd = wgid % NXCD, off = wgid / NXCD; wgid = (xcd < r ? xcd * (q + 1) : r * (q + 1) + (xcd - r) * q) + off; }
        const int nig = WGM * nN, gid = wgid / nig, fm = gid * WGM, gsz = (nM - fm) < WGM ? (nM - fm) : WGM;
        u.pm = fm + ((wgid % nig) % gsz); u.pn = (wgid % nig) / gsz; return true;
    }
    __device__ __forceinline__ void a_ready(const Unit&) const {}
    __device__ __forceinline__ void done(const Unit&) const {}
};

__device__ __forceinline__ unsigned cvt_pk_bf16(float lo, float hi) { unsigned r; asm volatile("v_cvt_pk_bf16_f32 %0, %1, %2" : "=v"(r) : "v"(lo), "v"(hi)); return r; }
typedef float f32x2 __attribute__((ext_vector_type(2)));
__device__ __forceinline__ f32x2 gelu_pk(f32x2 v) {
    const f32x2 av = __builtin_elementwise_abs(v), d = av * 0.2316418882f + 1.0f;
    f32x2 t; t.x = __builtin_amdgcn_rcpf(d.x); t.y = __builtin_amdgcn_rcpf(d.y);
    f32x2 q = t * 0.5307027145f + (-0.7265760135f); q = q * t + 0.7107068705f; q = q * t + (-0.142248368f); q = q * t + 0.127414796f; q = q * t;
    const f32x2 s = (v * v) * (-0.72134752044f);
    f32x2 e; e.x = __builtin_amdgcn_exp2f(s.x); e.y = __builtin_amdgcn_exp2f(s.y);
    const f32x2 m = v * (q * e), r = v - m;
    f32x2 o; o.x = v.x < 0.f ? m.x : r.x; o.y = v.y < 0.f ? m.y : r.y; return o;
}

template <int ACT  > struct EpiBf16 {
    static constexpr bool PERM = true, AFTER_DRAIN = false; static_assert(ACT == 0 || ACT == 1, "EpiBf16: ACT is 0 (none) or 1 (gelu_pk)");
    bf16_t* O; int ldc; const float* bias; int split_cols; size_t split_stride; float scale0;
    __device__ __forceinline__ void operator()(const f32x4 (&acc)[2][2][4][2], const Unit& u, int wr, int wc, int fr, int fq) const {
        const int row0 = u.pm * BM + wr * 64 + fr; int colt = u.pn * BM; bf16_t* base = O;
        float sc = 1.f; if (split_cols) { const int t = colt / split_cols; base += (size_t)t * split_stride; colt -= t * split_cols; if (t == 0) sc = scale0; }
        const int col0 = colt + wc * 32 + 8 * fq, bcol0 = u.pn * BM + wc * 32 + 8 * fq;
        f32x4 bv[2][2];
#pragma unroll
        for (int bj = 0; bj < 2; ++bj)
#pragma unroll
            for (int n = 0; n < 2; ++n) bv[bj][n] = bias ? *(const f32x4*)(bias + bcol0 + bj * HALF + 4 * n) : (f32x4){0.f, 0.f, 0.f, 0.f};
#pragma unroll
        for (int ai = 0; ai < 2; ++ai)
#pragma unroll
            for (int m = 0; m < 4; ++m) { bf16_t* rowp = base + (size_t)(row0 + ai * HALF + m * 16) * ldc + col0;
#pragma unroll
                for (int bj = 0; bj < 2; ++bj) { f32x4 v0 = acc[ai][bj][m][0] + bv[bj][0], v1 = acc[ai][bj][m][1] + bv[bj][1];
                    if (ACT == 1) { f32x2 a = gelu_pk((f32x2){v0[0], v0[1]}), b = gelu_pk((f32x2){v0[2], v0[3]}), c = gelu_pk((f32x2){v1[0], v1[1]}), d = gelu_pk((f32x2){v1[2], v1[3]});
                        v0 = (f32x4){a.x, a.y, b.x, b.y}; v1 = (f32x4){c.x, c.y, d.x, d.y}; }
                    v0 = v0 * sc; v1 = v1 * sc; u32x4 w; w.x = cvt_pk_bf16(v0[0], v0[1]); w.y = cvt_pk_bf16(v0[2], v0[3]); w.z = cvt_pk_bf16(v1[0], v1[1]); w.w = cvt_pk_bf16(v1[2], v1[3]);
                    *(u32x4*)(rowp + bj * HALF) = w; } }
    }
};
struct EpiResF32 {
    static constexpr bool PERM = false, AFTER_DRAIN = false;
    const float* base; float* out; int ldc; float alpha;
    __device__ __forceinline__ void operator()(const f32x4 (&acc)[2][2][4][2], const Unit& u, int wr, int wc, int fr, int fq) const {
        const int row0 = u.pm * BM + wr * 64 + fr, col0 = u.pn * BM + wc * 32 + 4 * fq;
#pragma unroll
        for (int ai = 0; ai < 2; ++ai)
#pragma unroll
            for (int m = 0; m < 4; ++m) { const size_t off = (size_t)(row0 + ai * HALF + m * 16) * ldc + col0;
#pragma unroll
                for (int bj = 0; bj < 2; ++bj)
#pragma unroll
                    for (int n = 0; n < 2; ++n) { const f32x4 bs = *(const f32x4*)(base + off + bj * HALF + n * 16); *(f32x4*)(out + off + bj * HALF + n * 16) = bs * alpha + acc[ai][bj][m][n]; }
                asm volatile("" ::: "memory"); }
    }
};

struct EpiResBf16 {
    static constexpr bool PERM = true, AFTER_DRAIN = false;
    const bf16_t* base; bf16_t* O; int ldc; float alpha;
    __device__ __forceinline__ void operator()(const f32x4 (&acc)[2][2][4][2], const Unit& u, int wr, int wc, int fr, int fq) const {
        const int row0 = u.pm * BM + wr * 64 + fr, col0 = u.pn * BM + wc * 32 + 8 * fq;
#pragma unroll
        for (int ai = 0; ai < 2; ++ai)
#pragma unroll
            for (int m = 0; m < 4; ++m) { const size_t off = (size_t)(row0 + ai * HALF + m * 16) * ldc + col0;
#pragma unroll
                for (int bj = 0; bj < 2; ++bj) {
                    const u32x4 bw = *(const u32x4*)(base + off + bj * HALF);
                    const f32x4 b0 = (f32x4){__uint_as_float(bw.x << 16), __uint_as_float(bw.x & 0xffff0000u), __uint_as_float(bw.y << 16), __uint_as_float(bw.y & 0xffff0000u)};
                    const f32x4 b1 = (f32x4){__uint_as_float(bw.z << 16), __uint_as_float(bw.z & 0xffff0000u), __uint_as_float(bw.w << 16), __uint_as_float(bw.w & 0xffff0000u)};
                    const f32x4 v0 = b0 * alpha + acc[ai][bj][m][0], v1 = b1 * alpha + acc[ai][bj][m][1];
                    u32x4 w; w.x = cvt_pk_bf16(v0[0], v0[1]); w.y = cvt_pk_bf16(v0[2], v0[3]); w.z = cvt_pk_bf16(v1[0], v1[1]); w.w = cvt_pk_bf16(v1[2], v1[3]);
                    *(u32x4*)(O + off + bj * HALF) = w; }
                asm volatile("" ::: "memory"); }
    }
};
template <class Epi, class Sched, bool ALIGN_EPI = false, bool SP2 = false>
__device__ __forceinline__ void gemm_phase(PG8_LAS unsigned char* lds, const Gemm g, const Sched& S, const Epi& E) {
    const int tid = threadIdx.x, wid = __builtin_amdgcn_readfirstlane(tid >> 6), lane = tid & 63, wr = wid >> 2, wc = wid & 3, fr = lane & 15, fq = lane >> 4;
    const int K = g.K, nt = K / BK;
    unsigned voffA[2], voffB[2];
#pragma unroll
    for (int i = 0; i < 2; ++i) { int R, C; stage_rc(tid * 16 + i * 8192, R, C); const int Rb = Epi::PERM ? ((R & ~31) + perm32(R & 31)) : R;
        voffA[i] = (unsigned)(R * K + C) * 2u; voffB[i] = (unsigned)(Rb * K + C) * 2u; }
    const size_t kstep = (size_t)(BK * 2);
    const size_t hstep = (size_t)HALF * K * 2;
    const size_t tstep = 2 * hstep;
    const unsigned ldsw = (unsigned)wid * 1024u;
    const int aoff = lds_byte(wr * 64 + fr, fq * 8), boff = lds_byte(wc * 32 + fr, fq * 8);
#define PG8_SA(b, h) (((b) * 2 + (h)) * HTB)
#define PG8_SB(b, h) ((4 + (b) * 2 + (h)) * HTB)
#define PG8_STAGE(bufoff, gbase, voff) do { _Pragma("unroll") for (int _i = 0; _i < 2; ++_i) \
        __builtin_amdgcn_global_load_lds((const unsigned*)((const char*)(gbase) + (voff)[_i]), (PG8_LAS unsigned*)(lds + (bufoff) + ldsw + _i * 8192), 16, 0, 0); } while (0)
#define PG8_LDA(dst, b, h) do { _Pragma("unroll") for (int m = 0; m < 4; ++m) _Pragma("unroll") for (int k = 0; k < 2; ++k) dst[m][k] = *(const PG8_LAS bf16x8*)(lds + PG8_SA(b, h) + aoff + m * 2048 + k * 1024); } while (0)
#define PG8_LDB(dst, b, h) do { _Pragma("unroll") for (int n = 0; n < 2; ++n) _Pragma("unroll") for (int k = 0; k < 2; ++k) dst[n][k] = *(const PG8_LAS bf16x8*)(lds + PG8_SB(b, h) + boff + n * 2048 + k * 1024); } while (0)
#define PG8_MMA(ai, bj, At, Bt) do { __builtin_amdgcn_s_setprio(1); _Pragma("unroll") for (int m = 0; m < 4; ++m) _Pragma("unroll") for (int n = 0; n < 2; ++n) _Pragma("unroll") for (int k = 0; k < 2; ++k) \
        acc[ai][bj][m][n] = __builtin_amdgcn_mfma_f32_16x16x32_bf16(Bt[n][k], At[m][k], acc[ai][bj][m][n], 0, 0, 0); __builtin_amdgcn_s_setprio(0); } while (0)
#define PG8_WAIT_V(n) asm volatile("s_waitcnt vmcnt(" #n ")" ::: "memory")
#define PG8_WAIT_L(n) asm volatile("s_waitcnt lgkmcnt(" #n ")" ::: "memory")
#define PG8_BAR __builtin_amdgcn_s_barrier()
#define PG8_SCHED __builtin_amdgcn_sched_barrier(0)
    Unit cur, nxt; int ui = 0;
    if (!S.next(0, cur)) return;
    f32x4 acc[2][2][4][2];
#pragma unroll
    for (int a = 0; a < 2; ++a)
#pragma unroll
        for (int b = 0; b < 2; ++b)
#pragma unroll
            for (int m = 0; m < 4; ++m)
#pragma unroll
                for (int n = 0; n < 2; ++n) acc[a][b][m][n] = (f32x4){0.f, 0.f, 0.f, 0.f};
    bf16x8 At[4][2], B0[2][2], B1[2][2];
    const char* cA = (const char*)g.A + (size_t)cur.pm * tstep; const char* cB = (const char*)g.Bt + (size_t)cur.pn * tstep;
    S.a_ready(cur);
    if constexpr (SP2) {
        PG8_STAGE(PG8_SB(0, 0), cB, voffB); PG8_STAGE(PG8_SB(0, 1), cB + hstep, voffB); PG8_STAGE(PG8_SA(0, 0), cA, voffA); PG8_STAGE(PG8_SA(0, 1), cA + hstep, voffA);
        if (wr == 1) PG8_BAR;
        PG8_WAIT_V(2); PG8_BAR;
        PG8_STAGE(PG8_SB(1, 0), cB + kstep, voffB); PG8_STAGE(PG8_SA(1, 0), cA + kstep, voffA); PG8_STAGE(PG8_SB(1, 1), cB + hstep + kstep, voffB);
        PG8_WAIT_V(6); PG8_BAR;
    } else {
        PG8_STAGE(PG8_SB(0, 0), cB, voffB); PG8_STAGE(PG8_SA(0, 0), cA, voffA); PG8_STAGE(PG8_SB(0, 1), cB + hstep, voffB); PG8_STAGE(PG8_SA(0, 1), cA + hstep, voffA);
        if (wr == 1) PG8_BAR;
        PG8_WAIT_V(4); PG8_BAR;
        PG8_STAGE(PG8_SB(1, 0), cB + kstep, voffB); PG8_STAGE(PG8_SA(1, 0), cA + kstep, voffA); PG8_STAGE(PG8_SB(1, 1), cB + hstep + kstep, voffB);
        PG8_WAIT_V(6); PG8_BAR;
    }
    for (;;) {
        const bool has_next = S.next(ui + 1, nxt);
        const char* nA = has_next ? (const char*)g.A + (size_t)nxt.pm * tstep : cA; const char* nB = has_next ? (const char*)g.Bt + (size_t)nxt.pn * tstep : cB;
        for (int t = 0; t < nt; t += 2) {
            const bool last = (t == nt - 2);
            const char* a1 = cA + (size_t)(t + 1) * kstep;
            const char* a2 = last ? nA : cA + (size_t)(t + 2) * kstep; const char* b2 = last ? nB : cB + (size_t)(t + 2) * kstep;
            const char* a3 = a2 + kstep; const char* b3 = b2 + kstep;
            if (last && has_next) S.a_ready(nxt);
            if constexpr (SP2) {
            PG8_LDB(B0, 0, 0); PG8_LDB(B1, 0, 1); PG8_SCHED; PG8_LDA(At, 0, 0); PG8_STAGE(PG8_SA(1, 1), a1 + hstep, voffA);
            PG8_WAIT_V(8); PG8_WAIT_L(0); PG8_BAR; PG8_MMA(0, 0, At, B0); PG8_MMA(0, 1, At, B1); PG8_BAR; PG8_SCHED;
            PG8_LDA(At, 0, 1); PG8_STAGE(PG8_SB(0, 0), b2, voffB); PG8_STAGE(PG8_SB(0, 1), b2 + hstep, voffB); PG8_STAGE(PG8_SA(0, 0), a2, voffA);
            PG8_WAIT_V(8); PG8_WAIT_L(0); PG8_BAR; PG8_MMA(1, 0, At, B0); PG8_MMA(1, 1, At, B1); PG8_BAR; PG8_SCHED;
            PG8_LDB(B0, 1, 0); PG8_LDB(B1, 1, 1); PG8_SCHED; PG8_LDA(At, 1, 0); PG8_STAGE(PG8_SA(0, 1), a2 + hstep, voffA);
            PG8_WAIT_V(8); PG8_WAIT_L(0); PG8_BAR; PG8_MMA(0, 0, At, B0); PG8_MMA(0, 1, At, B1); PG8_BAR; PG8_SCHED;
            PG8_LDA(At, 1, 1); PG8_STAGE(PG8_SB(1, 0), b3, voffB); PG8_STAGE(PG8_SB(1, 1), b3 + hstep, voffB); PG8_STAGE(PG8_SA(1, 0), a3, voffA);
            PG8_WAIT_V(8); PG8_WAIT_L(0); PG8_BAR; PG8_MMA(1, 0, At, B0); PG8_MMA(1, 1, At, B1); PG8_BAR; PG8_SCHED;
            } else {
            PG8_LDB(B0, 0, 0); PG8_SCHED; PG8_LDA(At, 0, 0); PG8_STAGE(PG8_SA(1, 1), a1 + hstep, voffA);
            PG8_WAIT_L(8); PG8_BAR; PG8_WAIT_L(0); PG8_MMA(0, 0, At, B0); PG8_BAR; PG8_SCHED;
            PG8_LDB(B1, 0, 1); PG8_STAGE(PG8_SB(0, 0), b2, voffB);
            PG8_BAR; PG8_WAIT_L(0); PG8_MMA(0, 1, At, B1); PG8_BAR;
            PG8_LDA(At, 0, 1); PG8_STAGE(PG8_SA(0, 0), a2, voffA);
            PG8_BAR; PG8_WAIT_L(0); PG8_MMA(1, 0, At, B0); PG8_BAR; PG8_SCHED;
            PG8_STAGE(PG8_SB(0, 1), b2 + hstep, voffB);
            PG8_WAIT_V(6); PG8_BAR; PG8_MMA(1, 1, At, B1); PG8_BAR;
            PG8_LDB(B0, 1, 0); PG8_SCHED; PG8_LDA(At, 1, 0); PG8_STAGE(PG8_SA(0, 1), a2 + hstep, voffA);
            PG8_WAIT_L(8); PG8_BAR; PG8_WAIT_L(0); PG8_MMA(0, 0, At, B0); PG8_BAR; PG8_SCHED;
            PG8_LDB(B1, 1, 1); PG8_STAGE(PG8_SB(1, 0), b3, voffB);
            PG8_BAR; PG8_WAIT_L(0); PG8_MMA(0, 1, At, B1); PG8_BAR;
            PG8_LDA(At, 1, 1); PG8_STAGE(PG8_SA(1, 0), a3, voffA);
            PG8_BAR; PG8_WAIT_L(0); PG8_MMA(1, 0, At, B0); PG8_BAR; PG8_SCHED;
            PG8_STAGE(PG8_SB(1, 1), b3 + hstep, voffB);
            PG8_WAIT_V(6); PG8_BAR; PG8_MMA(1, 1, At, B1); PG8_BAR;
            }
        }
        if constexpr (ALIGN_EPI) { if (wr == 0) PG8_BAR; }
        if constexpr (!Epi::AFTER_DRAIN) { E(acc, cur, wr, wc, fr, fq); S.done(cur); }
        if (!has_next) break;
#pragma unroll
        for (int a = 0; a < 2; ++a)
#pragma unroll
            for (int b = 0; b < 2; ++b)
#pragma unroll
                for (int m = 0; m < 4; ++m)
#pragma unroll
                    for (int n = 0; n < 2; ++n) acc[a][b][m][n] = (f32x4){0.f, 0.f, 0.f, 0.f};
        cur = nxt; cA = nA; cB = nB; ++ui;
        if constexpr (ALIGN_EPI) { if (wr == 1) PG8_BAR; }
    }
    PG8_WAIT_V(0);
    if constexpr (!ALIGN_EPI) { if (wr == 0) PG8_BAR; }
    PG8_BAR;
    if constexpr (Epi::AFTER_DRAIN) { E.fused(acc, cur, wr, wc, fr, fq, lds, wid, lane); S.done(cur); }
#undef PG8_SA
#undef PG8_SB
#undef PG8_STAGE
#undef PG8_LDA
#undef PG8_LDB
#undef PG8_MMA
#undef PG8_WAIT_V
#undef PG8_WAIT_L
#undef PG8_BAR
#undef PG8_SCHED
}
}
constexpr int S_ = 16384, D_ = 2048, INC = 6144, NH = 8, DH = 128, CH = 64, NCH = 256;
constexpr float DN_ALPHA = 1.189207115002721f;
constexpr float LN_EPS = 1e-5f, GN_EPS = 1e-6f;
constexpr int NWAVES = 8, NTHREADS = 512;
constexpr int LDS_BYTES = 163840;

constexpr size_t MiB = 1u << 20;
constexpr size_t WS_CTL = 0;
constexpr size_t WS_WOUT_T = 1 * MiB, WS_WPQ_T = 9 * MiB, WS_KEYS = 17 * MiB, WS_WRA_T = 17 * MiB + 512 * 1024, WS_WRI_T = 17 * MiB + 768 * 1024;
constexpr size_t WS_COS = 18 * MiB, WS_SIN = 22 * MiB, WS_SUMA = 26 * MiB, WS_SUMH = 27 * MiB, WS_HIN = 28 * MiB;
constexpr size_t WS_SU = 29 * MiB, WS_SV = 30 * MiB;
constexpr size_t WS_SX = 31 * MiB;
constexpr size_t WS_UQ = 32 * MiB, WS_VQ = 64 * MiB;
constexpr size_t WS_XQ = 96 * MiB;
constexpr size_t WS_PD = 328 * MiB, WS_ZS = 392 * MiB;
constexpr size_t WS_WIN_T = 160 * MiB, WS_XB = 184 * MiB, WS_GST = 160 * MiB, WS_H1B = 184 * MiB;
constexpr size_t WS_PROJ = 248 * MiB, WS_QP = 248 * MiB, WS_SELE = 312 * MiB, WS_SELG = 320 * MiB, WS_SELU = 456 * MiB, WS_COEF = 464 * MiB;
constexpr size_t WS_Z1B = 376 * MiB;
constexpr size_t WS_YCAT = 440 * MiB, WS_END = 504 * MiB;

#define LAS __attribute__((address_space(3)))
typedef unsigned short bf16_t;
typedef short bf16x8 __attribute__((ext_vector_type(8)));
typedef float f32x4 __attribute__((ext_vector_type(4)));
typedef unsigned u32x4 __attribute__((ext_vector_type(4)));
typedef unsigned u32x2 __attribute__((ext_vector_type(2)));

__device__ __forceinline__ unsigned f2bf(float f) { unsigned u = __float_as_uint(f); return (u + 0x7fffu + ((u >> 16) & 1u)) >> 16; }
__device__ __forceinline__ unsigned pk2(float lo, float hi) { return f2bf(lo) | (f2bf(hi) << 16); }
__device__ __forceinline__ float bflo(unsigned w) { return __uint_as_float(w << 16); }
__device__ __forceinline__ float bfhi(unsigned w) { return __uint_as_float(w & 0xffff0000u); }
__device__ __forceinline__ float bf2f(bf16_t b) { return __uint_as_float(((unsigned)b) << 16); }
__device__ __forceinline__ f32x4 mfma16(bf16x8 a, bf16x8 b, f32x4 c) { return __builtin_amdgcn_mfma_f32_16x16x32_bf16(a, b, c, 0, 0, 0); }
__device__ __forceinline__ float fexp_(float x) { return __builtin_amdgcn_exp2f(x * 1.4426950408889634f); }
__device__ __forceinline__ float sigmoidf_(float x) { return __builtin_amdgcn_rcpf(1.0f + fexp_(-x)); }
__device__ __forceinline__ float gelu_tanh(float x) { const float y = 0.7978845608028654f * (x + 0.044715f * x * x * x); return x * __builtin_amdgcn_rcpf(1.0f + fexp_(-2.0f * y)); }
__device__ __forceinline__ float wave_sum(float v) {
#pragma unroll
    for (int o = 1; o < 64; o <<= 1) v += __shfl_xor(v, o);
    return v;
}
__device__ __forceinline__ float wave_max(float v) {
#pragma unroll
    for (int o = 1; o < 64; o <<= 1) v = fmaxf(v, __shfl_xor(v, o));
    return v;
}
__device__ __forceinline__ int wave_sum_i(int v) {
#pragma unroll
    for (int o = 1; o < 64; o <<= 1) v += __shfl_xor(v, o);
    return v;
}
__device__ __forceinline__ int phase_tid() { int t = (int)threadIdx.x; asm volatile("" : "+v"(t)); return t; }
__device__ __forceinline__ int phase_wid(int tid) { return __builtin_amdgcn_readfirstlane(tid >> 6); }
__device__ __forceinline__ float head_log_gamma(int h) { return logf(1.0f - exp2f(-5.0f - (float)h)); }

__device__ __forceinline__ void transpose_item(const float* W, int K, int N, bf16_t* WT, LAS float* scr, int item, int lane) {
    const int nblk = N / 32, kb = item / nblk, nb = item % nblk, k0 = 64 * kb, n0 = 32 * nb;
    float tv[32];
#pragma unroll
    for (int i = 0; i < 32; ++i) { const int kk = 2 * i + (lane >> 5); tv[i] = W[(size_t)(k0 + kk) * N + n0 + (lane & 31)]; }
#pragma unroll
    for (int i = 0; i < 32; ++i) { const int kk = 2 * i + (lane >> 5); scr[kk * 33 + (lane & 31)] = tv[i]; }
    asm volatile("s_waitcnt lgkmcnt(0)" ::: "memory");
    const int c = lane & 7;
#pragma unroll
    for (int j = 0; j < 4; ++j) { const int n = (lane >> 3) + 8 * j; const LAS float* s = scr + (8 * c) * 33 + n;
        u32x4 o; o.x = pk2(s[0 * 33], s[1 * 33]); o.y = pk2(s[2 * 33], s[3 * 33]); o.z = pk2(s[4 * 33], s[5 * 33]); o.w = pk2(s[6 * 33], s[7 * 33]);
        *(u32x4*)(WT + (size_t)(n0 + n) * K + k0 + 8 * c) = o; }
    asm volatile("s_waitcnt lgkmcnt(0)" ::: "memory");
}
__device__ __forceinline__ void cvt_stream(const float* src, bf16_t* dst, size_t n8, size_t gtid, size_t gthreads) {
    size_t i = gtid;
    for (; i + 3 * gthreads < n8; i += 4 * gthreads) {
        f32x4 a[4], b[4];
#pragma unroll
        for (int u = 0; u < 4; ++u) { a[u] = __builtin_nontemporal_load((const f32x4*)src + 2 * (i + u * gthreads)); b[u] = __builtin_nontemporal_load((const f32x4*)src + 2 * (i + u * gthreads) + 1); }
#pragma unroll
        for (int u = 0; u < 4; ++u) { u32x4 o; o.x = pk2(a[u].x, a[u].y); o.y = pk2(a[u].z, a[u].w); o.z = pk2(b[u].x, b[u].y); o.w = pk2(b[u].z, b[u].w); ((u32x4*)dst)[i + u * gthreads] = o; }
    }
    for (; i < n8; i += gthreads) {
        const f32x4 a = ((const f32x4*)src)[2 * i], b = ((const f32x4*)src)[2 * i + 1];
        u32x4 o; o.x = pk2(a.x, a.y); o.y = pk2(a.z, a.w); o.z = pk2(b.x, b.y); o.w = pk2(b.z, b.w);
        ((u32x4*)dst)[i] = o;
    }
}
struct QRow { f32x4 v[8]; };
__device__ __forceinline__ void quant_issue(QRow& q, const float* table, int e, int lane) {
    const float* rp = table + (size_t)e * D_;
#pragma unroll
    for (int j = 0; j < 8; ++j) q.v[j] = __builtin_nontemporal_load((const f32x4*)(rp + 256 * j + 4 * lane));
}
template <int ISV>
__device__ __forceinline__ void quant_finish(const QRow& q, unsigned char* qtab, float* scales, int e, int lane) {
    float amax = 0.f;
#pragma unroll
    for (int j = 0; j < 8; ++j) amax = fmaxf(amax, fmaxf(fmaxf(fabsf(q.v[j].x), fabsf(q.v[j].y)), fmaxf(fabsf(q.v[j].z), fabsf(q.v[j].w))));
    amax = wave_max(amax);
    unsigned* qp = (unsigned*)qtab + (size_t)e * 64;
    {
        const float inv = amax > 0.f ? 127.0f / amax : 0.f;
        if (lane == 0) scales[e] = amax * (1.0f / 127.0f);
#pragma unroll
        for (int j = 0; j < 8; ++j) {
            const int a = (int)rintf(q.v[j].x * inv), bq = (int)rintf(q.v[j].y * inv), c = (int)rintf(q.v[j].z * inv), d = (int)rintf(q.v[j].w * inv);
            qp[(size_t)j * 16384 * 64 + lane] = (unsigned)(a & 255) | ((unsigned)(bq & 255) << 8) | ((unsigned)(c & 255) << 16) | ((unsigned)(d & 255) << 24);
        }
    }
}
struct Ptrs {
    const float *x; const int* pos; const float *w_in, *w_out, *conv_w, *conv_b, *w_ra, *b_ra, *w_ri, *b_ri, *lam, *ln1_g, *ln1_b, *w_pq, *sub_keys, *peer_u, *peer_v, *ln2_g, *ln2_b;
    float* out; unsigned char* ws;
};
__device__ __forceinline__ void prologue_phase(LAS unsigned char* lds, const Ptrs& P, int G, int b) {
    const int tid = phase_tid(), lane = tid & 63, wid = phase_wid(tid);
    LAS float* scr = (LAS float*)(lds + wid * 16384);
    const int gw = b * NWAVES + wid, NGW = G * NWAVES;
    unsigned char* ws = P.ws;
    constexpr int I_IN = (D_ / 64) * (INC / 32), I_SQ = (D_ / 64) * (D_ / 32), I_G = 2 * 4;
    constexpr int NITEMS = I_IN + 2 * I_SQ + 16 * I_G;
    for (int it = gw; it < NITEMS; it += NGW) {
        int r = it;
        if (r < I_IN) { transpose_item(P.w_in, D_, INC, (bf16_t*)(ws + WS_WIN_T), scr, r, lane); continue; } r -= I_IN;
        if (r < I_SQ) { transpose_item(P.w_out, D_, D_, (bf16_t*)(ws + WS_WOUT_T), scr, r, lane); continue; } r -= I_SQ;
        if (r < I_SQ) { transpose_item(P.w_pq, D_, D_, (bf16_t*)(ws + WS_WPQ_T), scr, r, lane); continue; } r -= I_SQ;
        if (r < 8 * I_G) { const int g = r / I_G; transpose_item(P.w_ra + g * 16384, 128, 128, (bf16_t*)(ws + WS_WRA_T) + g * 16384, scr, r % I_G, lane); continue; } r -= 8 * I_G;
        { const int g = r / I_G; transpose_item(P.w_ri + g * 16384, 128, 128, (bf16_t*)(ws + WS_WRI_T) + g * 16384, scr, r % I_G, lane); }
    }
    const size_t gtid = (size_t)b * NTHREADS + tid, gth = (size_t)G * NTHREADS;
    cvt_stream(P.x, (bf16_t*)(ws + WS_XB), (size_t)S_ * D_ / 8, gtid, gth);
    cvt_stream(P.sub_keys, (bf16_t*)(ws + WS_KEYS), (size_t)8 * 2 * 128 * 128 / 8, gtid, gth);
    float* cosT = (float*)(ws + WS_COS); float* sinT = (float*)(ws + WS_SIN);
    for (size_t i = gtid; i < (size_t)S_ * 64; i += gth) {
        const int s = (int)(i >> 6), f = (int)(i & 63);
        const float inv = powf(10000.0f, -(float)f / 64.0f);
        const float ang = (float)P.pos[s] * inv;
        float sn, cs; sincosf(ang, &sn, &cs);
        cosT[i] = cs; sinT[i] = sn;
    }
}
#define XB_TMO      128
#define XB_XCNT(j)  (256  + 64 * (j))
#define XB_XSUB(j)  (1280 + 64 * (j))
#define XB_XGEN(j)  (2304 + 64 * (j))
#define XB_TOP      3328
#define XB_TOPGEN   3392
#define XCD_BAR_WORDS 3456
#define XB_SPIN_CAP (1u << 18)

__device__ __forceinline__ unsigned xb_ld(unsigned* p)              { return __hip_atomic_load(p, __ATOMIC_RELAXED, __HIP_MEMORY_SCOPE_AGENT); }
__device__ __forceinline__ unsigned xb_add(unsigned* p, unsigned v) { return __hip_atomic_fetch_add(p, v, __ATOMIC_RELAXED, __HIP_MEMORY_SCOPE_AGENT); }
__device__ __forceinline__ unsigned xb_xcc_id() { return (unsigned)__builtin_amdgcn_s_getreg((3 << 11) | 20) & 0xFu; }
#define XB_SPIN(cond, bar) do { unsigned _sp = 0; while (cond) { __builtin_amdgcn_s_sleep(1); \
    if ((++_sp & 255u) == 0u) { if (xb_ld(&(bar)[XB_TMO])) break; if (_sp > XB_SPIN_CAP) { atomicAdd(&(bar)[XB_TMO], 1u); break; } } } } while (0)

struct XcdBarrier {
    unsigned* bar; unsigned x;
    volatile LAS unsigned* st;
};

__device__ __forceinline__ XcdBarrier xcd_barrier_post(unsigned* bar, volatile LAS unsigned* st) {
    XcdBarrier b; b.bar = bar; b.x = xb_xcc_id(); b.st = st;
    if (threadIdx.x == 0) (void)xb_add(&bar[XB_XCNT(b.x)], 1u);
    return b;
}
__device__ __forceinline__ void xcd_barrier_complete(unsigned* bar, unsigned x, unsigned& nloc, unsigned& nx) {
    const unsigned G = gridDim.x * gridDim.y * gridDim.z;
    unsigned sum, cnt, mine, sp = 0u;
    for (;;) {
        sum = 0u; cnt = 0u; mine = 0u;
#pragma unroll
        for (unsigned j = 0; j < 16; ++j) { const unsigned c = xb_ld(&bar[XB_XCNT(j)]); sum += c; cnt += (c > 0u) ? 1u : 0u; mine = (j == x) ? c : mine; }
        if (sum == G) break;
        __builtin_amdgcn_s_sleep(1);
        if ((++sp & 255u) == 0u) { if (xb_ld(&bar[XB_TMO])) break; if (sp > XB_SPIN_CAP) { atomicAdd(&bar[XB_TMO], 1u); break; } }
    }
    nloc = mine > 0u ? mine : 1u; nx = cnt > 0u ? cnt : 1u;
}

__device__ __forceinline__ void xcd_barrier(const XcdBarrier& b) {
    asm volatile("s_waitcnt vmcnt(0)" ::: "memory");
    __syncthreads();
    if (threadIdx.x == 0) {
        unsigned* bar = b.bar;
        __builtin_amdgcn_s_waitcnt(0);
        unsigned nloc = b.st[0], nx = b.st[1];
        if (nloc == 0u) { xcd_barrier_complete(bar, b.x, nloc, nx); b.st[0] = nloc; b.st[1] = nx; }
        const unsigned old = xb_add(&bar[XB_XSUB(b.x)], 1u);
        const unsigned gen = old / nloc;
        if (old + 1u == (gen + 1u) * nloc) {
            __builtin_amdgcn_fence(__ATOMIC_RELEASE, "agent");
            asm volatile("s_waitcnt vmcnt(0)" ::: "memory");
            const unsigned og = xb_add(&bar[XB_TOP], 1u);
            const unsigned tg = og / nx;
            if (og + 1u == (tg + 1u) * nx) xb_add(&bar[XB_TOPGEN], 1u);
            else XB_SPIN(xb_ld(&bar[XB_TOPGEN]) == tg, bar);
            __builtin_amdgcn_fence(__ATOMIC_ACQUIRE, "agent");
            xb_add(&bar[XB_XGEN(b.x)], 1u);
            asm volatile("s_waitcnt vmcnt(0)" ::: "memory");
        } else {
            XB_SPIN(xb_ld(&bar[XB_XGEN(b.x)]) == gen, bar);
            __builtin_amdgcn_fence(__ATOMIC_ACQUIRE, "agent");
            asm volatile("s_waitcnt vmcnt(0)" ::: "memory");
        }
    }
    __syncthreads();
}
__device__ __forceinline__ void rot8(const u32x4 x1, const u32x4 x2, const float* cp, const float* sp, float scale, float (&o1)[8], float (&o2)[8]) {
    const f32x4 c0 = *(const f32x4*)cp, c1 = *(const f32x4*)(cp + 4), s0 = *(const f32x4*)sp, s1 = *(const f32x4*)(sp + 4);
    const float cs[8] = {c0.x, c0.y, c0.z, c0.w, c1.x, c1.y, c1.z, c1.w}, sn[8] = {s0.x, s0.y, s0.z, s0.w, s1.x, s1.y, s1.z, s1.w};
    const unsigned w1[4] = {x1.x, x1.y, x1.z, x1.w}, w2[4] = {x2.x, x2.y, x2.z, x2.w};
#pragma unroll
    for (int j = 0; j < 8; ++j) {
        const float a = (j & 1) ? bfhi(w1[j >> 1]) : bflo(w1[j >> 1]);
        const float bb = (j & 1) ? bfhi(w2[j >> 1]) : bflo(w2[j >> 1]);
        o1[j] = (a * cs[j] - bb * sn[j]) * scale;
        o2[j] = (bb * cs[j] + a * sn[j]) * scale;
    }
}
struct RetPref { u32x4 q1, q2, k1, k2, v0, v1, g0, g1; f32x4 c0, c1, s0, s1; };
template <bool FULL>
__device__ __forceinline__ void ret_prefetch(RetPref& p, const bf16_t* proj, const float* cosT, const float* sinT, int s, int h, int tq) {
    const bf16_t* base = proj + (size_t)s * INC + h * 128;
    p.k1 = *(const u32x4*)(base + 1024 + tq * 8); p.k2 = *(const u32x4*)(base + 1024 + 64 + tq * 8);
    p.v0 = *(const u32x4*)(base + 2048 + tq * 16); p.v1 = *(const u32x4*)(base + 2048 + tq * 16 + 8);
    const float* cp = cosT + (size_t)s * 64 + tq * 8; const float* sp = sinT + (size_t)s * 64 + tq * 8;
    p.c0 = *(const f32x4*)cp; p.c1 = *(const f32x4*)(cp + 4); p.s0 = *(const f32x4*)sp; p.s1 = *(const f32x4*)(sp + 4);
    if (FULL) { p.q1 = *(const u32x4*)(base + tq * 8); p.q2 = *(const u32x4*)(base + 64 + tq * 8); p.g0 = *(const u32x4*)(base + 3072 + tq * 16); p.g1 = *(const u32x4*)(base + 3072 + tq * 16 + 8); }
}
__device__ __forceinline__ void rot8r(const u32x4 x1, const u32x4 x2, const RetPref& p, float scale, float (&o1)[8], float (&o2)[8]) {
    const float cs[8] = {p.c0.x, p.c0.y, p.c0.z, p.c0.w, p.c1.x, p.c1.y, p.c1.z, p.c1.w}, sn[8] = {p.s0.x, p.s0.y, p.s0.z, p.s0.w, p.s1.x, p.s1.y, p.s1.z, p.s1.w};
    const unsigned w1[4] = {x1.x, x1.y, x1.z, x1.w}, w2[4] = {x2.x, x2.y, x2.z, x2.w};
#pragma unroll
    for (int j = 0; j < 8; ++j) {
        const float a = (j & 1) ? bfhi(w1[j >> 1]) : bflo(w1[j >> 1]);
        const float bb = (j & 1) ? bfhi(w2[j >> 1]) : bflo(w2[j >> 1]);
        o1[j] = (a * cs[j] - bb * sn[j]) * scale;
        o2[j] = (bb * cs[j] + a * sn[j]) * scale;
    }
}
__device__ __forceinline__ void ret_stage_kv(const RetPref& p, LAS bf16_t* KT, LAS bf16_t* VT, int m, int tq, float kdec, float (&k1)[8], float (&k2)[8]) {
    rot8r(p.k1, p.k2, p, 1.0f, k1, k2);
#pragma unroll
    for (int j = 0; j < 8; ++j) { KT[(tq * 8 + j) * 72 + m] = (bf16_t)f2bf(k1[j] * kdec); KT[(64 + tq * 8 + j) * 72 + m] = (bf16_t)f2bf(k2[j] * kdec); }
    const unsigned yw[8] = {p.v0.x, p.v0.y, p.v0.z, p.v0.w, p.v1.x, p.v1.y, p.v1.z, p.v1.w};
#pragma unroll
    for (int j = 0; j < 8; ++j) { VT[(tq * 16 + 2 * j) * 72 + m] = (bf16_t)(yw[j] & 0xffffu); VT[(tq * 16 + 2 * j + 1) * 72 + m] = (bf16_t)(yw[j] >> 16); }
}
__device__ __forceinline__ void ret_state_update(f32x4 (&S)[8], const LAS bf16_t* KT, const LAS bf16_t* VT, float dec, int wid, int fr, int fq) {
#pragma unroll
    for (int tt = 0; tt < 8; ++tt) S[tt] = S[tt] * dec;
#pragma unroll
    for (int ks = 0; ks < 2; ++ks) {
        const bf16x8 bb = *(const LAS bf16x8*)(VT + (wid * 16 + fr) * 72 + ks * 32 + fq * 8);
#pragma unroll
        for (int tt = 0; tt < 8; ++tt) { const bf16x8 a = *(const LAS bf16x8*)(KT + (tt * 16 + fr) * 72 + ks * 32 + fq * 8); S[tt] = mfma16(a, bb, S[tt]); }
    }
}
__device__ __forceinline__ void ret_r1_phase(LAS unsigned char* lds, const bf16_t* proj, const float* cosT, const float* sinT, float* gst, int G, int b) {
    const int tid = phase_tid(), lane = tid & 63, wid = phase_wid(tid), fr = lane & 15, fq = lane >> 4;
    LAS bf16_t* KT = (LAS bf16_t*)lds;
    LAS bf16_t* VT = (LAS bf16_t*)(lds + 18432);
    const int m = tid >> 3, tq = tid & 7;
    for (int unit = b; unit < 32 * NH; unit += G) {
        const int gq = unit >> 3, h = unit & 7;
        const float log_g = head_log_gamma(h), dec = fexp_(64.0f * log_g), kdec = fexp_(log_g * (63.0f - (float)m));
        f32x4 S[8];
#pragma unroll
        for (int tt = 0; tt < 8; ++tt) S[tt] = (f32x4){0.f, 0.f, 0.f, 0.f};
        RetPref pn; ret_prefetch<false>(pn, proj, cosT, sinT, (gq * 8) * 64 + m, h, tq);
        for (int i = 0; i < 8; ++i) {
            float k1[8], k2[8];
            __syncthreads();
            ret_stage_kv(pn, KT, VT, m, tq, kdec, k1, k2);
            if (i + 1 < 8) ret_prefetch<false>(pn, proj, cosT, sinT, (gq * 8 + i + 1) * 64 + m, h, tq);
            __syncthreads();
            ret_state_update(S, KT, VT, dec, wid, fr, fq);
        }
        f32x4* op = (f32x4*)gst + ((size_t)unit * 64 + wid * 8) * 64 + lane;
#pragma unroll
        for (int tt = 0; tt < 8; ++tt) op[tt * 64] = S[tt];
    }
}
__device__ __forceinline__ void scan_phase(LAS unsigned char* lds, float* gst, const float* sumA, const float* sumH, float* Hin, int G, int b) {
    const int gtid = b * NTHREADS + phase_tid(), gth = G * NTHREADS;
    for (int p = gtid; p < 32768; p += gth) {
        const int h = p >> 12;
        const float dec8 = fexp_(512.0f * head_log_gamma(h));
        f32x4* ptr = (f32x4*)gst + p;
        f32x4 s = (f32x4){0.f, 0.f, 0.f, 0.f};
        for (int gq = 0; gq < 32; gq += 8) {
            f32x4 v[8];
#pragma unroll
            for (int j = 0; j < 8; ++j) v[j] = ptr[(size_t)(gq + j) * 32768];
#pragma unroll
            for (int j = 0; j < 8; ++j) { ptr[(size_t)(gq + j) * 32768] = s; s = s * dec8 + v[j]; }
        }
    }
    const int wg = G - 1 - b;
    if (wg < 16) {
        LAS float* SG = (LAS float*)lds;
        const int tid = phase_tid(), cl = tid & 63, sg = tid >> 6, c = wg * 64 + cl;
        float a[32], hh[32];
#pragma unroll
        for (int j = 0; j < 32; ++j) { a[j] = sumA[(sg * 32 + j) * 1024 + c]; hh[j] = sumH[(sg * 32 + j) * 1024 + c]; }
        float ap = 1.f, he = 0.f;
#pragma unroll
        for (int j = 0; j < 32; ++j) { he = a[j] * he + hh[j]; ap *= a[j]; }
        SG[sg * 64 + cl] = ap; SG[512 + sg * 64 + cl] = he;
        __syncthreads();
        float H = 0.f;
#pragma unroll
        for (int s2 = 0; s2 < 7; ++s2) if (s2 < sg) H = SG[s2 * 64 + cl] * H + SG[512 + s2 * 64 + cl];
#pragma unroll
        for (int j = 0; j < 32; ++j) { Hin[(sg * 32 + j) * 1024 + c] = H; H = a[j] * H + hh[j]; }
    }
}
__device__ __forceinline__ void ret_r3_phase(LAS unsigned char* lds, const bf16_t* proj, const float* cosT, const float* sinT, const float* gst, bf16_t* ycat, int G, int b) {
    const int tid = phase_tid(), lane = tid & 63, wid = phase_wid(tid), fr = lane & 15, fq = lane >> 4;
    LAS bf16_t* QS = (LAS bf16_t*)lds;
    LAS bf16_t* KS = (LAS bf16_t*)(lds + 17408);
    LAS bf16_t* KT = (LAS bf16_t*)(lds + 34816);
    LAS bf16_t* VT = (LAS bf16_t*)(lds + 53248);
    LAS bf16_t* PS = (LAS bf16_t*)(lds + 71680);
    LAS float*  OS = (LAS float*)(lds + 80896);
    const int m = tid >> 3, tq = tid & 7;
    for (int unit = b; unit < 32 * NH; unit += G) {
        const int gq = unit >> 3, h = unit & 7;
        const float log_g = head_log_gamma(h), dec = fexp_(64.0f * log_g), kdec = fexp_(log_g * (63.0f - (float)m));
        f32x4 S[8];
        {   const f32x4* ip = (const f32x4*)gst + ((size_t)unit * 64 + wid * 8) * 64 + lane;
#pragma unroll
            for (int tt = 0; tt < 8; ++tt) S[tt] = ip[tt * 64]; }
        RetPref pn; ret_prefetch<true>(pn, proj, cosT, sinT, (gq * 8) * 64 + m, h, tq);
        for (int i = 0; i < 8; ++i) {
            const int s = (gq * 8 + i) * 64 + m;
            const u32x4 gc0 = pn.g0, gc1 = pn.g1;
            {
                float o1[8], o2[8];
                rot8r(pn.q1, pn.q2, pn, 0.08838834764831845f, o1, o2);
                *(LAS u32x4*)(QS + m * 136 + tq * 8) = (u32x4){pk2(o1[0], o1[1]), pk2(o1[2], o1[3]), pk2(o1[4], o1[5]), pk2(o1[6], o1[7])};
                *(LAS u32x4*)(QS + m * 136 + 64 + tq * 8) = (u32x4){pk2(o2[0], o2[1]), pk2(o2[2], o2[3]), pk2(o2[4], o2[5]), pk2(o2[6], o2[7])};
                ret_stage_kv(pn, KT, VT, m, tq, kdec, o1, o2);
                *(LAS u32x4*)(KS + m * 136 + tq * 8) = (u32x4){pk2(o1[0], o1[1]), pk2(o1[2], o1[3]), pk2(o1[4], o1[5]), pk2(o1[6], o1[7])};
                *(LAS u32x4*)(KS + m * 136 + 64 + tq * 8) = (u32x4){pk2(o2[0], o2[1]), pk2(o2[2], o2[3]), pk2(o2[4], o2[5]), pk2(o2[6], o2[7])};
            }
            if (i + 1 < 8) ret_prefetch<true>(pn, proj, cosT, sinT, s + 64, h, tq);
            __syncthreads();
            f32x4 oacc[4];
            {
                const int ct = wid & 3, mt0 = (wid >> 2) * 2;
                f32x4 sacc[2] = {(f32x4){0.f, 0.f, 0.f, 0.f}, (f32x4){0.f, 0.f, 0.f, 0.f}};
#pragma unroll
                for (int ks = 0; ks < 4; ++ks) {
                    const bf16x8 a = *(const LAS bf16x8*)(QS + (ct * 16 + fr) * 136 + ks * 32 + fq * 8);
#pragma unroll
                    for (int j = 0; j < 2; ++j) { const bf16x8 bb = *(const LAS bf16x8*)(KS + ((mt0 + j) * 16 + fr) * 136 + ks * 32 + fq * 8); sacc[j] = mfma16(a, bb, sacc[j]); }
                }
#pragma unroll
                for (int j = 0; j < 2; ++j)
#pragma unroll
                    for (int r = 0; r < 4; ++r) { const int c = ct * 16 + fq * 4 + r, mm = (mt0 + j) * 16 + fr; const float dd = fabsf((float)(c - mm));
                        PS[c * 72 + mm] = (bf16_t)f2bf(sacc[j][r] * fexp_(log_g * dd)); }
                asm volatile("" ::: "memory");
#pragma unroll
                for (int c4 = 0; c4 < 4; ++c4) oacc[c4] = (f32x4){0.f, 0.f, 0.f, 0.f};
#pragma unroll
                for (int a4 = 0; a4 < 4; ++a4) {
                    u32x4 bw; bw.x = pk2(S[2 * a4][0], S[2 * a4][1]); bw.y = pk2(S[2 * a4][2], S[2 * a4][3]); bw.z = pk2(S[2 * a4 + 1][0], S[2 * a4 + 1][1]); bw.w = pk2(S[2 * a4 + 1][2], S[2 * a4 + 1][3]);
                    const bf16x8 bb = __builtin_bit_cast(bf16x8, bw);
#pragma unroll
                    for (int c4 = 0; c4 < 4; ++c4) {
                        const u32x2 lo = *(const LAS u32x2*)(QS + (c4 * 16 + fr) * 136 + a4 * 32 + fq * 4), hi = *(const LAS u32x2*)(QS + (c4 * 16 + fr) * 136 + a4 * 32 + 16 + fq * 4);
                        const bf16x8 a = __builtin_bit_cast(bf16x8, (u32x4){lo.x, lo.y, hi.x, hi.y});
                        oacc[c4] = mfma16(a, bb, oacc[c4]);
                    }
                    asm volatile("" ::: "memory");
                }
#pragma unroll
                for (int c4 = 0; c4 < 4; ++c4)
#pragma unroll
                    for (int r = 0; r < 4; ++r) oacc[c4][r] *= fexp_(log_g * (float)(c4 * 16 + fq * 4 + r + 1));
            }
            __syncthreads();
            {
#pragma unroll
                for (int ks = 0; ks < 2; ++ks) {
                    const bf16x8 bb = *(const LAS bf16x8*)(VT + (wid * 16 + fr) * 72 + ks * 32 + fq * 8);
#pragma unroll
                    for (int c4 = 0; c4 < 4; ++c4) { const bf16x8 a = *(const LAS bf16x8*)(PS + (c4 * 16 + fr) * 72 + ks * 32 + fq * 8); oacc[c4] = mfma16(a, bb, oacc[c4]); }
                }
#pragma unroll
                for (int c4 = 0; c4 < 4; ++c4)
#pragma unroll
                    for (int r = 0; r < 4; ++r) OS[(c4 * 16 + fq * 4 + r) * 132 + wid * 16 + fr] = oacc[c4][r];
                ret_state_update(S, KT, VT, dec, wid, fr, fq);
            }
            __syncthreads();
            {
                float v[16]; float sum = 0.f;
#pragma unroll
                for (int q = 0; q < 4; ++q) { const f32x4 t = *(const LAS f32x4*)(OS + m * 132 + tq * 16 + q * 4); v[4 * q] = t.x; v[4 * q + 1] = t.y; v[4 * q + 2] = t.z; v[4 * q + 3] = t.w; sum += (t.x + t.y) + (t.z + t.w); }
                sum += __shfl_xor(sum, 1); sum += __shfl_xor(sum, 2); sum += __shfl_xor(sum, 4);
                const float mean = sum * (1.0f / 128.0f); float sq = 0.f;
#pragma unroll
                for (int q = 0; q < 16; ++q) { v[q] -= mean; sq += v[q] * v[q]; }
                sq += __shfl_xor(sq, 1); sq += __shfl_xor(sq, 2); sq += __shfl_xor(sq, 4);
                const float rstd = 1.0f / sqrtf(sq * (1.0f / 128.0f) + GN_EPS);
                const unsigned gw[8] = {gc0.x, gc0.y, gc0.z, gc0.w, gc1.x, gc1.y, gc1.z, gc1.w};
                unsigned ow[8];
#pragma unroll
                for (int j = 0; j < 8; ++j) { const float ga = bflo(gw[j]), gb = bfhi(gw[j]);
                    ow[j] = pk2(ga * sigmoidf_(ga) * v[2 * j] * rstd, gb * sigmoidf_(gb) * v[2 * j + 1] * rstd); }
                bf16_t* yp = ycat + (size_t)s * D_ + h * 128 + tq * 16;
                *(u32x4*)yp = (u32x4){ow[0], ow[1], ow[2], ow[3]}; *(u32x4*)(yp + 8) = (u32x4){ow[4], ow[5], ow[6], ow[7]};
            }
        }
        __syncthreads();
    }
}
template <int MODE>
__device__ __forceinline__ void lru_phase(LAS unsigned char* lds, const bf16_t* proj, const Ptrs& P, const bf16_t* wraT, const bf16_t* wriT,
                                          float* sumA, float* sumH, const float* Hin, bf16_t* ycat, int G, int b) {
    const int tid = phase_tid(), lane = tid & 63, wid = phase_wid(tid), fr = lane & 15, fq = lane >> 4;
    LAS float*  XC  = (LAS float*)lds;
    LAS bf16_t* XCb = (LAS bf16_t*)(lds + 33792);
    LAS float*  AA  = (LAS float*)(lds + 51200);
    LAS float*  SEG = (LAS float*)(lds + 84992);
    LAS bf16_t* WR  = (LAS bf16_t*)(lds + 89088);
    LAS bf16_t* WI  = (LAS bf16_t*)(lds + 123904);
    LAS float*  BB  = XC;
    const int st = wid & 3, jt0 = (wid >> 2) * 4;
    const int m = tid >> 3, part = tid & 7, j0 = part * 16;
    const int sj = tid & 127, seg = tid >> 7;
    int gcur = -1;
    float bra[4], bri[4], ls[4]; float cw0[4], cw1[4], cb0 = 0.f, cb1 = 0.f;
    unsigned xnext[11]; u32x4 gnext[2] = {(u32x4){0u, 0u, 0u, 0u}, (u32x4){0u, 0u, 0u, 0u}}; float hnext = 0.f;
    auto issue = [&](int unit) {
        const int n = unit >> 3, c0 = (unit & 7) * 128;
        const int r0 = n * 64 + wid * 8 - 3;
#pragma unroll
        for (int q = 0; q < 11; ++q) { const int row = r0 + q; xnext[q] = row >= 0 ? *(const unsigned*)(proj + (size_t)row * INC + 4096 + c0 + 2 * lane) : 0u; }
        if (MODE == 1) {
            const bf16_t* gp = proj + (size_t)(n * 64 + m) * INC + 5120 + c0 + j0;
            gnext[0] = *(const u32x4*)gp; gnext[1] = *(const u32x4*)(gp + 8);
            hnext = Hin[n * 1024 + c0 + sj];
        }
    };
    if (b < NCH * 8) issue(b);
    for (int unit = b; unit < NCH * 8; unit += G) {
        const int n = unit >> 3, g = unit & 7, c0 = g * 128;
        if (g != gcur) {
            gcur = g;
            __syncthreads();
            {
                const int row = tid >> 2, pc = tid & 3;
#pragma unroll
                for (int q = 0; q < 4; ++q) { const int piece = pc * 4 + q;
                    *(LAS u32x4*)(WR + row * 136 + piece * 8) = *(const u32x4*)(wraT + (size_t)g * 16384 + row * 128 + piece * 8);
                    *(LAS u32x4*)(WI + row * 136 + piece * 8) = *(const u32x4*)(wriT + (size_t)g * 16384 + row * 128 + piece * 8); }
            }
#pragma unroll
            for (int j = 0; j < 4; ++j) {
                const int c = c0 + (jt0 + j) * 16 + fr;
                bra[j] = P.b_ra[c]; bri[j] = P.b_ri[c]; ls[j] = -8.0f * log1pf(expf(-P.lam[c]));
            }
#pragma unroll
            for (int kk = 0; kk < 4; ++kk) { cw0[kk] = P.conv_w[kk * 1024 + c0 + 2 * lane]; cw1[kk] = P.conv_w[kk * 1024 + c0 + 2 * lane + 1]; }
            cb0 = P.conv_b[c0 + 2 * lane]; cb1 = P.conv_b[c0 + 2 * lane + 1];
        }
        unsigned xcur[11];
#pragma unroll
        for (int q = 0; q < 11; ++q) xcur[q] = xnext[q];
        const u32x4 gc0 = gnext[0], gc1 = gnext[1]; const float hin0 = hnext;
        if (unit + G < NCH * 8) issue(unit + G);
        QRow qrow; const int qe = unit * 8 + wid;
        quant_issue(qrow, MODE == 1 ? P.peer_v : P.peer_u, qe, lane);
#pragma unroll
        for (int rr = 0; rr < 8; ++rr) {
            float x0 = cb0, x1 = cb1;
#pragma unroll
            for (int kk = 0; kk < 4; ++kk) { x0 += cw0[kk] * bflo(xcur[rr + kk]); x1 += cw1[kk] * bfhi(xcur[rr + kk]); }
            const int row = wid * 8 + rr;
            XC[row * 132 + 2 * lane] = x0; XC[row * 132 + 2 * lane + 1] = x1;
            *(LAS unsigned*)(XCb + row * 136 + 2 * lane) = pk2(x0, x1);
        }
        __syncthreads();
        {
            f32x4 ar[4], ai[4];
#pragma unroll
            for (int j = 0; j < 4; ++j) { ar[j] = (f32x4){0.f, 0.f, 0.f, 0.f}; ai[j] = (f32x4){0.f, 0.f, 0.f, 0.f}; }
#pragma unroll
            for (int ks = 0; ks < 4; ++ks) {
                const bf16x8 a = *(const LAS bf16x8*)(XCb + (st * 16 + fr) * 136 + ks * 32 + fq * 8);
#pragma unroll
                for (int j = 0; j < 4; ++j) { const int wo = ((jt0 + j) * 16 + fr) * 136 + ks * 32 + fq * 8;
                    ar[j] = mfma16(a, *(const LAS bf16x8*)(WR + wo), ar[j]); ai[j] = mfma16(a, *(const LAS bf16x8*)(WI + wo), ai[j]); }
            }
#pragma unroll
            for (int j = 0; j < 4; ++j) {
                const int col = (jt0 + j) * 16 + fr;
#pragma unroll
                for (int r = 0; r < 4; ++r) {
                    const int sl = st * 16 + fq * 4 + r;
                    const float rg = sigmoidf_(ar[j][r] + bra[j]), ig = sigmoidf_(ai[j][r] + bri[j]);
                    const float a = fexp_(rg * ls[j]);
                    const float bv = __builtin_amdgcn_sqrtf(fmaxf(1.0f - a * a, 0.f)) * (ig * XC[sl * 132 + col]);
                    AA[sl * 132 + col] = a; BB[sl * 132 + col] = bv;
                }
            }
        }
        __syncthreads();
        float ap = 1.f, he = 0.f;
#pragma unroll
        for (int q = 0; q < 16; ++q) { const float a = AA[(seg * 16 + q) * 132 + sj], bv = BB[(seg * 16 + q) * 132 + sj]; he = a * he + bv; ap *= a; }
        SEG[seg * 128 + sj] = ap; SEG[512 + seg * 128 + sj] = he;
        __syncthreads();
        float hin = (MODE == 1) ? hin0 : 0.f;
#pragma unroll
        for (int s2 = 0; s2 < 3; ++s2) if (s2 < seg) hin = SEG[s2 * 128 + sj] * hin + SEG[512 + s2 * 128 + sj];
        if (MODE == 0) {
            if (seg == 3) { sumA[n * 1024 + c0 + sj] = SEG[sj] * SEG[128 + sj] * SEG[256 + sj] * ap; sumH[n * 1024 + c0 + sj] = ap * hin + he; }
        } else {
            float hcur = hin;
#pragma unroll
            for (int q = 0; q < 16; ++q) { const int o = (seg * 16 + q) * 132 + sj; hcur = AA[o] * hcur + BB[o]; BB[o] = hcur; }
            __syncthreads();
            const unsigned gw[8] = {gc0.x, gc0.y, gc0.z, gc0.w, gc1.x, gc1.y, gc1.z, gc1.w};
            unsigned ow[8];
#pragma unroll
            for (int q = 0; q < 8; ++q) { const float h0 = BB[m * 132 + j0 + 2 * q], h1 = BB[m * 132 + j0 + 2 * q + 1];
                ow[q] = pk2(h0 * gelu_tanh(bflo(gw[q])), h1 * gelu_tanh(bfhi(gw[q]))); }
            bf16_t* yp = ycat + (size_t)(n * 64 + m) * D_ + 1024 + c0 + j0;
            *(u32x4*)yp = (u32x4){ow[0], ow[1], ow[2], ow[3]}; *(u32x4*)(yp + 8) = (u32x4){ow[4], ow[5], ow[6], ow[7]};
        }
        quant_finish<MODE>(qrow, P.ws + (MODE == 1 ? WS_VQ : WS_UQ), (float*)(P.ws + (MODE == 1 ? WS_SV : WS_SU)), qe, lane);
        __syncthreads();
    }
}
__device__ __forceinline__ void ln1_phase(const bf16_t* buf, bf16_t* h1b, unsigned* xqs, float* sx, const float* gam, const float* bet, int G, int b) {
    const int tid_ = phase_tid(), lane = tid_ & 63, wid = phase_wid(tid_);
    const int gw = b * NWAVES + wid, NGW = G * NWAVES;
    constexpr int R = 4;
    for (int row0 = gw; row0 < S_; row0 += R * NGW) {
        f32x4 v[R][8]; float sum[R], sq[R], amax[R];
#pragma unroll
        for (int q = 0; q < R; ++q) {
            const int row = min(row0 + q * NGW, S_ - 1);
            const bf16_t* rp = buf + (size_t)row * D_;
            sum[q] = 0.f;
#pragma unroll
            for (int j = 0; j < 8; ++j) { const u32x2 w = *(const u32x2*)(rp + 256 * j + 4 * lane); v[q][j] = (f32x4){bflo(w.x), bfhi(w.x), bflo(w.y), bfhi(w.y)}; sum[q] += (v[q][j].x + v[q][j].y) + (v[q][j].z + v[q][j].w); }
        }
#pragma unroll
        for (int q = 0; q < R; ++q) sum[q] = wave_sum(sum[q]) * (1.0f / D_);
#pragma unroll
        for (int q = 0; q < R; ++q) { sq[q] = 0.f;
#pragma unroll
            for (int j = 0; j < 8; ++j) { v[q][j] = v[q][j] - sum[q]; sq[q] += (v[q][j].x * v[q][j].x + v[q][j].y * v[q][j].y) + (v[q][j].z * v[q][j].z + v[q][j].w * v[q][j].w); } }
#pragma unroll
        for (int q = 0; q < R; ++q) sq[q] = 1.0f / sqrtf(wave_sum(sq[q]) * (1.0f / D_) + LN_EPS);
#pragma unroll
        for (int j = 0; j < 8; ++j) {
            const f32x4 gg = *(const f32x4*)(gam + 256 * j + 4 * lane), bb = *(const f32x4*)(bet + 256 * j + 4 * lane);
#pragma unroll
            for (int q = 0; q < R; ++q) v[q][j] = v[q][j] * sq[q] * gg + bb;
        }
#pragma unroll
        for (int q = 0; q < R; ++q) { amax[q] = 0.f;
#pragma unroll
            for (int j = 0; j < 8; ++j) amax[q] = fmaxf(amax[q], fmaxf(fmaxf(fabsf(v[q][j].x), fabsf(v[q][j].y)), fmaxf(fabsf(v[q][j].z), fabsf(v[q][j].w)))); }
#pragma unroll
        for (int q = 0; q < R; ++q) amax[q] = wave_max(amax[q]);
#pragma unroll
        for (int q = 0; q < R; ++q) {
            const int row = row0 + q * NGW;
            if (row < S_) {
                const float inv = amax[q] > 0.f ? 127.0f / amax[q] : 0.f;
                if (lane == 0) sx[row] = amax[q] * (1.0f / 127.0f);
#pragma unroll
                for (int j = 0; j < 8; ++j) {
                    *(u32x2*)(h1b + (size_t)row * D_ + 256 * j + 4 * lane) = (u32x2){pk2(v[q][j].x, v[q][j].y), pk2(v[q][j].z, v[q][j].w)};
                    const int a = (int)rintf(v[q][j].x * inv), bq = (int)rintf(v[q][j].y * inv), c = (int)rintf(v[q][j].z * inv), d = (int)rintf(v[q][j].w * inv);
                    xqs[((size_t)j * S_ + row) * 64 + lane] = (unsigned)(a & 255) | ((unsigned)(bq & 255) << 8) | ((unsigned)(c & 255) << 16) | ((unsigned)(d & 255) << 24);
                }
            }
        }
    }
}
__device__ __forceinline__ unsigned mono(float f) { const unsigned u = __float_as_uint(f); return (u & 0x80000000u) ? ~u : (u ^ 0x80000000u); }
__device__ __forceinline__ float unmono(unsigned u) { return __uint_as_float((u & 0x80000000u) ? (u ^ 0x80000000u) : ~u); }
__device__ __forceinline__ unsigned umax_(unsigned a, unsigned b) { return a > b ? a : b; }
__device__ __forceinline__ constexpr int cand_i(int c) { return c < 16 ? 0 : c < 24 ? 1 : c < 29 ? 2 : c < 33 ? 3 : c < 36 ? 4 : c < 38 ? 5 : c < 40 ? 6 : c < 42 ? 7 : c - 34; }
__device__ __forceinline__ constexpr int cand_j(int c) { return c < 16 ? c : c < 24 ? c - 16 : c < 29 ? c - 24 : c < 33 ? c - 29 : c < 36 ? c - 33 : c < 38 ? c - 36 : c < 40 ? c - 38 : c < 42 ? c - 40 : 0; }

__device__ __forceinline__ unsigned umin_(unsigned a, unsigned b) { return a < b ? a : b; }
#define SN_CE(x, y) do { const unsigned hi_ = umax_(x, y), lo_ = umin_(x, y); x = hi_; y = lo_; } while (0)
#define SN_SORT16(a) do { SN_CE(a[0], a[1]); SN_CE(a[2], a[3]); SN_CE(a[0], a[2]); SN_CE(a[1], a[3]); SN_CE(a[1], a[2]); SN_CE(a[4], a[5]); SN_CE(a[6], a[7]); SN_CE(a[4], a[6]); SN_CE(a[5], a[7]); SN_CE(a[5], a[6]); SN_CE(a[0], a[4]); SN_CE(a[2], a[6]); SN_CE(a[2], a[4]); SN_CE(a[1], a[5]); SN_CE(a[3], a[7]); SN_CE(a[3], a[5]); SN_CE(a[1], a[2]); SN_CE(a[3], a[4]); SN_CE(a[5], a[6]); SN_CE(a[8], a[9]); SN_CE(a[10], a[11]); SN_CE(a[8], a[10]); SN_CE(a[9], a[11]); SN_CE(a[9], a[10]); SN_CE(a[12], a[13]); SN_CE(a[14], a[15]); SN_CE(a[12], a[14]); SN_CE(a[13], a[15]); SN_CE(a[13], a[14]); SN_CE(a[8], a[12]); SN_CE(a[10], a[14]); SN_CE(a[10], a[12]); SN_CE(a[9], a[13]); SN_CE(a[11], a[15]); SN_CE(a[11], a[13]); SN_CE(a[9], a[10]); SN_CE(a[11], a[12]); SN_CE(a[13], a[14]); SN_CE(a[0], a[8]); SN_CE(a[4], a[12]); SN_CE(a[4], a[8]); SN_CE(a[2], a[10]); SN_CE(a[6], a[14]); SN_CE(a[6], a[10]); SN_CE(a[2], a[4]); SN_CE(a[6], a[8]); SN_CE(a[10], a[12]); SN_CE(a[1], a[9]); SN_CE(a[5], a[13]); SN_CE(a[5], a[9]); SN_CE(a[3], a[11]); SN_CE(a[7], a[15]); SN_CE(a[7], a[11]); SN_CE(a[3], a[5]); SN_CE(a[7], a[9]); SN_CE(a[11], a[13]); SN_CE(a[1], a[2]); SN_CE(a[3], a[4]); SN_CE(a[5], a[6]); SN_CE(a[7], a[8]); SN_CE(a[9], a[10]); SN_CE(a[11], a[12]); SN_CE(a[13], a[14]); } while (0)
#define SN_BITONIC16(a) do { SN_CE(a[0], a[8]); SN_CE(a[1], a[9]); SN_CE(a[2], a[10]); SN_CE(a[3], a[11]); SN_CE(a[4], a[12]); SN_CE(a[5], a[13]); SN_CE(a[6], a[14]); SN_CE(a[7], a[15]); SN_CE(a[0], a[4]); SN_CE(a[1], a[5]); SN_CE(a[2], a[6]); SN_CE(a[3], a[7]); SN_CE(a[8], a[12]); SN_CE(a[9], a[13]); SN_CE(a[10], a[14]); SN_CE(a[11], a[15]); SN_CE(a[0], a[2]); SN_CE(a[1], a[3]); SN_CE(a[4], a[6]); SN_CE(a[5], a[7]); SN_CE(a[8], a[10]); SN_CE(a[9], a[11]); SN_CE(a[12], a[14]); SN_CE(a[13], a[15]); SN_CE(a[0], a[1]); SN_CE(a[2], a[3]); SN_CE(a[4], a[5]); SN_CE(a[6], a[7]); SN_CE(a[8], a[9]); SN_CE(a[10], a[11]); SN_CE(a[12], a[13]); SN_CE(a[14], a[15]); } while (0)

#define TOPK_XMERGE(T, mask) do { unsigned pt_[16]; \
    _Pragma("unroll") for (int i_ = 0; i_ < 16; ++i_) pt_[i_] = (unsigned)__shfl_xor((int)T[15 - i_], mask); \
    _Pragma("unroll") for (int i_ = 0; i_ < 16; ++i_) T[i_] = umax_(T[i_], pt_[i_]); \
    SN_BITONIC16(T); } while (0)
__device__ __forceinline__ void topk_phase(LAS unsigned char* lds, const bf16_t* qp, const bf16_t* keys, const float* SU, const float* SV, int* sel_e, float* sel_g, float* sel_su, int G, int b) {
    const int tid = phase_tid(), lane = tid & 63, wid = phase_wid(tid), fr = lane & 15, fq = lane >> 4;
    LAS unsigned* wl = (LAS unsigned*)(lds + wid * 4096 + fr * 256);
    LAS bf16_t* KL = (LAS bf16_t*)(lds + 32768);
    pg8::StaticOrder SO; SO.init(S_, D_, G, b);
    for (int ui = 0; ; ++ui) {
        pg8::Unit gu; if (!SO.next(ui >> 1, gu)) break;
        const int tt = gu.pm * 2 + (ui & 1), h = gu.pn;
        const int tok = tt * 128 + wid * 16 + fr;
        if ((ui & 1) == 0) {
            __syncthreads();
            const int row = tid >> 1, hf = tid & 1;
            const bf16_t* src = keys + (size_t)h * 2 * 16384 + (size_t)row * 128 + hf * 64;
            LAS bf16_t* dst = KL + row * 136 + hf * 64;
#pragma unroll
            for (int q8 = 0; q8 < 8; ++q8) *(LAS u32x4*)(dst + q8 * 8) = *(const u32x4*)(src + q8 * 8);
            __syncthreads();
        }
        unsigned T[2][16];
#pragma unroll
        for (int p = 0; p < 2; ++p) {
            f32x4 acc[8];
#pragma unroll
            for (int mt = 0; mt < 8; ++mt) acc[mt] = (f32x4){0.f, 0.f, 0.f, 0.f};
            bf16x8 bq[4];
#pragma unroll
            for (int ks = 0; ks < 4; ++ks) bq[ks] = *(const bf16x8*)(qp + (size_t)tok * D_ + h * 256 + p * 128 + ks * 32 + fq * 8);
            const LAS bf16_t* kb = KL + p * 128 * 136;
#pragma unroll
            for (int mt = 0; mt < 8; ++mt)
#pragma unroll
                for (int ks = 0; ks < 4; ++ks) { const bf16x8 a = *(const LAS bf16x8*)(kb + (mt * 16 + fr) * 136 + ks * 32 + fq * 8); acc[mt] = mfma16(a, bq[ks], acc[mt]); }
            unsigned lo16[16];
#pragma unroll
            for (int mt = 0; mt < 4; ++mt)
#pragma unroll
                for (int r = 0; r < 4; ++r) {
                    T[p][mt * 4 + r] = (mono(acc[mt][r]) & ~127u) | (unsigned)(127 - (mt * 16 + fq * 4 + r));
                    lo16[mt * 4 + r] = (mono(acc[mt + 4][r]) & ~127u) | (unsigned)(127 - ((mt + 4) * 16 + fq * 4 + r));
                }
            SN_SORT16(T[p]); SN_SORT16(lo16);
#pragma unroll
            for (int i = 0; i < 16; ++i) T[p][i] = umax_(T[p][i], lo16[15 - i]);
            SN_BITONIC16(T[p]);
            TOPK_XMERGE(T[p], 16); TOPK_XMERGE(T[p], 32);
        }
        float v1[16], v2[16];
#pragma unroll
        for (int i = 0; i < 16; ++i) { v1[i] = unmono(T[0][i] & ~127u); v2[i] = unmono(T[1][i] & ~127u); }
        unsigned ck[16];
#pragma unroll
        for (int sidx = 0; sidx < 13; ++sidx) {
            unsigned keyk[4];
#pragma unroll
            for (int k = 0; k < 4; ++k) {
                const int c = 4 * sidx + k;
                if (c < 50) { const int ci = cand_i(c), cj = cand_j(c); keyk[k] = (mono(v1[ci] + v2[cj]) & ~255u) | (unsigned)(255 - (ci * 16 + cj)); }
                else keyk[k] = 0u;
            }
            ck[sidx] = fq == 0 ? keyk[0] : fq == 1 ? keyk[1] : fq == 2 ? keyk[2] : keyk[3];
        }
        ck[13] = 0u; ck[14] = 0u; ck[15] = 0u;
        SN_SORT16(ck);
        TOPK_XMERGE(ck, 16); TOPK_XMERGE(ck, 32);
        if (fq == 0) {
#pragma unroll
            for (int i = 0; i < 16; ++i) { wl[i] = T[0][i]; wl[16 + i] = T[1][i]; }
        }
        __syncthreads();
        {
            const float vmax = unmono(ck[0] & ~255u);
            float esum = 0.f;
#pragma unroll
            for (int k = 0; k < 16; ++k) esum += __expf(unmono(ck[k] & ~255u) - vmax);
            const float einv = 1.0f / esum;
#pragma unroll
            for (int kk = 0; kk < 4; ++kk) {
                const unsigned W = fq == 0 ? ck[kk] : fq == 1 ? ck[4 + kk] : fq == 2 ? ck[8 + kk] : ck[12 + kk];
                const int k = fq * 4 + kk;
                const unsigned id = 255u - (W & 255u);
                const unsigned e1 = 127u - (wl[id >> 4] & 127u), e2 = 127u - (wl[16 + (id & 15u)] & 127u);
                const size_t o = ((size_t)tok * 8 + h) * 16 + k;
                const unsigned ex = e1 * 128u + e2;
                sel_e[o] = (int)ex; sel_g[o] = __expf(unmono(W & ~255u) - vmax) * einv * SV[ex]; sel_su[o] = SU[ex];
            }
        }
        __syncthreads();
    }
}
__device__ __forceinline__ int row16_sum_i(int v) {
    v += __builtin_amdgcn_update_dpp(0, v, 0xB1, 0xF, 0xF, true);
    v += __builtin_amdgcn_update_dpp(0, v, 0x4E, 0xF, 0xF, true);
    v += __builtin_amdgcn_update_dpp(0, v, 0x141, 0xF, 0xF, true);
    v += __builtin_amdgcn_update_dpp(0, v, 0x140, 0xF, 0xF, true);
    return v;
}
__device__ __forceinline__ int dot16_i8(const u32x4 a, const u32x4 x) {
    int d = __builtin_amdgcn_sdot4((int)a.x, (int)x.x, 0, false); d = __builtin_amdgcn_sdot4((int)a.y, (int)x.y, d, false);
    d = __builtin_amdgcn_sdot4((int)a.z, (int)x.z, d, false); return __builtin_amdgcn_sdot4((int)a.w, (int)x.w, d, false);
}
template <int EMASK>
__device__ __forceinline__ void peer_u_phase(LAS unsigned char* lds, const unsigned char* UQs, const unsigned char* XQs, const int* sel_e, int* pd, int xi, int nx, int rank, int nloc) {
    const int tid_ = phase_tid(), lane = tid_ & 63, wid = phase_wid(tid_), r = lane >> 4, i = lane & 15;
    LAS int* esb = (LAS int*)(lds + wid * 2048);
    const int wx = rank * NWAVES + wid, nwx = nloc * NWAVES;
    if (wx >= S_) return;
    const int NT = (S_ - wx + nwx - 1) / nwx;
    for (int j = xi; j < 8; j += nx) {
        const unsigned char* Uj = UQs + (size_t)j * 16384 * 256; const unsigned li = 16u * (unsigned)i;
        const unsigned char* Xj = XQs + (size_t)j * S_ * 256 + 16 * i;
        u32x4 A[16], B[16];
        int ma, mb; u32x4 xc, xn;
        {
            const int t0 = wx, t1 = (NT > 1) ? wx + nwx : wx;
            ma = sel_e[(size_t)t0 * 128 + lane]; mb = sel_e[(size_t)t0 * 128 + 64 + lane]; xc = *(const u32x4*)(Xj + (size_t)t0 * 256);
            esb[lane] = ma; esb[64 + lane] = mb;
            asm volatile("" ::: "memory");
            ma = sel_e[(size_t)t1 * 128 + lane]; mb = sel_e[(size_t)t1 * 128 + 64 + lane]; xn = *(const u32x4*)(Xj + (size_t)t1 * 256);
            asm volatile("" ::: "memory");
#pragma unroll
            for (int it = 0; it < 16; ++it) A[it] = *(const u32x4*)(Uj + (((unsigned)esb[4 * it + r] & (unsigned)EMASK) * 256u + li));
#pragma unroll
            for (int it = 0; it < 16; ++it) B[it] = *(const u32x4*)(Uj + (((unsigned)esb[64 + 4 * it + r] & (unsigned)EMASK) * 256u + li));
        }
        for (int n = 0; n < NT; ++n) {
            const int t = wx + n * nwx;
            const int t2 = (n + 2 < NT) ? t + 2 * nwx : t;
            LAS int* esn = esb + ((n + 1) & 1) * 128;
            esn[lane] = ma; esn[64 + lane] = mb;
            const u32x4 xnn = xn;
            asm volatile("" ::: "memory");
            ma = sel_e[(size_t)t2 * 128 + lane]; mb = sel_e[(size_t)t2 * 128 + 64 + lane]; xn = *(const u32x4*)(Xj + (size_t)t2 * 256);
            int keepA = 0, keepB = 0;
#pragma unroll
            for (int it = 0; it < 16; ++it) { const int d = row16_sum_i(dot16_i8(A[it], xc)); keepA = (i == it) ? d : keepA; }
            asm volatile("" : "+v"(keepA) :: "memory");
#pragma unroll
            for (int it = 0; it < 16; ++it) A[it] = *(const u32x4*)(Uj + (((unsigned)esn[4 * it + r] & (unsigned)EMASK) * 256u + li));
            asm volatile("" ::: "memory");
#pragma unroll
            for (int it = 0; it < 16; ++it) { const int d = row16_sum_i(dot16_i8(B[it], xc)); keepB = (i == it) ? d : keepB; }
            asm volatile("" : "+v"(keepB) :: "memory");
#pragma unroll
            for (int it = 0; it < 16; ++it) B[it] = *(const u32x4*)(Uj + (((unsigned)esn[64 + 4 * it + r] & (unsigned)EMASK) * 256u + li));
            asm volatile("" ::: "memory");
            int* pp = pd + ((size_t)t * 8 + j) * 128 + 4 * i + r;
            pp[0] = keepA; pp[64] = keepB;
            xc = xnn;
        }
    }
}
typedef float f32x2 __attribute__((ext_vector_type(2)));
__device__ __forceinline__ void acc16_fp8(f32x2 (&acc)[8], const u32x4 v, float c) {
    const int w[4] = {(int)v.x, (int)v.y, (int)v.z, (int)v.w};
    const f32x2 cc = {c, c};
#pragma unroll
    for (int q = 0; q < 4; ++q) {
        const f32x2 lo = __builtin_amdgcn_cvt_pk_f32_fp8(w[q], false), hi = __builtin_amdgcn_cvt_pk_f32_fp8(w[q], true);
        acc[2 * q] = __builtin_elementwise_fma(cc, lo, acc[2 * q]); acc[2 * q + 1] = __builtin_elementwise_fma(cc, hi, acc[2 * q + 1]);
    }
}
__device__ __forceinline__ void peer_coef_phase(const float* sel_g, const float* sel_su, const int* pd, const float* SX, float* coef, int G, int b) {
    const int tid_ = phase_tid(), lane = tid_ & 63, wid = phase_wid(tid_);
    const int gw = b * NWAVES + wid, NGW = G * NWAVES;
    for (int t = gw; t < S_; t += NGW) {
        const float* gp = sel_g + (size_t)t * 128 + lane; const float* up = sel_su + (size_t)t * 128 + lane; const int* pp = pd + (size_t)t * 1024 + lane;
        const float sxt = SX[t];
#pragma unroll
        for (int hh = 0; hh < 2; ++hh) {
            int ds = 0;
#pragma unroll
            for (int jj = 0; jj < 8; ++jj) ds += pp[jj * 128 + 64 * hh];
            coef[(size_t)t * 128 + 64 * hh + lane] = gp[64 * hh] * gelu_tanh((float)ds * (up[64 * hh] * sxt));
        }
    }
}
struct PeerMeta { int e[2]; float c[2]; };
__device__ __forceinline__ void peer_meta_load(PeerMeta& m, const int* sel_e, const float* coef, int t, int lane) {
    const int* ep = sel_e + (size_t)t * 128 + lane; const float* cp = coef + (size_t)t * 128 + lane;
    m.e[0] = ep[0]; m.e[1] = ep[64]; m.c[0] = cp[0]; m.c[1] = cp[64];
}
__device__ __forceinline__ void tr4x4(unsigned r0, unsigned r1, unsigned r2, unsigned r3, unsigned (&c)[4]) {
    const unsigned t0 = __builtin_amdgcn_perm(r1, r0, 0x05010400u), t1 = __builtin_amdgcn_perm(r1, r0, 0x07030602u);
    const unsigned t2 = __builtin_amdgcn_perm(r3, r2, 0x05010400u), t3 = __builtin_amdgcn_perm(r3, r2, 0x07030602u);
    c[0] = __builtin_amdgcn_perm(t2, t0, 0x05040100u); c[1] = __builtin_amdgcn_perm(t2, t0, 0x07060302u);
    c[2] = __builtin_amdgcn_perm(t3, t1, 0x05040100u); c[3] = __builtin_amdgcn_perm(t3, t1, 0x07060302u);
}
typedef int i32x4 __attribute__((ext_vector_type(4)));
__device__ __forceinline__ void acc_half_mfma(int (&ah)[16], const u32x4 (&R)[16], const LAS unsigned* ch4  , int r) {
    i32x4 Aop; Aop.x = (int)ch4[0 * 4 + r]; Aop.y = (int)ch4[1 * 4 + r]; Aop.z = (int)ch4[2 * 4 + r]; Aop.w = (int)ch4[3 * 4 + r];
#pragma unroll
    for (int q = 0; q < 4; ++q) {
        unsigned cg[4][4];
#pragma unroll
        for (int gg = 0; gg < 4; ++gg) {
            const unsigned w0 = q == 0 ? R[4 * gg].x : q == 1 ? R[4 * gg].y : q == 2 ? R[4 * gg].z : R[4 * gg].w;
            const unsigned w1 = q == 0 ? R[4 * gg + 1].x : q == 1 ? R[4 * gg + 1].y : q == 2 ? R[4 * gg + 1].z : R[4 * gg + 1].w;
            const unsigned w2 = q == 0 ? R[4 * gg + 2].x : q == 1 ? R[4 * gg + 2].y : q == 2 ? R[4 * gg + 2].z : R[4 * gg + 2].w;
            const unsigned w3 = q == 0 ? R[4 * gg + 3].x : q == 1 ? R[4 * gg + 3].y : q == 2 ? R[4 * gg + 3].z : R[4 * gg + 3].w;
            tr4x4(w0, w1, w2, w3, cg[gg]);
        }
#pragma unroll
        for (int cc = 0; cc < 4; ++cc) {
            i32x4 Bop; Bop.x = (int)cg[0][cc]; Bop.y = (int)cg[1][cc]; Bop.z = (int)cg[2][cc]; Bop.w = (int)cg[3][cc];
            const i32x4 d = __builtin_amdgcn_mfma_i32_16x16x64_i8(Aop, Bop, (i32x4){0, 0, 0, 0}, 0, 0, 0);
            ah[4 * q + cc] += d.x;
        }
    }
}
__device__ __forceinline__ void peer_stage_lists(const PeerMeta& m, LAS int* es, LAS unsigned char* chB, LAS unsigned char* clB, LAS float* scp, int lane) {
    es[lane] = m.e[0]; es[64 + lane] = m.e[1];
    const float cmax = wave_max(fmaxf(fabsf(m.c[0]), fabsf(m.c[1])));
    const float inv = cmax > 0.f ? 127.0f / cmax : 0.f;
    if (lane == 0) scp[0] = cmax * (1.0f / 127.0f);
#pragma unroll
    for (int hh = 0; hh < 2; ++hh) {
        const int k = 64 * hh + lane;
        const int h = (int)rintf(m.c[hh] * inv), l = 0;
        const int idx = (k >> 4) * 16 + (k & 3) * 4 + ((k >> 2) & 3);
        chB[idx] = (unsigned char)(h & 255); clB[idx] = (unsigned char)(l & 255);
    }
}
template <int STRIP>
__device__ __forceinline__ void peer_v_phase(LAS unsigned char* lds, const unsigned char* VQs, const int* sel_e, const float* coef,
                                             bf16_t* zs, int xi, int nx, int rank, int nloc) {
    const int tid_ = phase_tid(), lane = tid_ & 63, wid = phase_wid(tid_), r = lane >> 4, i = lane & 15;
    LAS unsigned char* wl = lds + wid * 2048;
    LAS int* esb = (LAS int*)wl;
    const int wx = rank * NWAVES + wid, nwx = nloc * NWAVES;
    if (wx >= S_) return;
    const int NT = (S_ - wx + nwx - 1) / nwx;
    for (int j = xi; j < 8; j += nx) {
        const unsigned char* Vj = VQs + (size_t)j * 16384 * 256; const unsigned li = 16u * (unsigned)i;
        u32x4 A[16], B[16];
        PeerMeta m;
        {
            peer_meta_load(m, sel_e, coef, wx, lane);
            peer_stage_lists(m, esb, wl + 1024, wl + 1280, (LAS float*)(wl + 1536), lane);
            asm volatile("" ::: "memory");
            peer_meta_load(m, sel_e, coef, (NT > 1) ? wx + nwx : wx, lane);
            asm volatile("" ::: "memory");
#pragma unroll
            for (int it = 0; it < 16; ++it) A[it] = *(const u32x4*)(Vj + ((unsigned)esb[4 * it + r] * 256u + li));
#pragma unroll
            for (int it = 0; it < 16; ++it) B[it] = *(const u32x4*)(Vj + ((unsigned)esb[64 + 4 * it + r] * 256u + li));
        }
        for (int n = 0; n < NT; ++n) {
            const int t = wx + n * nwx;
            const int t2 = (n + 2 < NT) ? t + 2 * nwx : t;
            const int pc = n & 1, pn = pc ^ 1;
            LAS int* esn = esb + pn * 128;
            const LAS unsigned* chc = (const LAS unsigned*)(wl + 1024 + pc * 128); const LAS unsigned* clc = (const LAS unsigned*)(wl + 1280 + pc * 128);
            peer_stage_lists(m, esn, wl + 1024 + pn * 128, wl + 1280 + pn * 128, (LAS float*)(wl + 1536) + pn, lane);
            asm volatile("" ::: "memory");
            peer_meta_load(m, sel_e, coef, t2, lane);
            int ah[16], al[16];
#pragma unroll
            for (int q = 0; q < 16; ++q) { ah[q] = 0; al[q] = 0; }
            if (STRIP == 1) { for (int gg = 0; gg < 4; ++gg) ah[gg] += (int)(A[4 * gg].x ^ A[4 * gg + 1].y ^ A[4 * gg + 2].z ^ A[4 * gg + 3].w ^ chc[gg * 4 + r]); } else acc_half_mfma(ah, A, chc, r);
            asm volatile("" : "+v"(ah[0]), "+v"(ah[1]), "+v"(ah[2]), "+v"(ah[3]), "+v"(ah[4]), "+v"(ah[5]), "+v"(ah[6]), "+v"(ah[7]), "+v"(ah[8]), "+v"(ah[9]), "+v"(ah[10]), "+v"(ah[11]), "+v"(ah[12]), "+v"(ah[13]), "+v"(ah[14]), "+v"(ah[15]) :: "memory");
            asm volatile("" : "+v"(al[0]), "+v"(al[1]), "+v"(al[2]), "+v"(al[3]), "+v"(al[4]), "+v"(al[5]), "+v"(al[6]), "+v"(al[7]), "+v"(al[8]), "+v"(al[9]), "+v"(al[10]), "+v"(al[11]), "+v"(al[12]), "+v"(al[13]), "+v"(al[14]), "+v"(al[15]) :: "memory");
#pragma unroll
            for (int it = 0; it < 16; ++it) A[it] = *(const u32x4*)(Vj + ((unsigned)esn[4 * it + r] * 256u + li));
            asm volatile("" ::: "memory");
            if (STRIP == 1) { for (int gg = 0; gg < 4; ++gg) al[gg] += (int)(B[4 * gg].x ^ B[4 * gg + 1].y ^ B[4 * gg + 2].z ^ B[4 * gg + 3].w ^ chc[(4 + gg) * 4 + r]); } else acc_half_mfma(ah, B, chc + 16, r);
            asm volatile("" : "+v"(ah[0]), "+v"(ah[1]), "+v"(ah[2]), "+v"(ah[3]), "+v"(ah[4]), "+v"(ah[5]), "+v"(ah[6]), "+v"(ah[7]), "+v"(ah[8]), "+v"(ah[9]), "+v"(ah[10]), "+v"(ah[11]), "+v"(ah[12]), "+v"(ah[13]), "+v"(ah[14]), "+v"(ah[15]) :: "memory");
            asm volatile("" : "+v"(al[0]), "+v"(al[1]), "+v"(al[2]), "+v"(al[3]), "+v"(al[4]), "+v"(al[5]), "+v"(al[6]), "+v"(al[7]), "+v"(al[8]), "+v"(al[9]), "+v"(al[10]), "+v"(al[11]), "+v"(al[12]), "+v"(al[13]), "+v"(al[14]), "+v"(al[15]) :: "memory");
#pragma unroll
            for (int it = 0; it < 16; ++it) B[it] = *(const u32x4*)(Vj + ((unsigned)esn[64 + 4 * it + r] * 256u + li));
            asm volatile("" ::: "memory");
            const float sc = ((const LAS float*)(wl + 1536))[pc];
            float acc[16];
#pragma unroll
            for (int q = 0; q < 16; ++q) acc[q] = (float)(ah[q] + (STRIP == 1 ? al[q] : 0)) * sc;
            if (r == 0) {
                bf16_t* zp = zs + (size_t)t * D_ + 256 * j + 16 * i;
                *(u32x4*)zp = (u32x4){pk2(acc[0], acc[1]), pk2(acc[2], acc[3]), pk2(acc[4], acc[5]), pk2(acc[6], acc[7])};
                *(u32x4*)(zp + 8) = (u32x4){pk2(acc[8], acc[9]), pk2(acc[10], acc[11]), pk2(acc[12], acc[13]), pk2(acc[14], acc[15])};
            }
            asm volatile("" ::: "memory");
        }
    }
}
__device__ __forceinline__ void ln2_phase(const bf16_t* h1b, const bf16_t* zs, float* out, const float* gam, const float* bet, int G, int b) {
    const int tid_ = phase_tid(), lane = tid_ & 63, wid = phase_wid(tid_);
    const int gw = b * NWAVES + wid, NGW = G * NWAVES;
    constexpr int R = 1;
    for (int row0 = gw; row0 < S_; row0 += R * NGW) {
        f32x4 v[R][8]; float sum[R], sq[R];
#pragma unroll
        for (int q = 0; q < R; ++q) {
            const int row = min(row0 + q * NGW, S_ - 1);
            sum[q] = 0.f;
#pragma unroll
            for (int j = 0; j < 8; ++j) {
                const u32x2 hw = *(const u32x2*)(h1b + (size_t)row * D_ + 256 * j + 4 * lane), zw = *(const u32x2*)(zs + (size_t)row * D_ + 256 * j + 4 * lane);
                v[q][j] = (f32x4){DN_ALPHA * bflo(hw.x) + bflo(zw.x), DN_ALPHA * bfhi(hw.x) + bfhi(zw.x), DN_ALPHA * bflo(hw.y) + bflo(zw.y), DN_ALPHA * bfhi(hw.y) + bfhi(zw.y)};
                sum[q] += (v[q][j].x + v[q][j].y) + (v[q][j].z + v[q][j].w);
            }
        }
#pragma unroll
        for (int q = 0; q < R; ++q) sum[q] = wave_sum(sum[q]) * (1.0f / D_);
#pragma unroll
        for (int q = 0; q < R; ++q) { sq[q] = 0.f;
#pragma unroll
            for (int j = 0; j < 8; ++j) { v[q][j] = v[q][j] - sum[q]; sq[q] += (v[q][j].x * v[q][j].x + v[q][j].y * v[q][j].y) + (v[q][j].z * v[q][j].z + v[q][j].w * v[q][j].w); } }
#pragma unroll
        for (int q = 0; q < R; ++q) sq[q] = 1.0f / sqrtf(wave_sum(sq[q]) * (1.0f / D_) + LN_EPS);
#pragma unroll
        for (int j = 0; j < 8; ++j) {
            const f32x4 gg = *(const f32x4*)(gam + 256 * j + 4 * lane), bb = *(const f32x4*)(bet + 256 * j + 4 * lane);
#pragma unroll
            for (int q = 0; q < R; ++q) { const int row = row0 + q * NGW; if (row < S_) *(f32x4*)(out + (size_t)row * D_ + 256 * j + 4 * lane) = v[q][j] * sq[q] * gg + bb; }
        }
    }
}
#ifndef PROBE_PHASE
#define PROBE_PHASE -1
#endif
constexpr int LDSCTL_OFF = 163328, MISC_OFF = LDSCTL_OFF;
constexpr int CW_BAR = 1024;
constexpr size_t CTL_ZERO_BYTES = 64 * 1024;
static_assert((CW_BAR + XCD_BAR_WORDS) * 4 <= (int)CTL_ZERO_BYTES && MISC_OFF + 128 <= LDS_BYTES, "control words");

__global__ void __launch_bounds__(NTHREADS, 2) mega_fwd(Ptrs P) {
    extern __shared__ __attribute__((aligned(16))) unsigned char lds_raw[];
    LAS unsigned char* lds = (LAS unsigned char*)lds_raw;
    unsigned char* ws = P.ws;
    const int G = gridDim.x, b = blockIdx.x;
    for (int u = threadIdx.x; u < (LDS_BYTES - LDSCTL_OFF) / 4; u += NTHREADS) ((LAS unsigned*)(lds + LDSCTL_OFF))[u] = 0u;
    __syncthreads();
    volatile LAS unsigned* MISC = (volatile LAS unsigned*)(lds + MISC_OFF);
    XcdBarrier bar; bar.bar = (unsigned*)(ws + WS_CTL) + CW_BAR; bar.x = xb_xcc_id(); bar.st = MISC + 8;
    if (threadIdx.x == 0) MISC[10] = xb_add(&bar.bar[XB_XCNT(bar.x)], 1u);

    bf16_t* const proj = (bf16_t*)(ws + WS_PROJ); float* const gst = (float*)(ws + WS_GST); bf16_t* const ycat = (bf16_t*)(ws + WS_YCAT);
    const float* const cosT = (const float*)(ws + WS_COS); const float* const sinT = (const float*)(ws + WS_SIN);
    float* const sumA = (float*)(ws + WS_SUMA); float* const sumH = (float*)(ws + WS_SUMH); float* const Hin = (float*)(ws + WS_HIN);
    const bf16_t* const wraT = (const bf16_t*)(ws + WS_WRA_T); const bf16_t* const wriT = (const bf16_t*)(ws + WS_WRI_T);

#define NREP(k) ((PROBE_PHASE == (k)) ? 2 : 1)
    for (int r_ = 0; r_ < NREP(0); ++r_) { prologue_phase(lds, P, G, b); xcd_barrier(bar); }
    if (threadIdx.x == 0) { unsigned xi_ = 0; for (unsigned jx = 0; jx < bar.x; ++jx) xi_ += xb_ld(&bar.bar[XB_XCNT(jx)]) > 0u ? 1u : 0u; MISC[11] = xi_; }
    __syncthreads();
    const int x_nloc = __builtin_amdgcn_readfirstlane((int)MISC[8]), x_nx = __builtin_amdgcn_readfirstlane((int)MISC[9]), x_rank = __builtin_amdgcn_readfirstlane((int)MISC[10]), x_xi = __builtin_amdgcn_readfirstlane((int)MISC[11]);
#define RUN_P1 { pg8::Gemm g{(const pg8::bf16_t*)(ws + WS_XB), (const pg8::bf16_t*)(ws + WS_WIN_T), S_, INC, D_}; \
        pg8::StaticOrder S; S.init(S_, INC, G, b); \
        pg8::EpiBf16<0> E{(pg8::bf16_t*)proj, INC, nullptr, 0, 0, 1.f}; \
        pg8::gemm_phase<pg8::EpiBf16<0>, pg8::StaticOrder, true, true>(lds, g, S, E); \
        xcd_barrier(bar); }
    RUN_P1
#if PROBE_PHASE == 1
    RUN_P1
#endif
    for (int r2_ = 0; r2_ < NREP(22); ++r2_) {
    for (int r_ = 0; r_ < NREP(2); ++r_) { ret_r1_phase(lds, proj, cosT, sinT, gst, G, b); if (PROBE_PHASE >= 0) xcd_barrier(bar); }
    for (int r_ = 0; r_ < NREP(3); ++r_) { lru_phase<0>(lds, proj, P, wraT, wriT, sumA, sumH, Hin, ycat, G, b); xcd_barrier(bar); }
    scan_phase(lds, gst, sumA, sumH, Hin, G, b);
    xcd_barrier(bar);
    }
    for (int r_ = 0; r_ < NREP(4); ++r_) { ret_r3_phase(lds, proj, cosT, sinT, gst, ycat, G, b); if (PROBE_PHASE >= 0) xcd_barrier(bar); }
    for (int r_ = 0; r_ < NREP(5); ++r_) { lru_phase<1>(lds, proj, P, wraT, wriT, sumA, sumH, Hin, ycat, G, b); xcd_barrier(bar); }
#define RUN_P3 { pg8::Gemm g{(const pg8::bf16_t*)ycat, (const pg8::bf16_t*)(ws + WS_WOUT_T), S_, D_, D_}; \
        pg8::StaticOrder S; S.init(S_, D_, G, b); \
        pg8::EpiResBf16 E{(const pg8::bf16_t*)(ws + WS_XB), (pg8::bf16_t*)(ws + WS_Z1B), D_, DN_ALPHA}; \
        pg8::gemm_phase<pg8::EpiResBf16, pg8::StaticOrder, true, true>(lds, g, S, E); \
        xcd_barrier(bar); }
    RUN_P3
#if PROBE_PHASE == 6
    RUN_P3
#endif
    ln1_phase((const bf16_t*)(ws + WS_Z1B), (bf16_t*)(ws + WS_H1B), (unsigned*)(ws + WS_XQ), (float*)(ws + WS_SX), P.ln1_g, P.ln1_b, G, b);
    xcd_barrier(bar);
#if PROBE_PHASE == 67
    ln1_phase((const bf16_t*)(ws + WS_Z1B), (bf16_t*)(ws + WS_H1B), (unsigned*)(ws + WS_XQ), (float*)(ws + WS_SX), P.ln1_g, P.ln1_b, G, b);
    xcd_barrier(bar);
#endif
#if PROBE_PHASE == 66
    RUN_P3
    ln1_phase((const bf16_t*)(ws + WS_Z1B), (bf16_t*)(ws + WS_H1B), (unsigned*)(ws + WS_XQ), (float*)(ws + WS_SX), P.ln1_g, P.ln1_b, G, b);
    xcd_barrier(bar);
#endif
#define RUN_P5 { pg8::Gemm g{(const pg8::bf16_t*)(ws + WS_H1B), (const pg8::bf16_t*)(ws + WS_WPQ_T), S_, D_, D_}; \
        pg8::StaticOrder S; S.init(S_, D_, G, b); \
        pg8::EpiBf16<0> E{(pg8::bf16_t*)(ws + WS_QP), D_, nullptr, 0, 0, 1.f}; \
        pg8::gemm_phase<pg8::EpiBf16<0>, pg8::StaticOrder, true, true>(lds, g, S, E); \
        if (PROBE_PHASE >= 0) xcd_barrier(bar); else { asm volatile("s_waitcnt vmcnt(0)" ::: "memory"); __syncthreads(); } }
    RUN_P5
#if PROBE_PHASE == 7
    RUN_P5
#endif
    for (int r_ = 0; r_ < NREP(8); ++r_) { topk_phase(lds, (const bf16_t*)(ws + WS_QP), (const bf16_t*)(ws + WS_KEYS), (const float*)(ws + WS_SU), (const float*)(ws + WS_SV), (int*)(ws + WS_SELE), (float*)(ws + WS_SELG), (float*)(ws + WS_SELU), G, b); xcd_barrier(bar); }
    for (int r_ = 0; r_ < NREP(9); ++r_) { peer_u_phase<0x3FFF>(lds, (const unsigned char*)(ws + WS_UQ), (const unsigned char*)(ws + WS_XQ), (const int*)(ws + WS_SELE), (int*)(ws + WS_PD), x_xi, x_nx, x_rank, x_nloc); xcd_barrier(bar); }
#if PROBE_PHASE == 15 || PROBE_PHASE == 16
    peer_u_phase<(PROBE_PHASE == 15 ? 0x1FFF : 0x0FFF)>(lds, (const unsigned char*)(ws + WS_UQ), (const unsigned char*)(ws + WS_XQ), (const int*)(ws + WS_SELE), (int*)(ws + 248 * MiB), x_xi, x_nx, x_rank, x_nloc); xcd_barrier(bar);
#endif
    for (int r_ = 0; r_ < NREP(13); ++r_) { peer_coef_phase((const float*)(ws + WS_SELG), (const float*)(ws + WS_SELU), (const int*)(ws + WS_PD), (const float*)(ws + WS_SX), (float*)(ws + WS_COEF), G, b); xcd_barrier(bar); }
    for (int r_ = 0; r_ < NREP(10); ++r_) { peer_v_phase<0>(lds, (const unsigned char*)(ws + WS_VQ), (const int*)(ws + WS_SELE), (const float*)(ws + WS_COEF),
                     (bf16_t*)(ws + WS_ZS), x_xi, x_nx, x_rank, x_nloc); xcd_barrier(bar); }
#if PROBE_PHASE == 12 || PROBE_PHASE == 14
    peer_v_phase<(PROBE_PHASE == 12 ? 1 : 2)>(lds, (const unsigned char*)(ws + WS_VQ), (const int*)(ws + WS_SELE), (const float*)(ws + WS_COEF),
                     (bf16_t*)(ws + 248 * MiB), x_xi, x_nx, x_rank, x_nloc); xcd_barrier(bar);
#endif
#if PROBE_PHASE == 90
    for (int r_ = 0; r_ < 10; ++r_) xcd_barrier(bar);
#endif
    for (int r_ = 0; r_ < NREP(11); ++r_) ln2_phase((const bf16_t*)(ws + WS_H1B), (const bf16_t*)(ws + WS_ZS), P.out, P.ln2_g, P.ln2_b, G, b);
}

extern "C" void kernel_launch(void* const* d_in, const int* in_sizes, int n_in, void* d_out, int out_size, void* d_ws, size_t ws_size, hipStream_t stream) {
    static int grid = 0;
    if (grid == 0) {
        if (n_in != 19 || in_sizes[0] != S_ * D_ || out_size != S_ * D_ || ws_size < WS_END) {
            fprintf(stderr, "kernel_launch: unexpected shapes: n_in %d in0 %d out %d ws %zu (need >= %zu)\n", n_in, n_in > 0 ? in_sizes[0] : -1, out_size, ws_size, (size_t)WS_END); grid = -1; return; }
        int dev = 0, cus = 0, per_cu = 0;
        if (hipGetDevice(&dev) != hipSuccess || hipDeviceGetAttribute(&cus, hipDeviceAttributeMultiprocessorCount, dev) != hipSuccess) { grid = -1; return; }
        if (hipFuncSetAttribute((const void*)mega_fwd, hipFuncAttributeMaxDynamicSharedMemorySize, LDS_BYTES) != hipSuccess) { fprintf(stderr, "kernel_launch: hipFuncSetAttribute failed\n"); grid = -1; return; }
        if (hipOccupancyMaxActiveBlocksPerMultiprocessor(&per_cu, (const void*)mega_fwd, NTHREADS, LDS_BYTES) != hipSuccess || per_cu < 1) {
            fprintf(stderr, "kernel_launch: occupancy query reports %d workgroups per CU; nothing launched\n", per_cu); (void)hipGetLastError(); grid = -1; return; }
        grid = cus;
    }
    if (grid < 0) return;
    Ptrs P{};
    P.x = (const float*)d_in[0]; P.pos = (const int*)d_in[1]; P.w_in = (const float*)d_in[2]; P.w_out = (const float*)d_in[3]; P.conv_w = (const float*)d_in[4]; P.conv_b = (const float*)d_in[5];
    P.w_ra = (const float*)d_in[6]; P.b_ra = (const float*)d_in[7]; P.w_ri = (const float*)d_in[8]; P.b_ri = (const float*)d_in[9]; P.lam = (const float*)d_in[10];
    P.ln1_g = (const float*)d_in[11]; P.ln1_b = (const float*)d_in[12]; P.w_pq = (const float*)d_in[13]; P.sub_keys = (const float*)d_in[14]; P.peer_u = (const float*)d_in[15]; P.peer_v = (const float*)d_in[16];
    P.ln2_g = (const float*)d_in[17]; P.ln2_b = (const float*)d_in[18]; P.out = (float*)d_out; P.ws = (unsigned char*)d_ws;
    if (hipMemsetAsync((char*)d_ws + WS_CTL, 0, CTL_ZERO_BYTES, stream) != hipSuccess) { fprintf(stderr, "kernel_launch: hipMemsetAsync failed\n"); return; }
    void* args[] = {&P};
    const hipError_t e = hipLaunchCooperativeKernel((const void*)mega_fwd, dim3(grid), dim3(NTHREADS), args, LDS_BYTES, stream);
    if (e != hipSuccess) fprintf(stderr, "kernel_launch: cooperative launch failed: %s (grid %d)\n", hipGetErrorString(e), grid);
}
```
